# Optimizing an MI355X kernel written in HIP

```python
import jax, jax.numpy as jnp
from jax import lax
import numpy as np

D_MODEL = 1024
BATCH = 16
SEQ = 2048
DEPTH = 2

GRID_W = 64
HEAD_DIM = 64
Q_BLOCK = 128
NORM_EPS = 1e-6
NEG_INF = -1e30
ROPE_THETA = 500000.0
PARTIAL_ROPE_DIM = HEAD_DIM // 4
GQA_Q_HEADS = 8
GQA_KV_HEADS = 2
GQA_GROUP = GQA_Q_HEADS // GQA_KV_HEADS
AXIAL_THETA = 10000.0
MLA_HEADS = 8
MLA_Q_RANK = 256
MLA_KV_RANK = 128
MLA_NOPE_DIM = 64
MLA_ROPE_DIM = 32
MLA_V_DIM = 64
MLA_ROPE_THETA = 10000.0
AB_SPLITS = (GQA_Q_HEADS * HEAD_DIM,
             GQA_Q_HEADS * HEAD_DIM + GQA_KV_HEADS * HEAD_DIM,
             GQA_Q_HEADS * HEAD_DIM + 2 * GQA_KV_HEADS * HEAD_DIM,
             GQA_Q_HEADS * HEAD_DIM + 2 * GQA_KV_HEADS * HEAD_DIM + MLA_Q_RANK,
             GQA_Q_HEADS * HEAD_DIM + 2 * GQA_KV_HEADS * HEAD_DIM + MLA_Q_RANK + MLA_KV_RANK)
AB_IN_WIDTH = AB_SPLITS[-1] + MLA_ROPE_DIM
AB_OUT_WIDTH = GQA_Q_HEADS * HEAD_DIM + MLA_HEADS * MLA_V_DIM
DIL_CONFIGS = ((128, 1), (512, 4), (2048, 16))
DIL_GROUPS = len(DIL_CONFIGS)
DIL_HEADS = 8
DIL_IN_WIDTH = DIL_GROUPS * 3 * DIL_HEADS * HEAD_DIM
DIL_OUT_WIDTH = DIL_HEADS * HEAD_DIM
D_FF = 3584
N_EXPERTS = 8
TOP_K = 2
D_FF_EXPERT = 3584
MOE_BLOCK = 256
PLE_DIM = 256
N_EVEN = (DEPTH + 1) // 2
N_ODD = DEPTH // 2

kernel_name = 'hybrid_gqa_mla_dilated_moe_encoder'


def rms_norm(x, g):
    xf = x.astype(jnp.float32)
    y = xf * lax.rsqrt(jnp.mean(xf * xf, axis=-1, keepdims=True) + NORM_EPS)
    return (y * g.astype(jnp.float32)).astype(x.dtype)


def rotary_tables(pos, dim, theta):
    exponent = jnp.arange(0, dim, 2, dtype=jnp.float32) / dim
    inv_freq = jnp.power(jnp.float32(theta), -exponent)
    ang = pos.astype(jnp.float32)[:, None] * inv_freq[None, :]
    return jnp.cos(ang), jnp.sin(ang)


def apply_rotary(x, cos, sin):
    half = x.shape[-1] // 2
    shape = (cos.shape[0],) + (1,) * (x.ndim - 3) + (half,)
    c = cos.reshape(shape)
    s_ = sin.reshape(shape)
    xf = x.astype(jnp.float32)
    x1, x2 = xf[..., :half], xf[..., half:]
    return jnp.concatenate([x1 * c - x2 * s_, x2 * c + x1 * s_], axis=-1).astype(x.dtype)


def axial_rotary(x, row_cs, col_cs):
    half = x.shape[-1] // 2
    return jnp.concatenate([apply_rotary(x[..., :half], *row_cs),
                            apply_rotary(x[..., half:], *col_cs)], axis=-1)


def dense_blocked_attention(q, k, v, scale):
    b, s, hk, g, dk = q.shape
    nblk = s // Q_BLOCK
    qb = jnp.moveaxis(q.reshape(b, nblk, Q_BLOCK, hk, g, dk), 1, 0)

    def one_block(qblk):
        sc = jnp.einsum('bqhgd,bkhd->bhgqk', qblk, k, preferred_element_type=jnp.float32) * scale
        probs = jax.nn.softmax(sc, axis=-1)
        return jnp.einsum('bhgqk,bkhe->bqhge', probs.astype(v.dtype), v)

    o = lax.map(one_block, qb)
    return jnp.moveaxis(o, 0, 1).reshape(b, s, hk, g, v.shape[-1])


def dilated_window_attention(q, k, v, dilation, half, scale):
    b, s, h, dh = q.shape
    L = s // dilation
    nb = -(-L // half)
    Lp = nb * half
    z = b * dilation

    def residues(x):
        e = x.shape[-1]
        return x.reshape(b, L, dilation, h, e).transpose(0, 2, 1, 3, 4).reshape(z, L, h, e)

    def windows(x):
        e = x.shape[-1]
        xp = jnp.pad(residues(x), ((0, 0), (half, Lp - L + half), (0, 0), (0, 0)))
        xp = xp.reshape(z, nb + 2, half, h, e)
        return jnp.concatenate([xp[:, :-2], xp[:, 1:-1], xp[:, 2:]], axis=2)

    qs = jnp.pad(residues(q), ((0, 0), (0, Lp - L), (0, 0), (0, 0))).reshape(z, nb, half, h, dh)
    kw = windows(k)
    vw = windows(v)
    qi = jnp.arange(nb)[:, None] * half + jnp.arange(half)[None, :]
    ki = jnp.arange(nb)[:, None] * half - half + jnp.arange(3 * half)[None, :]
    mask = ((jnp.abs(qi[:, :, None] - ki[:, None, :]) <= half)
            & (ki[:, None, :] >= 0) & (ki[:, None, :] < L))
    sc = jnp.einsum('znqhd,znkhd->znhqk', qs, kw, preferred_element_type=jnp.float32) * scale
    sc = jnp.where(mask[None, :, None], sc, NEG_INF)
    m = jnp.max(sc, axis=-1, keepdims=True)
    pexp = jnp.exp(sc - m)
    l = jnp.sum(pexp, axis=-1, keepdims=True)
    o = jnp.einsum('znhqk,znkhd->znqhd', (pexp / l).astype(v.dtype), vw)
    lse = jnp.swapaxes((m + jnp.log(l))[..., 0], 2, 3)

    def unresidue(y):
        e = y.shape[-1]
        y = y.reshape(b, dilation, Lp, h, e)[:, :, :L]
        return y.transpose(0, 2, 1, 3, 4).reshape(b, s, h, e)

    o = unresidue(o.reshape(z, Lp, h, dh))
    lse = unresidue(lse.reshape(z, Lp, h, 1))[..., 0]
    return o, lse


def mixer_gqa_mla(a, w_in, gqa_qn, gqa_kn, mla_qn, w_uq, mla_kvn, w_ukv, w_out, row_cs, col_cs, mla_cs):
    b, s, _ = a.shape
    zin = a @ w_in
    q_a, k_a, v_a, c_q, c_kv, k_r = jnp.split(zin, AB_SPLITS, axis=-1)
    q_a = rms_norm(q_a.reshape(b, s, GQA_KV_HEADS, GQA_GROUP, HEAD_DIM), gqa_qn)
    k_a = rms_norm(k_a.reshape(b, s, GQA_KV_HEADS, HEAD_DIM), gqa_kn)
    v_a = v_a.reshape(b, s, GQA_KV_HEADS, HEAD_DIM)
    q_a = axial_rotary(q_a, row_cs, col_cs)
    k_a = axial_rotary(k_a, row_cs, col_cs)
    o_a = dense_blocked_attention(q_a, k_a, v_a, HEAD_DIM ** -0.5).reshape(b, s, GQA_Q_HEADS * HEAD_DIM)
    q_m = (rms_norm(c_q, mla_qn) @ w_uq).reshape(b, s, MLA_HEADS, MLA_NOPE_DIM + MLA_ROPE_DIM)
    q_m = jnp.concatenate([q_m[..., :MLA_NOPE_DIM], apply_rotary(q_m[..., MLA_NOPE_DIM:], *mla_cs)], axis=-1)
    kv = (rms_norm(c_kv, mla_kvn) @ w_ukv).reshape(b, s, MLA_HEADS, MLA_NOPE_DIM + MLA_V_DIM)
    k_rope = apply_rotary(k_r.reshape(b, s, 1, MLA_ROPE_DIM), *mla_cs)
    k_m = jnp.concatenate([kv[..., :MLA_NOPE_DIM],
                           jnp.broadcast_to(k_rope, (b, s, MLA_HEADS, MLA_ROPE_DIM))], axis=-1)
    v_m = kv[..., MLA_NOPE_DIM:]
    o_m = dense_blocked_attention(q_m[:, :, :, None, :], k_m, v_m,
                                  (MLA_NOPE_DIM + MLA_ROPE_DIM) ** -0.5).reshape(b, s, MLA_HEADS * MLA_V_DIM)
    return jnp.concatenate([o_a, o_m], axis=-1) @ w_out


def mixer_dilated(a, w_qkv, w_out, part_cs):
    b, s, _ = a.shape
    zin = (a @ w_qkv).reshape(b, s, DIL_GROUPS, 3, DIL_HEADS, HEAD_DIM)

    def partial_rope(x):
        return jnp.concatenate([apply_rotary(x[..., :PARTIAL_ROPE_DIM], *part_cs),
                                x[..., PARTIAL_ROPE_DIM:]], axis=-1)

    q = partial_rope(zin[:, :, :, 0])
    k = partial_rope(zin[:, :, :, 1])
    v = zin[:, :, :, 2]
    outs, lses = [], []
    for gi, (window, dilation) in enumerate(DIL_CONFIGS):
        o_g, lse_g = dilated_window_attention(q[:, :, gi], k[:, :, gi], v[:, :, gi],
                                              dilation, window // (2 * dilation), HEAD_DIM ** -0.5)
        outs.append(o_g)
        lses.append(lse_g)
    alpha = jax.nn.softmax(jnp.stack(lses, axis=0), axis=0)
    o = jnp.sum(alpha[..., None] * jnp.stack(outs, axis=0).astype(jnp.float32), axis=0).astype(a.dtype)
    return o.reshape(b, s, DIL_OUT_WIDTH) @ w_out


def swiglu(a, w_gate, w_up, w_down):
    return (jax.nn.silu(a @ w_gate) * (a @ w_up)) @ w_down


def moe_swiglu(a, w_router, w_gate, w_up, w_down):
    b, s, d = a.shape
    n = b * s
    nk = n * TOP_K
    af = a.reshape(n, d)
    logits = jnp.einsum('nd,de->ne', af, w_router, preferred_element_type=jnp.float32)
    top_logits, top_idx = lax.top_k(logits, TOP_K)
    gates = jax.nn.softmax(top_logits, axis=-1)
    flat_e = top_idx.reshape(nk).astype(jnp.int32)
    flat_tok = jnp.arange(nk, dtype=jnp.int32) // TOP_K
    flat_g = gates.reshape(nk)
    order = jnp.argsort(flat_e)
    sorted_e = flat_e[order]
    counts = jnp.bincount(flat_e, length=N_EXPERTS).astype(jnp.int32)
    padded = (counts + MOE_BLOCK - 1) // MOE_BLOCK * MOE_BLOCK
    end_pad = jnp.cumsum(padded)
    start_pad = end_pad - padded
    start_unp = jnp.cumsum(counts) - counts
    dest = start_pad[sorted_e] + jnp.arange(nk, dtype=jnp.int32) - start_unp[sorted_e]
    n_slots = nk + N_EXPERTS * MOE_BLOCK
    n_blk = n_slots // MOE_BLOCK
    slot_tok = jnp.zeros((n_slots,), jnp.int32).at[dest].set(flat_tok[order])
    slot_gate = jnp.zeros((n_slots,), jnp.float32).at[dest].set(flat_g[order])
    blk_start = jnp.arange(n_blk, dtype=jnp.int32) * MOE_BLOCK
    blk_e = jnp.minimum(jnp.searchsorted(end_pad, blk_start, side='right'), N_EXPERTS - 1)
    xs = af[slot_tok].reshape(n_blk, MOE_BLOCK, d)

    def expert_block(args):
        xb, e = args
        return (jax.nn.silu(xb @ w_gate[e]) * (xb @ w_up[e])) @ w_down[e]

    ys = lax.map(expert_block, (xs, blk_e)).reshape(n_slots, d)
    out = jnp.zeros((n, d), jnp.float32).at[slot_tok].add(ys.astype(jnp.float32) * slot_gate[:, None])
    return out.astype(a.dtype).reshape(b, s, d)


def setup_inputs(seed: int = 0) -> dict:
    key = jax.random.key(seed)
    ks = list(jax.random.split(key, 32))
    counter = [0]

    def nk():
        counter[0] += 1
        return ks[counter[0] - 1]

    def w(shape, fan_in):
        return jax.random.normal(nk(), shape, jnp.float32) * (fan_in ** -0.5)

    def g(shape):
        return 1.0 + 0.05 * jax.random.normal(nk(), shape, jnp.float32)

    D = D_MODEL
    return {
        'x': jax.random.normal(nk(), (BATCH, SEQ, D), jnp.float32),
        'p': jax.random.normal(nk(), (DEPTH, BATCH, SEQ, PLE_DIM), jnp.float32),
        'mix_pre_g': g((DEPTH, D)),
        'mix_post_g': g((DEPTH, D)),
        'ffn_pre_g': g((DEPTH, D)),
        'ffn_post_g': g((DEPTH, D)),
        'ple_w_proj': w((DEPTH, PLE_DIM, D), PLE_DIM),
        'ple_gate_norm_g': g((DEPTH, D)),
        'ple_w_gate': w((DEPTH, D, D), D),
        'ple_post_g': g((DEPTH, D)),
        'ab_w_in': w((N_EVEN, D, AB_IN_WIDTH), D),
        'gqa_q_norm_g': g((N_EVEN, HEAD_DIM)),
        'gqa_k_norm_g': g((N_EVEN, HEAD_DIM)),
        'mla_q_norm_g': g((N_EVEN, MLA_Q_RANK)),
        'mla_w_uq': w((N_EVEN, MLA_Q_RANK, MLA_HEADS * (MLA_NOPE_DIM + MLA_ROPE_DIM)), MLA_Q_RANK),
        'mla_kv_norm_g': g((N_EVEN, MLA_KV_RANK)),
        'mla_w_ukv': w((N_EVEN, MLA_KV_RANK, MLA_HEADS * (MLA_NOPE_DIM + MLA_V_DIM)), MLA_KV_RANK),
        'ab_w_out': w((N_EVEN, AB_OUT_WIDTH, D), AB_OUT_WIDTH),
        'ffn_w_gate': w((N_EVEN, D, D_FF), D),
        'ffn_w_up': w((N_EVEN, D, D_FF), D),
        'ffn_w_down': w((N_EVEN, D_FF, D), D_FF),
        'dil_w_qkv': w((N_ODD, D, DIL_IN_WIDTH), D),
        'dil_w_out': w((N_ODD, DIL_OUT_WIDTH, D), DIL_OUT_WIDTH),
        'moe_w_router': w((N_ODD, D, N_EXPERTS), D),
        'moe_w_gate': w((N_ODD, N_EXPERTS, D, D_FF_EXPERT), D),
        'moe_w_up': w((N_ODD, N_EXPERTS, D, D_FF_EXPERT), D),
        'moe_w_down': w((N_ODD, N_EXPERTS, D_FF_EXPERT, D), D_FF_EXPERT),
    }


def reference(x, p, mix_pre_g, mix_post_g, ffn_pre_g, ffn_post_g, ple_w_proj, ple_gate_norm_g,
              ple_w_gate, ple_post_g, ab_w_in, gqa_q_norm_g, gqa_k_norm_g, mla_q_norm_g, mla_w_uq,
              mla_kv_norm_g, mla_w_ukv, ab_w_out, ffn_w_gate, ffn_w_up, ffn_w_down, dil_w_qkv,
              dil_w_out, moe_w_router, moe_w_gate, moe_w_up, moe_w_down):
    s = x.shape[1]
    rows = s // GRID_W
    t = jnp.arange(s, dtype=jnp.int32)
    row_pos = jnp.repeat(jnp.arange(rows, dtype=jnp.int32), GRID_W)
    col_pos = jnp.tile(jnp.arange(GRID_W, dtype=jnp.int32), rows)
    row_cs = rotary_tables(row_pos, HEAD_DIM // 2, AXIAL_THETA)
    col_cs = rotary_tables(col_pos, HEAD_DIM // 2, AXIAL_THETA)
    mla_cs = rotary_tables(t, MLA_ROPE_DIM, MLA_ROPE_THETA)
    part_cs = rotary_tables(t, PARTIAL_ROPE_DIM, ROPE_THETA)

    h = x
    for i in range(DEPTH):
        j = i // 2
        a = rms_norm(h, mix_pre_g[i])
        if i % 2 == 0:
            m = mixer_gqa_mla(a, ab_w_in[j], gqa_q_norm_g[j], gqa_k_norm_g[j], mla_q_norm_g[j],
                              mla_w_uq[j], mla_kv_norm_g[j], mla_w_ukv[j], ab_w_out[j],
                              row_cs, col_cs, mla_cs)
        else:
            m = mixer_dilated(a, dil_w_qkv[j], dil_w_out[j], part_cs)
        h = h + rms_norm(m, mix_post_g[i])
        a = rms_norm(h, ffn_pre_g[i])
        if i % 2 == 0:
            f = swiglu(a, ffn_w_gate[j], ffn_w_up[j], ffn_w_down[j])
        else:
            f = moe_swiglu(a, moe_w_router[j], moe_w_gate[j], moe_w_up[j], moe_w_down[j])
        h = h + rms_norm(f, ffn_post_g[i])
        gate = jax.nn.sigmoid(rms_norm(h, ple_gate_norm_g[i]) @ ple_w_gate[i])
        e = (p[i].astype(h.dtype) @ ple_w_proj[i]) * gate
        h = h + rms_norm(e, ple_post_g[i])
    return h
```

```cpp
#include <hip/hip_runtime.h>
#include <cstdio>
#include <cstdint>

#define DI __device__ __forceinline__
#define LAS __attribute__((address_space(3)))
#define GAS __attribute__((address_space(1)))
typedef unsigned short bf16;
typedef short bf16x8 __attribute__((ext_vector_type(8)));
typedef short s16x4 __attribute__((ext_vector_type(4)));
typedef float f32x2 __attribute__((ext_vector_type(2)));
typedef float f32x4 __attribute__((ext_vector_type(4)));
typedef float f32x16 __attribute__((ext_vector_type(16)));
typedef unsigned u32x2 __attribute__((ext_vector_type(2)));
typedef unsigned u32x4 __attribute__((ext_vector_type(4)));
typedef __bf16 bf16x2_t __attribute__((ext_vector_type(2)));

constexpr int BATCH = 16, SEQ = 2048, DM = 1024, NTOK = BATCH * SEQ;
constexpr int ZW = 1280;
constexpr int DFF = 3584, NEXP = 8;
constexpr int QKVW = 4608;
constexpr float EPS = 1e-6f;
constexpr float LOG2E = 1.4426950408889634f;
constexpr float C2_64 = 0.125f * LOG2E;
constexpr float C2_96 = 0.10206207261596577f * LOG2E;
constexpr int NWAVES = 8, NTHREADS = 512;
constexpr int MAXTILES = 264;
constexpr int NSLOTS = MAXTILES * 256;

constexpr size_t MiB = 1u << 20;
constexpr size_t WS_CTL = 0, CTL_ZERO_BYTES = 64 * 1024;
constexpr size_t WS_TABA = 1 * MiB;
constexpr size_t WS_TABP = WS_TABA + 2048 * 16 * 8;
constexpr size_t WS_TOKE = 2 * MiB;
constexpr size_t WS_TOKG = WS_TOKE + NTOK * 4;
constexpr size_t WS_TOKS = WS_TOKG + NTOK * 8;
constexpr size_t WS_CNT = WS_TOKS + NTOK * 8;
constexpr size_t WS_TILEE = WS_CNT + 256 * 8 * 4;
constexpr size_t WS_LSE = 3 * MiB;
constexpr size_t WS_W = 6 * MiB;
constexpr size_t W_IN = WS_W;
constexpr size_t W_UQ = W_IN + (size_t)ZW * 1024 * 2;
constexpr size_t W_UKV = W_UQ + 768 * 256 * 2;
constexpr size_t W_OUT0 = W_UKV + 1024 * 256 * 2;
constexpr size_t W_GU0 = W_OUT0 + 1024 * 1024 * 2;
constexpr size_t W_D0 = W_GU0 + (size_t)7168 * 1024 * 2;
constexpr size_t W_PP = W_D0 + (size_t)1024 * 3584 * 2;
constexpr size_t W_PG = W_PP + 2 * 1024 * 256 * 2;
constexpr size_t W_QKV1 = W_PG + 2 * 1024 * 1024 * 2;
constexpr size_t W_OUT1 = W_QKV1 + (size_t)QKVW * 1024 * 2;
constexpr size_t W_END = W_OUT1 + 1024 * 512 * 2;
constexpr size_t WS_PB = 48 * MiB;
constexpr size_t WS_XN = 80 * MiB;
constexpr size_t WS_BIG = 144 * MiB;
static_assert(W_END <= WS_PB, "weights");
constexpr size_t B_ZIN = WS_BIG;
constexpr size_t B_QA = WS_BIG + 80 * MiB;
constexpr size_t B_KA = WS_BIG + 112 * MiB;
constexpr size_t B_CQN = WS_BIG + 120 * MiB;
constexpr size_t B_CKVN = WS_BIG + 136 * MiB;
constexpr size_t B_KR = WS_BIG + 152 * MiB;
constexpr size_t B_QM = WS_BIG + 154 * MiB;
constexpr size_t B_KV = WS_BIG + 202 * MiB;
constexpr size_t B_O0 = WS_BIG + 266 * MiB;
constexpr size_t B_MO0 = WS_BIG;
constexpr size_t B_HID = WS_BIG;
constexpr size_t B_F = WS_BIG + 224 * MiB;
constexpr size_t B_E0 = WS_BIG + 288 * MiB;
constexpr size_t B_E = WS_BIG;
constexpr size_t B_QKV = WS_BIG;
constexpr size_t B_OG = WS_BIG + 288 * MiB;
constexpr size_t B_O1 = WS_BIG + 388 * MiB;
constexpr size_t B_MO1 = WS_BIG + 288 * MiB;
constexpr size_t B_WGU = WS_BIG;
constexpr size_t B_WD = WS_BIG + 112 * MiB;
constexpr size_t B_XS = WS_BIG + 168 * MiB;
constexpr size_t B_HC = WS_BIG + 300 * MiB;
constexpr size_t B_E0b = WS_BIG + 300 * MiB;
constexpr size_t B_Eb = WS_BIG;
constexpr size_t WS_END = WS_BIG + 420 * MiB;

constexpr int CW_BAR = 1024;

constexpr int RING_BYTES = 133120;
constexpr int LDSCTL_OFF = RING_BYTES, MISC_OFF = LDSCTL_OFF + 320;
constexpr int LDS_BYTES = 147456;

DI float bf2f(unsigned short v) { return __uint_as_float((unsigned)v << 16); }
DI unsigned pk2(float lo, float hi) { f32x2 v = {lo, hi}; bf16x2_t b = __builtin_convertvector(v, bf16x2_t); return __builtin_bit_cast(unsigned, b); }
DI float wave_sum(float v) {
#pragma unroll
    for (int o = 1; o < 64; o <<= 1) v += __shfl_xor(v, o);
    return v;
}
DI int fresh_tid() { int t = threadIdx.x; asm volatile("" : "+v"(t)); return t; }
DI float ex2(float x) { return __builtin_amdgcn_exp2f(x); }
DI float rsq(float x) { return 1.0f / sqrtf(x); }
DI void unpack8(u32x4 w, float (&x)[8]) {
    x[0] = __uint_as_float(w.x << 16); x[1] = __uint_as_float(w.x & 0xffff0000u);
    x[2] = __uint_as_float(w.y << 16); x[3] = __uint_as_float(w.y & 0xffff0000u);
    x[4] = __uint_as_float(w.z << 16); x[5] = __uint_as_float(w.z & 0xffff0000u);
    x[6] = __uint_as_float(w.w << 16); x[7] = __uint_as_float(w.w & 0xffff0000u);
}
DI u32x4 pack8(const float (&x)[8]) { u32x4 w; w.x = pk2(x[0], x[1]); w.y = pk2(x[2], x[3]); w.z = pk2(x[4], x[5]); w.w = pk2(x[6], x[7]); return w; }

namespace pg8 {
constexpr int BM = 256, BK = 64, HALF = 128, HTB = HALF * BK * 2, STAGE_BYTES = 8 * HTB, NXCD = 8, WGM = 8;
__host__ __device__ __forceinline__ int lds_byte(int r, int c) { const int st = (r >> 4) * 2 + (c >> 5), rr = r & 15, cc = c & 31, ob = rr * 64 + cc * 2; return st * 1024 + (ob ^ (((ob >> 9) & 1) << 5)); }
__host__ __device__ __forceinline__ void stage_rc(int b, int& R, int& C) { const int st = b / 1024, sb = b % 1024, swz = sb ^ (((sb >> 9) & 1) << 5); R = (st >> 1) * 16 + swz / 64; C = (st & 1) * 32 + (swz % 64) / 2; }
__host__ __device__ __forceinline__ int perm32(int rho) { const int n = rho >> 4, i = rho & 15; return 8 * (i >> 2) + 4 * n + (i & 3); }

struct Unit { int pm, pn, pa, pb; };
struct Gemm { const bf16* A; const bf16* Bt; int lda, ldb, K; };

struct StaticOrder {
    int nM, nN, nwg, G, c;
    DI void init(int nM_, int nN_, int G_, int c_) { nM = nM_; nN = nN_; nwg = nM * nN; G = G_; c = c_; }
    DI bool map(int i, int& pm, int& pn) const {
        const long L = (long)i * G + c; if (L >= nwg) return false;
        int wgid = (int)L; { const int q = nwg / NXCD, r = nwg % NXCD, xcd = wgid % NXCD, off = wgid / NXCD; wgid = (xcd < r ? xcd * (q + 1) : r * (q + 1) + (xcd - r) * q) + off; }
        const int nig = WGM * nN, gid = wgid / nig, fm = gid * WGM, gsz = (nM - fm) < WGM ? (nM - fm) : WGM;
        pm = fm + ((wgid % nig) % gsz); pn = (wgid % nig) / gsz; return true;
    }
    DI bool next(int i, Unit& u) const { int pm, pn; if (!map(i, pm, pn)) return false; u.pm = pm; u.pn = pn; u.pa = pm; u.pb = pn; return true; }
};
struct MoeOrder {
    StaticOrder so; const int* tile_e; int tile0, nbt; bool a_global;
    DI bool next(int i, Unit& u) const {
        int pm, pn; if (!so.map(i, pm, pn)) return false;
        const int e = __builtin_amdgcn_readfirstlane(tile_e[tile0 + pm]);
        u.pn = pn; u.pb = e * nbt + pn;
        if (a_global) { u.pa = tile0 + pm; u.pm = pm; } else { u.pa = pm; u.pm = tile0 + pm; }
        return true;
    }
};

struct EpiStore {
    bf16* O; int ldc; float scale;
    DI void operator()(const f32x4 (&acc)[2][2][4][2], const Unit& u, int wr, int wc, int fr, int fq) const {
        const int row0 = u.pm * BM + wr * 64 + fr, col0 = u.pn * BM + wc * 32 + 8 * fq;
#pragma unroll
        for (int ai = 0; ai < 2; ++ai)
#pragma unroll
            for (int m = 0; m < 4; ++m) { bf16* rowp = O + (size_t)(row0 + ai * HALF + m * 16) * ldc + col0;
#pragma unroll
                for (int bj = 0; bj < 2; ++bj) { const f32x4 v0 = acc[ai][bj][m][0] * scale, v1 = acc[ai][bj][m][1] * scale;
                    u32x4 w; w.x = pk2(v0[0], v0[1]); w.y = pk2(v0[2], v0[3]); w.z = pk2(v1[0], v1[1]); w.w = pk2(v1[2], v1[3]);
                    *(u32x4*)(rowp + bj * HALF) = w; } }
    }
};
DI float silu_mul(float g, float u) { return g * u / (1.0f + ex2(-g * LOG2E)); }
struct EpiSwiGLU {
    bf16* H; int ldh;
    DI void operator()(const f32x4 (&acc)[2][2][4][2], const Unit& u, int wr, int wc, int fr, int fq) const {
        const int row0 = u.pm * BM + wr * 64 + fr, col0 = u.pn * HALF + wc * 32 + 8 * fq;
#pragma unroll
        for (int ai = 0; ai < 2; ++ai)
#pragma unroll
            for (int m = 0; m < 4; ++m) { bf16* rowp = H + (size_t)(row0 + ai * HALF + m * 16) * ldh + col0;
                const f32x4 g0 = acc[ai][0][m][0], g1 = acc[ai][0][m][1], u0 = acc[ai][1][m][0], u1 = acc[ai][1][m][1];
                u32x4 w; w.x = pk2(silu_mul(g0[0], u0[0]), silu_mul(g0[1], u0[1])); w.y = pk2(silu_mul(g0[2], u0[2]), silu_mul(g0[3], u0[3]));
                w.z = pk2(silu_mul(g1[0], u1[0]), silu_mul(g1[1], u1[1])); w.w = pk2(silu_mul(g1[2], u1[2]), silu_mul(g1[3], u1[3]));
                *(u32x4*)rowp = w; }
    }
};
struct EpiPleGate {
    const bf16* E0; bf16* E; int ldc;
    DI void operator()(const f32x4 (&acc)[2][2][4][2], const Unit& u, int wr, int wc, int fr, int fq) const {
        const int row0 = u.pm * BM + wr * 64 + fr, col0 = u.pn * BM + wc * 32 + 8 * fq;
#pragma unroll
        for (int ai = 0; ai < 2; ++ai)
#pragma unroll
            for (int m = 0; m < 4; ++m) { const size_t off = (size_t)(row0 + ai * HALF + m * 16) * ldc + col0;
#pragma unroll
                for (int bj = 0; bj < 2; ++bj) { const u32x4 ew = *(const u32x4*)(E0 + off + bj * HALF); float e[8]; unpack8(ew, e);
                    const f32x4 v0 = acc[ai][bj][m][0], v1 = acc[ai][bj][m][1]; float o[8];
#pragma unroll
                    for (int j = 0; j < 4; ++j) { o[j] = e[j] / (1.0f + ex2(-v0[j] * LOG2E)); o[4 + j] = e[4 + j] / (1.0f + ex2(-v1[j] * LOG2E)); }
                    *(u32x4*)(E + off + bj * HALF) = pack8(o); } }
    }
};
struct EpiQKV1 {
    bf16* O; const f32x2* tabp;
    DI void operator()(const f32x4 (&acc)[2][2][4][2], const Unit& u, int wr, int wc, int fr, int fq) const {
        const int row0 = u.pm * BM + wr * 64 + fr, col0 = u.pn * BM + wc * 32 + 8 * fq;
        const int which = ((u.pn * BM) % 1536) / 512;
        const float sc = which == 0 ? C2_64 : 1.0f;
        const bool rot = which < 2;
        const bool mine = ((wc & 1) == 0) && (fq < 2);
#pragma unroll
        for (int ai = 0; ai < 2; ++ai)
#pragma unroll
            for (int m = 0; m < 4; ++m) { const int row = row0 + ai * HALF + m * 16; bf16* rowp = O + (size_t)row * QKVW + col0;
                const f32x2* tp = tabp + (size_t)(row & (SEQ - 1)) * 8;
#pragma unroll
                for (int bj = 0; bj < 2; ++bj) { float v[8];
#pragma unroll
                    for (int j = 0; j < 4; ++j) { v[j] = acc[ai][bj][m][0][j]; v[4 + j] = acc[ai][bj][m][1][j]; }
                    if (rot) {
                        float p[8];
#pragma unroll
                        for (int j = 0; j < 8; ++j) p[j] = __shfl_xor(v[j], 16);
                        if (mine) {
#pragma unroll
                            for (int j = 0; j < 8; ++j) { const f32x2 cs = tp[j]; v[j] = (fq == 0) ? (v[j] * cs.x - p[j] * cs.y) : (v[j] * cs.x + p[j] * cs.y); }
                        }
                    }
#pragma unroll
                    for (int j = 0; j < 8; ++j) v[j] *= sc;
                    *(u32x4*)(rowp + bj * HALF) = pack8(v); } }
    }
};

template <class Epi, class Sched>
DI void gemm_phase(LAS unsigned char* lds, const Gemm g, const Sched& S, const Epi& E) {
    const int tid = fresh_tid(), wid = __builtin_amdgcn_readfirstlane(tid >> 6), lane = tid & 63, wr = wid >> 2, wc = wid & 3, fr = lane & 15, fq = lane >> 4;
    const int K = g.K, nt = K / BK;
    unsigned voffA[2], voffB[2];
#pragma unroll
    for (int i = 0; i < 2; ++i) { int R, C; stage_rc(tid * 16 + i * 8192, R, C); const int Rb = (R & ~31) + perm32(R & 31);
        voffA[i] = (unsigned)(R * g.lda + C) * 2u; voffB[i] = (unsigned)(Rb * g.ldb + C) * 2u; }
    const size_t kstep = (size_t)(BK * 2);
    const size_t hstepA = (size_t)HALF * g.lda * 2, hstepB = (size_t)HALF * g.ldb * 2;
    const size_t tstepA = 2 * hstepA, tstepB = 2 * hstepB;
    const unsigned ldsw = (unsigned)wid * 1024u;
    const int aoff = lds_byte(wr * 64 + fr, fq * 8), boff = lds_byte(wc * 32 + fr, fq * 8);
#define PG8_SA(b, h) (((b) * 2 + (h)) * HTB)
#define PG8_SB(b, h) ((4 + (b) * 2 + (h)) * HTB)
#define PG8_STAGE(bufoff, gbase, voff) do { _Pragma("unroll") for (int _i = 0; _i < 2; ++_i) \
        __builtin_amdgcn_global_load_lds((const unsigned*)((const char*)(gbase) + (voff)[_i]), (LAS unsigned*)(lds + (bufoff) + ldsw + _i * 8192), 16, 0, 0); } while (0)
#define PG8_LDA(dst, b, h) do { _Pragma("unroll") for (int m = 0; m < 4; ++m) _Pragma("unroll") for (int k = 0; k < 2; ++k) dst[m][k] = *(const LAS bf16x8*)(lds + PG8_SA(b, h) + aoff + m * 2048 + k * 1024); } while (0)
#define PG8_LDB(dst, b, h) do { _Pragma("unroll") for (int n = 0; n < 2; ++n) _Pragma("unroll") for (int k = 0; k < 2; ++k) dst[n][k] = *(const LAS bf16x8*)(lds + PG8_SB(b, h) + boff + n * 2048 + k * 1024); } while (0)
#define PG8_MMA(ai, bj, At, Bt) do { __builtin_amdgcn_s_setprio(1); _Pragma("unroll") for (int m = 0; m < 4; ++m) _Pragma("unroll") for (int n = 0; n < 2; ++n) _Pragma("unroll") for (int k = 0; k < 2; ++k) \
        acc[ai][bj][m][n] = __builtin_amdgcn_mfma_f32_16x16x32_bf16(Bt[n][k], At[m][k], acc[ai][bj][m][n], 0, 0, 0); __builtin_amdgcn_s_setprio(0); } while (0)
#define PG8_WAIT_V(n) asm volatile("s_waitcnt vmcnt(" #n ")" ::: "memory")
#define PG8_WAIT_L(n) asm volatile("s_waitcnt lgkmcnt(" #n ")" ::: "memory")
#define PG8_BAR __builtin_amdgcn_s_barrier()
#define PG8_SCHED __builtin_amdgcn_sched_barrier(0)
    Unit cur, nxt; int ui = 0;
    if (!S.next(0, cur)) return;
    f32x4 acc[2][2][4][2];
#pragma unroll
    for (int a = 0; a < 2; ++a)
#pragma unroll
        for (int b = 0; b < 2; ++b)
#pragma unroll
            for (int m = 0; m < 4; ++m)
#pragma unroll
                for (int n = 0; n < 2; ++n) acc[a][b][m][n] = (f32x4){0.f, 0.f, 0.f, 0.f};
    bf16x8 At[4][2], B0[2][2], B1[2][2];
    const char* cA = (const char*)g.A + (size_t)cur.pa * tstepA; const char* cB = (const char*)g.Bt + (size_t)cur.pb * tstepB;
    PG8_STAGE(PG8_SB(0, 0), cB, voffB); PG8_STAGE(PG8_SB(0, 1), cB + hstepB, voffB); PG8_STAGE(PG8_SA(0, 0), cA, voffA); PG8_STAGE(PG8_SA(0, 1), cA + hstepA, voffA);
    if (wr == 1) PG8_BAR;
    PG8_WAIT_V(2); PG8_BAR;
    PG8_STAGE(PG8_SB(1, 0), cB + kstep, voffB); PG8_STAGE(PG8_SA(1, 0), cA + kstep, voffA); PG8_STAGE(PG8_SB(1, 1), cB + hstepB + kstep, voffB);
    PG8_WAIT_V(6); PG8_BAR;
    for (;;) {
        const bool has_next = S.next(ui + 1, nxt);
        const char* nA = has_next ? (const char*)g.A + (size_t)nxt.pa * tstepA : cA; const char* nB = has_next ? (const char*)g.Bt + (size_t)nxt.pb * tstepB : cB;
        for (int t = 0; t < nt; t += 2) {
            const bool last = (t == nt - 2);
            const char* a1 = cA + (size_t)(t + 1) * kstep;
            const char* a2 = last ? nA : cA + (size_t)(t + 2) * kstep; const char* b2 = last ? nB : cB + (size_t)(t + 2) * kstep;
            const char* a3 = a2 + kstep; const char* b3 = b2 + kstep;
            PG8_LDB(B0, 0, 0); PG8_LDB(B1, 0, 1); PG8_SCHED; PG8_LDA(At, 0, 0); PG8_STAGE(PG8_SA(1, 1), a1 + hstepA, voffA);
            PG8_WAIT_V(8); PG8_WAIT_L(0); PG8_BAR; PG8_MMA(0, 0, At, B0); PG8_MMA(0, 1, At, B1); PG8_BAR; PG8_SCHED;
            PG8_LDA(At, 0, 1); PG8_STAGE(PG8_SB(0, 0), b2, voffB); PG8_STAGE(PG8_SB(0, 1), b2 + hstepB, voffB); PG8_STAGE(PG8_SA(0, 0), a2, voffA);
            PG8_WAIT_V(8); PG8_WAIT_L(0); PG8_BAR; PG8_MMA(1, 0, At, B0); PG8_MMA(1, 1, At, B1); PG8_BAR; PG8_SCHED;
            PG8_LDB(B0, 1, 0); PG8_LDB(B1, 1, 1); PG8_SCHED; PG8_LDA(At, 1, 0); PG8_STAGE(PG8_SA(0, 1), a2 + hstepA, voffA);
            PG8_WAIT_V(8); PG8_WAIT_L(0); PG8_BAR; PG8_MMA(0, 0, At, B0); PG8_MMA(0, 1, At, B1); PG8_BAR; PG8_SCHED;
            PG8_LDA(At, 1, 1); PG8_STAGE(PG8_SB(1, 0), b3, voffB); PG8_STAGE(PG8_SB(1, 1), b3 + hstepB, voffB); PG8_STAGE(PG8_SA(1, 0), a3, voffA);
            PG8_WAIT_V(8); PG8_WAIT_L(0); PG8_BAR; PG8_MMA(1, 0, At, B0); PG8_MMA(1, 1, At, B1); PG8_BAR; PG8_SCHED;
        }
        if (wr == 0) PG8_BAR;
        E(acc, cur, wr, wc, fr, fq);
        if (!has_next) break;
#pragma unroll
        for (int a = 0; a < 2; ++a)
#pragma unroll
            for (int b = 0; b < 2; ++b)
#pragma unroll
                for (int m = 0; m < 4; ++m)
#pragma unroll
                    for (int n = 0; n < 2; ++n) acc[a][b][m][n] = (f32x4){0.f, 0.f, 0.f, 0.f};
        cur = nxt; cA = nA; cB = nB; ++ui;
        if (wr == 1) PG8_BAR;
    }
    PG8_WAIT_V(0);
    PG8_BAR;
#undef PG8_SA
#undef PG8_SB
#undef PG8_STAGE
#undef PG8_LDA
#undef PG8_LDB
#undef PG8_MMA
#undef PG8_WAIT_V
#undef PG8_WAIT_L
#undef PG8_BAR
#undef PG8_SCHED
}
}

namespace att {
#define MFMA32(a, b, c) __builtin_amdgcn_mfma_f32_32x32x16_bf16((a), (b), (c), 0, 0, 0)
DI int crow(int i, int h) { return (i & 3) + 8 * (i >> 2) + 4 * h; }
typedef short v4i16_t __attribute__((ext_vector_type(4)));
DI s16x4 vtr(const LAS unsigned char* p) { return __builtin_bit_cast(s16x4, __builtin_amdgcn_ds_read_tr16_b64_v4i16((LAS v4i16_t*)p)); }
DI bf16x8 packp(const f32x16& p, int b) {
    u32x4 w; w.x = pk2(p[b], p[b + 1]); w.y = pk2(p[b + 2], p[b + 3]); w.z = pk2(p[b + 4], p[b + 5]); w.w = pk2(p[b + 6], p[b + 7]);
    return __builtin_bit_cast(bf16x8, w);
}
constexpr float NEGBIG = -1.0e30f;
template <int DK, bool MASK>
DI void tile_step(const LAS unsigned char* Kb, const LAS unsigned char* Vb, const bf16x8 (&qr)[DK / 16], f32x16& o0, f32x16& o1, float& m, float& l,
                  LAS float* wsf, int r, int h, int lane, int qi, int kj0) {
    f32x16 p0, p1;
#pragma unroll
    for (int i = 0; i < 16; ++i) { p0[i] = 0.f; p1[i] = 0.f; }
    const LAS unsigned char* kp = Kb + h * 1024 + r * 16;
#pragma unroll
    for (int ks = 0; ks < DK / 16; ++ks) {
        const bf16x8 a0 = *(const LAS bf16x8*)(kp + ks * 2048);
        const bf16x8 a1 = *(const LAS bf16x8*)(kp + ks * 2048 + 512);
        p0 = MFMA32(a0, qr[ks], p0); p1 = MFMA32(a1, qr[ks], p1);
    }
    if (MASK) {
#pragma unroll
        for (int i = 0; i < 16; ++i) { const int d0 = qi - (kj0 + crow(i, h)), d1 = d0 - 32;
            if (d0 > 64 || d0 < -64) p0[i] = NEGBIG; if (d1 > 64 || d1 < -64) p1[i] = NEGBIG; }
    }
    float tm = fmaxf(p0[0], p1[0]);
#pragma unroll
    for (int i = 1; i < 16; ++i) tm = fmaxf(tm, fmaxf(p0[i], p1[i]));
    tm = fmaxf(tm, __shfl_xor(tm, 32));
    const float mn = fmaxf(m, tm);
    if (__any(mn > m)) {
        const float al = ex2(m - mn); l *= al; m = mn;
        if (h == 0) wsf[r] = al;
#pragma unroll
        for (int i = 0; i < 16; ++i) { const float f = wsf[crow(i, h)]; o0[i] *= f; o1[i] *= f; }
    }
    float sum = 0.f;
#pragma unroll
    for (int i = 0; i < 16; ++i) { p0[i] = ex2(p0[i] - m); p1[i] = ex2(p1[i] - m); sum += p0[i] + p1[i]; }
    l += sum;
    const LAS unsigned char* vp = Vb + ((lane >> 4) & 1) * 32 + (lane & 3) * 8 + (4 * h + ((lane & 15) >> 2)) * 64;
#pragma unroll
    for (int s = 0; s < 4; ++s) {
        const bf16x8 pa = (s == 0) ? packp(p0, 0) : (s == 1) ? packp(p0, 8) : (s == 2) ? packp(p1, 0) : packp(p1, 8);
#pragma unroll
        for (int db = 0; db < 2; ++db) {
            const s16x4 lo = vtr(vp + db * 4096 + s * 1024), hi = vtr(vp + db * 4096 + s * 1024 + 512);
            const bf16x8 vf = {lo[0], lo[1], lo[2], lo[3], hi[0], hi[1], hi[2], hi[3]};
            if (db == 0) o0 = MFMA32(pa, vf, o0); else o1 = MFMA32(pa, vf, o1);
        }
    }
}
DI void finish_store(const f32x16& o0, const f32x16& o1, float l, LAS float* wsf, LAS unsigned short* stg, int r, int h, int lane, bf16* orow0, size_t rstride) {
    const float lt = l + __shfl_xor(l, 32);
    if (h == 0) wsf[r] = 1.0f / lt;
#pragma unroll
    for (int i = 0; i < 16; ++i) { const int row = crow(i, h); const float f = wsf[row];
        stg[row * 64 + r] = (unsigned short)(pk2(o0[i] * f, 0.f) & 0xffffu); stg[row * 64 + 32 + r] = (unsigned short)(pk2(o1[i] * f, 0.f) & 0xffffu); }
#pragma unroll
    for (int it = 0; it < 4; ++it) { const int row = it * 8 + (lane >> 3), ch = lane & 7;
        const u32x4 v = *(const LAS u32x4*)(stg + row * 64 + ch * 8);
        *(u32x4*)(orow0 + (size_t)row * rstride + ch * 8) = v; }
}
#define ATT_WAITBAR(N) asm volatile("s_waitcnt vmcnt(" #N ") lgkmcnt(0)\n\ts_barrier" ::: "memory")
DI void dma16(const void* gsrc, LAS unsigned char* ldst) { __builtin_amdgcn_global_load_lds((const unsigned*)gsrc, (LAS unsigned*)ldst, 16, 0, 0); }

template <int DK>
DI void dense_unit(LAS unsigned char* lds, const bf16* qS, int qp, int q0, const bf16* kA, int kpA, const bf16* kB, const bf16* vS, int vpitch, bf16* oS, int op, const f32x2* taba) {
    constexpr int NKC = DK / 8, KSLOT = NKC * 1024, VSLOT = 8192, NS = 3;
    constexpr int OFF_V = NS * KSLOT, OFF_WS = OFF_V + NS * VSLOT, OFF_STG = OFF_WS + NWAVES * 256;
    const int tid = fresh_tid(), lane = tid & 63, r = lane & 31, h = lane >> 5; const int w = __builtin_amdgcn_readfirstlane(tid >> 6);
    LAS float* wsf = (LAS float*)(lds + OFF_WS) + w * 64;
    LAS unsigned short* stg = (LAS unsigned short*)(lds + OFF_STG) + w * 2048;
    const bf16* ksrcA = kA + (size_t)lane * kpA + w * 8;
    const bf16* ksrcB = (DK == 96) ? (kB + (size_t)lane * 32 + (w & 3) * 8) : kA;
    const bf16* vsrc = vS + (size_t)(16 * (w & 3) + (lane >> 2)) * vpitch + (w >> 2) * 32 + (lane & 3) * 8;
    const size_t kstA = (size_t)64 * kpA, kstB = 64 * 32, vst = (size_t)64 * vpitch;
#define DENSE_ISSUE(t) do { const int sl_ = (t) % NS; \
        dma16(ksrcA + (size_t)(t) * kstA, lds + sl_ * KSLOT + w * 1024); \
        if (DK == 96) dma16(ksrcB + (size_t)(t) * kstB, lds + sl_ * KSLOT + (8 + (w & 3)) * 1024); \
        dma16(vsrc + (size_t)(t) * vst, lds + OFF_V + sl_ * VSLOT + w * 1024); } while (0)
    bf16x8 qr[DK / 16];
    const bf16* qrow = qS + (size_t)(q0 + w * 32 + r) * qp + 8 * h;
#pragma unroll
    for (int ks = 0; ks < DK / 16; ++ks) qr[ks] = *(const bf16x8*)(qrow + 16 * ks);
    DENSE_ISSUE(0); DENSE_ISSUE(1);
    if (DK == 96) {
        const f32x2* tp = taba + (size_t)(q0 + w * 32 + r) * 16 + 8 * h;
        bf16x8 a = qr[4], b = qr[5];
#pragma unroll
        for (int j = 0; j < 8; ++j) { const f32x2 cs = tp[j]; const float x1 = bf2f((unsigned short)a[j]), x2 = bf2f((unsigned short)b[j]);
            a[j] = (short)(pk2(x1 * cs.x - x2 * cs.y, 0.f) & 0xffffu); b[j] = (short)(pk2(x2 * cs.x + x1 * cs.y, 0.f) & 0xffffu); }
        qr[4] = a; qr[5] = b;
    }
    f32x16 o0, o1;
#pragma unroll
    for (int i = 0; i < 16; ++i) { o0[i] = 0.f; o1[i] = 0.f; }
    float m = NEGBIG, l = 0.f;
    constexpr int NT = SEQ / 64;
    for (int t = 0; t < NT; ++t) {
        if (t + 1 < NT) { if (DK == 96) ATT_WAITBAR(3); else ATT_WAITBAR(2); } else ATT_WAITBAR(0);
        if (t + 2 < NT) DENSE_ISSUE(t + 2);
        const int sl = t % NS;
        tile_step<DK, false>(lds + sl * KSLOT, lds + OFF_V + sl * VSLOT, qr, o0, o1, m, l, wsf, r, h, lane, 0, 0);
    }
    finish_store(o0, o1, l, wsf, stg, r, h, lane, oS + (size_t)(q0 + w * 32) * op, (size_t)op);
    ATT_WAITBAR(0);
#undef DENSE_ISSUE
}

DI void dil_unit(LAS unsigned char* lds, int grp, int b, int head, int res, int c, const bf16* qkv, bf16* og, float* lse) {
    constexpr int SLOT = 16384, OFF_WS = 6 * SLOT, OFF_STG = OFF_WS + NWAVES * 256;
    const int tid = fresh_tid(), lane = tid & 63, r = lane & 31, h = lane >> 5; const int w = __builtin_amdgcn_readfirstlane(tid >> 6);
    LAS float* wsf = (LAS float*)(lds + OFF_WS) + w * 64;
    LAS unsigned short* stg = (LAS unsigned short*)(lds + OFF_STG) + w * 2048;
    const int dil = grp == 0 ? 1 : (grp == 1 ? 4 : 16), ntile = SEQ / dil / 64;
    const bf16* base = qkv + (size_t)b * SEQ * QKVW + grp * 1536 + head * 64;
#pragma unroll
    for (int s = 0; s < 6; ++s) {
        int sres, kb; bool valid;
        if (grp < 2) { sres = res; kb = 4 * c - 1 + s; valid = (kb >= 0) && (kb < ntile); }
        else { sres = 2 * res + (s >> 1); kb = s & 1; valid = s < 4; }
        if (valid) {
            const int krow = 64 * kb + lane, vrow = 64 * kb + 16 * (w & 3) + (lane >> 2);
            dma16(base + (size_t)(sres + dil * krow) * QKVW + 512 + w * 8, lds + s * SLOT + w * 1024);
            dma16(base + (size_t)(sres + dil * vrow) * QKVW + 1024 + (w >> 2) * 32 + (lane & 3) * 8, lds + s * SLOT + 8192 + w * 1024);
        }
    }
    int wres, qi0, s0, kb0, nts;
    if (grp < 2) { wres = res; qi0 = 256 * c + 32 * w; s0 = w >> 1; kb0 = 4 * c + (w >> 1) - 1; nts = 3; }
    else { wres = 2 * res + (w >> 2); qi0 = 32 * (w & 3); s0 = 2 * (w >> 2); kb0 = 0; nts = 2; }
    bf16x8 qr[4];
    const bf16* qrow = base + (size_t)(wres + dil * (qi0 + r)) * QKVW + 8 * h;
#pragma unroll
    for (int ks = 0; ks < 4; ++ks) qr[ks] = *(const bf16x8*)(qrow + 16 * ks);
    f32x16 o0, o1;
#pragma unroll
    for (int i = 0; i < 16; ++i) { o0[i] = 0.f; o1[i] = 0.f; }
    float m = NEGBIG, l = 0.f;
    ATT_WAITBAR(0);
    for (int j = 0; j < nts; ++j) {
        const int kb = kb0 + j;
        if (kb >= 0 && kb < ntile) {
            const LAS unsigned char* sp = lds + (s0 + j) * SLOT;
            tile_step<64, true>(sp, sp + 8192, qr, o0, o1, m, l, wsf, r, h, lane, qi0 + r, 64 * kb);
        }
    }
    const size_t tok0 = (size_t)b * SEQ + wres + (size_t)dil * qi0;
    finish_store(o0, o1, l, wsf, stg, r, h, lane, og + tok0 * 512 + head * 64, (size_t)dil * 512);
    const float lt = l + __shfl_xor(l, 32);
    if (h == 0) lse[(tok0 + (size_t)dil * r) * 8 + head] = m + __builtin_amdgcn_logf(lt);
    ATT_WAITBAR(0);
}
}

#define XB_TMO      128
#define XB_XCNT(j)  (256  + 64 * (j))
#define XB_XSUB(j)  (1280 + 64 * (j))
#define XB_XGEN(j)  (2304 + 64 * (j))
#define XB_TOP      3328
#define XB_TOPGEN   3392
#define XCD_BAR_WORDS 3456
#define XB_SPIN_CAP (1u << 18)
DI unsigned xb_ld(unsigned* p)              { return __hip_atomic_load(p, __ATOMIC_RELAXED, __HIP_MEMORY_SCOPE_AGENT); }
DI unsigned xb_add(unsigned* p, unsigned v) { return __hip_atomic_fetch_add(p, v, __ATOMIC_RELAXED, __HIP_MEMORY_SCOPE_AGENT); }
DI unsigned xb_xcc_id() { return (unsigned)__builtin_amdgcn_s_getreg((3 << 11) | 20) & 0xFu; }
#define XB_SPIN(cond, bar) do { unsigned _sp = 0; while (cond) { __builtin_amdgcn_s_sleep(1); \
    if ((++_sp & 255u) == 0u) { if (xb_ld(&(bar)[XB_TMO])) break; if (_sp > XB_SPIN_CAP) { atomicAdd(&(bar)[XB_TMO], 1u); break; } } } } while (0)
struct XcdBarrier { unsigned* bar; unsigned x; volatile LAS unsigned* st; };
DI XcdBarrier xcd_barrier_post(unsigned* bar, volatile LAS unsigned* st) {
    XcdBarrier b; b.bar = bar; b.x = xb_xcc_id(); b.st = st;
    if (threadIdx.x == 0) (void)xb_add(&bar[XB_XCNT(b.x)], 1u);
    return b;
}
DI void xcd_barrier_complete(unsigned* bar, unsigned x, unsigned& nloc, unsigned& nx) {
    const unsigned G = gridDim.x * gridDim.y * gridDim.z;
    unsigned sum, cnt, mine, sp = 0u;
    for (;;) {
        sum = 0u; cnt = 0u; mine = 0u;
#pragma unroll
        for (unsigned j = 0; j < 16; ++j) { const unsigned c = xb_ld(&bar[XB_XCNT(j)]); sum += c; cnt += (c > 0u) ? 1u : 0u; mine = (j == x) ? c : mine; }
        if (sum == G) break;
        __builtin_amdgcn_s_sleep(1);
        if ((++sp & 255u) == 0u) { if (xb_ld(&bar[XB_TMO])) break; if (sp > XB_SPIN_CAP) { atomicAdd(&bar[XB_TMO], 1u); break; } }
    }
    nloc = mine > 0u ? mine : 1u; nx = cnt > 0u ? cnt : 1u;
}
DI void xcd_barrier(const XcdBarrier& b) {
    asm volatile("s_waitcnt vmcnt(0)" ::: "memory");
    __syncthreads();
    if (threadIdx.x == 0) {
        unsigned* bar = b.bar;
        __builtin_amdgcn_s_waitcnt(0);
        unsigned nloc = b.st[0], nx = b.st[1];
        if (nloc == 0u) { xcd_barrier_complete(bar, b.x, nloc, nx); b.st[0] = nloc; b.st[1] = nx; }
        const unsigned old = xb_add(&bar[XB_XSUB(b.x)], 1u);
        const unsigned gen = old / nloc;
        if (old + 1u == (gen + 1u) * nloc) {
            __builtin_amdgcn_fence(__ATOMIC_RELEASE, "agent");
            asm volatile("s_waitcnt vmcnt(0)" ::: "memory");
            const unsigned og = xb_add(&bar[XB_TOP], 1u);
            const unsigned tg = og / nx;
            if (og + 1u == (tg + 1u) * nx) xb_add(&bar[XB_TOPGEN], 1u);
            else XB_SPIN(xb_ld(&bar[XB_TOPGEN]) == tg, bar);
            __builtin_amdgcn_fence(__ATOMIC_ACQUIRE, "agent");
            xb_add(&bar[XB_XGEN(b.x)], 1u);
            asm volatile("s_waitcnt vmcnt(0)" ::: "memory");
        } else {
            XB_SPIN(xb_ld(&bar[XB_XGEN(b.x)]) == gen, bar);
            __builtin_amdgcn_fence(__ATOMIC_ACQUIRE, "agent");
            asm volatile("s_waitcnt vmcnt(0)" ::: "memory");
        }
    }
    __syncthreads();
}

struct Ctx { int wave, G, bid; LAS unsigned char* lds; };

DI void transpose_item(const float* W, int K, int N, bf16* WT, int ldo, int row_off, int gu, LAS float* scr, int item, int lane) {
    const int nblk = N / 32, kb = item / nblk, nb = item % nblk, k0 = 64 * kb, n0 = 32 * nb;
#pragma unroll 8
    for (int i = 0; i < 32; ++i) { const int kk = 2 * i + (lane >> 5); scr[kk * 33 + (lane & 31)] = W[(size_t)(k0 + kk) * N + n0 + (lane & 31)]; }
    asm volatile("s_waitcnt lgkmcnt(0)" ::: "memory");
    const int c = lane & 7;
    const int orow0 = row_off + (gu == 0 ? n0 : ((n0 >> 7) * 256 + (gu - 1) * 128 + (n0 & 127)));
#pragma unroll
    for (int j = 0; j < 4; ++j) { const int n = (lane >> 3) + 8 * j; const LAS float* s = scr + (8 * c) * 33 + n;
        u32x4 o; o.x = pk2(s[0 * 33], s[1 * 33]); o.y = pk2(s[2 * 33], s[3 * 33]); o.z = pk2(s[4 * 33], s[5 * 33]); o.w = pk2(s[6 * 33], s[7 * 33]);
        *(u32x4*)(WT + (size_t)(orow0 + n) * ldo + k0 + 8 * c) = o; }
    asm volatile("s_waitcnt lgkmcnt(0)" ::: "memory");
}

DI void sincos_d(double a, float& c, float& s) {
    const double TWO_PI = 6.283185307179586476925286766559, INV = 0.15915494309189533576888376337251;
    const double n = __builtin_rint(a * INV); double x = (a - n * TWO_PI) * 0.25; const double x2 = x * x;
    double sn = x * (1.0 + x2 * (-1.0 / 6 + x2 * (1.0 / 120 + x2 * (-1.0 / 5040 + x2 * (1.0 / 362880 + x2 * (-1.0 / 39916800 + x2 * (1.0 / 6227020800.0)))))));
    double cs = 1.0 + x2 * (-0.5 + x2 * (1.0 / 24 + x2 * (-1.0 / 720 + x2 * (1.0 / 40320 + x2 * (-1.0 / 3628800 + x2 * (1.0 / 479001600.0))))));
#pragma unroll
    for (int i = 0; i < 2; ++i) { const double s2 = 2.0 * sn * cs, c2 = cs * cs - sn * sn; sn = s2; cs = c2; }
    c = (float)cs; s = (float)sn;
}

DI void rows_norm_only(const Ctx& C, const float* x, const float* g, bf16* xn) {
    const int gw = C.bid * NWAVES + C.wave, NGW = C.G * NWAVES, lane = fresh_tid() & 63;
    f32x4 gv[4];
#pragma unroll
    for (int j = 0; j < 4; ++j) gv[j] = *((const f32x4*)g + lane + 64 * j);
    for (int m = gw; m < NTOK; m += NGW) {
        const f32x4* xr = (const f32x4*)(x + (size_t)m * DM) + lane;
        f32x4 v[4]; float s = 0.f;
#pragma unroll
        for (int j = 0; j < 4; ++j) { v[j] = xr[64 * j]; s += (v[j].x * v[j].x + v[j].y * v[j].y) + (v[j].z * v[j].z + v[j].w * v[j].w); }
        const float ri = rsq(wave_sum(s) * (1.f / DM) + EPS);
        u32x2* o8 = (u32x2*)(xn + (size_t)m * DM) + lane;
#pragma unroll
        for (int j = 0; j < 4; ++j) { const f32x4 y = v[j] * ri * gv[j]; u32x2 o; o.x = pk2(y.x, y.y); o.y = pk2(y.z, y.w); o8[64 * j] = o; }
    }
}

template <bool MOE, bool NEXT, bool ROUTE>
DI void rows_residual(const Ctx& C, const float* hold, float* hout, const bf16* term, const float* gpost, const float* gnext, bf16* xn,
                      const int* toks, const f32x2* tokg, const float* wrouter, int* toke, f32x2* tokg_out, int* cnt_out) {
    const int gw = C.bid * NWAVES + C.wave, NGW = C.G * NWAVES, tid_ = fresh_tid(), lane_ = tid_ & 63;
    f32x4 gp[4], gn[4];
#pragma unroll
    for (int j = 0; j < 4; ++j) { gp[j] = *((const f32x4*)gpost + lane_ + 64 * j); gn[j] = NEXT ? *((const f32x4*)gnext + lane_ + 64 * j) : (f32x4){0.f, 0.f, 0.f, 0.f}; }
    LAS int* lcnt = (LAS int*)C.lds;
    if (ROUTE) { if (tid_ < 8) lcnt[tid_] = 0; __syncthreads(); }
    const int rows_per_wave = NTOK / NGW;
    const int nrows = ROUTE ? rows_per_wave : (NTOK - gw + NGW - 1) / NGW;
    for (int it = 0; it < nrows; ++it) {
        const int m = ROUTE ? (gw * rows_per_wave + it) : (gw + it * NGW);
        f32x4 t[4];
        if (MOE) {
            const int s1 = toks[2 * m], s2 = toks[2 * m + 1]; const f32x2 gg = tokg[m];
            const u32x2* y1 = (const u32x2*)(term + (size_t)s1 * DM) + lane_; const u32x2* y2 = (const u32x2*)(term + (size_t)s2 * DM) + lane_;
#pragma unroll
            for (int j = 0; j < 4; ++j) { const u32x2 a = y1[64 * j], b = y2[64 * j];
                t[j].x = gg.x * __uint_as_float(a.x << 16) + gg.y * __uint_as_float(b.x << 16); t[j].y = gg.x * __uint_as_float(a.x & 0xffff0000u) + gg.y * __uint_as_float(b.x & 0xffff0000u);
                t[j].z = gg.x * __uint_as_float(a.y << 16) + gg.y * __uint_as_float(b.y << 16); t[j].w = gg.x * __uint_as_float(a.y & 0xffff0000u) + gg.y * __uint_as_float(b.y & 0xffff0000u); }
        } else {
            const u32x2* tr = (const u32x2*)(term + (size_t)m * DM) + lane_;
#pragma unroll
            for (int j = 0; j < 4; ++j) { const u32x2 a = tr[64 * j]; t[j].x = __uint_as_float(a.x << 16); t[j].y = __uint_as_float(a.x & 0xffff0000u); t[j].z = __uint_as_float(a.y << 16); t[j].w = __uint_as_float(a.y & 0xffff0000u); }
        }
        const f32x4* hr = (const f32x4*)(hold + (size_t)m * DM) + lane_;
        f32x4 hv[4]; float s = 0.f;
#pragma unroll
        for (int j = 0; j < 4; ++j) { hv[j] = hr[64 * j]; s += (t[j].x * t[j].x + t[j].y * t[j].y) + (t[j].z * t[j].z + t[j].w * t[j].w); }
        const float ri = rsq(wave_sum(s) * (1.f / DM) + EPS);
        f32x4* ho = (f32x4*)(hout + (size_t)m * DM) + lane_; float s2 = 0.f;
#pragma unroll
        for (int j = 0; j < 4; ++j) { hv[j] = hv[j] + t[j] * ri * gp[j]; ho[64 * j] = hv[j]; s2 += (hv[j].x * hv[j].x + hv[j].y * hv[j].y) + (hv[j].z * hv[j].z + hv[j].w * hv[j].w); }
        if (NEXT) {
            const float r2 = rsq(wave_sum(s2) * (1.f / DM) + EPS);
            u32x2* o8 = (u32x2*)(xn + (size_t)m * DM) + lane_;
#pragma unroll
            for (int j = 0; j < 4; ++j) { hv[j] = hv[j] * r2 * gn[j]; u32x2 o; o.x = pk2(hv[j].x, hv[j].y); o.y = pk2(hv[j].z, hv[j].w); o8[64 * j] = o; }
            if (ROUTE) {
                float lg[8];
#pragma unroll
                for (int e = 0; e < 8; ++e) lg[e] = 0.f;
#pragma unroll
                for (int j = 0; j < 4; ++j)
#pragma unroll
                    for (int q = 0; q < 4; ++q) { const f32x4* wp = (const f32x4*)(wrouter + (size_t)(4 * lane_ + 256 * j + q) * 8); const f32x4 w0 = wp[0], w1 = wp[1]; const float a = hv[j][q];
                        lg[0] += a * w0.x; lg[1] += a * w0.y; lg[2] += a * w0.z; lg[3] += a * w0.w; lg[4] += a * w1.x; lg[5] += a * w1.y; lg[6] += a * w1.z; lg[7] += a * w1.w; }
#pragma unroll
                for (int e = 0; e < 8; ++e) lg[e] = wave_sum(lg[e]);
                int e1 = 0; float l1 = lg[0];
#pragma unroll
                for (int e = 1; e < 8; ++e) if (lg[e] > l1) { l1 = lg[e]; e1 = e; }
                int e2 = -1; float l2 = -3.0e38f;
#pragma unroll
                for (int e = 0; e < 8; ++e) if (e != e1 && lg[e] > l2) { l2 = lg[e]; e2 = e; }
                if (lane_ == 0) { const float p2 = 1.0f / (1.0f + ex2((l1 - l2) * LOG2E)); toke[m] = e1 | (e2 << 8); tokg_out[m] = (f32x2){1.0f - p2, p2};
                    atomicAdd((int*)lcnt + e1, 1); atomicAdd((int*)lcnt + e2, 1); }
            }
        }
    }
    if (ROUTE) { __syncthreads(); if (tid_ < 8) cnt_out[C.bid * 8 + tid_] = lcnt[tid_]; }
}

DI void rows_l0_post(const Ctx& C, const bf16* zin, const float* gq, const float* gk, const float* gcq, const float* gckv, const f32x2* taba,
                     bf16* qa, bf16* ka, bf16* cqn, bf16* ckvn, bf16* kr) {
    const int gw = C.bid * NWAVES + C.wave, NGW = C.G * NWAVES, lane = fresh_tid() & 63;
    const int s8 = lane & 7;
    float gqv[8], gkv[8], gcqv[8], gckvv[8];
#pragma unroll
    for (int j = 0; j < 8; ++j) { gqv[j] = gq[8 * s8 + j]; gkv[j] = gk[8 * s8 + j]; gcqv[j] = gcq[8 * (lane & 31) + j]; gckvv[j] = gckv[8 * (lane & 15) + j]; }
    const int part = s8 >> 2, isx2 = (s8 >> 1) & 1, fb = 8 * (s8 & 1);
    for (int tok = gw; tok < NTOK; tok += NGW) {
        const int t = tok & (SEQ - 1), prow = t >> 6, pcol = t & 63;
        const bf16* z = zin + (size_t)tok * ZW;
        float x[8], y[8], p[8];
        unpack8(*(const u32x4*)(z + 8 * lane), x);
        float ss = 0.f;
#pragma unroll
        for (int j = 0; j < 8; ++j) ss += x[j] * x[j];
        ss += __shfl_xor(ss, 1); ss += __shfl_xor(ss, 2); ss += __shfl_xor(ss, 4);
        float ri = rsq(ss * (1.f / 64) + EPS);
#pragma unroll
        for (int j = 0; j < 8; ++j) y[j] = x[j] * ri * gqv[j];
#pragma unroll
        for (int j = 0; j < 8; ++j) p[j] = __shfl_xor(y[j], 2);
        const f32x2* tp = taba + (size_t)(part ? pcol : prow) * 16 + fb;
#pragma unroll
        for (int j = 0; j < 8; ++j) { const f32x2 cs = tp[j]; y[j] = (isx2 ? (y[j] * cs.x + p[j] * cs.y) : (y[j] * cs.x - p[j] * cs.y)) * C2_64; }
        *(u32x4*)(qa + (size_t)tok * 512 + 8 * lane) = pack8(y);
        unpack8(*(const u32x4*)(z + 512 + 8 * lane), x);
        ss = 0.f;
#pragma unroll
        for (int j = 0; j < 8; ++j) ss += x[j] * x[j];
        float s3 = ss; s3 += __shfl_xor(s3, 1); s3 += __shfl_xor(s3, 2); s3 += __shfl_xor(s3, 4);
        float s5 = s3; s5 += __shfl_xor(s5, 8); s5 += __shfl_xor(s5, 16);
        if (lane < 16) {
            ri = rsq(s3 * (1.f / 64) + EPS);
#pragma unroll
            for (int j = 0; j < 8; ++j) y[j] = x[j] * ri * gkv[j];
        } else {
            ri = rsq(s5 * (1.f / 256) + EPS);
#pragma unroll
            for (int j = 0; j < 8; ++j) y[j] = x[j] * ri * gcqv[j];
        }
#pragma unroll
        for (int j = 0; j < 8; ++j) p[j] = __shfl_xor(y[j], 2);
        if (lane < 16) {
#pragma unroll
            for (int j = 0; j < 8; ++j) { const f32x2 cs = tp[j]; y[j] = isx2 ? (y[j] * cs.x + p[j] * cs.y) : (y[j] * cs.x - p[j] * cs.y); }
            *(u32x4*)(ka + (size_t)tok * 128 + 8 * lane) = pack8(y);
        } else if (lane >= 32) {
            *(u32x4*)(cqn + (size_t)tok * 256 + 8 * (lane - 32)) = pack8(y);
        }
        u32x4 w2 = (u32x4){0u, 0u, 0u, 0u};
        if (lane < 32) w2 = *(const u32x4*)(z + 1024 + 8 * lane);
        unpack8(w2, x);
        ss = 0.f;
#pragma unroll
        for (int j = 0; j < 8; ++j) ss += x[j] * x[j];
        ss += __shfl_xor(ss, 1); ss += __shfl_xor(ss, 2); ss += __shfl_xor(ss, 4); ss += __shfl_xor(ss, 8);
#pragma unroll
        for (int j = 0; j < 8; ++j) p[j] = __shfl_xor(x[j], 2);
        if (lane < 16) {
            ri = rsq(ss * (1.f / 128) + EPS);
#pragma unroll
            for (int j = 0; j < 8; ++j) y[j] = x[j] * ri * gckvv[j];
            *(u32x4*)(ckvn + (size_t)tok * 256 + 8 * lane) = pack8(y);
        } else if (lane < 32) {
            *(u32x4*)(ckvn + (size_t)tok * 256 + 8 * lane) = (u32x4){0u, 0u, 0u, 0u};
            if (lane < 20) {
                const int sl = lane - 16; const f32x2* tq = taba + (size_t)t * 16 + 8 * (sl & 1);
#pragma unroll
                for (int j = 0; j < 8; ++j) { const f32x2 cs = tq[j]; y[j] = (sl >> 1) ? (x[j] * cs.x + p[j] * cs.y) : (x[j] * cs.x - p[j] * cs.y); }
                *(u32x4*)(kr + (size_t)tok * 32 + 8 * sl) = pack8(y);
            }
        }
    }
}

DI void rows_merge(const Ctx& C, const bf16* og, const float* lse, bf16* o1) {
    const int gw = C.bid * NWAVES + C.wave, NGW = C.G * NWAVES, lane = fresh_tid() & 63, head = lane >> 3;
    for (int tok = gw; tok < NTOK; tok += NGW) {
        const float l0 = lse[(size_t)tok * 8 + head], l1 = lse[(size_t)(NTOK + tok) * 8 + head], l2 = lse[(size_t)(2 * NTOK + tok) * 8 + head];
        const float mx = fmaxf(l0, fmaxf(l1, l2));
        float w0 = ex2(l0 - mx), w1 = ex2(l1 - mx), w2 = ex2(l2 - mx); const float inv = 1.0f / (w0 + w1 + w2); w0 *= inv; w1 *= inv; w2 *= inv;
        float a[8], b[8], c[8], o[8];
        unpack8(*(const u32x4*)(og + (size_t)tok * 512 + 8 * lane), a);
        unpack8(*(const u32x4*)(og + (size_t)(NTOK + tok) * 512 + 8 * lane), b);
        unpack8(*(const u32x4*)(og + (size_t)(2 * NTOK + tok) * 512 + 8 * lane), c);
#pragma unroll
        for (int j = 0; j < 8; ++j) o[j] = w0 * a[j] + w1 * b[j] + w2 * c[j];
        *(u32x4*)(o1 + (size_t)tok * 512 + 8 * lane) = pack8(o);
    }
}

DI void moe_assign_gather(const Ctx& C, const int* cnt, const int* toke, int* toks, int* tilee, const bf16* xn, bf16* xs) {
    LAS int* L = (LAS int*)C.lds;
    const int lane = fresh_tid() & 63, w = C.bid;
    if (C.wave == 0) {
        int base[8]; int tot[8];
#pragma unroll
        for (int e = 0; e < 8; ++e) { int below = 0, all = 0;
            for (int i = lane; i < C.G; i += 64) { const int c = cnt[i * 8 + e]; all += c; if (i < w) below += c; }
#pragma unroll
            for (int o = 1; o < 64; o <<= 1) { below += __shfl_xor(below, o); all += __shfl_xor(all, o); }
            base[e] = below; tot[e] = all; }
        int start = 0;
#pragma unroll
        for (int e = 0; e < 8; ++e) { const int padded = (tot[e] + 255) & ~255; base[e] += start;
            if (w == 0) { for (int tix = (start >> 8) + lane; tix < ((start + padded) >> 8); tix += 64) tilee[8 + tix] = e; }
            start += padded; }
        if (w == 0 && lane == 0) tilee[0] = start >> 8;
#pragma unroll
        for (int k = 0; k < 4; ++k) {
            const int pidx = 64 * k + lane, tok = 128 * w + (pidx >> 1), kk = pidx & 1;
            const int e = (toke[tok] >> (8 * kk)) & 0xff; int slot = 0;
#pragma unroll
            for (int ee = 0; ee < 8; ++ee) { const unsigned long long mk = __ballot(e == ee); const int rank = __popcll(mk & ((1ull << lane) - 1ull));
                if (e == ee) slot = base[ee] + rank; base[ee] += __popcll(mk); }
            toks[2 * tok + kk] = slot; L[16 + pidx] = slot;
        }
    }
    __syncthreads();
    for (int i = 0; i < 32; ++i) { const int pidx = 32 * C.wave + i, tok = 128 * w + (pidx >> 1), slot = L[16 + pidx];
        const u32x4* src = (const u32x4*)(xn + (size_t)tok * DM) + lane; u32x4* dst = (u32x4*)(xs + (size_t)slot * DM) + lane;
        const u32x4 a = src[0], b = src[64]; dst[0] = a; dst[64] = b; }
    __syncthreads();
}

struct Args { const float* in[27]; float* out; unsigned char* ws; };
enum { I_X = 0, I_P, I_MIXPRE, I_MIXPOST, I_FFNPRE, I_FFNPOST, I_PLEPROJ, I_PLEGN, I_PLEGATE, I_PLEPOST, I_WIN, I_GQ, I_GK, I_GCQ, I_WUQ, I_GCKV, I_WUKV, I_WOUT0,
       I_WG0, I_WU0, I_WD0, I_WQKV1, I_WOUT1, I_WR, I_MWG, I_MWU, I_MWD };

DI const float* arg_in(int i) { const __attribute__((address_space(4))) char* kp = (const __attribute__((address_space(4))) char*)__builtin_amdgcn_kernarg_segment_ptr(); asm volatile("" : "+s"(kp));
    return *(const float* const __attribute__((address_space(4)))*)(kp + 8 * i); }
__global__ void __launch_bounds__(NTHREADS, 2) fwd_kernel(Args a) {
    extern __shared__ __attribute__((aligned(16))) unsigned char lds_raw[];
    LAS unsigned char* lds = (LAS unsigned char*)lds_raw;
    volatile LAS unsigned* MISC = (volatile LAS unsigned*)(lds + MISC_OFF);
    Ctx C; C.wave = __builtin_amdgcn_readfirstlane((int)threadIdx.x >> 6); C.G = gridDim.x; C.bid = blockIdx.x; C.lds = lds;
    unsigned char* ws = a.ws;
#define AIN(i) arg_in(i)
    unsigned* ctl = (unsigned*)(ws + WS_CTL);
    for (int u = threadIdx.x; u < (LDS_BYTES - LDSCTL_OFF) / 4; u += NTHREADS) ((LAS unsigned*)(lds + LDSCTL_OFF))[u] = 0u;
    __syncthreads();
    XcdBarrier bar = xcd_barrier_post(ctl + CW_BAR, MISC + 8);
#define GRID_BAR() xcd_barrier(bar)
    const int gw = C.bid * NWAVES + C.wave, NGW = C.G * NWAVES, NGT = C.G * NTHREADS;
    const f32x2* taba = (const f32x2*)(ws + WS_TABA); const f32x2* tabp = (const f32x2*)(ws + WS_TABP);
    bf16* XN = (bf16*)(ws + WS_XN);
    float* hres = a.out;

    {
        LAS float* scr = (LAS float*)(lds + C.wave * 16384);
        const int tid = fresh_tid(), lane = tid & 63, gtid = C.bid * NTHREADS + tid;
#define TR(Wp, Kd, Nd, dst, ldo, roff, gu) { constexpr int NI_ = ((Kd) / 64) * ((Nd) / 32); if (r < NI_) { transpose_item((Wp), (Kd), (Nd), (bf16*)(dst), (ldo), (roff), (gu), scr, r, lane); continue; } r -= NI_; }
        constexpr int NSMALL = 16 * 37 + 4 * 24 + 2 * 32 + 16 * 32 + 3 * 1792 + 2 * 128 + 2 * 512 + 16 * 144 + 8 * 32;
        for (int it = gw; it < NSMALL; it += NGW) {
            int r = it;
            TR(AIN(I_WIN), 1024, 1184, ws + W_IN, 1024, 0, 0)
            TR(AIN(I_WUQ), 256, 768, ws + W_UQ, 256, 0, 0)
            TR(AIN(I_WUKV), 128, 1024, ws + W_UKV, 256, 0, 0)
            TR(AIN(I_WOUT0), 1024, 1024, ws + W_OUT0, 1024, 0, 0)
            TR(AIN(I_WG0), 1024, 3584, ws + W_GU0, 1024, 0, 1)
            TR(AIN(I_WU0), 1024, 3584, ws + W_GU0, 1024, 0, 2)
            TR(AIN(I_WD0), 3584, 1024, ws + W_D0, 3584, 0, 0)
            TR(AIN(I_PLEPROJ), 256, 1024, ws + W_PP, 256, 0, 0)
            TR(AIN(I_PLEPROJ) + 256 * 1024, 256, 1024, ws + W_PP + 1024 * 256 * 2, 256, 0, 0)
            TR(AIN(I_PLEGATE), 1024, 1024, ws + W_PG, 1024, 0, 0)
            TR(AIN(I_PLEGATE) + 1024 * 1024, 1024, 1024, ws + W_PG + 1024 * 1024 * 2, 1024, 0, 0)
            TR(AIN(I_WQKV1), 1024, 4608, ws + W_QKV1, 1024, 0, 0)
            TR(AIN(I_WOUT1), 512, 1024, ws + W_OUT1, 512, 0, 0)
        }
        for (int i = gtid; i < 12288; i += NGT) ((u32x4*)(ws + W_IN + (size_t)1184 * 1024 * 2))[i] = (u32x4){0u, 0u, 0u, 0u};
        for (int i = gtid; i < 16384; i += NGT) ((u32x4*)(ws + W_UKV))[(size_t)(i >> 4) * 32 + 16 + (i & 15)] = (u32x4){0u, 0u, 0u, 0u};
        for (int i = gtid; i < 2048 * 16; i += NGT) { const int t = i >> 4, f = i & 15; double iv = 1.0; for (int k = 0; k < f; ++k) iv *= 0.56234132519034907; const float ang = (float)t * (float)iv;
            float c, s; sincos_d((double)ang, c, s); ((f32x2*)(ws + WS_TABA))[i] = (f32x2){c, s}; }
        for (int i = gtid; i < 2048 * 8; i += NGT) { const int t = i >> 3, f = i & 7; double iv = 1.0; for (int k = 0; k < f; ++k) iv *= 0.19392274474868576; const float ang = (float)t * (float)iv;
            float c, s; sincos_d((double)ang, c, s); ((f32x2*)(ws + WS_TABP))[i] = (f32x2){c, s}; }
        for (int i = gtid; i < 2 * NTOK * 256 / 8; i += NGT) { const f32x4 u0 = ((const f32x4*)AIN(I_P))[2 * i], u1 = ((const f32x4*)AIN(I_P))[2 * i + 1];
            u32x4 o; o.x = pk2(u0.x, u0.y); o.y = pk2(u0.z, u0.w); o.z = pk2(u1.x, u1.y); o.w = pk2(u1.z, u1.w); ((u32x4*)(ws + WS_PB))[i] = o; }
        rows_norm_only(C, AIN(I_X), AIN(I_MIXPRE), XN);
    }
    GRID_BAR();

    { pg8::Gemm g{XN, (const bf16*)(ws + W_IN), 1024, 1024, 1024}; pg8::StaticOrder S; S.init(NTOK / 256, ZW / 256, C.G, C.bid);
      pg8::EpiStore E{(bf16*)(ws + B_ZIN), ZW, 1.0f}; pg8::gemm_phase(lds, g, S, E); }
    GRID_BAR();
    rows_l0_post(C, (const bf16*)(ws + B_ZIN), AIN(I_GQ), AIN(I_GK), AIN(I_GCQ), AIN(I_GCKV), taba,
                 (bf16*)(ws + B_QA), (bf16*)(ws + B_KA), (bf16*)(ws + B_CQN), (bf16*)(ws + B_CKVN), (bf16*)(ws + B_KR));
    GRID_BAR();
    { pg8::Gemm g{(const bf16*)(ws + B_CQN), (const bf16*)(ws + W_UQ), 256, 256, 256}; pg8::StaticOrder S; S.init(NTOK / 256, 3, C.G, C.bid);
      pg8::EpiStore E{(bf16*)(ws + B_QM), 768, C2_96}; pg8::gemm_phase(lds, g, S, E); }
    { pg8::Gemm g{(const bf16*)(ws + B_CKVN), (const bf16*)(ws + W_UKV), 256, 256, 256}; pg8::StaticOrder S; S.init(NTOK / 256, 4, C.G, C.bid);
      pg8::EpiStore E{(bf16*)(ws + B_KV), 1024, 1.0f}; pg8::gemm_phase(lds, g, S, E); }
    GRID_BAR();
    for (int u = C.bid; u < 1024; u += C.G) {
        const int b = u >> 6, head = (u >> 3) & 7, ch = u & 7, kvh = head >> 2; const size_t rb = (size_t)b * SEQ;
        att::dense_unit<64>(lds, (const bf16*)(ws + B_QA) + rb * 512 + head * 64, 512, 256 * ch, (const bf16*)(ws + B_KA) + rb * 128 + kvh * 64, 128, nullptr,
                            (const bf16*)(ws + B_ZIN) + rb * ZW + 640 + kvh * 64, ZW, (bf16*)(ws + B_O0) + rb * 1024 + head * 64, 1024, taba);
    }
    for (int u = C.bid; u < 1024; u += C.G) {
        const int b = u >> 6, head = (u >> 3) & 7, ch = u & 7; const size_t rb = (size_t)b * SEQ;
        att::dense_unit<96>(lds, (const bf16*)(ws + B_QM) + rb * 768 + head * 96, 768, 256 * ch, (const bf16*)(ws + B_KV) + rb * 1024 + head * 128, 1024, (const bf16*)(ws + B_KR) + rb * 32,
                            (const bf16*)(ws + B_KV) + rb * 1024 + head * 128 + 64, 1024, (bf16*)(ws + B_O0) + rb * 1024 + 512 + head * 64, 1024, taba);
    }
    GRID_BAR();
    { pg8::Gemm g{(const bf16*)(ws + B_O0), (const bf16*)(ws + W_OUT0), 1024, 1024, 1024}; pg8::StaticOrder S; S.init(NTOK / 256, 4, C.G, C.bid);
      pg8::EpiStore E{(bf16*)(ws + B_MO0), 1024, 1.0f}; pg8::gemm_phase(lds, g, S, E); }
    GRID_BAR();
    rows_residual<false, true, false>(C, AIN(I_X), hres, (const bf16*)(ws + B_MO0), AIN(I_MIXPOST), AIN(I_FFNPRE), XN, nullptr, nullptr, nullptr, nullptr, nullptr, nullptr);
    GRID_BAR();
    { pg8::Gemm g{XN, (const bf16*)(ws + W_GU0), 1024, 1024, 1024}; pg8::StaticOrder S; S.init(NTOK / 256, 28, C.G, C.bid);
      pg8::EpiSwiGLU E{(bf16*)(ws + B_HID), DFF}; pg8::gemm_phase(lds, g, S, E); }
    GRID_BAR();
    { pg8::Gemm g{(const bf16*)(ws + B_HID), (const bf16*)(ws + W_D0), DFF, DFF, DFF}; pg8::StaticOrder S; S.init(NTOK / 256, 4, C.G, C.bid);
      pg8::EpiStore E{(bf16*)(ws + B_F), 1024, 1.0f}; pg8::gemm_phase(lds, g, S, E); }
    { pg8::Gemm g{(const bf16*)(ws + WS_PB), (const bf16*)(ws + W_PP), 256, 256, 256}; pg8::StaticOrder S; S.init(NTOK / 256, 4, C.G, C.bid);
      pg8::EpiStore E{(bf16*)(ws + B_E0), 1024, 1.0f}; pg8::gemm_phase(lds, g, S, E); }
    GRID_BAR();
    rows_residual<false, true, false>(C, hres, hres, (const bf16*)(ws + B_F), AIN(I_FFNPOST), AIN(I_PLEGN), XN, nullptr, nullptr, nullptr, nullptr, nullptr, nullptr);
    GRID_BAR();
    { pg8::Gemm g{XN, (const bf16*)(ws + W_PG), 1024, 1024, 1024}; pg8::StaticOrder S; S.init(NTOK / 256, 4, C.G, C.bid);
      pg8::EpiPleGate E{(const bf16*)(ws + B_E0), (bf16*)(ws + B_E), 1024}; pg8::gemm_phase(lds, g, S, E); }
    GRID_BAR();
    rows_residual<false, true, false>(C, hres, hres, (const bf16*)(ws + B_E), AIN(I_PLEPOST), AIN(I_MIXPRE) + DM, XN, nullptr, nullptr, nullptr, nullptr, nullptr, nullptr);
    GRID_BAR();

    { pg8::Gemm g{XN, (const bf16*)(ws + W_QKV1), 1024, 1024, 1024}; pg8::StaticOrder S; S.init(NTOK / 256, 18, C.G, C.bid);
      pg8::EpiQKV1 E{(bf16*)(ws + B_QKV), tabp}; pg8::gemm_phase(lds, g, S, E); }
    GRID_BAR();
    for (int u = C.bid; u < 3072; u += C.G) {
        const int grp = u >> 10, idx = u & 1023, b = idx >> 6, head = (idx >> 3) & 7;
        const int res = grp == 0 ? 0 : (grp == 1 ? ((idx >> 1) & 3) : (idx & 7)), ch = grp == 0 ? (idx & 7) : (grp == 1 ? (idx & 1) : 0);
        att::dil_unit(lds, grp, b, head, res, ch, (const bf16*)(ws + B_QKV), (bf16*)(ws + B_OG) + (size_t)grp * NTOK * 512, (float*)(ws + WS_LSE) + (size_t)grp * NTOK * 8);
    }
    GRID_BAR();
    rows_merge(C, (const bf16*)(ws + B_OG), (const float*)(ws + WS_LSE), (bf16*)(ws + B_O1));
    {
        LAS float* scr = (LAS float*)(lds + C.wave * 16384);
        const int lane = fresh_tid() & 63;
        for (int it = gw; it < 3 * 8 * 1792; it += NGW) {
            const int kind = it / (8 * 1792), e = (it / 1792) & 7, r = it % 1792;
            if (kind == 0) transpose_item(AIN(I_MWG) + (size_t)e * 1024 * DFF, 1024, DFF, (bf16*)(ws + B_WGU) + (size_t)e * 7168 * 1024, 1024, 0, 1, scr, r, lane);
            else if (kind == 1) transpose_item(AIN(I_MWU) + (size_t)e * 1024 * DFF, 1024, DFF, (bf16*)(ws + B_WGU) + (size_t)e * 7168 * 1024, 1024, 0, 2, scr, r, lane);
            else transpose_item(AIN(I_MWD) + (size_t)e * DFF * 1024, DFF, 1024, (bf16*)(ws + B_WD) + (size_t)e * 1024 * DFF, DFF, 0, 0, scr, r, lane);
        }
    }
    GRID_BAR();
    { pg8::Gemm g{(const bf16*)(ws + B_O1), (const bf16*)(ws + W_OUT1), 512, 512, 512}; pg8::StaticOrder S; S.init(NTOK / 256, 4, C.G, C.bid);
      pg8::EpiStore E{(bf16*)(ws + B_MO1), 1024, 1.0f}; pg8::gemm_phase(lds, g, S, E); }
    GRID_BAR();
    rows_residual<false, true, true>(C, hres, hres, (const bf16*)(ws + B_MO1), AIN(I_MIXPOST) + DM, AIN(I_FFNPRE) + DM, XN, nullptr, nullptr, AIN(I_WR),
                                     (int*)(ws + WS_TOKE), (f32x2*)(ws + WS_TOKG), (int*)(ws + WS_CNT));
    GRID_BAR();
    moe_assign_gather(C, (const int*)(ws + WS_CNT), (const int*)(ws + WS_TOKE), (int*)(ws + WS_TOKS), (int*)(ws + WS_TILEE), XN, (bf16*)(ws + B_XS));
    GRID_BAR();
    {
        const int* tilee = (const int*)(ws + WS_TILEE);
        const int ntiles = __builtin_amdgcn_readfirstlane(tilee[0]);
        for (int c = 0; c < 5; ++c) {
            const int tile0 = 64 * c; int ntl = ntiles - tile0; if (ntl <= 0) break; if (ntl > 64) ntl = 64;
            { pg8::Gemm g{(const bf16*)(ws + B_XS), (const bf16*)(ws + B_WGU), 1024, 1024, 1024};
              pg8::MoeOrder S; S.so.init(ntl, 28, C.G, C.bid); S.tile_e = tilee + 8; S.tile0 = tile0; S.nbt = 28; S.a_global = true;
              pg8::EpiSwiGLU E{(bf16*)(ws + B_HC), DFF}; pg8::gemm_phase(lds, g, S, E); }
            GRID_BAR();
            { pg8::Gemm g{(const bf16*)(ws + B_HC), (const bf16*)(ws + B_WD), DFF, DFF, DFF};
              pg8::MoeOrder S; S.so.init(ntl, 4, C.G, C.bid); S.tile_e = tilee + 8; S.tile0 = tile0; S.nbt = 4; S.a_global = false;
              pg8::EpiStore E{(bf16*)(ws + B_XS), 1024, 1.0f}; pg8::gemm_phase(lds, g, S, E); }
            GRID_BAR();
        }
    }
    rows_residual<true, true, false>(C, hres, hres, (const bf16*)(ws + B_XS), AIN(I_FFNPOST) + DM, AIN(I_PLEGN) + DM, XN, (const int*)(ws + WS_TOKS), (const f32x2*)(ws + WS_TOKG),
                                     nullptr, nullptr, nullptr, nullptr);
    { pg8::Gemm g{(const bf16*)(ws + WS_PB) + (size_t)NTOK * 256, (const bf16*)(ws + W_PP) + 1024 * 256, 256, 256, 256}; pg8::StaticOrder S; S.init(NTOK / 256, 4, C.G, C.bid);
      pg8::EpiStore E{(bf16*)(ws + B_E0b), 1024, 1.0f}; pg8::gemm_phase(lds, g, S, E); }
    GRID_BAR();
    { pg8::Gemm g{XN, (const bf16*)(ws + W_PG) + 1024 * 1024, 1024, 1024, 1024}; pg8::StaticOrder S; S.init(NTOK / 256, 4, C.G, C.bid);
      pg8::EpiPleGate E{(const bf16*)(ws + B_E0b), (bf16*)(ws + B_Eb), 1024}; pg8::gemm_phase(lds, g, S, E); }
    GRID_BAR();
    rows_residual<false, false, false>(C, hres, hres, (const bf16*)(ws + B_Eb), AIN(I_PLEPOST) + DM, nullptr, nullptr, nullptr, nullptr, nullptr, nullptr, nullptr, nullptr);
#undef TR
#undef GRID_BAR
#undef AIN
}

extern "C" void kernel_launch(void* const* d_in, const int* in_sizes, int n_in, void* d_out, int out_size, void* d_ws, size_t ws_size, hipStream_t stream) {
    static int grid = 0;
    if (grid == 0) {
        if (n_in != 27 || in_sizes[0] != NTOK * DM || out_size != NTOK * DM || ws_size < WS_END) { fprintf(stderr, "kernel_launch: unexpected shapes / workspace (%zu < %zu)\n", ws_size, (size_t)WS_END); grid = -1; return; }
        int dev = 0, cus = 0;
        if (hipGetDevice(&dev) != hipSuccess || hipDeviceGetAttribute(&cus, hipDeviceAttributeMultiprocessorCount, dev) != hipSuccess) { grid = -1; return; }
        if (hipFuncSetAttribute((const void*)fwd_kernel, hipFuncAttributeMaxDynamicSharedMemorySize, LDS_BYTES) != hipSuccess) { fprintf(stderr, "kernel_launch: hipFuncSetAttribute failed\n"); grid = -1; return; }
        int per_cu = 0;
        if (hipOccupancyMaxActiveBlocksPerMultiprocessor(&per_cu, (const void*)fwd_kernel, NTHREADS, LDS_BYTES) != hipSuccess || per_cu < 1) fprintf(stderr, "kernel_launch: occupancy query reports %d\n", per_cu);
        (void)hipGetLastError();
        if (cus != 256) { fprintf(stderr, "kernel_launch: built for 256 CUs, device has %d\n", cus); grid = -1; return; }
        grid = cus;
    }
    if (grid < 0) return;
    (void)hipMemsetAsync((char*)d_ws + WS_CTL, 0, CTL_ZERO_BYTES, stream);
    Args a{};
    for (int i = 0; i < 27; ++i) a.in[i] = (const float*)d_in[i];
    a.out = (float*)d_out; a.ws = (unsigned char*)d_ws;
    hipLaunchKernelGGL(fwd_kernel, dim3(grid), dim3(NTHREADS), LDS_BYTES, stream, a);
}
```

```cpp
#include <hip/hip_runtime.h>
#include <cstdio>
#include <cstdint>

#define DI __device__ __forceinline__
#define LAS __attribute__((address_space(3)))
#define GAS __attribute__((address_space(1)))
typedef unsigned short bf16;
typedef short bf16x8 __attribute__((ext_vector_type(8)));
typedef short s16x4 __attribute__((ext_vector_type(4)));
typedef float f32x2 __attribute__((ext_vector_type(2)));
typedef float f32x4 __attribute__((ext_vector_type(4)));
typedef float f32x16 __attribute__((ext_vector_type(16)));
typedef unsigned u32x2 __attribute__((ext_vector_type(2)));
typedef unsigned u32x4 __attribute__((ext_vector_type(4)));
typedef __bf16 bf16x2_t __attribute__((ext_vector_type(2)));

constexpr int BATCH = 16, SEQ = 2048, DM = 1024, NTOK = BATCH * SEQ;
constexpr int ZW = 1280;
constexpr int DFF = 3584, NEXP = 8;
constexpr int QKVW = 4608;
constexpr float EPS = 1e-6f;
constexpr float LOG2E = 1.4426950408889634f;
constexpr float C2_64 = 0.125f * LOG2E;
constexpr float C2_96 = 0.10206207261596577f * LOG2E;
constexpr int NWAVES = 8, NTHREADS = 512;
constexpr int MAXTILES = 264;
constexpr int NSLOTS = MAXTILES * 256;

constexpr size_t MiB = 1u << 20;
constexpr size_t WS_CTL = 0, CTL_ZERO_BYTES = 64 * 1024;
constexpr size_t WS_TABA = 1 * MiB;
constexpr size_t WS_TABP = WS_TABA + 2048 * 16 * 8;
constexpr size_t WS_TOKE = 2 * MiB;
constexpr size_t WS_TOKG = WS_TOKE + NTOK * 4;
constexpr size_t WS_TOKS = WS_TOKG + NTOK * 8;
constexpr size_t WS_CNT = WS_TOKS + NTOK * 8;
constexpr size_t WS_TILEE = WS_CNT + 256 * 8 * 4;
constexpr size_t WS_LSE = 3 * MiB;
constexpr size_t WS_W = 6 * MiB;
constexpr size_t W_IN = WS_W;
constexpr size_t W_UQ = W_IN + (size_t)ZW * 1024 * 2;
constexpr size_t W_UKV = W_UQ + 768 * 256 * 2;
constexpr size_t W_OUT0 = W_UKV + 1024 * 256 * 2;
constexpr size_t W_GU0 = W_OUT0 + 1024 * 1024 * 2;
constexpr size_t W_D0 = W_GU0 + (size_t)7168 * 1024 * 2;
constexpr size_t W_PP = W_D0 + (size_t)1024 * 3584 * 2;
constexpr size_t W_PG = W_PP + 2 * 1024 * 256 * 2;
constexpr size_t W_QKV1 = W_PG + 2 * 1024 * 1024 * 2;
constexpr size_t W_OUT1 = W_QKV1 + (size_t)QKVW * 1024 * 2;
constexpr size_t W_END = W_OUT1 + 1024 * 512 * 2;
constexpr size_t WS_PB = 48 * MiB;
constexpr size_t WS_XN = 80 * MiB;
constexpr size_t WS_BIG = 144 * MiB;
static_assert(W_END <= WS_PB, "weights");
constexpr size_t B_ZIN = WS_BIG;
constexpr size_t B_QA = WS_BIG + 80 * MiB;
constexpr size_t B_KA = WS_BIG + 112 * MiB;
constexpr size_t B_CQN = WS_BIG + 120 * MiB;
constexpr size_t B_CKVN = WS_BIG + 136 * MiB;
constexpr size_t B_KR = WS_BIG + 152 * MiB;
constexpr size_t B_QM = WS_BIG + 154 * MiB;
constexpr size_t B_KV = WS_BIG + 202 * MiB;
constexpr size_t B_O0 = WS_BIG + 266 * MiB;
constexpr size_t B_MO0 = WS_BIG;
constexpr size_t B_HID = WS_BIG;
constexpr size_t B_F = WS_BIG + 224 * MiB;
constexpr size_t B_E0 = WS_BIG + 288 * MiB;
constexpr size_t B_E = WS_BIG;
constexpr size_t B_QKV = WS_BIG;
constexpr size_t B_OG = WS_BIG + 288 * MiB;
constexpr size_t B_O1 = WS_BIG + 388 * MiB;
constexpr size_t B_MO1 = WS_BIG + 288 * MiB;
constexpr size_t B_WGU = WS_BIG;
constexpr size_t B_WD = WS_BIG + 56 * MiB;
constexpr size_t B_XS = WS_BIG + 84 * MiB;
constexpr size_t B_Y = WS_BIG + 152 * MiB;
constexpr size_t B_HC = WS_BIG + 356 * MiB;
constexpr size_t B_E0b = WS_BIG + 356 * MiB;
constexpr size_t B_Eb = WS_BIG;
constexpr size_t WS_END = WS_BIG + 420 * MiB;

constexpr int CW_BAR = 1024;

constexpr int RING_BYTES = 133120;
constexpr int LDSCTL_OFF = RING_BYTES, MISC_OFF = LDSCTL_OFF + 320;
constexpr int LDS_BYTES = 147456;

DI float bf2f(unsigned short v) { return __uint_as_float((unsigned)v << 16); }
DI unsigned pk2(float lo, float hi) { f32x2 v = {lo, hi}; bf16x2_t b = __builtin_convertvector(v, bf16x2_t); return __builtin_bit_cast(unsigned, b); }
DI float wave_sum(float v) {
#pragma unroll
    for (int o = 1; o < 64; o <<= 1) v += __shfl_xor(v, o);
    return v;
}
DI int fresh_tid() { int t = threadIdx.x; asm volatile("" : "+v"(t)); return t; }
DI float ex2(float x) { return __builtin_amdgcn_exp2f(x); }
DI float rsq(float x) { return 1.0f / sqrtf(x); }
DI void unpack8(u32x4 w, float (&x)[8]) {
    x[0] = __uint_as_float(w.x << 16); x[1] = __uint_as_float(w.x & 0xffff0000u);
    x[2] = __uint_as_float(w.y << 16); x[3] = __uint_as_float(w.y & 0xffff0000u);
    x[4] = __uint_as_float(w.z << 16); x[5] = __uint_as_float(w.z & 0xffff0000u);
    x[6] = __uint_as_float(w.w << 16); x[7] = __uint_as_float(w.w & 0xffff0000u);
}
DI u32x4 pack8(const float (&x)[8]) { u32x4 w; w.x = pk2(x[0], x[1]); w.y = pk2(x[2], x[3]); w.z = pk2(x[4], x[5]); w.w = pk2(x[6], x[7]); return w; }

namespace pg8 {
constexpr int BM = 256, BK = 64, HALF = 128, HTB = HALF * BK * 2, STAGE_BYTES = 8 * HTB, NXCD = 8, WGM = 8;
__host__ __device__ __forceinline__ int lds_byte(int r, int c) { const int st = (r >> 4) * 2 + (c >> 5), rr = r & 15, cc = c & 31, ob = rr * 64 + cc * 2; return st * 1024 + (ob ^ (((ob >> 9) & 1) << 5)); }
__host__ __device__ __forceinline__ void stage_rc(int b, int& R, int& C) { const int st = b / 1024, sb = b % 1024, swz = sb ^ (((sb >> 9) & 1) << 5); R = (st >> 1) * 16 + swz / 64; C = (st & 1) * 32 + (swz % 64) / 2; }
__host__ __device__ __forceinline__ int perm32(int rho) { const int n = rho >> 4, i = rho & 15; return 8 * (i >> 2) + 4 * n + (i & 3); }

struct Unit { int pm, pn, pa, pb; };
struct Gemm { const bf16* A; const bf16* Bt; int lda, ldb, K; };

struct StaticOrder {
    int nM, nN, nwg, G, c;
    DI void init(int nM_, int nN_, int G_, int c_) { nM = nM_; nN = nN_; nwg = nM * nN; G = G_; c = c_; }
    DI bool map(int i, int& pm, int& pn) const {
        const long L = (long)i * G + c; if (L >= nwg) return false;
        int wgid = (int)L; { const int q = nwg / NXCD, r = nwg % NXCD, xcd = wgid % NXCD, off = wgid / NXCD; wgid = (xcd < r ? xcd * (q + 1) : r * (q + 1) + (xcd - r) * q) + off; }
        const int nig = WGM * nN, gid = wgid / nig, fm = gid * WGM, gsz = (nM - fm) < WGM ? (nM - fm) : WGM;
        pm = fm + ((wgid % nig) % gsz); pn = (wgid % nig) / gsz; return true;
    }
    DI bool next(int i, Unit& u) const { int pm, pn; if (!map(i, pm, pn)) return false; u.pm = pm; u.pn = pn; u.pa = pm; u.pb = pn; return true; }
};
struct MoeOrder {
    StaticOrder so; const int* tile_e; int tile0, nbt; bool a_global;
    DI bool next(int i, Unit& u) const {
        int pm, pn; if (!so.map(i, pm, pn)) return false;
        const int e = __builtin_amdgcn_readfirstlane(tile_e[tile0 + pm]);
        u.pn = pn; u.pb = e * nbt + pn;
        if (a_global) { u.pa = tile0 + pm; u.pm = pm; } else { u.pa = pm; u.pm = tile0 + pm; }
        return true;
    }
};

struct EpiStore {
    bf16* O; int ldc; float scale;
    DI void operator()(const f32x4 (&acc)[2][2][4][2], const Unit& u, int wr, int wc, int fr, int fq) const {
        const int row0 = u.pm * BM + wr * 64 + fr, col0 = u.pn * BM + wc * 32 + 8 * fq;
#pragma unroll
        for (int ai = 0; ai < 2; ++ai)
#pragma unroll
            for (int m = 0; m < 4; ++m) { bf16* rowp = O + (size_t)(row0 + ai * HALF + m * 16) * ldc + col0;
#pragma unroll
                for (int bj = 0; bj < 2; ++bj) { const f32x4 v0 = acc[ai][bj][m][0] * scale, v1 = acc[ai][bj][m][1] * scale;
                    u32x4 w; w.x = pk2(v0[0], v0[1]); w.y = pk2(v0[2], v0[3]); w.z = pk2(v1[0], v1[1]); w.w = pk2(v1[2], v1[3]);
                    *(u32x4*)(rowp + bj * HALF) = w; } }
    }
};
DI float silu_mul(float g, float u) { return g * u / (1.0f + ex2(-g * LOG2E)); }
struct EpiSwiGLU {
    bf16* H; int ldh;
    DI void operator()(const f32x4 (&acc)[2][2][4][2], const Unit& u, int wr, int wc, int fr, int fq) const {
        const int row0 = u.pm * BM + wr * 64 + fr, col0 = u.pn * HALF + wc * 32 + 8 * fq;
#pragma unroll
        for (int ai = 0; ai < 2; ++ai)
#pragma unroll
            for (int m = 0; m < 4; ++m) { bf16* rowp = H + (size_t)(row0 + ai * HALF + m * 16) * ldh + col0;
                const f32x4 g0 = acc[ai][0][m][0], g1 = acc[ai][0][m][1], u0 = acc[ai][1][m][0], u1 = acc[ai][1][m][1];
                u32x4 w; w.x = pk2(silu_mul(g0[0], u0[0]), silu_mul(g0[1], u0[1])); w.y = pk2(silu_mul(g0[2], u0[2]), silu_mul(g0[3], u0[3]));
                w.z = pk2(silu_mul(g1[0], u1[0]), silu_mul(g1[1], u1[1])); w.w = pk2(silu_mul(g1[2], u1[2]), silu_mul(g1[3], u1[3]));
                *(u32x4*)rowp = w; }
    }
};
DI unsigned pk4_fp8(float a, float b, float c, float d) {
    a = __builtin_fminf(__builtin_fmaxf(a, -448.f), 448.f); b = __builtin_fminf(__builtin_fmaxf(b, -448.f), 448.f); c = __builtin_fminf(__builtin_fmaxf(c, -448.f), 448.f); d = __builtin_fminf(__builtin_fmaxf(d, -448.f), 448.f);
    int w = 0; w = __builtin_amdgcn_cvt_pk_fp8_f32(a, b, w, false); w = __builtin_amdgcn_cvt_pk_fp8_f32(c, d, w, true); return (unsigned)w; }
struct EpiSwiGLU8 {
    unsigned char* H; int ldh;
    DI void operator()(const f32x4 (&acc)[2][2][4][2], const Unit& u, int wr, int wc, int fr, int fq) const {
        const int row0 = u.pm * BM + wr * 64 + fr, col0 = u.pn * HALF + wc * 32 + 8 * fq;
#pragma unroll
        for (int ai = 0; ai < 2; ++ai)
#pragma unroll
            for (int m = 0; m < 4; ++m) { unsigned char* rowp = H + (size_t)(row0 + ai * HALF + m * 16) * ldh + col0;
                const f32x4 g0 = acc[ai][0][m][0], g1 = acc[ai][0][m][1], u0 = acc[ai][1][m][0] * 8.0f, u1 = acc[ai][1][m][1] * 8.0f;
                u32x2 w; w.x = pk4_fp8(silu_mul(g0[0], u0[0]), silu_mul(g0[1], u0[1]), silu_mul(g0[2], u0[2]), silu_mul(g0[3], u0[3]));
                w.y = pk4_fp8(silu_mul(g1[0], u1[0]), silu_mul(g1[1], u1[1]), silu_mul(g1[2], u1[2]), silu_mul(g1[3], u1[3]));
                *(u32x2*)rowp = w; }
    }
};
struct EpiPleGate {
    const bf16* E0; bf16* E; int ldc;
    DI void operator()(const f32x4 (&acc)[2][2][4][2], const Unit& u, int wr, int wc, int fr, int fq) const {
        const int row0 = u.pm * BM + wr * 64 + fr, col0 = u.pn * BM + wc * 32 + 8 * fq;
#pragma unroll
        for (int ai = 0; ai < 2; ++ai)
#pragma unroll
            for (int m = 0; m < 4; ++m) { const size_t off = (size_t)(row0 + ai * HALF + m * 16) * ldc + col0;
#pragma unroll
                for (int bj = 0; bj < 2; ++bj) { const u32x4 ew = *(const u32x4*)(E0 + off + bj * HALF); float e[8]; unpack8(ew, e);
                    const f32x4 v0 = acc[ai][bj][m][0], v1 = acc[ai][bj][m][1]; float o[8];
#pragma unroll
                    for (int j = 0; j < 4; ++j) { o[j] = e[j] / (1.0f + ex2(-v0[j] * LOG2E)); o[4 + j] = e[4 + j] / (1.0f + ex2(-v1[j] * LOG2E)); }
                    *(u32x4*)(E + off + bj * HALF) = pack8(o); } }
    }
};
struct EpiQKV1 {
    bf16* O; const f32x2* tabp;
    DI void operator()(const f32x4 (&acc)[2][2][4][2], const Unit& u, int wr, int wc, int fr, int fq) const {
        const int row0 = u.pm * BM + wr * 64 + fr, col0 = u.pn * BM + wc * 32 + 8 * fq;
        const int which = ((u.pn * BM) % 1536) / 512;
        const float sc = which == 0 ? C2_64 : 1.0f;
        const bool rot = which < 2;
        const bool mine = ((wc & 1) == 0) && (fq < 2);
#pragma unroll
        for (int ai = 0; ai < 2; ++ai)
#pragma unroll
            for (int m = 0; m < 4; ++m) { const int row = row0 + ai * HALF + m * 16; bf16* rowp = O + (size_t)row * QKVW + col0;
                const f32x2* tp = tabp + (size_t)(row & (SEQ - 1)) * 8;
#pragma unroll
                for (int bj = 0; bj < 2; ++bj) { float v[8];
#pragma unroll
                    for (int j = 0; j < 4; ++j) { v[j] = acc[ai][bj][m][0][j]; v[4 + j] = acc[ai][bj][m][1][j]; }
                    if (rot) {
                        float p[8];
#pragma unroll
                        for (int j = 0; j < 8; ++j) p[j] = __shfl_xor(v[j], 16);
                        if (mine) {
#pragma unroll
                            for (int j = 0; j < 8; ++j) { const f32x2 cs = tp[j]; v[j] = (fq == 0) ? (v[j] * cs.x - p[j] * cs.y) : (v[j] * cs.x + p[j] * cs.y); }
                        }
                    }
#pragma unroll
                    for (int j = 0; j < 8; ++j) v[j] *= sc;
                    *(u32x4*)(rowp + bj * HALF) = pack8(v); } }
    }
};

typedef int v8i32 __attribute__((ext_vector_type(8)));
typedef int v4i32 __attribute__((ext_vector_type(4)));
DI v8i32 cat8(bf16x8 lo, bf16x8 hi) { const v4i32 a = __builtin_bit_cast(v4i32, lo), b = __builtin_bit_cast(v4i32, hi); return __builtin_shufflevector(a, b, 0, 1, 2, 3, 4, 5, 6, 7); }
template <class Epi, class Sched, bool FP8 = false>
DI void gemm_phase(LAS unsigned char* lds, const Gemm g, const Sched& S, const Epi& E, const int scw = 0x7f7f7f7f, const int sca = 0x7f7f7f7f) {
    const int tid = fresh_tid(), wid = __builtin_amdgcn_readfirstlane(tid >> 6), lane = tid & 63, wr = wid >> 2, wc = wid & 3, fr = lane & 15, fq = lane >> 4;
    const int K = g.K; int nt = K / BK; if constexpr (FP8) asm volatile("" : "+s"(nt));
    unsigned voffA[2], voffB[2];
#pragma unroll
    for (int i = 0; i < 2; ++i) { int R, C; stage_rc(tid * 16 + i * 8192, R, C); const int Rb = (R & ~31) + perm32(R & 31);
        voffA[i] = (unsigned)(R * g.lda + C) * 2u; voffB[i] = (unsigned)(Rb * g.ldb + C) * 2u; }
    const size_t kstep = (size_t)(BK * 2);
    const size_t hstepA = (size_t)HALF * g.lda * 2, hstepB = (size_t)HALF * g.ldb * 2;
    const size_t tstepA = 2 * hstepA, tstepB = 2 * hstepB;
    const unsigned ldsw = (unsigned)wid * 1024u;
    const int aoff = lds_byte(wr * 64 + fr, fq * 8), boff = lds_byte(wc * 32 + fr, fq * 8);
#define PG8_SA(b, h) (((b) * 2 + (h)) * HTB)
#define PG8_SB(b, h) ((4 + (b) * 2 + (h)) * HTB)
#define PG8_STAGE(bufoff, gbase, voff) do { _Pragma("unroll") for (int _i = 0; _i < 2; ++_i) \
        __builtin_amdgcn_global_load_lds((const unsigned*)((const char*)(gbase) + (voff)[_i]), (LAS unsigned*)(lds + (bufoff) + ldsw + _i * 8192), 16, 0, 0); } while (0)
#define PG8_LDA(dst, b, h) do { _Pragma("unroll") for (int m = 0; m < 4; ++m) { \
        if constexpr (FP8) dst##8[m] = cat8(*(const LAS bf16x8*)(lds + PG8_SA(b, h) + aoff + m * 2048), *(const LAS bf16x8*)(lds + PG8_SA(b, h) + aoff + m * 2048 + 1024)); \
        else { _Pragma("unroll") for (int k = 0; k < 2; ++k) dst[m][k] = *(const LAS bf16x8*)(lds + PG8_SA(b, h) + aoff + m * 2048 + k * 1024); } } } while (0)
#define PG8_LDB(dst, b, h) do { _Pragma("unroll") for (int n = 0; n < 2; ++n) { \
        if constexpr (FP8) dst##8[n] = cat8(*(const LAS bf16x8*)(lds + PG8_SB(b, h) + boff + n * 2048), *(const LAS bf16x8*)(lds + PG8_SB(b, h) + boff + n * 2048 + 1024)); \
        else { _Pragma("unroll") for (int k = 0; k < 2; ++k) dst[n][k] = *(const LAS bf16x8*)(lds + PG8_SB(b, h) + boff + n * 2048 + k * 1024); } } } while (0)
#define PG8_MMA(ai, bj, At, Bt) do { __builtin_amdgcn_s_setprio(1); _Pragma("unroll") for (int m = 0; m < 4; ++m) _Pragma("unroll") for (int n = 0; n < 2; ++n) { \
        if constexpr (FP8) asm volatile("s_nop 1\n\tv_mfma_scale_f32_16x16x128_f8f6f4 %0, %1, %2, %0, %3, %4 op_sel_hi:[0,0,0]" : "+v"(acc[ai][bj][m][n]) : "v"(Bt##8[n]), "v"(At##8[m]), "v"(scw), "v"(sca)); \
        else { _Pragma("unroll") for (int k = 0; k < 2; ++k) acc[ai][bj][m][n] = __builtin_amdgcn_mfma_f32_16x16x32_bf16(Bt[n][k], At[m][k], acc[ai][bj][m][n], 0, 0, 0); } } \
        __builtin_amdgcn_s_setprio(0); } while (0)
#define PG8_WAIT_V(n) asm volatile("s_waitcnt vmcnt(" #n ")" ::: "memory")
#define PG8_WAIT_L(n) asm volatile("s_waitcnt lgkmcnt(" #n ")" ::: "memory")
#define PG8_BAR __builtin_amdgcn_s_barrier()
#define PG8_SCHED __builtin_amdgcn_sched_barrier(0)
    Unit cur, nxt; int ui = 0;
    if (!S.next(0, cur)) return;
    f32x4 acc[2][2][4][2];
#pragma unroll
    for (int a = 0; a < 2; ++a)
#pragma unroll
        for (int b = 0; b < 2; ++b)
#pragma unroll
            for (int m = 0; m < 4; ++m)
#pragma unroll
                for (int n = 0; n < 2; ++n) acc[a][b][m][n] = (f32x4){0.f, 0.f, 0.f, 0.f};
    bf16x8 At[4][2], B0[2][2], B1[2][2]; v8i32 At8[4], B08[2], B18[2];
    const char* cA = (const char*)g.A + (size_t)cur.pa * tstepA; const char* cB = (const char*)g.Bt + (size_t)cur.pb * tstepB;
    PG8_STAGE(PG8_SB(0, 0), cB, voffB); PG8_STAGE(PG8_SB(0, 1), cB + hstepB, voffB); PG8_STAGE(PG8_SA(0, 0), cA, voffA); PG8_STAGE(PG8_SA(0, 1), cA + hstepA, voffA);
    if (wr == 1) PG8_BAR;
    PG8_WAIT_V(2); PG8_BAR;
    PG8_STAGE(PG8_SB(1, 0), cB + kstep, voffB); PG8_STAGE(PG8_SA(1, 0), cA + kstep, voffA); PG8_STAGE(PG8_SB(1, 1), cB + hstepB + kstep, voffB);
    PG8_WAIT_V(6); PG8_BAR;
    for (;;) {
        const bool has_next = S.next(ui + 1, nxt);
        const char* nA = has_next ? (const char*)g.A + (size_t)nxt.pa * tstepA : cA; const char* nB = has_next ? (const char*)g.Bt + (size_t)nxt.pb * tstepB : cB;
        for (int t = 0; t < nt; t += 2) {
            const bool last = (t == nt - 2);
            const char* a1 = cA + (size_t)(t + 1) * kstep;
            const char* a2 = last ? nA : cA + (size_t)(t + 2) * kstep; const char* b2 = last ? nB : cB + (size_t)(t + 2) * kstep;
            const char* a3 = a2 + kstep; const char* b3 = b2 + kstep;
            PG8_LDB(B0, 0, 0); PG8_LDB(B1, 0, 1); PG8_SCHED; PG8_LDA(At, 0, 0); PG8_STAGE(PG8_SA(1, 1), a1 + hstepA, voffA);
            PG8_WAIT_V(8); PG8_WAIT_L(0); PG8_BAR; PG8_MMA(0, 0, At, B0); PG8_MMA(0, 1, At, B1); PG8_BAR; PG8_SCHED;
            PG8_LDA(At, 0, 1); PG8_STAGE(PG8_SB(0, 0), b2, voffB); PG8_STAGE(PG8_SB(0, 1), b2 + hstepB, voffB); PG8_STAGE(PG8_SA(0, 0), a2, voffA);
            PG8_WAIT_V(8); PG8_WAIT_L(0); PG8_BAR; PG8_MMA(1, 0, At, B0); PG8_MMA(1, 1, At, B1); PG8_BAR; PG8_SCHED;
            PG8_LDB(B0, 1, 0); PG8_LDB(B1, 1, 1); PG8_SCHED; PG8_LDA(At, 1, 0); PG8_STAGE(PG8_SA(0, 1), a2 + hstepA, voffA);
            PG8_WAIT_V(8); PG8_WAIT_L(0); PG8_BAR; PG8_MMA(0, 0, At, B0); PG8_MMA(0, 1, At, B1); PG8_BAR; PG8_SCHED;
            PG8_LDA(At, 1, 1); PG8_STAGE(PG8_SB(1, 0), b3, voffB); PG8_STAGE(PG8_SB(1, 1), b3 + hstepB, voffB); PG8_STAGE(PG8_SA(1, 0), a3, voffA);
            PG8_WAIT_V(8); PG8_WAIT_L(0); PG8_BAR; PG8_MMA(1, 0, At, B0); PG8_MMA(1, 1, At, B1); PG8_BAR; PG8_SCHED;
        }
        if (wr == 0) PG8_BAR;
        if constexpr (FP8) asm volatile("s_nop 15\n\ts_nop 15" ::: "memory");
        E(acc, cur, wr, wc, fr, fq);
        if (!has_next) break;
#pragma unroll
        for (int a = 0; a < 2; ++a)
#pragma unroll
            for (int b = 0; b < 2; ++b)
#pragma unroll
                for (int m = 0; m < 4; ++m)
#pragma unroll
                    for (int n = 0; n < 2; ++n) acc[a][b][m][n] = (f32x4){0.f, 0.f, 0.f, 0.f};
        cur = nxt; cA = nA; cB = nB; ++ui;
        if (wr == 1) PG8_BAR;
    }
    PG8_WAIT_V(0);
    PG8_BAR;
#undef PG8_SA
#undef PG8_SB
#undef PG8_STAGE
#undef PG8_LDA
#undef PG8_LDB
#undef PG8_MMA
#undef PG8_WAIT_V
#undef PG8_WAIT_L
#undef PG8_BAR
#undef PG8_SCHED
}
}

namespace att {
#define MFMA32(a, b, c) __builtin_amdgcn_mfma_f32_32x32x16_bf16((a), (b), (c), 0, 0, 0)
DI int crow(int i, int h) { return (i & 3) + 8 * (i >> 2) + 4 * h; }
typedef short v4i16_t __attribute__((ext_vector_type(4)));
DI s16x4 vtr(const LAS unsigned char* p) { return __builtin_bit_cast(s16x4, __builtin_amdgcn_ds_read_tr16_b64_v4i16((LAS v4i16_t*)p)); }
DI bf16x8 packp(const f32x16& p, int b) {
    u32x4 w; w.x = pk2(p[b], p[b + 1]); w.y = pk2(p[b + 2], p[b + 3]); w.z = pk2(p[b + 4], p[b + 5]); w.w = pk2(p[b + 6], p[b + 7]);
    return __builtin_bit_cast(bf16x8, w);
}
constexpr float NEGBIG = -1.0e30f;
template <int DK, bool MASK>
DI void tile_step(const LAS unsigned char* Kb, const LAS unsigned char* Vb, const bf16x8 (&qr)[DK / 16], f32x16& o0, f32x16& o1, float& m, float& l,
                  LAS float* wsf, int r, int h, int lane, int qi, int kj0) {
    f32x16 p0, p1;
#pragma unroll
    for (int i = 0; i < 16; ++i) { p0[i] = 0.f; p1[i] = 0.f; }
    const LAS unsigned char* kp = Kb + h * 1024 + r * 16;
#pragma unroll
    for (int ks = 0; ks < DK / 16; ++ks) {
        const bf16x8 a0 = *(const LAS bf16x8*)(kp + ks * 2048);
        const bf16x8 a1 = *(const LAS bf16x8*)(kp + ks * 2048 + 512);
        p0 = MFMA32(a0, qr[ks], p0); p1 = MFMA32(a1, qr[ks], p1);
    }
    if (MASK) {
#pragma unroll
        for (int i = 0; i < 16; ++i) { const int d0 = qi - (kj0 + crow(i, h)), d1 = d0 - 32;
            if (d0 > 64 || d0 < -64) p0[i] = NEGBIG; if (d1 > 64 || d1 < -64) p1[i] = NEGBIG; }
    }
    float tm = fmaxf(p0[0], p1[0]);
#pragma unroll
    for (int i = 1; i < 16; ++i) tm = fmaxf(tm, fmaxf(p0[i], p1[i]));
    tm = fmaxf(tm, __shfl_xor(tm, 32));
    const float mn = fmaxf(m, tm);
    if (__any(mn > m)) {
        const float al = ex2(m - mn); l *= al; m = mn;
        if (h == 0) wsf[r] = al;
#pragma unroll
        for (int i = 0; i < 16; ++i) { const float f = wsf[crow(i, h)]; o0[i] *= f; o1[i] *= f; }
    }
    float sum = 0.f;
#pragma unroll
    for (int i = 0; i < 16; ++i) { p0[i] = ex2(p0[i] - m); p1[i] = ex2(p1[i] - m); sum += p0[i] + p1[i]; }
    l += sum;
    const LAS unsigned char* vp = Vb + ((lane >> 4) & 1) * 32 + (lane & 3) * 8 + (4 * h + ((lane & 15) >> 2)) * 64;
#pragma unroll
    for (int s = 0; s < 4; ++s) {
        const bf16x8 pa = (s == 0) ? packp(p0, 0) : (s == 1) ? packp(p0, 8) : (s == 2) ? packp(p1, 0) : packp(p1, 8);
#pragma unroll
        for (int db = 0; db < 2; ++db) {
            const s16x4 lo = vtr(vp + db * 4096 + s * 1024), hi = vtr(vp + db * 4096 + s * 1024 + 512);
            const bf16x8 vf = {lo[0], lo[1], lo[2], lo[3], hi[0], hi[1], hi[2], hi[3]};
            if (db == 0) o0 = MFMA32(pa, vf, o0); else o1 = MFMA32(pa, vf, o1);
        }
    }
}
DI void finish_store(const f32x16& o0, const f32x16& o1, float l, LAS float* wsf, LAS unsigned short* stg, int r, int h, int lane, bf16* orow0, size_t rstride) {
    const float lt = l + __shfl_xor(l, 32);
    if (h == 0) wsf[r] = 1.0f / lt;
#pragma unroll
    for (int i = 0; i < 16; ++i) { const int row = crow(i, h); const float f = wsf[row];
        stg[row * 64 + r] = (unsigned short)(pk2(o0[i] * f, 0.f) & 0xffffu); stg[row * 64 + 32 + r] = (unsigned short)(pk2(o1[i] * f, 0.f) & 0xffffu); }
#pragma unroll
    for (int it = 0; it < 4; ++it) { const int row = it * 8 + (lane >> 3), ch = lane & 7;
        const u32x4 v = *(const LAS u32x4*)(stg + row * 64 + ch * 8);
        *(u32x4*)(orow0 + (size_t)row * rstride + ch * 8) = v; }
}
#define ATT_WAITBAR(N) asm volatile("s_waitcnt vmcnt(" #N ") lgkmcnt(0)\n\ts_barrier" ::: "memory")
DI void dma16(const void* gsrc, LAS unsigned char* ldst) { __builtin_amdgcn_global_load_lds((const unsigned*)gsrc, (LAS unsigned*)ldst, 16, 0, 0); }

template <int DK>
DI void dense_unit(LAS unsigned char* lds, const bf16* qS, int qp, int q0, const bf16* kA, int kpA, const bf16* kB, const bf16* vS, int vpitch, bf16* oS, int op, const f32x2* taba) {
    constexpr int NKC = DK / 8, KSLOT = NKC * 1024, VSLOT = 8192, NS = 3;
    constexpr int OFF_V = NS * KSLOT, OFF_WS = OFF_V + NS * VSLOT, OFF_STG = OFF_WS + NWAVES * 256;
    const int tid = fresh_tid(), lane = tid & 63, r = lane & 31, h = lane >> 5; const int w = __builtin_amdgcn_readfirstlane(tid >> 6);
    LAS float* wsf = (LAS float*)(lds + OFF_WS) + w * 64;
    LAS unsigned short* stg = (LAS unsigned short*)(lds + OFF_STG) + w * 2048;
    const bf16* ksrcA = kA + (size_t)lane * kpA + w * 8;
    const bf16* ksrcB = (DK == 96) ? (kB + (size_t)lane * 32 + (w & 3) * 8) : kA;
    const bf16* vsrc = vS + (size_t)(16 * (w & 3) + (lane >> 2)) * vpitch + (w >> 2) * 32 + (lane & 3) * 8;
    const size_t kstA = (size_t)64 * kpA, kstB = 64 * 32, vst = (size_t)64 * vpitch;
#define DENSE_ISSUE(t) do { const int sl_ = (t) % NS; \
        dma16(ksrcA + (size_t)(t) * kstA, lds + sl_ * KSLOT + w * 1024); \
        if (DK == 96) dma16(ksrcB + (size_t)(t) * kstB, lds + sl_ * KSLOT + (8 + (w & 3)) * 1024); \
        dma16(vsrc + (size_t)(t) * vst, lds + OFF_V + sl_ * VSLOT + w * 1024); } while (0)
    bf16x8 qr[DK / 16];
    const bf16* qrow = qS + (size_t)(q0 + w * 32 + r) * qp + 8 * h;
#pragma unroll
    for (int ks = 0; ks < DK / 16; ++ks) qr[ks] = *(const bf16x8*)(qrow + 16 * ks);
    DENSE_ISSUE(0); DENSE_ISSUE(1);
    if (DK == 96) {
        const f32x2* tp = taba + (size_t)(q0 + w * 32 + r) * 16 + 8 * h;
        bf16x8 a = qr[4], b = qr[5];
#pragma unroll
        for (int j = 0; j < 8; ++j) { const f32x2 cs = tp[j]; const float x1 = bf2f((unsigned short)a[j]), x2 = bf2f((unsigned short)b[j]);
            a[j] = (short)(pk2(x1 * cs.x - x2 * cs.y, 0.f) & 0xffffu); b[j] = (short)(pk2(x2 * cs.x + x1 * cs.y, 0.f) & 0xffffu); }
        qr[4] = a; qr[5] = b;
    }
    f32x16 o0, o1;
#pragma unroll
    for (int i = 0; i < 16; ++i) { o0[i] = 0.f; o1[i] = 0.f; }
    float m = NEGBIG, l = 0.f;
    constexpr int NT = SEQ / 64;
    for (int t = 0; t < NT; ++t) {
        if (t + 1 < NT) { if (DK == 96) ATT_WAITBAR(3); else ATT_WAITBAR(2); } else ATT_WAITBAR(0);
        if (t + 2 < NT) DENSE_ISSUE(t + 2);
        const int sl = t % NS;
        tile_step<DK, false>(lds + sl * KSLOT, lds + OFF_V + sl * VSLOT, qr, o0, o1, m, l, wsf, r, h, lane, 0, 0);
    }
    finish_store(o0, o1, l, wsf, stg, r, h, lane, oS + (size_t)(q0 + w * 32) * op, (size_t)op);
    ATT_WAITBAR(0);
#undef DENSE_ISSUE
}

DI void dil_unit(LAS unsigned char* lds, int grp, int b, int head, int res, int c, const bf16* qkv, bf16* og, float* lse) {
    constexpr int SLOT = 16384, OFF_WS = 6 * SLOT, OFF_STG = OFF_WS + NWAVES * 256;
    const int tid = fresh_tid(), lane = tid & 63, r = lane & 31, h = lane >> 5; const int w = __builtin_amdgcn_readfirstlane(tid >> 6);
    LAS float* wsf = (LAS float*)(lds + OFF_WS) + w * 64;
    LAS unsigned short* stg = (LAS unsigned short*)(lds + OFF_STG) + w * 2048;
    const int dil = grp == 0 ? 1 : (grp == 1 ? 4 : 16), ntile = SEQ / dil / 64;
    const bf16* base = qkv + (size_t)b * SEQ * QKVW + grp * 1536 + head * 64;
#pragma unroll
    for (int s = 0; s < 6; ++s) {
        int sres, kb; bool valid;
        if (grp < 2) { sres = res; kb = 4 * c - 1 + s; valid = (kb >= 0) && (kb < ntile); }
        else { sres = 2 * res + (s >> 1); kb = s & 1; valid = s < 4; }
        if (valid) {
            const int krow = 64 * kb + lane, vrow = 64 * kb + 16 * (w & 3) + (lane >> 2);
            dma16(base + (size_t)(sres + dil * krow) * QKVW + 512 + w * 8, lds + s * SLOT + w * 1024);
            dma16(base + (size_t)(sres + dil * vrow) * QKVW + 1024 + (w >> 2) * 32 + (lane & 3) * 8, lds + s * SLOT + 8192 + w * 1024);
        }
    }
    int wres, qi0, s0, kb0, nts;
    if (grp < 2) { wres = res; qi0 = 256 * c + 32 * w; s0 = w >> 1; kb0 = 4 * c + (w >> 1) - 1; nts = 3; }
    else { wres = 2 * res + (w >> 2); qi0 = 32 * (w & 3); s0 = 2 * (w >> 2); kb0 = 0; nts = 2; }
    bf16x8 qr[4];
    const bf16* qrow = base + (size_t)(wres + dil * (qi0 + r)) * QKVW + 8 * h;
#pragma unroll
    for (int ks = 0; ks < 4; ++ks) qr[ks] = *(const bf16x8*)(qrow + 16 * ks);
    f32x16 o0, o1;
#pragma unroll
    for (int i = 0; i < 16; ++i) { o0[i] = 0.f; o1[i] = 0.f; }
    float m = NEGBIG, l = 0.f;
    ATT_WAITBAR(0);
    for (int j = 0; j < nts; ++j) {
        const int kb = kb0 + j;
        if (kb >= 0 && kb < ntile) {
            const LAS unsigned char* sp = lds + (s0 + j) * SLOT;
            tile_step<64, true>(sp, sp + 8192, qr, o0, o1, m, l, wsf, r, h, lane, qi0 + r, 64 * kb);
        }
    }
    const size_t tok0 = (size_t)b * SEQ + wres + (size_t)dil * qi0;
    finish_store(o0, o1, l, wsf, stg, r, h, lane, og + tok0 * 512 + head * 64, (size_t)dil * 512);
    const float lt = l + __shfl_xor(l, 32);
    if (h == 0) lse[(tok0 + (size_t)dil * r) * 8 + head] = m + __builtin_amdgcn_logf(lt);
    ATT_WAITBAR(0);
}
}

#define XB_TMO      128
#define XB_XCNT(j)  (256  + 64 * (j))
#define XB_XSUB(j)  (1280 + 64 * (j))
#define XB_XGEN(j)  (2304 + 64 * (j))
#define XB_TOP      3328
#define XB_TOPGEN   3392
#define XCD_BAR_WORDS 3456
#define XB_SPIN_CAP (1u << 18)
DI unsigned xb_ld(unsigned* p)              { return __hip_atomic_load(p, __ATOMIC_RELAXED, __HIP_MEMORY_SCOPE_AGENT); }
DI unsigned xb_add(unsigned* p, unsigned v) { return __hip_atomic_fetch_add(p, v, __ATOMIC_RELAXED, __HIP_MEMORY_SCOPE_AGENT); }
DI unsigned xb_xcc_id() { return (unsigned)__builtin_amdgcn_s_getreg((3 << 11) | 20) & 0xFu; }
#define XB_SPIN(cond, bar) do { unsigned _sp = 0; while (cond) { __builtin_amdgcn_s_sleep(1); \
    if ((++_sp & 255u) == 0u) { if (xb_ld(&(bar)[XB_TMO])) break; if (_sp > XB_SPIN_CAP) { atomicAdd(&(bar)[XB_TMO], 1u); break; } } } } while (0)
struct XcdBarrier { unsigned* bar; unsigned x; volatile LAS unsigned* st; };
DI XcdBarrier xcd_barrier_post(unsigned* bar, volatile LAS unsigned* st) {
    XcdBarrier b; b.bar = bar; b.x = xb_xcc_id(); b.st = st;
    if (threadIdx.x == 0) (void)xb_add(&bar[XB_XCNT(b.x)], 1u);
    return b;
}
DI void xcd_barrier_complete(unsigned* bar, unsigned x, unsigned& nloc, unsigned& nx) {
    const unsigned G = gridDim.x * gridDim.y * gridDim.z;
    unsigned sum, cnt, mine, sp = 0u;
    for (;;) {
        sum = 0u; cnt = 0u; mine = 0u;
#pragma unroll
        for (unsigned j = 0; j < 16; ++j) { const unsigned c = xb_ld(&bar[XB_XCNT(j)]); sum += c; cnt += (c > 0u) ? 1u : 0u; mine = (j == x) ? c : mine; }
        if (sum == G) break;
        __builtin_amdgcn_s_sleep(1);
        if ((++sp & 255u) == 0u) { if (xb_ld(&bar[XB_TMO])) break; if (sp > XB_SPIN_CAP) { atomicAdd(&bar[XB_TMO], 1u); break; } }
    }
    nloc = mine > 0u ? mine : 1u; nx = cnt > 0u ? cnt : 1u;
}
DI void xcd_barrier(const XcdBarrier& b) {
    asm volatile("s_waitcnt vmcnt(0)" ::: "memory");
    __syncthreads();
    if (threadIdx.x == 0) {
        unsigned* bar = b.bar;
        __builtin_amdgcn_s_waitcnt(0);
        unsigned nloc = b.st[0], nx = b.st[1];
        if (nloc == 0u) { xcd_barrier_complete(bar, b.x, nloc, nx); b.st[0] = nloc; b.st[1] = nx; }
        const unsigned old = xb_add(&bar[XB_XSUB(b.x)], 1u);
        const unsigned gen = old / nloc;
        if (old + 1u == (gen + 1u) * nloc) {
            __builtin_amdgcn_fence(__ATOMIC_RELEASE, "agent");
            asm volatile("s_waitcnt vmcnt(0)" ::: "memory");
            const unsigned og = xb_add(&bar[XB_TOP], 1u);
            const unsigned tg = og / nx;
            if (og + 1u == (tg + 1u) * nx) xb_add(&bar[XB_TOPGEN], 1u);
            else XB_SPIN(xb_ld(&bar[XB_TOPGEN]) == tg, bar);
            __builtin_amdgcn_fence(__ATOMIC_ACQUIRE, "agent");
            xb_add(&bar[XB_XGEN(b.x)], 1u);
            asm volatile("s_waitcnt vmcnt(0)" ::: "memory");
        } else {
            XB_SPIN(xb_ld(&bar[XB_XGEN(b.x)]) == gen, bar);
            __builtin_amdgcn_fence(__ATOMIC_ACQUIRE, "agent");
            asm volatile("s_waitcnt vmcnt(0)" ::: "memory");
        }
    }
    __syncthreads();
}

struct Ctx { int wave, G, bid; LAS unsigned char* lds; };

template <bool F8>
DI void transpose_item(const float* W, int K, int N, void* WTv, int ldo, int row_off, int gu, LAS float* scr, int item, int lane) {
    const int nblk = N / 32, kb = item / nblk, nb = item % nblk, k0 = 64 * kb, n0 = 32 * nb;
    float v[32];
    const float* src = W + (size_t)(k0 + (lane >> 5)) * N + n0 + (lane & 31);
#pragma unroll
    for (int i = 0; i < 32; ++i) v[i] = src[(size_t)(2 * i) * N];
#pragma unroll
    for (int i = 0; i < 32; ++i) scr[(2 * i + (lane >> 5)) * 33 + (lane & 31)] = v[i];
    asm volatile("s_waitcnt lgkmcnt(0)" ::: "memory");
    const int c = lane & 7;
    const int orow0 = row_off + (gu == 0 ? n0 : ((n0 >> 7) * 256 + (gu - 1) * 128 + (n0 & 127)));
#pragma unroll
    for (int j = 0; j < 4; ++j) { const int n = (lane >> 3) + 8 * j; const LAS float* s = scr + (8 * c) * 33 + n;
        if (F8) { u32x2 o; o.x = pg8::pk4_fp8(64.f * s[0 * 33], 64.f * s[1 * 33], 64.f * s[2 * 33], 64.f * s[3 * 33]); o.y = pg8::pk4_fp8(64.f * s[4 * 33], 64.f * s[5 * 33], 64.f * s[6 * 33], 64.f * s[7 * 33]);
            *(u32x2*)((unsigned char*)WTv + (size_t)(orow0 + n) * ldo + k0 + 8 * c) = o; }
        else { u32x4 o; o.x = pk2(s[0 * 33], s[1 * 33]); o.y = pk2(s[2 * 33], s[3 * 33]); o.z = pk2(s[4 * 33], s[5 * 33]); o.w = pk2(s[6 * 33], s[7 * 33]);
            *(u32x4*)((bf16*)WTv + (size_t)(orow0 + n) * ldo + k0 + 8 * c) = o; } }
    asm volatile("s_waitcnt lgkmcnt(0)" ::: "memory");
}

DI void sincos_d(double a, float& c, float& s) {
    const double TWO_PI = 6.283185307179586476925286766559, INV = 0.15915494309189533576888376337251;
    const double n = __builtin_rint(a * INV); double x = (a - n * TWO_PI) * 0.25; const double x2 = x * x;
    double sn = x * (1.0 + x2 * (-1.0 / 6 + x2 * (1.0 / 120 + x2 * (-1.0 / 5040 + x2 * (1.0 / 362880 + x2 * (-1.0 / 39916800 + x2 * (1.0 / 6227020800.0)))))));
    double cs = 1.0 + x2 * (-0.5 + x2 * (1.0 / 24 + x2 * (-1.0 / 720 + x2 * (1.0 / 40320 + x2 * (-1.0 / 3628800 + x2 * (1.0 / 479001600.0))))));
#pragma unroll
    for (int i = 0; i < 2; ++i) { const double s2 = 2.0 * sn * cs, c2 = cs * cs - sn * sn; sn = s2; cs = c2; }
    c = (float)cs; s = (float)sn;
}

DI void rows_norm_only(const Ctx& C, const float* x, const float* g, bf16* xn) {
    const int gw = C.bid * NWAVES + C.wave, NGW = C.G * NWAVES, lane = fresh_tid() & 63;
    f32x4 gv[4];
#pragma unroll
    for (int j = 0; j < 4; ++j) gv[j] = *((const f32x4*)g + lane + 64 * j);
    for (int m = gw; m < NTOK; m += NGW) {
        const f32x4* xr = (const f32x4*)(x + (size_t)m * DM) + lane;
        f32x4 v[4]; float s = 0.f;
#pragma unroll
        for (int j = 0; j < 4; ++j) { v[j] = xr[64 * j]; s += (v[j].x * v[j].x + v[j].y * v[j].y) + (v[j].z * v[j].z + v[j].w * v[j].w); }
        const float ri = rsq(wave_sum(s) * (1.f / DM) + EPS);
        u32x2* o8 = (u32x2*)(xn + (size_t)m * DM) + lane;
#pragma unroll
        for (int j = 0; j < 4; ++j) { const f32x4 y = v[j] * ri * gv[j]; u32x2 o; o.x = pk2(y.x, y.y); o.y = pk2(y.z, y.w); o8[64 * j] = o; }
    }
}

template <bool MOE, bool NEXT, bool ROUTE>
DI void rows_residual(const Ctx& C, const float* hold, float* hout, const bf16* term, const float* gpost, const float* gnext, bf16* xn,
                      const int* toks, const f32x2* tokg, const float* wrouter, int* toke, f32x2* tokg_out, int* cnt_out) {
    const int gw = C.bid * NWAVES + C.wave, NGW = C.G * NWAVES, tid_ = fresh_tid(), lane_ = tid_ & 63;
    f32x4 gp[4], gn[4];
#pragma unroll
    for (int j = 0; j < 4; ++j) { gp[j] = *((const f32x4*)gpost + lane_ + 64 * j); gn[j] = NEXT ? *((const f32x4*)gnext + lane_ + 64 * j) : (f32x4){0.f, 0.f, 0.f, 0.f}; }
    LAS int* lcnt = (LAS int*)C.lds;
    if (ROUTE) { if (tid_ < 8) lcnt[tid_] = 0; __syncthreads(); }
    const int rows_per_wave = NTOK / NGW;
    const int nrows = ROUTE ? rows_per_wave : (NTOK - gw + NGW - 1) / NGW;
    for (int it = 0; it < nrows; ++it) {
        const int m = ROUTE ? (gw * rows_per_wave + it) : (gw + it * NGW);
        f32x4 t[4];
        if (MOE) {
            const int s1 = toks[2 * m], s2 = toks[2 * m + 1]; const f32x2 gg = tokg[m];
            const u32x2* y1 = (const u32x2*)(term + (size_t)s1 * DM) + lane_; const u32x2* y2 = (const u32x2*)(term + (size_t)s2 * DM) + lane_;
#pragma unroll
            for (int j = 0; j < 4; ++j) { const u32x2 a = y1[64 * j], b = y2[64 * j];
                t[j].x = gg.x * __uint_as_float(a.x << 16) + gg.y * __uint_as_float(b.x << 16); t[j].y = gg.x * __uint_as_float(a.x & 0xffff0000u) + gg.y * __uint_as_float(b.x & 0xffff0000u);
                t[j].z = gg.x * __uint_as_float(a.y << 16) + gg.y * __uint_as_float(b.y << 16); t[j].w = gg.x * __uint_as_float(a.y & 0xffff0000u) + gg.y * __uint_as_float(b.y & 0xffff0000u); }
        } else {
            const u32x2* tr = (const u32x2*)(term + (size_t)m * DM) + lane_;
#pragma unroll
            for (int j = 0; j < 4; ++j) { const u32x2 a = tr[64 * j]; t[j].x = __uint_as_float(a.x << 16); t[j].y = __uint_as_float(a.x & 0xffff0000u); t[j].z = __uint_as_float(a.y << 16); t[j].w = __uint_as_float(a.y & 0xffff0000u); }
        }
        const f32x4* hr = (const f32x4*)(hold + (size_t)m * DM) + lane_;
        f32x4 hv[4]; float s = 0.f;
#pragma unroll
        for (int j = 0; j < 4; ++j) { hv[j] = hr[64 * j]; s += (t[j].x * t[j].x + t[j].y * t[j].y) + (t[j].z * t[j].z + t[j].w * t[j].w); }
        const float ri = rsq(wave_sum(s) * (1.f / DM) + EPS);
        f32x4* ho = (f32x4*)(hout + (size_t)m * DM) + lane_; float s2 = 0.f;
#pragma unroll
        for (int j = 0; j < 4; ++j) { hv[j] = hv[j] + t[j] * ri * gp[j]; ho[64 * j] = hv[j]; s2 += (hv[j].x * hv[j].x + hv[j].y * hv[j].y) + (hv[j].z * hv[j].z + hv[j].w * hv[j].w); }
        if (NEXT) {
            const float r2 = rsq(wave_sum(s2) * (1.f / DM) + EPS);
            u32x2* o8 = (u32x2*)(xn + (size_t)m * DM) + lane_;
#pragma unroll
            for (int j = 0; j < 4; ++j) { hv[j] = hv[j] * r2 * gn[j]; u32x2 o; o.x = pk2(hv[j].x, hv[j].y); o.y = pk2(hv[j].z, hv[j].w); o8[64 * j] = o; }
            if (ROUTE) {
                float lg[8];
#pragma unroll
                for (int e = 0; e < 8; ++e) lg[e] = 0.f;
#pragma unroll
                for (int j = 0; j < 4; ++j)
#pragma unroll
                    for (int q = 0; q < 4; ++q) { const f32x4* wp = (const f32x4*)(wrouter + (size_t)(4 * lane_ + 256 * j + q) * 8); const f32x4 w0 = wp[0], w1 = wp[1]; const float a = hv[j][q];
                        lg[0] += a * w0.x; lg[1] += a * w0.y; lg[2] += a * w0.z; lg[3] += a * w0.w; lg[4] += a * w1.x; lg[5] += a * w1.y; lg[6] += a * w1.z; lg[7] += a * w1.w; }
#pragma unroll
                for (int e = 0; e < 8; ++e) lg[e] = wave_sum(lg[e]);
                int e1 = 0; float l1 = lg[0];
#pragma unroll
                for (int e = 1; e < 8; ++e) if (lg[e] > l1) { l1 = lg[e]; e1 = e; }
                int e2 = -1; float l2 = -3.0e38f;
#pragma unroll
                for (int e = 0; e < 8; ++e) if (e != e1 && lg[e] > l2) { l2 = lg[e]; e2 = e; }
                if (lane_ == 0) { const float p2 = 1.0f / (1.0f + ex2((l1 - l2) * LOG2E)); toke[m] = e1 | (e2 << 8); tokg_out[m] = (f32x2){1.0f - p2, p2};
                    atomicAdd((int*)lcnt + e1, 1); atomicAdd((int*)lcnt + e2, 1); }
            }
        }
    }
    if (ROUTE) { __syncthreads(); if (tid_ < 8) cnt_out[C.bid * 8 + tid_] = lcnt[tid_]; }
}

DI void rows_l0_post(const Ctx& C, const bf16* zin, const float* gq, const float* gk, const float* gcq, const float* gckv, const f32x2* taba,
                     bf16* qa, bf16* ka, bf16* cqn, bf16* ckvn, bf16* kr) {
    const int gw = C.bid * NWAVES + C.wave, NGW = C.G * NWAVES, lane = fresh_tid() & 63;
    const int s8 = lane & 7;
    float gqv[8], gkv[8], gcqv[8], gckvv[8];
#pragma unroll
    for (int j = 0; j < 8; ++j) { gqv[j] = gq[8 * s8 + j]; gkv[j] = gk[8 * s8 + j]; gcqv[j] = gcq[8 * (lane & 31) + j]; gckvv[j] = gckv[8 * (lane & 15) + j]; }
    const int part = s8 >> 2, isx2 = (s8 >> 1) & 1, fb = 8 * (s8 & 1);
    for (int tok = gw; tok < NTOK; tok += NGW) {
        const int t = tok & (SEQ - 1), prow = t >> 6, pcol = t & 63;
        const bf16* z = zin + (size_t)tok * ZW;
        float x[8], y[8], p[8];
        unpack8(*(const u32x4*)(z + 8 * lane), x);
        float ss = 0.f;
#pragma unroll
        for (int j = 0; j < 8; ++j) ss += x[j] * x[j];
        ss += __shfl_xor(ss, 1); ss += __shfl_xor(ss, 2); ss += __shfl_xor(ss, 4);
        float ri = rsq(ss * (1.f / 64) + EPS);
#pragma unroll
        for (int j = 0; j < 8; ++j) y[j] = x[j] * ri * gqv[j];
#pragma unroll
        for (int j = 0; j < 8; ++j) p[j] = __shfl_xor(y[j], 2);
        const f32x2* tp = taba + (size_t)(part ? pcol : prow) * 16 + fb;
#pragma unroll
        for (int j = 0; j < 8; ++j) { const f32x2 cs = tp[j]; y[j] = (isx2 ? (y[j] * cs.x + p[j] * cs.y) : (y[j] * cs.x - p[j] * cs.y)) * C2_64; }
        *(u32x4*)(qa + (size_t)tok * 512 + 8 * lane) = pack8(y);
        unpack8(*(const u32x4*)(z + 512 + 8 * lane), x);
        ss = 0.f;
#pragma unroll
        for (int j = 0; j < 8; ++j) ss += x[j] * x[j];
        float s3 = ss; s3 += __shfl_xor(s3, 1); s3 += __shfl_xor(s3, 2); s3 += __shfl_xor(s3, 4);
        float s5 = s3; s5 += __shfl_xor(s5, 8); s5 += __shfl_xor(s5, 16);
        if (lane < 16) {
            ri = rsq(s3 * (1.f / 64) + EPS);
#pragma unroll
            for (int j = 0; j < 8; ++j) y[j] = x[j] * ri * gkv[j];
        } else {
            ri = rsq(s5 * (1.f / 256) + EPS);
#pragma unroll
            for (int j = 0; j < 8; ++j) y[j] = x[j] * ri * gcqv[j];
        }
#pragma unroll
        for (int j = 0; j < 8; ++j) p[j] = __shfl_xor(y[j], 2);
        if (lane < 16) {
#pragma unroll
            for (int j = 0; j < 8; ++j) { const f32x2 cs = tp[j]; y[j] = isx2 ? (y[j] * cs.x + p[j] * cs.y) : (y[j] * cs.x - p[j] * cs.y); }
            *(u32x4*)(ka + (size_t)tok * 128 + 8 * lane) = pack8(y);
        } else if (lane >= 32) {
            *(u32x4*)(cqn + (size_t)tok * 256 + 8 * (lane - 32)) = pack8(y);
        }
        u32x4 w2 = (u32x4){0u, 0u, 0u, 0u};
        if (lane < 32) w2 = *(const u32x4*)(z + 1024 + 8 * lane);
        unpack8(w2, x);
        ss = 0.f;
#pragma unroll
        for (int j = 0; j < 8; ++j) ss += x[j] * x[j];
        ss += __shfl_xor(ss, 1); ss += __shfl_xor(ss, 2); ss += __shfl_xor(ss, 4); ss += __shfl_xor(ss, 8);
#pragma unroll
        for (int j = 0; j < 8; ++j) p[j] = __shfl_xor(x[j], 2);
        if (lane < 16) {
            ri = rsq(ss * (1.f / 128) + EPS);
#pragma unroll
            for (int j = 0; j < 8; ++j) y[j] = x[j] * ri * gckvv[j];
            *(u32x4*)(ckvn + (size_t)tok * 256 + 8 * lane) = pack8(y);
        } else if (lane < 32) {
            *(u32x4*)(ckvn + (size_t)tok * 256 + 8 * lane) = (u32x4){0u, 0u, 0u, 0u};
            if (lane < 20) {
                const int sl = lane - 16; const f32x2* tq = taba + (size_t)t * 16 + 8 * (sl & 1);
#pragma unroll
                for (int j = 0; j < 8; ++j) { const f32x2 cs = tq[j]; y[j] = (sl >> 1) ? (x[j] * cs.x + p[j] * cs.y) : (x[j] * cs.x - p[j] * cs.y); }
                *(u32x4*)(kr + (size_t)tok * 32 + 8 * sl) = pack8(y);
            }
        }
    }
}

DI void rows_merge(const Ctx& C, const bf16* og, const float* lse, bf16* o1) {
    const int gw = C.bid * NWAVES + C.wave, NGW = C.G * NWAVES, lane = fresh_tid() & 63, head = lane >> 3;
    for (int tok = gw; tok < NTOK; tok += NGW) {
        const float l0 = lse[(size_t)tok * 8 + head], l1 = lse[(size_t)(NTOK + tok) * 8 + head], l2 = lse[(size_t)(2 * NTOK + tok) * 8 + head];
        const float mx = fmaxf(l0, fmaxf(l1, l2));
        float w0 = ex2(l0 - mx), w1 = ex2(l1 - mx), w2 = ex2(l2 - mx); const float inv = 1.0f / (w0 + w1 + w2); w0 *= inv; w1 *= inv; w2 *= inv;
        float a[8], b[8], c[8], o[8];
        unpack8(*(const u32x4*)(og + (size_t)tok * 512 + 8 * lane), a);
        unpack8(*(const u32x4*)(og + (size_t)(NTOK + tok) * 512 + 8 * lane), b);
        unpack8(*(const u32x4*)(og + (size_t)(2 * NTOK + tok) * 512 + 8 * lane), c);
#pragma unroll
        for (int j = 0; j < 8; ++j) o[j] = w0 * a[j] + w1 * b[j] + w2 * c[j];
        *(u32x4*)(o1 + (size_t)tok * 512 + 8 * lane) = pack8(o);
    }
}

DI void moe_assign_gather(const Ctx& C, const int* cnt, const int* toke, int* toks, int* tilee, const bf16* xn, unsigned char* xs) {
    LAS int* L = (LAS int*)C.lds;
    const int lane = fresh_tid() & 63, w = C.bid;
    if (C.wave == 0) {
        int base[8]; int tot[8];
#pragma unroll
        for (int e = 0; e < 8; ++e) { int below = 0, all = 0;
            for (int i = lane; i < C.G; i += 64) { const int c = cnt[i * 8 + e]; all += c; if (i < w) below += c; }
#pragma unroll
            for (int o = 1; o < 64; o <<= 1) { below += __shfl_xor(below, o); all += __shfl_xor(all, o); }
            base[e] = below; tot[e] = all; }
        int start = 0;
#pragma unroll
        for (int e = 0; e < 8; ++e) { const int padded = (tot[e] + 255) & ~255; base[e] += start;
            if (w == 0) { for (int tix = (start >> 8) + lane; tix < ((start + padded) >> 8); tix += 64) tilee[8 + tix] = e; }
            start += padded; }
        if (w == 0 && lane == 0) tilee[0] = start >> 8;
#pragma unroll
        for (int k = 0; k < 4; ++k) {
            const int pidx = 64 * k + lane, tok = 128 * w + (pidx >> 1), kk = pidx & 1;
            const int e = (toke[tok] >> (8 * kk)) & 0xff; int slot = 0;
#pragma unroll
            for (int ee = 0; ee < 8; ++ee) { const unsigned long long mk = __ballot(e == ee); const int rank = __popcll(mk & ((1ull << lane) - 1ull));
                if (e == ee) slot = base[ee] + rank; base[ee] += __popcll(mk); }
            toks[2 * tok + kk] = slot; L[16 + pidx] = slot;
        }
    }
    __syncthreads();
    for (int i = 0; i < 32; ++i) { const int pidx = 32 * C.wave + i, tok = 128 * w + (pidx >> 1), slot = L[16 + pidx];
        const u32x4* src = (const u32x4*)(xn + (size_t)tok * DM) + 2 * lane; const u32x4 a = src[0], b = src[1]; float x[8], y[8]; unpack8(a, x); unpack8(b, y);
        u32x4 o; o.x = pg8::pk4_fp8(x[0], x[1], x[2], x[3]); o.y = pg8::pk4_fp8(x[4], x[5], x[6], x[7]); o.z = pg8::pk4_fp8(y[0], y[1], y[2], y[3]); o.w = pg8::pk4_fp8(y[4], y[5], y[6], y[7]);
        *((u32x4*)(xs + (size_t)slot * DM) + lane) = o; }
    __syncthreads();
}

struct Args { const float* in[27]; float* out; unsigned char* ws; };
enum { I_X = 0, I_P, I_MIXPRE, I_MIXPOST, I_FFNPRE, I_FFNPOST, I_PLEPROJ, I_PLEGN, I_PLEGATE, I_PLEPOST, I_WIN, I_GQ, I_GK, I_GCQ, I_WUQ, I_GCKV, I_WUKV, I_WOUT0,
       I_WG0, I_WU0, I_WD0, I_WQKV1, I_WOUT1, I_WR, I_MWG, I_MWU, I_MWD };

DI const float* arg_in(int i) { const __attribute__((address_space(4))) char* kp = (const __attribute__((address_space(4))) char*)__builtin_amdgcn_kernarg_segment_ptr(); asm volatile("" : "+s"(kp));
    return *(const float* const __attribute__((address_space(4)))*)(kp + 8 * i); }
__global__ void __launch_bounds__(NTHREADS, 2) fwd_kernel(Args a) {
    extern __shared__ __attribute__((aligned(16))) unsigned char lds_raw[];
    LAS unsigned char* lds = (LAS unsigned char*)lds_raw;
    volatile LAS unsigned* MISC = (volatile LAS unsigned*)(lds + MISC_OFF);
    Ctx C; C.wave = __builtin_amdgcn_readfirstlane((int)threadIdx.x >> 6); C.G = gridDim.x; C.bid = blockIdx.x; C.lds = lds;
    unsigned char* ws = a.ws;
#define AIN(i) arg_in(i)
    unsigned* ctl = (unsigned*)(ws + WS_CTL);
    for (int u = threadIdx.x; u < (LDS_BYTES - LDSCTL_OFF) / 4; u += NTHREADS) ((LAS unsigned*)(lds + LDSCTL_OFF))[u] = 0u;
    __syncthreads();
    XcdBarrier bar = xcd_barrier_post(ctl + CW_BAR, MISC + 8);
#define GRID_BAR() xcd_barrier(bar)
    const int gw = C.bid * NWAVES + C.wave, NGW = C.G * NWAVES, NGT = C.G * NTHREADS;
    const f32x2* taba = (const f32x2*)(ws + WS_TABA); const f32x2* tabp = (const f32x2*)(ws + WS_TABP);
    bf16* XN = (bf16*)(ws + WS_XN);
    float* hres = a.out;

    {
        LAS float* scr = (LAS float*)(lds + C.wave * 16384);
        const int tid = fresh_tid(), lane = tid & 63, gtid = C.bid * NTHREADS + tid;
#define TR(Wp, Kd, Nd, dst, ldo, roff, gu) { constexpr int NI_ = ((Kd) / 64) * ((Nd) / 32); if (r < NI_) { transpose_item<false>((Wp), (Kd), (Nd), (bf16*)(dst), (ldo), (roff), (gu), scr, r, lane); continue; } r -= NI_; }
        constexpr int NSMALL = 16 * 37 + 4 * 24 + 2 * 32 + 16 * 32 + 3 * 1792 + 2 * 128 + 2 * 512 + 16 * 144 + 8 * 32;
        for (int it = gw; it < NSMALL; it += NGW) {
            int r = it;
            TR(AIN(I_WIN), 1024, 1184, ws + W_IN, 1024, 0, 0)
            TR(AIN(I_WUQ), 256, 768, ws + W_UQ, 256, 0, 0)
            TR(AIN(I_WUKV), 128, 1024, ws + W_UKV, 256, 0, 0)
            TR(AIN(I_WOUT0), 1024, 1024, ws + W_OUT0, 1024, 0, 0)
            TR(AIN(I_WG0), 1024, 3584, ws + W_GU0, 1024, 0, 1)
            TR(AIN(I_WU0), 1024, 3584, ws + W_GU0, 1024, 0, 2)
            TR(AIN(I_WD0), 3584, 1024, ws + W_D0, 3584, 0, 0)
            TR(AIN(I_PLEPROJ), 256, 1024, ws + W_PP, 256, 0, 0)
            TR(AIN(I_PLEPROJ) + 256 * 1024, 256, 1024, ws + W_PP + 1024 * 256 * 2, 256, 0, 0)
            TR(AIN(I_PLEGATE), 1024, 1024, ws + W_PG, 1024, 0, 0)
            TR(AIN(I_PLEGATE) + 1024 * 1024, 1024, 1024, ws + W_PG + 1024 * 1024 * 2, 1024, 0, 0)
            TR(AIN(I_WQKV1), 1024, 4608, ws + W_QKV1, 1024, 0, 0)
            TR(AIN(I_WOUT1), 512, 1024, ws + W_OUT1, 512, 0, 0)
        }
        for (int i = gtid; i < 12288; i += NGT) ((u32x4*)(ws + W_IN + (size_t)1184 * 1024 * 2))[i] = (u32x4){0u, 0u, 0u, 0u};
        for (int i = gtid; i < 16384; i += NGT) ((u32x4*)(ws + W_UKV))[(size_t)(i >> 4) * 32 + 16 + (i & 15)] = (u32x4){0u, 0u, 0u, 0u};
        for (int i = gtid; i < 2048 * 16; i += NGT) { const int t = i >> 4, f = i & 15; double iv = 1.0; for (int k = 0; k < f; ++k) iv *= 0.56234132519034907; const float ang = (float)t * (float)iv;
            float c, s; sincos_d((double)ang, c, s); ((f32x2*)(ws + WS_TABA))[i] = (f32x2){c, s}; }
        for (int i = gtid; i < 2048 * 8; i += NGT) { const int t = i >> 3, f = i & 7; double iv = 1.0; for (int k = 0; k < f; ++k) iv *= 0.19392274474868576; const float ang = (float)t * (float)iv;
            float c, s; sincos_d((double)ang, c, s); ((f32x2*)(ws + WS_TABP))[i] = (f32x2){c, s}; }
        for (int i = gtid; i < 2 * NTOK * 256 / 8; i += NGT) { const f32x4 u0 = ((const f32x4*)AIN(I_P))[2 * i], u1 = ((const f32x4*)AIN(I_P))[2 * i + 1];
            u32x4 o; o.x = pk2(u0.x, u0.y); o.y = pk2(u0.z, u0.w); o.z = pk2(u1.x, u1.y); o.w = pk2(u1.z, u1.w); ((u32x4*)(ws + WS_PB))[i] = o; }
        rows_norm_only(C, AIN(I_X), AIN(I_MIXPRE), XN);
    }
    GRID_BAR();

    { pg8::Gemm g{XN, (const bf16*)(ws + W_IN), 1024, 1024, 1024}; pg8::StaticOrder S; S.init(NTOK / 256, ZW / 256, C.G, C.bid);
      pg8::EpiStore E{(bf16*)(ws + B_ZIN), ZW, 1.0f}; pg8::gemm_phase(lds, g, S, E); }
    GRID_BAR();
    rows_l0_post(C, (const bf16*)(ws + B_ZIN), AIN(I_GQ), AIN(I_GK), AIN(I_GCQ), AIN(I_GCKV), taba,
                 (bf16*)(ws + B_QA), (bf16*)(ws + B_KA), (bf16*)(ws + B_CQN), (bf16*)(ws + B_CKVN), (bf16*)(ws + B_KR));
    GRID_BAR();
    { pg8::Gemm g{(const bf16*)(ws + B_CQN), (const bf16*)(ws + W_UQ), 256, 256, 256}; pg8::StaticOrder S; S.init(NTOK / 256, 3, C.G, C.bid);
      pg8::EpiStore E{(bf16*)(ws + B_QM), 768, C2_96}; pg8::gemm_phase(lds, g, S, E); }
    { pg8::Gemm g{(const bf16*)(ws + B_CKVN), (const bf16*)(ws + W_UKV), 256, 256, 256}; pg8::StaticOrder S; S.init(NTOK / 256, 4, C.G, C.bid);
      pg8::EpiStore E{(bf16*)(ws + B_KV), 1024, 1.0f}; pg8::gemm_phase(lds, g, S, E); }
    GRID_BAR();
    for (int u = C.bid; u < 1024; u += C.G) {
        const int b = u >> 6, head = (u >> 3) & 7, ch = u & 7, kvh = head >> 2; const size_t rb = (size_t)b * SEQ;
        att::dense_unit<64>(lds, (const bf16*)(ws + B_QA) + rb * 512 + head * 64, 512, 256 * ch, (const bf16*)(ws + B_KA) + rb * 128 + kvh * 64, 128, nullptr,
                            (const bf16*)(ws + B_ZIN) + rb * ZW + 640 + kvh * 64, ZW, (bf16*)(ws + B_O0) + rb * 1024 + head * 64, 1024, taba);
    }
    for (int u = C.bid; u < 1024; u += C.G) {
        const int b = u >> 6, head = (u >> 3) & 7, ch = u & 7; const size_t rb = (size_t)b * SEQ;
        att::dense_unit<96>(lds, (const bf16*)(ws + B_QM) + rb * 768 + head * 96, 768, 256 * ch, (const bf16*)(ws + B_KV) + rb * 1024 + head * 128, 1024, (const bf16*)(ws + B_KR) + rb * 32,
                            (const bf16*)(ws + B_KV) + rb * 1024 + head * 128 + 64, 1024, (bf16*)(ws + B_O0) + rb * 1024 + 512 + head * 64, 1024, taba);
    }
    GRID_BAR();
    { pg8::Gemm g{(const bf16*)(ws + B_O0), (const bf16*)(ws + W_OUT0), 1024, 1024, 1024}; pg8::StaticOrder S; S.init(NTOK / 256, 4, C.G, C.bid);
      pg8::EpiStore E{(bf16*)(ws + B_MO0), 1024, 1.0f}; pg8::gemm_phase(lds, g, S, E); }
    GRID_BAR();
    rows_residual<false, true, false>(C, AIN(I_X), hres, (const bf16*)(ws + B_MO0), AIN(I_MIXPOST), AIN(I_FFNPRE), XN, nullptr, nullptr, nullptr, nullptr, nullptr, nullptr);
    GRID_BAR();
    { pg8::Gemm g{XN, (const bf16*)(ws + W_GU0), 1024, 1024, 1024}; pg8::StaticOrder S; S.init(NTOK / 256, 28, C.G, C.bid);
      pg8::EpiSwiGLU E{(bf16*)(ws + B_HID), DFF}; pg8::gemm_phase(lds, g, S, E); }
    GRID_BAR();
    { pg8::Gemm g{(const bf16*)(ws + B_HID), (const bf16*)(ws + W_D0), DFF, DFF, DFF}; pg8::StaticOrder S; S.init(NTOK / 256, 4, C.G, C.bid);
      pg8::EpiStore E{(bf16*)(ws + B_F), 1024, 1.0f}; pg8::gemm_phase(lds, g, S, E); }
    { pg8::Gemm g{(const bf16*)(ws + WS_PB), (const bf16*)(ws + W_PP), 256, 256, 256}; pg8::StaticOrder S; S.init(NTOK / 256, 4, C.G, C.bid);
      pg8::EpiStore E{(bf16*)(ws + B_E0), 1024, 1.0f}; pg8::gemm_phase(lds, g, S, E); }
    GRID_BAR();
    rows_residual<false, true, false>(C, hres, hres, (const bf16*)(ws + B_F), AIN(I_FFNPOST), AIN(I_PLEGN), XN, nullptr, nullptr, nullptr, nullptr, nullptr, nullptr);
    GRID_BAR();
    { pg8::Gemm g{XN, (const bf16*)(ws + W_PG), 1024, 1024, 1024}; pg8::StaticOrder S; S.init(NTOK / 256, 4, C.G, C.bid);
      pg8::EpiPleGate E{(const bf16*)(ws + B_E0), (bf16*)(ws + B_E), 1024}; pg8::gemm_phase(lds, g, S, E); }
    GRID_BAR();
    rows_residual<false, true, false>(C, hres, hres, (const bf16*)(ws + B_E), AIN(I_PLEPOST), AIN(I_MIXPRE) + DM, XN, nullptr, nullptr, nullptr, nullptr, nullptr, nullptr);
    GRID_BAR();

    { pg8::Gemm g{XN, (const bf16*)(ws + W_QKV1), 1024, 1024, 1024}; pg8::StaticOrder S; S.init(NTOK / 256, 18, C.G, C.bid);
      pg8::EpiQKV1 E{(bf16*)(ws + B_QKV), tabp}; pg8::gemm_phase(lds, g, S, E); }
    GRID_BAR();
    for (int u = C.bid; u < 3072; u += C.G) {
        const int grp = u >> 10, idx = u & 1023, b = idx >> 6, head = (idx >> 3) & 7;
        const int res = grp == 0 ? 0 : (grp == 1 ? ((idx >> 1) & 3) : (idx & 7)), ch = grp == 0 ? (idx & 7) : (grp == 1 ? (idx & 1) : 0);
        att::dil_unit(lds, grp, b, head, res, ch, (const bf16*)(ws + B_QKV), (bf16*)(ws + B_OG) + (size_t)grp * NTOK * 512, (float*)(ws + WS_LSE) + (size_t)grp * NTOK * 8);
    }
    GRID_BAR();
    rows_merge(C, (const bf16*)(ws + B_OG), (const float*)(ws + WS_LSE), (bf16*)(ws + B_O1));
    {
        LAS float* scr = (LAS float*)(lds + C.wave * 16384);
        const int lane = fresh_tid() & 63;
        for (int it = gw; it < 3 * 8 * 1792; it += NGW) {
            const int kind = it / (8 * 1792), e = (it / 1792) & 7, r = it % 1792;
            if (kind == 0) transpose_item<true>(AIN(I_MWG) + (size_t)e * 1024 * DFF, 1024, DFF, ws + B_WGU + (size_t)e * 7168 * 1024, 1024, 0, 1, scr, r, lane);
            else if (kind == 1) transpose_item<true>(AIN(I_MWU) + (size_t)e * 1024 * DFF, 1024, DFF, ws + B_WGU + (size_t)e * 7168 * 1024, 1024, 0, 2, scr, r, lane);
            else transpose_item<true>(AIN(I_MWD) + (size_t)e * DFF * 1024, DFF, 1024, ws + B_WD + (size_t)e * 1024 * DFF, DFF, 0, 0, scr, r, lane);
        }
    }
    GRID_BAR();
    { pg8::Gemm g{(const bf16*)(ws + B_O1), (const bf16*)(ws + W_OUT1), 512, 512, 512}; pg8::StaticOrder S; S.init(NTOK / 256, 4, C.G, C.bid);
      pg8::EpiStore E{(bf16*)(ws + B_MO1), 1024, 1.0f}; pg8::gemm_phase(lds, g, S, E); }
    GRID_BAR();
    rows_residual<false, true, true>(C, hres, hres, (const bf16*)(ws + B_MO1), AIN(I_MIXPOST) + DM, AIN(I_FFNPRE) + DM, XN, nullptr, nullptr, AIN(I_WR),
                                     (int*)(ws + WS_TOKE), (f32x2*)(ws + WS_TOKG), (int*)(ws + WS_CNT));
    GRID_BAR();
    moe_assign_gather(C, (const int*)(ws + WS_CNT), (const int*)(ws + WS_TOKE), (int*)(ws + WS_TOKS), (int*)(ws + WS_TILEE), XN, ws + B_XS);
    GRID_BAR();
    {
        const int* tilee = (const int*)(ws + WS_TILEE);
        const int ntiles = __builtin_amdgcn_readfirstlane(tilee[0]);
        for (int c = 0; c < 5; ++c) {
            const int tile0 = 64 * c; int ntl = ntiles - tile0; if (ntl <= 0) break; if (ntl > 64) ntl = 64;
            { pg8::Gemm g{(const bf16*)(ws + B_XS), (const bf16*)(ws + B_WGU), 512, 512, 512};
              pg8::MoeOrder S; S.so.init(ntl, 28, C.G, C.bid); S.tile_e = tilee + 8; S.tile0 = tile0; S.nbt = 28; S.a_global = true;
              pg8::EpiSwiGLU8 E{ws + B_HC, DFF}; pg8::gemm_phase<pg8::EpiSwiGLU8, pg8::MoeOrder, true>(lds, g, S, E, 0x79797979, 0x7f7f7f7f); }
            GRID_BAR();
            { pg8::Gemm g{(const bf16*)(ws + B_HC), (const bf16*)(ws + B_WD), DFF / 2, DFF / 2, DFF / 2};
              pg8::MoeOrder S; S.so.init(ntl, 4, C.G, C.bid); S.tile_e = tilee + 8; S.tile0 = tile0; S.nbt = 4; S.a_global = false;
              pg8::EpiStore E{(bf16*)(ws + B_Y), 1024, 1.0f}; pg8::gemm_phase<pg8::EpiStore, pg8::MoeOrder, true>(lds, g, S, E, 0x79797979, 0x7c7c7c7c); }
            GRID_BAR();
        }
    }
    rows_residual<true, true, false>(C, hres, hres, (const bf16*)(ws + B_Y), AIN(I_FFNPOST) + DM, AIN(I_PLEGN) + DM, XN, (const int*)(ws + WS_TOKS), (const f32x2*)(ws + WS_TOKG),
                                     nullptr, nullptr, nullptr, nullptr);
    { pg8::Gemm g{(const bf16*)(ws + WS_PB) + (size_t)NTOK * 256, (const bf16*)(ws + W_PP) + 1024 * 256, 256, 256, 256}; pg8::StaticOrder S; S.init(NTOK / 256, 4, C.G, C.bid);
      pg8::EpiStore E{(bf16*)(ws + B_E0b), 1024, 1.0f}; pg8::gemm_phase(lds, g, S, E); }
    GRID_BAR();
    { pg8::Gemm g{XN, (const bf16*)(ws + W_PG) + 1024 * 1024, 1024, 1024, 1024}; pg8::StaticOrder S; S.init(NTOK / 256, 4, C.G, C.bid);
      pg8::EpiPleGate E{(const bf16*)(ws + B_E0b), (bf16*)(ws + B_Eb), 1024}; pg8::gemm_phase(lds, g, S, E); }
    GRID_BAR();
    rows_residual<false, false, false>(C, hres, hres, (const bf16*)(ws + B_Eb), AIN(I_PLEPOST) + DM, nullptr, nullptr, nullptr, nullptr, nullptr, nullptr, nullptr, nullptr);
#undef TR
#undef GRID_BAR
#undef AIN
}

extern "C" void kernel_launch(void* const* d_in, const int* in_sizes, int n_in, void* d_out, int out_size, void* d_ws, size_t ws_size, hipStream_t stream) {
    static int grid = 0;
    if (grid == 0) {
        if (n_in != 27 || in_sizes[0] != NTOK * DM || out_size != NTOK * DM || ws_size < WS_END) { fprintf(stderr, "kernel_launch: unexpected shapes / workspace (%zu < %zu)\n", ws_size, (size_t)WS_END); grid = -1; return; }
        int dev = 0, cus = 0;
        if (hipGetDevice(&dev) != hipSuccess || hipDeviceGetAttribute(&cus, hipDeviceAttributeMultiprocessorCount, dev) != hipSuccess) { grid = -1; return; }
        if (hipFuncSetAttribute((const void*)fwd_kernel, hipFuncAttributeMaxDynamicSharedMemorySize, LDS_BYTES) != hipSuccess) { fprintf(stderr, "kernel_launch: hipFuncSetAttribute failed\n"); grid = -1; return; }
        int per_cu = 0;
        if (hipOccupancyMaxActiveBlocksPerMultiprocessor(&per_cu, (const void*)fwd_kernel, NTHREADS, LDS_BYTES) != hipSuccess || per_cu < 1) fprintf(stderr, "kernel_launch: occupancy query reports %d\n", per_cu);
        (void)hipGetLastError();
        if (cus != 256) { fprintf(stderr, "kernel_launch: built for 256 CUs, device has %d\n", cus); grid = -1; return; }
        grid = cus;
    }
    if (grid < 0) return;
    (void)hipMemsetAsync((char*)d_ws + WS_CTL, 0, CTL_ZERO_BYTES, stream);
    Args a{};
    for (int i = 0; i < 27; ++i) a.in[i] = (const float*)d_in[i];
    a.out = (float*)d_out; a.ws = (unsigned char*)d_ws;
    hipLaunchKernelGGL(fwd_kernel, dim3(grid), dim3(NTHREADS), LDS_BYTES, stream, a);
}
```

```cpp
#include <hip/hip_runtime.h>
#include <cstdio>
#include <cstdint>

#define DI __device__ __forceinline__
#define LAS __attribute__((address_space(3)))
#define GAS __attribute__((address_space(1)))
typedef unsigned short bf16;
typedef short bf16x8 __attribute__((ext_vector_type(8)));
typedef short s16x4 __attribute__((ext_vector_type(4)));
typedef float f32x2 __attribute__((ext_vector_type(2)));
typedef float f32x4 __attribute__((ext_vector_type(4)));
typedef float f32x16 __attribute__((ext_vector_type(16)));
typedef unsigned u32x2 __attribute__((ext_vector_type(2)));
typedef unsigned u32x4 __attribute__((ext_vector_type(4)));
typedef __bf16 bf16x2_t __attribute__((ext_vector_type(2)));

constexpr int BATCH = 16, SEQ = 2048, DM = 1024, NTOK = BATCH * SEQ;
constexpr int ZW = 1280;
constexpr int DFF = 3584, NEXP = 8;
constexpr int QKVW = 4608;
constexpr float EPS = 1e-6f;
constexpr float LOG2E = 1.4426950408889634f;
constexpr float C2_64 = 0.125f * LOG2E;
constexpr float C2_96 = 0.10206207261596577f * LOG2E;
constexpr int NWAVES = 8, NTHREADS = 512;
constexpr int MAXTILES = 264;
constexpr int NSLOTS = MAXTILES * 256;

constexpr size_t MiB = 1u << 20;
constexpr size_t WS_CTL = 0, CTL_ZERO_BYTES = 64 * 1024;
constexpr size_t WS_TABA = 1 * MiB;
constexpr size_t WS_TABP = WS_TABA + 2048 * 16 * 8;
constexpr size_t WS_TOKE = 2 * MiB;
constexpr size_t WS_TOKG = WS_TOKE + NTOK * 4;
constexpr size_t WS_TOKS = WS_TOKG + NTOK * 8;
constexpr size_t WS_CNT = WS_TOKS + NTOK * 8;
constexpr size_t WS_TILEE = WS_CNT + 256 * 8 * 4;
constexpr size_t WS_RSTD = 2 * MiB + 768 * 1024;
constexpr size_t WS_LSE = 3 * MiB;
constexpr size_t WS_W = 6 * MiB;
constexpr size_t W_IN = WS_W;
constexpr size_t W_UQ = W_IN + (size_t)ZW * 1024 * 2;
constexpr size_t W_UKV = W_UQ + 768 * 256 * 2;
constexpr size_t W_OUT0 = W_UKV + 1024 * 256 * 2;
constexpr size_t W_GU0 = W_OUT0 + 1024 * 1024 * 2;
constexpr size_t W_D0 = W_GU0 + (size_t)7168 * 1024 * 2;
constexpr size_t W_PP = W_D0 + (size_t)1024 * 3584 * 2;
constexpr size_t W_PG = W_PP + 2 * 1024 * 256 * 2;
constexpr size_t W_QKV1 = W_PG + 2 * 1024 * 1024 * 2;
constexpr size_t W_OUT1 = W_QKV1 + (size_t)QKVW * 1024 * 2;
constexpr size_t W_END = W_OUT1 + 1024 * 512 * 2;
constexpr size_t WS_PB = 48 * MiB;
constexpr size_t WS_XN = 80 * MiB;
constexpr size_t WS_BIG = 144 * MiB;
static_assert(W_END <= WS_PB, "weights");
constexpr size_t B_ZIN = WS_BIG;
constexpr size_t B_QA = WS_BIG + 80 * MiB;
constexpr size_t B_KA = WS_BIG + 112 * MiB;
constexpr size_t B_CQN = WS_BIG + 120 * MiB;
constexpr size_t B_CKVN = WS_BIG + 136 * MiB;
constexpr size_t B_KR = WS_BIG + 152 * MiB;
constexpr size_t B_QM = WS_BIG + 154 * MiB;
constexpr size_t B_KV = WS_BIG + 202 * MiB;
constexpr size_t B_O0 = WS_BIG + 266 * MiB;
constexpr size_t B_MO0 = WS_BIG;
constexpr size_t B_HID = WS_BIG;
constexpr size_t B_F = WS_BIG + 224 * MiB;
constexpr size_t B_E0 = WS_BIG + 288 * MiB;
constexpr size_t B_E = WS_BIG;
constexpr size_t B_QKV = WS_BIG;
constexpr size_t B_OG = WS_BIG + 288 * MiB;
constexpr size_t B_O1 = WS_BIG + 388 * MiB;
constexpr size_t B_MO1 = WS_BIG + 288 * MiB;
constexpr size_t B_WGU = WS_BIG;
constexpr size_t B_WD = WS_BIG + 56 * MiB;
constexpr size_t B_XS = WS_BIG + 84 * MiB;
constexpr size_t B_Y = WS_BIG + 152 * MiB;
constexpr size_t B_HC = WS_BIG + 356 * MiB;
constexpr size_t B_E0b = WS_BIG + 356 * MiB;
constexpr size_t B_Eb = WS_BIG;
constexpr size_t WS_END = WS_BIG + 420 * MiB;

constexpr int CW_BAR = 1024;

constexpr int RING_BYTES = 133120;
constexpr int LDSCTL_OFF = RING_BYTES, MISC_OFF = LDSCTL_OFF + 320;
constexpr int LDS_BYTES = 147456;

DI float bf2f(unsigned short v) { return __uint_as_float((unsigned)v << 16); }
DI unsigned pk2(float lo, float hi) { f32x2 v = {lo, hi}; bf16x2_t b = __builtin_convertvector(v, bf16x2_t); return __builtin_bit_cast(unsigned, b); }
DI float wave_sum(float v) {
#pragma unroll
    for (int o = 1; o < 64; o <<= 1) v += __shfl_xor(v, o);
    return v;
}
DI int fresh_tid() { int t = threadIdx.x; asm volatile("" : "+v"(t)); return t; }
DI float ex2(float x) { return __builtin_amdgcn_exp2f(x); }
DI float rsq(float x) { return 1.0f / sqrtf(x); }
DI void unpack8(u32x4 w, float (&x)[8]) {
    x[0] = __uint_as_float(w.x << 16); x[1] = __uint_as_float(w.x & 0xffff0000u);
    x[2] = __uint_as_float(w.y << 16); x[3] = __uint_as_float(w.y & 0xffff0000u);
    x[4] = __uint_as_float(w.z << 16); x[5] = __uint_as_float(w.z & 0xffff0000u);
    x[6] = __uint_as_float(w.w << 16); x[7] = __uint_as_float(w.w & 0xffff0000u);
}
DI u32x4 pack8(const float (&x)[8]) { u32x4 w; w.x = pk2(x[0], x[1]); w.y = pk2(x[2], x[3]); w.z = pk2(x[4], x[5]); w.w = pk2(x[6], x[7]); return w; }

namespace pg8 {
constexpr int BM = 256, BK = 64, HALF = 128, HTB = HALF * BK * 2, STAGE_BYTES = 8 * HTB, NXCD = 8, WGM = 8;
__host__ __device__ __forceinline__ int lds_byte(int r, int c) { const int st = (r >> 4) * 2 + (c >> 5), rr = r & 15, cc = c & 31, ob = rr * 64 + cc * 2; return st * 1024 + (ob ^ (((ob >> 9) & 1) << 5)); }
__host__ __device__ __forceinline__ void stage_rc(int b, int& R, int& C) { const int st = b / 1024, sb = b % 1024, swz = sb ^ (((sb >> 9) & 1) << 5); R = (st >> 1) * 16 + swz / 64; C = (st & 1) * 32 + (swz % 64) / 2; }
__host__ __device__ __forceinline__ int perm32(int rho) { const int n = rho >> 4, i = rho & 15; return 8 * (i >> 2) + 4 * n + (i & 3); }

struct Unit { int pm, pn, pa, pb; };
struct Gemm { const bf16* A; const bf16* Bt; int lda, ldb, K; };

struct StaticOrder {
    int nM, nN, nwg, G, c;
    DI void init(int nM_, int nN_, int G_, int c_) { nM = nM_; nN = nN_; nwg = nM * nN; G = G_; c = c_; }
    DI bool map(int i, int& pm, int& pn) const {
        const long L = (long)i * G + c; if (L >= nwg) return false;
        int wgid = (int)L; { const int q = nwg / NXCD, r = nwg % NXCD, xcd = wgid % NXCD, off = wgid / NXCD; wgid = (xcd < r ? xcd * (q + 1) : r * (q + 1) + (xcd - r) * q) + off; }
        const int nig = WGM * nN, gid = wgid / nig, fm = gid * WGM, gsz = (nM - fm) < WGM ? (nM - fm) : WGM;
        pm = fm + ((wgid % nig) % gsz); pn = (wgid % nig) / gsz; return true;
    }
    DI bool next(int i, Unit& u) const { int pm, pn; if (!map(i, pm, pn)) return false; u.pm = pm; u.pn = pn; u.pa = pm; u.pb = pn; return true; }
};
struct MoeOrder {
    StaticOrder so; const int* tile_e; int tile0, nbt; bool a_global;
    DI bool next(int i, Unit& u) const {
        int pm, pn; if (!so.map(i, pm, pn)) return false;
        const int e = __builtin_amdgcn_readfirstlane(tile_e[tile0 + pm]);
        u.pn = pn; u.pb = e * nbt + pn;
        if (a_global) { u.pa = tile0 + pm; u.pm = pm; } else { u.pa = pm; u.pm = tile0 + pm; }
        return true;
    }
};

struct EpiStore {
    bf16* O; int ldc; float scale; const float* rs;
    DI void operator()(const f32x4 (&acc)[2][2][4][2], const Unit& u, int wr, int wc, int fr, int fq) const {
        const int row0 = u.pm * BM + wr * 64 + fr, col0 = u.pn * BM + wc * 32 + 8 * fq;
#pragma unroll
        for (int ai = 0; ai < 2; ++ai)
#pragma unroll
            for (int m = 0; m < 4; ++m) { bf16* rowp = O + (size_t)(row0 + ai * HALF + m * 16) * ldc + col0; const float sc = rs ? scale * rs[row0 + ai * HALF + m * 16] : scale;
#pragma unroll
                for (int bj = 0; bj < 2; ++bj) { const f32x4 v0 = acc[ai][bj][m][0] * sc, v1 = acc[ai][bj][m][1] * sc;
                    u32x4 w; w.x = pk2(v0[0], v0[1]); w.y = pk2(v0[2], v0[3]); w.z = pk2(v1[0], v1[1]); w.w = pk2(v1[2], v1[3]);
                    *(u32x4*)(rowp + bj * HALF) = w; } }
    }
};
DI float silu_mul(float g, float u) { return g * u * __builtin_amdgcn_rcpf(1.0f + ex2(-g * LOG2E)); }
struct EpiSwiGLU {
    bf16* H; int ldh; const float* rs;
    DI void operator()(const f32x4 (&acc)[2][2][4][2], const Unit& u, int wr, int wc, int fr, int fq) const {
        const int row0 = u.pm * BM + wr * 64 + fr, col0 = u.pn * HALF + wc * 32 + 8 * fq;
#pragma unroll
        for (int ai = 0; ai < 2; ++ai)
#pragma unroll
            for (int m = 0; m < 4; ++m) { bf16* rowp = H + (size_t)(row0 + ai * HALF + m * 16) * ldh + col0; const float sc = rs[row0 + ai * HALF + m * 16];
                const f32x4 g0 = acc[ai][0][m][0] * sc, g1 = acc[ai][0][m][1] * sc, u0 = acc[ai][1][m][0] * sc, u1 = acc[ai][1][m][1] * sc;
                u32x4 w; w.x = pk2(silu_mul(g0[0], u0[0]), silu_mul(g0[1], u0[1])); w.y = pk2(silu_mul(g0[2], u0[2]), silu_mul(g0[3], u0[3]));
                w.z = pk2(silu_mul(g1[0], u1[0]), silu_mul(g1[1], u1[1])); w.w = pk2(silu_mul(g1[2], u1[2]), silu_mul(g1[3], u1[3]));
                *(u32x4*)rowp = w; }
    }
};
DI unsigned pk4_fp8(float a, float b, float c, float d) {
    a = __builtin_fminf(__builtin_fmaxf(a, -448.f), 448.f); b = __builtin_fminf(__builtin_fmaxf(b, -448.f), 448.f); c = __builtin_fminf(__builtin_fmaxf(c, -448.f), 448.f); d = __builtin_fminf(__builtin_fmaxf(d, -448.f), 448.f);
    int w = 0; w = __builtin_amdgcn_cvt_pk_fp8_f32(a, b, w, false); w = __builtin_amdgcn_cvt_pk_fp8_f32(c, d, w, true); return (unsigned)w; }
struct EpiSwiGLU8 {
    unsigned char* H; int ldh;
    DI void operator()(const f32x4 (&acc)[2][2][4][2], const Unit& u, int wr, int wc, int fr, int fq) const {
        const int row0 = u.pm * BM + wr * 64 + fr, col0 = u.pn * HALF + wc * 32 + 8 * fq;
#pragma unroll
        for (int ai = 0; ai < 2; ++ai)
#pragma unroll
            for (int m = 0; m < 4; ++m) { unsigned char* rowp = H + (size_t)(row0 + ai * HALF + m * 16) * ldh + col0;
                const f32x4 g0 = acc[ai][0][m][0], g1 = acc[ai][0][m][1], u0 = acc[ai][1][m][0] * 8.0f, u1 = acc[ai][1][m][1] * 8.0f;
                u32x2 w; w.x = pk4_fp8(silu_mul(g0[0], u0[0]), silu_mul(g0[1], u0[1]), silu_mul(g0[2], u0[2]), silu_mul(g0[3], u0[3]));
                w.y = pk4_fp8(silu_mul(g1[0], u1[0]), silu_mul(g1[1], u1[1]), silu_mul(g1[2], u1[2]), silu_mul(g1[3], u1[3]));
                *(u32x2*)rowp = w; }
    }
};
struct EpiPleGate {
    const bf16* E0; bf16* E; int ldc; const float* rs;
    DI void operator()(const f32x4 (&acc)[2][2][4][2], const Unit& u, int wr, int wc, int fr, int fq) const {
        const int row0 = u.pm * BM + wr * 64 + fr, col0 = u.pn * BM + wc * 32 + 8 * fq;
#pragma unroll
        for (int ai = 0; ai < 2; ++ai)
#pragma unroll
            for (int m = 0; m < 4; ++m) { const size_t off = (size_t)(row0 + ai * HALF + m * 16) * ldc + col0; const float sc = rs[row0 + ai * HALF + m * 16] * LOG2E;
#pragma unroll
                for (int bj = 0; bj < 2; ++bj) { const u32x4 ew = *(const u32x4*)(E0 + off + bj * HALF); float e[8]; unpack8(ew, e);
                    const f32x4 v0 = acc[ai][bj][m][0] * sc, v1 = acc[ai][bj][m][1] * sc; float o[8];
#pragma unroll
                    for (int j = 0; j < 4; ++j) { o[j] = e[j] * __builtin_amdgcn_rcpf(1.0f + ex2(-v0[j])); o[4 + j] = e[4 + j] * __builtin_amdgcn_rcpf(1.0f + ex2(-v1[j])); }
                    *(u32x4*)(E + off + bj * HALF) = pack8(o); } }
    }
};
struct EpiQKV1 {
    bf16* O; const f32x2* tabp; const float* rs;
    DI void operator()(const f32x4 (&acc)[2][2][4][2], const Unit& u, int wr, int wc, int fr, int fq) const {
        const int row0 = u.pm * BM + wr * 64 + fr;
        const int which = ((u.pn * BM) % 1536) / 512;
        const int grp = (u.pn * BM) / 1536, sh = 2 * grp;
        const float sc = which == 0 ? C2_64 : 1.0f;
        const bool rot = which < 2;
        const bool mine = ((wc & 1) == 0) && (fq < 2);
#pragma unroll
        for (int ai = 0; ai < 2; ++ai)
#pragma unroll
            for (int m = 0; m < 4; ++m) { const int row = row0 + ai * HALF + m * 16, bb = row >> 11, t = row & (SEQ - 1);
                const int pos = ((t & ((1 << sh) - 1)) << (11 - sh)) + (t >> sh);
                const f32x2* tp = tabp + (size_t)t * 8; const float scr = sc * rs[row];
#pragma unroll
                for (int bj = 0; bj < 2; ++bj) { float v[8];
                    const int head = ((u.pn * BM + bj * HALF + wc * 32) % 512) / 64, d0 = ((wc & 1) * 32) + 8 * fq;
                    bf16* dst = O + ((size_t)((((bb * 3 + grp) * 3 + which) * 8 + head) * SEQ + pos)) * 64 + d0;
#pragma unroll
                    for (int j = 0; j < 4; ++j) { v[j] = acc[ai][bj][m][0][j]; v[4 + j] = acc[ai][bj][m][1][j]; }
                    if (rot) {
                        float p[8];
#pragma unroll
                        for (int j = 0; j < 8; ++j) p[j] = __shfl_xor(v[j], 16);
                        if (mine) {
#pragma unroll
                            for (int j = 0; j < 8; ++j) { const f32x2 cs = tp[j]; v[j] = (fq == 0) ? (v[j] * cs.x - p[j] * cs.y) : (v[j] * cs.x + p[j] * cs.y); }
                        }
                    }
#pragma unroll
                    for (int j = 0; j < 8; ++j) v[j] *= scr;
                    *(u32x4*)dst = pack8(v); } }
    }
};

typedef int v8i32 __attribute__((ext_vector_type(8)));
typedef int v4i32 __attribute__((ext_vector_type(4)));
DI v8i32 cat8(bf16x8 lo, bf16x8 hi) { const v4i32 a = __builtin_bit_cast(v4i32, lo), b = __builtin_bit_cast(v4i32, hi); return __builtin_shufflevector(a, b, 0, 1, 2, 3, 4, 5, 6, 7); }
template <class Epi, class Sched, bool FP8 = false>
DI void gemm_phase(LAS unsigned char* lds, const Gemm g, const Sched& S, const Epi& E, const int scw = 0x7f7f7f7f, const int sca = 0x7f7f7f7f) {
    const int tid = fresh_tid(), wid = __builtin_amdgcn_readfirstlane(tid >> 6), lane = tid & 63, wr = wid >> 2, wc = wid & 3, fr = lane & 15, fq = lane >> 4;
    const int K = g.K; int nt = K / BK; if constexpr (FP8) asm volatile("" : "+s"(nt));
    unsigned voffA[2], voffB[2];
#pragma unroll
    for (int i = 0; i < 2; ++i) { int R, C; stage_rc(tid * 16 + i * 8192, R, C); const int Rb = (R & ~31) + perm32(R & 31);
        voffA[i] = (unsigned)(R * g.lda + C) * 2u; voffB[i] = (unsigned)(Rb * g.ldb + C) * 2u; }
    const size_t kstep = (size_t)(BK * 2);
    const size_t hstepA = (size_t)HALF * g.lda * 2, hstepB = (size_t)HALF * g.ldb * 2;
    const size_t tstepA = 2 * hstepA, tstepB = 2 * hstepB;
    const unsigned ldsw = (unsigned)wid * 1024u;
    const int aoff = lds_byte(wr * 64 + fr, fq * 8), boff = lds_byte(wc * 32 + fr, fq * 8);
#define PG8_SA(b, h) (((b) * 2 + (h)) * HTB)
#define PG8_SB(b, h) ((4 + (b) * 2 + (h)) * HTB)
#define PG8_STAGE(bufoff, gbase, voff) do { _Pragma("unroll") for (int _i = 0; _i < 2; ++_i) \
        __builtin_amdgcn_global_load_lds((const unsigned*)((const char*)(gbase) + (voff)[_i]), (LAS unsigned*)(lds + (bufoff) + ldsw + _i * 8192), 16, 0, 0); } while (0)
#define PG8_LDA(dst, b, h) do { _Pragma("unroll") for (int m = 0; m < 4; ++m) { \
        if constexpr (FP8) dst##8[m] = cat8(*(const LAS bf16x8*)(lds + PG8_SA(b, h) + aoff + m * 2048), *(const LAS bf16x8*)(lds + PG8_SA(b, h) + aoff + m * 2048 + 1024)); \
        else { _Pragma("unroll") for (int k = 0; k < 2; ++k) dst[m][k] = *(const LAS bf16x8*)(lds + PG8_SA(b, h) + aoff + m * 2048 + k * 1024); } } } while (0)
#define PG8_LDB(dst, b, h) do { _Pragma("unroll") for (int n = 0; n < 2; ++n) { \
        if constexpr (FP8) dst##8[n] = cat8(*(const LAS bf16x8*)(lds + PG8_SB(b, h) + boff + n * 2048), *(const LAS bf16x8*)(lds + PG8_SB(b, h) + boff + n * 2048 + 1024)); \
        else { _Pragma("unroll") for (int k = 0; k < 2; ++k) dst[n][k] = *(const LAS bf16x8*)(lds + PG8_SB(b, h) + boff + n * 2048 + k * 1024); } } } while (0)
#define PG8_MMA(ai, bj, At, Bt) do { __builtin_amdgcn_s_setprio(1); _Pragma("unroll") for (int m = 0; m < 4; ++m) _Pragma("unroll") for (int n = 0; n < 2; ++n) { \
        if constexpr (FP8) asm volatile("s_nop 1\n\tv_mfma_scale_f32_16x16x128_f8f6f4 %0, %1, %2, %0, %3, %4 op_sel_hi:[0,0,0]" : "+v"(acc[ai][bj][m][n]) : "v"(Bt##8[n]), "v"(At##8[m]), "v"(scw), "v"(sca)); \
        else { _Pragma("unroll") for (int k = 0; k < 2; ++k) acc[ai][bj][m][n] = __builtin_amdgcn_mfma_f32_16x16x32_bf16(Bt[n][k], At[m][k], acc[ai][bj][m][n], 0, 0, 0); } } \
        __builtin_amdgcn_s_setprio(0); } while (0)
#define PG8_WAIT_V(n) asm volatile("s_waitcnt vmcnt(" #n ")" ::: "memory")
#define PG8_WAIT_L(n) asm volatile("s_waitcnt lgkmcnt(" #n ")" ::: "memory")
#define PG8_BAR __builtin_amdgcn_s_barrier()
#define PG8_SCHED __builtin_amdgcn_sched_barrier(0)
    Unit cur, nxt; int ui = 0;
    if (!S.next(0, cur)) return;
    f32x4 acc[2][2][4][2];
#pragma unroll
    for (int a = 0; a < 2; ++a)
#pragma unroll
        for (int b = 0; b < 2; ++b)
#pragma unroll
            for (int m = 0; m < 4; ++m)
#pragma unroll
                for (int n = 0; n < 2; ++n) acc[a][b][m][n] = (f32x4){0.f, 0.f, 0.f, 0.f};
    bf16x8 At[4][2], B0[2][2], B1[2][2]; v8i32 At8[4], B08[2], B18[2];
    const char* cA = (const char*)g.A + (size_t)cur.pa * tstepA; const char* cB = (const char*)g.Bt + (size_t)cur.pb * tstepB;
    PG8_STAGE(PG8_SB(0, 0), cB, voffB); PG8_STAGE(PG8_SB(0, 1), cB + hstepB, voffB); PG8_STAGE(PG8_SA(0, 0), cA, voffA); PG8_STAGE(PG8_SA(0, 1), cA + hstepA, voffA);
    if (wr == 1) PG8_BAR;
    PG8_WAIT_V(2); PG8_BAR;
    PG8_STAGE(PG8_SB(1, 0), cB + kstep, voffB); PG8_STAGE(PG8_SA(1, 0), cA + kstep, voffA); PG8_STAGE(PG8_SB(1, 1), cB + hstepB + kstep, voffB);
    PG8_WAIT_V(6); PG8_BAR;
    for (;;) {
        const bool has_next = S.next(ui + 1, nxt);
        const char* nA = has_next ? (const char*)g.A + (size_t)nxt.pa * tstepA : cA; const char* nB = has_next ? (const char*)g.Bt + (size_t)nxt.pb * tstepB : cB;
        for (int t = 0; t < nt; t += 2) {
            const bool last = (t == nt - 2);
            const char* a1 = cA + (size_t)(t + 1) * kstep;
            const char* a2 = last ? nA : cA + (size_t)(t + 2) * kstep; const char* b2 = last ? nB : cB + (size_t)(t + 2) * kstep;
            const char* a3 = a2 + kstep; const char* b3 = b2 + kstep;
            PG8_LDB(B0, 0, 0); PG8_LDB(B1, 0, 1); PG8_SCHED; PG8_LDA(At, 0, 0); PG8_STAGE(PG8_SA(1, 1), a1 + hstepA, voffA);
            PG8_WAIT_V(8); PG8_WAIT_L(0); PG8_BAR; PG8_MMA(0, 0, At, B0); PG8_MMA(0, 1, At, B1); PG8_BAR; PG8_SCHED;
            PG8_LDA(At, 0, 1); PG8_STAGE(PG8_SB(0, 0), b2, voffB); PG8_STAGE(PG8_SB(0, 1), b2 + hstepB, voffB); PG8_STAGE(PG8_SA(0, 0), a2, voffA);
            PG8_WAIT_V(8); PG8_WAIT_L(0); PG8_BAR; PG8_MMA(1, 0, At, B0); PG8_MMA(1, 1, At, B1); PG8_BAR; PG8_SCHED;
            PG8_LDB(B0, 1, 0); PG8_LDB(B1, 1, 1); PG8_SCHED; PG8_LDA(At, 1, 0); PG8_STAGE(PG8_SA(0, 1), a2 + hstepA, voffA);
            PG8_WAIT_V(8); PG8_WAIT_L(0); PG8_BAR; PG8_MMA(0, 0, At, B0); PG8_MMA(0, 1, At, B1); PG8_BAR; PG8_SCHED;
            PG8_LDA(At, 1, 1); PG8_STAGE(PG8_SB(1, 0), b3, voffB); PG8_STAGE(PG8_SB(1, 1), b3 + hstepB, voffB); PG8_STAGE(PG8_SA(1, 0), a3, voffA);
            PG8_WAIT_V(8); PG8_WAIT_L(0); PG8_BAR; PG8_MMA(1, 0, At, B0); PG8_MMA(1, 1, At, B1); PG8_BAR; PG8_SCHED;
        }
        if (wr == 0) PG8_BAR;
        if constexpr (FP8) asm volatile("s_nop 15\n\ts_nop 15" ::: "memory");
        E(acc, cur, wr, wc, fr, fq);
        if (!has_next) break;
#pragma unroll
        for (int a = 0; a < 2; ++a)
#pragma unroll
            for (int b = 0; b < 2; ++b)
#pragma unroll
                for (int m = 0; m < 4; ++m)
#pragma unroll
                    for (int n = 0; n < 2; ++n) acc[a][b][m][n] = (f32x4){0.f, 0.f, 0.f, 0.f};
        cur = nxt; cA = nA; cB = nB; ++ui;
        if (wr == 1) PG8_BAR;
    }
    PG8_WAIT_V(0);
    PG8_BAR;
#undef PG8_SA
#undef PG8_SB
#undef PG8_STAGE
#undef PG8_LDA
#undef PG8_LDB
#undef PG8_MMA
#undef PG8_WAIT_V
#undef PG8_WAIT_L
#undef PG8_BAR
#undef PG8_SCHED
}
}

namespace att {
#define MFMA32(a, b, c) __builtin_amdgcn_mfma_f32_32x32x16_bf16((a), (b), (c), 0, 0, 0)
DI int crow(int i, int h) { return (i & 3) + 8 * (i >> 2) + 4 * h; }
typedef short v4i16_t __attribute__((ext_vector_type(4)));
DI s16x4 vtr(const LAS unsigned char* p) { return __builtin_bit_cast(s16x4, __builtin_amdgcn_ds_read_tr16_b64_v4i16((LAS v4i16_t*)p)); }
DI bf16x8 packp(const f32x16& p, int b) {
    u32x4 w; w.x = pk2(p[b], p[b + 1]); w.y = pk2(p[b + 2], p[b + 3]); w.z = pk2(p[b + 4], p[b + 5]); w.w = pk2(p[b + 6], p[b + 7]);
    return __builtin_bit_cast(bf16x8, w);
}
constexpr float NEGBIG = -1.0e30f;
template <int DK, bool MASK>
DI void tile_step(const LAS unsigned char* Kb, const LAS unsigned char* Vb, const int (&koff)[4], const bf16x8 (&qr)[DK / 16], f32x16& o0, f32x16& o1, float& m, float& l,
                  LAS float* wsf, int r, int h, int lane, int qi, int kj0) {
    f32x16 p0, p1;
#pragma unroll
    for (int i = 0; i < 16; ++i) { p0[i] = 0.f; p1[i] = 0.f; }
#pragma unroll
    for (int ks = 0; ks < DK / 16; ++ks) {
        const bf16x8 a0 = *(const LAS bf16x8*)(Kb + koff[ks]);
        const bf16x8 a1 = *(const LAS bf16x8*)(Kb + koff[ks] + 4096);
        p0 = MFMA32(a0, qr[ks], p0); p1 = MFMA32(a1, qr[ks], p1);
    }
    if (MASK) {
#pragma unroll
        for (int i = 0; i < 16; ++i) { const int d0 = qi - (kj0 + crow(i, h)), d1 = d0 - 32;
            if (d0 > 64 || d0 < -64) p0[i] = NEGBIG; if (d1 > 64 || d1 < -64) p1[i] = NEGBIG; }
    }
    float tm = fmaxf(p0[0], p1[0]);
#pragma unroll
    for (int i = 1; i < 16; ++i) tm = fmaxf(tm, fmaxf(p0[i], p1[i]));
    tm = fmaxf(tm, __shfl_xor(tm, 32));
    const float mn = fmaxf(m, tm);
    if (__any(mn > m)) {
        const float al = ex2(m - mn); l *= al; m = mn;
        if (h == 0) wsf[r] = al;
#pragma unroll
        for (int i = 0; i < 16; ++i) { const float f = wsf[crow(i, h)]; o0[i] *= f; o1[i] *= f; }
    }
    float sum = 0.f;
#pragma unroll
    for (int i = 0; i < 16; ++i) { p0[i] = ex2(p0[i] - m); p1[i] = ex2(p1[i] - m); sum += p0[i] + p1[i]; }
    l += sum;
    const LAS unsigned char* vp = Vb + ((lane >> 4) & 1) * 32 + (lane & 3) * 8 + (4 * h + ((lane & 15) >> 2)) * 64;
#pragma unroll
    for (int s = 0; s < 4; ++s) {
        const bf16x8 pa = (s == 0) ? packp(p0, 0) : (s == 1) ? packp(p0, 8) : (s == 2) ? packp(p1, 0) : packp(p1, 8);
#pragma unroll
        for (int db = 0; db < 2; ++db) {
            const s16x4 lo = vtr(vp + db * 4096 + s * 1024), hi = vtr(vp + db * 4096 + s * 1024 + 512);
            const bf16x8 vf = {lo[0], lo[1], lo[2], lo[3], hi[0], hi[1], hi[2], hi[3]};
            if (db == 0) o0 = MFMA32(pa, vf, o0); else o1 = MFMA32(pa, vf, o1);
        }
    }
}
DI void finish_store(const f32x16& o0, const f32x16& o1, float l, LAS float* wsf, LAS unsigned short* stg, int r, int h, int lane, bf16* orow0, size_t rstride) {
    const float lt = l + __shfl_xor(l, 32);
    if (h == 0) wsf[r] = 1.0f / lt;
#pragma unroll
    for (int i = 0; i < 16; ++i) { const int row = crow(i, h); const float f = wsf[row];
        stg[row * 64 + r] = (unsigned short)(pk2(o0[i] * f, 0.f) & 0xffffu); stg[row * 64 + 32 + r] = (unsigned short)(pk2(o1[i] * f, 0.f) & 0xffffu); }
#pragma unroll
    for (int it = 0; it < 4; ++it) { const int row = it * 8 + (lane >> 3), ch = lane & 7;
        const u32x4 v = *(const LAS u32x4*)(stg + row * 64 + ch * 8);
        *(u32x4*)(orow0 + (size_t)row * rstride + ch * 8) = v; }
}
#define ATT_WAITBAR(N) asm volatile("s_waitcnt vmcnt(" #N ") lgkmcnt(0)\n\ts_barrier" ::: "memory")
DI void dma16(const void* gsrc, LAS unsigned char* ldst) { __builtin_amdgcn_global_load_lds((const unsigned*)gsrc, (LAS unsigned*)ldst, 16, 0, 0); }

template <int DK>
DI void dense_unit(LAS unsigned char* lds, const bf16* qS, int qp, int q0, const bf16* kA, int kpA, const bf16* kB, const bf16* vS, int vpitch, bf16* oS, int op, const f32x2* taba) {
    constexpr int NKC = DK / 8, KSLOT = NKC * 1024, VSLOT = 8192, NS = 3, KS = DK / 16;
    constexpr int OFF_V = NS * KSLOT, OFF_WS = OFF_V + NS * VSLOT, OFF_STG = OFF_WS + NWAVES * 256;
    const int tid = fresh_tid(), lane = tid & 63, r = lane & 31, h = lane >> 5; const int w = __builtin_amdgcn_readfirstlane(tid >> 6);
    LAS float* wsf = (LAS float*)(lds + OFF_WS) + w * 64;
    LAS unsigned short* stg = (LAS unsigned short*)(lds + OFF_STG) + w * 2048;
    const bf16* ksrcA = kA + (size_t)(8 * w + (lane >> 3)) * kpA + ((lane & 7) ^ (lane >> 3)) * 8;
    const bf16* ksrcB = (DK == 96) ? (kB + (size_t)(16 * (w & 3) + (lane >> 2)) * 32 + ((lane & 3) ^ ((lane >> 4) & 3)) * 8) : kA;
    const bf16* vsrc = vS + (size_t)(16 * (w & 3) + (lane >> 2)) * vpitch + (w >> 2) * 32 + (lane & 3) * 8;
    const size_t kstA = (size_t)64 * kpA, kstB = 64 * 32, vst = (size_t)64 * vpitch;
    int koff[KS];
#pragma unroll
    for (int ks = 0; ks < KS; ++ks) koff[ks] = (ks < 4) ? (r * 128 + (((2 * ks + h) ^ (r & 7)) << 4)) : (8192 + r * 64 + (((2 * (ks - 4) + h) ^ ((r >> 2) & 3)) << 4));
#define ISSUE_K(t) do { const int sl_ = (t) % NS; dma16(ksrcA + (size_t)(t) * kstA, lds + sl_ * KSLOT + w * 1024); \
        if (DK == 96) dma16(ksrcB + (size_t)(t) * kstB, lds + sl_ * KSLOT + (8 + (w & 3)) * 1024); } while (0)
#define ISSUE_V(t) do { const int sl_ = (t) % NS; dma16(vsrc + (size_t)(t) * vst, lds + OFF_V + sl_ * VSLOT + w * 1024); } while (0)
    bf16x8 qr[KS];
    const bf16* qrow = qS + (size_t)(q0 + w * 32 + r) * qp + 8 * h;
#pragma unroll
    for (int ks = 0; ks < KS; ++ks) qr[ks] = *(const bf16x8*)(qrow + 16 * ks);
    ISSUE_K(0); ISSUE_K(1); ISSUE_V(0); ISSUE_K(2); ISSUE_V(1);
    if (DK == 96) {
        const f32x2* tp = taba + (size_t)(q0 + w * 32 + r) * 16 + 8 * h;
        bf16x8 a = qr[4], b = qr[5];
#pragma unroll
        for (int j = 0; j < 8; ++j) { const f32x2 cs = tp[j]; const float x1 = bf2f((unsigned short)a[j]), x2 = bf2f((unsigned short)b[j]);
            a[j] = (short)(pk2(x1 * cs.x - x2 * cs.y, 0.f) & 0xffffu); b[j] = (short)(pk2(x2 * cs.x + x1 * cs.y, 0.f) & 0xffffu); }
        qr[4] = a; qr[5] = b;
    }
    f32x16 o0, o1, negm, pA0, pA1, pB0, pB1;
#pragma unroll
    for (int i = 0; i < 16; ++i) { o0[i] = 0.f; o1[i] = 0.f; negm[i] = 0.f; }
    float m = 0.f, l = 0.f;
    const LAS unsigned char* kp0 = lds;
    const LAS unsigned char* vp0 = lds + OFF_V + ((lane >> 4) & 1) * 32 + (lane & 3) * 8 + (4 * h + ((lane & 15) >> 2)) * 64;
#define QK_TILE(P0, P1, kb_) do { _Pragma("unroll") for (int ks = 0; ks < KS; ++ks) { \
        const bf16x8 a0_ = *(const LAS bf16x8*)((kb_) + koff[ks]), a1_ = *(const LAS bf16x8*)((kb_) + koff[ks] + (ks < 4 ? 4096 : 2048)); \
        if (ks == 0) { P0 = MFMA32(a0_, qr[0], negm); P1 = MFMA32(a1_, qr[0], negm); } else { P0 = MFMA32(a0_, qr[ks], P0); P1 = MFMA32(a1_, qr[ks], P1); } } } while (0)
    constexpr int NT = SEQ / 64, G = (DK == 96) ? 3 : 2;
#define ROWMAX(dst, P0, P1) do { float a_ = fmaxf(fmaxf(P0[0], P0[1]), P1[0]), b_ = fmaxf(fmaxf(P0[2], P0[3]), P1[1]); a_ = fmaxf(fmaxf(a_, P1[2]), P1[3]); \
        _Pragma("unroll") for (int i = 4; i < 16; i += 4) { a_ = fmaxf(fmaxf(a_, P0[i]), P0[i + 1]); b_ = fmaxf(fmaxf(b_, P0[i + 2]), P0[i + 3]); a_ = fmaxf(fmaxf(a_, P1[i]), P1[i + 1]); b_ = fmaxf(fmaxf(b_, P1[i + 2]), P1[i + 3]); } \
        const float m_ = fmaxf(a_, b_); const auto rr_ = __builtin_amdgcn_permlane32_swap(__float_as_uint(m_), __float_as_uint(m_), false, false); \
        dst = fmaxf(__uint_as_float(rr_[0]), __uint_as_float(rr_[1])); } while (0)
    if (DK == 96) ATT_WAITBAR(6); else ATT_WAITBAR(4);
    QK_TILE(pA0, pA1, kp0);
    float dl; bool rebase = true;
    ROWMAX(dl, pA0, pA1);
#define STEP(t, P0, P1, Pn0, Pn1) do { \
        if ((t) + 3 <= NT) { if (DK == 96) ATT_WAITBAR(3); else ATT_WAITBAR(2); } else ATT_WAITBAR(0);       \
        if ((t) + 3 < NT) ISSUE_K((t) + 3); if ((t) + 2 < NT) ISSUE_V((t) + 2); \
          \
        if (rebase) { m += dl; const float al = ex2(-dl); l *= al; \
              _Pragma("unroll") for (int i = 0; i < 16; ++i) { P0[i] -= dl; P1[i] -= dl; negm[i] = -m; } \
              if (h == 0) wsf[r] = al; \
              _Pragma("unroll") for (int i = 0; i < 16; ++i) { const float f = wsf[crow(i, h)]; o0[i] *= f; o1[i] *= f; } } \
          \
        if ((t) + 1 < NT) QK_TILE(Pn0, Pn1, kp0 + (((t) + 1) % NS) * KSLOT); \
        _Pragma("unroll") for (int i = 0; i < 16; ++i) { P0[i] = ex2(P0[i]); l += P0[i]; P1[i] = ex2(P1[i]); l += P1[i]; } \
        const bf16x8 pa0_ = packp(P0, 0), pa1_ = packp(P0, 8), pa2_ = packp(P1, 0), pa3_ = packp(P1, 8); \
          \
        { const LAS unsigned char* vp_ = vp0 + ((t) % NS) * VSLOT; \
          _Pragma("unroll") for (int s_ = 0; s_ < 4; ++s_) { const bf16x8 pa_ = (s_ == 0) ? pa0_ : (s_ == 1) ? pa1_ : (s_ == 2) ? pa2_ : pa3_; \
            _Pragma("unroll") for (int db = 0; db < 2; ++db) { const s16x4 lo_ = vtr(vp_ + db * 4096 + s_ * 1024), hi_ = vtr(vp_ + db * 4096 + s_ * 1024 + 512); \
                const bf16x8 vf_ = {lo_[0], lo_[1], lo_[2], lo_[3], hi_[0], hi_[1], hi_[2], hi_[3]}; \
                if (db == 0) o0 = MFMA32(pa_, vf_, o0); else o1 = MFMA32(pa_, vf_, o1); } } } \
        if ((t) + 1 < NT) { float tm_; ROWMAX(tm_, Pn0, Pn1); dl = fmaxf(tm_, 0.f); rebase = __any(tm_ > 0.f); } \
    } while (0)
    for (int t = 0; t < NT; t += 2) {
        STEP(t, pA0, pA1, pB0, pB1);
        STEP(t + 1, pB0, pB1, pA0, pA1);
    }
    finish_store(o0, o1, l, wsf, stg, r, h, lane, oS + (size_t)(q0 + w * 32) * op, (size_t)op);
    ATT_WAITBAR(0);
#undef STEP
#undef ROWMAX
#undef QK_TILE
#undef ISSUE_K
#undef ISSUE_V
}

DI void dil_unit(LAS unsigned char* lds, int grp, int b, int head, int res, int c, const bf16* qkv, bf16* og, float* lse) {
    constexpr int SLOT = 16384, OFF_WS = 6 * SLOT, OFF_STG = OFF_WS + NWAVES * 256;
    const int tid = fresh_tid(), lane = tid & 63, r = lane & 31, h = lane >> 5; const int w = __builtin_amdgcn_readfirstlane(tid >> 6);
    LAS float* wsf = (LAS float*)(lds + OFF_WS) + w * 64;
    LAS unsigned short* stg = (LAS unsigned short*)(lds + OFF_STG) + w * 2048;
    const int dil = grp == 0 ? 1 : (grp == 1 ? 4 : 16), L = SEQ / dil, ntile = L / 64;
    const bf16* qb = qkv + (size_t)((((b * 3 + grp) * 3 + 0) * 8 + head) * SEQ) * 64;
    const bf16* kbp = qb + (size_t)8 * SEQ * 64; const bf16* vbp = qb + (size_t)16 * SEQ * 64;
#pragma unroll
    for (int s = 0; s < 6; ++s) {
        int sres, kb; bool valid;
        if (grp < 2) { sres = res; kb = 4 * c - 1 + s; valid = (kb >= 0) && (kb < ntile); }
        else { sres = 2 * res + (s >> 1); kb = s & 1; valid = s < 4; }
        if (valid) {
            const int krow = 64 * kb + 8 * w + (lane >> 3), vrow = 64 * kb + 16 * (w & 3) + (lane >> 2);
            dma16(kbp + (size_t)(sres * L + krow) * 64 + ((lane & 7) ^ (lane >> 3)) * 8, lds + s * SLOT + w * 1024);
            dma16(vbp + (size_t)(sres * L + vrow) * 64 + (w >> 2) * 32 + (lane & 3) * 8, lds + s * SLOT + 8192 + w * 1024);
        }
    }
    int wres, qi0, s0, kb0, nts;
    if (grp < 2) { wres = res; qi0 = 256 * c + 32 * w; s0 = w >> 1; kb0 = 4 * c + (w >> 1) - 1; nts = 3; }
    else { wres = 2 * res + (w >> 2); qi0 = 32 * (w & 3); s0 = 2 * (w >> 2); kb0 = 0; nts = 2; }
    bf16x8 qr[4]; int koff[4];
#pragma unroll
    for (int ks = 0; ks < 4; ++ks) koff[ks] = r * 128 + (((2 * ks + h) ^ (r & 7)) << 4);
    const bf16* qrow = qb + (size_t)(wres * L + qi0 + r) * 64 + 8 * h;
#pragma unroll
    for (int ks = 0; ks < 4; ++ks) qr[ks] = *(const bf16x8*)(qrow + 16 * ks);
    f32x16 o0, o1;
#pragma unroll
    for (int i = 0; i < 16; ++i) { o0[i] = 0.f; o1[i] = 0.f; }
    float m = NEGBIG, l = 0.f;
    ATT_WAITBAR(0);
    for (int j = 0; j < nts; ++j) {
        const int kb = kb0 + j;
        if (kb >= 0 && kb < ntile) {
            const LAS unsigned char* sp = lds + (s0 + j) * SLOT;
            tile_step<64, true>(sp, sp + 8192, koff, qr, o0, o1, m, l, wsf, r, h, lane, qi0 + r, 64 * kb);
        }
    }
    const size_t tok0 = (size_t)b * SEQ + wres + (size_t)dil * qi0;
    finish_store(o0, o1, l, wsf, stg, r, h, lane, og + tok0 * 512 + head * 64, (size_t)dil * 512);
    const float lt = l + __shfl_xor(l, 32);
    if (h == 0) lse[(tok0 + (size_t)dil * r) * 8 + head] = m + __builtin_amdgcn_logf(lt);
    ATT_WAITBAR(0);
}
}

#define XB_TMO      128
#define XB_XCNT(j)  (256  + 64 * (j))
#define XB_XSUB(j)  (1280 + 64 * (j))
#define XB_XGEN(j)  (2304 + 64 * (j))
#define XB_TOP      3328
#define XB_TOPGEN   3392
#define XCD_BAR_WORDS 3456
#define XB_SPIN_CAP (1u << 18)
DI unsigned xb_ld(unsigned* p)              { return __hip_atomic_load(p, __ATOMIC_RELAXED, __HIP_MEMORY_SCOPE_AGENT); }
DI unsigned xb_add(unsigned* p, unsigned v) { return __hip_atomic_fetch_add(p, v, __ATOMIC_RELAXED, __HIP_MEMORY_SCOPE_AGENT); }
DI unsigned xb_xcc_id() { return (unsigned)__builtin_amdgcn_s_getreg((3 << 11) | 20) & 0xFu; }
#define XB_SPIN(cond, bar) do { unsigned _sp = 0; while (cond) { __builtin_amdgcn_s_sleep(1); \
    if ((++_sp & 255u) == 0u) { if (xb_ld(&(bar)[XB_TMO])) break; if (_sp > XB_SPIN_CAP) { atomicAdd(&(bar)[XB_TMO], 1u); break; } } } } while (0)
struct XcdBarrier { unsigned* bar; unsigned x; volatile LAS unsigned* st; };
DI XcdBarrier xcd_barrier_post(unsigned* bar, volatile LAS unsigned* st) {
    XcdBarrier b; b.bar = bar; b.x = xb_xcc_id(); b.st = st;
    if (threadIdx.x == 0) (void)xb_add(&bar[XB_XCNT(b.x)], 1u);
    return b;
}
DI void xcd_barrier_complete(unsigned* bar, unsigned x, unsigned& nloc, unsigned& nx) {
    const unsigned G = gridDim.x * gridDim.y * gridDim.z;
    unsigned sum, cnt, mine, sp = 0u;
    for (;;) {
        sum = 0u; cnt = 0u; mine = 0u;
#pragma unroll
        for (unsigned j = 0; j < 16; ++j) { const unsigned c = xb_ld(&bar[XB_XCNT(j)]); sum += c; cnt += (c > 0u) ? 1u : 0u; mine = (j == x) ? c : mine; }
        if (sum == G) break;
        __builtin_amdgcn_s_sleep(1);
        if ((++sp & 255u) == 0u) { if (xb_ld(&bar[XB_TMO])) break; if (sp > XB_SPIN_CAP) { atomicAdd(&bar[XB_TMO], 1u); break; } }
    }
    nloc = mine > 0u ? mine : 1u; nx = cnt > 0u ? cnt : 1u;
}
DI void xcd_barrier(const XcdBarrier& b) {
    asm volatile("s_waitcnt vmcnt(0)" ::: "memory");
    __syncthreads();
    if (threadIdx.x == 0) {
        unsigned* bar = b.bar;
        __builtin_amdgcn_s_waitcnt(0);
        unsigned nloc = b.st[0], nx = b.st[1];
        if (nloc == 0u) { xcd_barrier_complete(bar, b.x, nloc, nx); b.st[0] = nloc; b.st[1] = nx; }
        const unsigned old = xb_add(&bar[XB_XSUB(b.x)], 1u);
        const unsigned gen = old / nloc;
        if (old + 1u == (gen + 1u) * nloc) {
            __builtin_amdgcn_fence(__ATOMIC_RELEASE, "agent");
            asm volatile("s_waitcnt vmcnt(0)" ::: "memory");
            const unsigned og = xb_add(&bar[XB_TOP], 1u);
            const unsigned tg = og / nx;
            if (og + 1u == (tg + 1u) * nx) xb_add(&bar[XB_TOPGEN], 1u);
            else XB_SPIN(xb_ld(&bar[XB_TOPGEN]) == tg, bar);
            __builtin_amdgcn_fence(__ATOMIC_ACQUIRE, "agent");
            xb_add(&bar[XB_XGEN(b.x)], 1u);
            asm volatile("s_waitcnt vmcnt(0)" ::: "memory");
        } else {
            XB_SPIN(xb_ld(&bar[XB_XGEN(b.x)]) == gen, bar);
            __builtin_amdgcn_fence(__ATOMIC_ACQUIRE, "agent");
            asm volatile("s_waitcnt vmcnt(0)" ::: "memory");
        }
    }
    __syncthreads();
}

struct Ctx { int wave, G, bid; LAS unsigned char* lds; };

template <bool F8>
DI void transpose_item(const float* W, int K, int N, void* WTv, int ldo, int row_off, int gu, LAS float* scr, int item, int lane, const float* gk = nullptr) {
    const int nblk = N / 32, kb = item / nblk, nb = item % nblk, k0 = 64 * kb, n0 = 32 * nb;
    float v[32];
    const float* src = W + (size_t)(k0 + (lane >> 5)) * N + n0 + (lane & 31);
#pragma unroll
    for (int i = 0; i < 32; ++i) v[i] = src[(size_t)(2 * i) * N];
    if (gk) {
#pragma unroll
        for (int i = 0; i < 32; ++i) v[i] *= gk[k0 + 2 * i + (lane >> 5)];
    }
#pragma unroll
    for (int i = 0; i < 32; ++i) scr[(2 * i + (lane >> 5)) * 33 + (lane & 31)] = v[i];
    asm volatile("s_waitcnt lgkmcnt(0)" ::: "memory");
    const int c = lane & 7;
    const int orow0 = row_off + (gu == 0 ? n0 : ((n0 >> 7) * 256 + (gu - 1) * 128 + (n0 & 127)));
#pragma unroll
    for (int j = 0; j < 4; ++j) { const int n = (lane >> 3) + 8 * j; const LAS float* s = scr + (8 * c) * 33 + n;
        if (F8) { u32x2 o; o.x = pg8::pk4_fp8(64.f * s[0 * 33], 64.f * s[1 * 33], 64.f * s[2 * 33], 64.f * s[3 * 33]); o.y = pg8::pk4_fp8(64.f * s[4 * 33], 64.f * s[5 * 33], 64.f * s[6 * 33], 64.f * s[7 * 33]);
            *(u32x2*)((unsigned char*)WTv + (size_t)(orow0 + n) * ldo + k0 + 8 * c) = o; }
        else { u32x4 o; o.x = pk2(s[0 * 33], s[1 * 33]); o.y = pk2(s[2 * 33], s[3 * 33]); o.z = pk2(s[4 * 33], s[5 * 33]); o.w = pk2(s[6 * 33], s[7 * 33]);
            *(u32x4*)((bf16*)WTv + (size_t)(orow0 + n) * ldo + k0 + 8 * c) = o; } }
    asm volatile("s_waitcnt lgkmcnt(0)" ::: "memory");
}

DI void sincos_d(double a, float& c, float& s) {
    const double TWO_PI = 6.283185307179586476925286766559, INV = 0.15915494309189533576888376337251;
    const double n = __builtin_rint(a * INV); double x = (a - n * TWO_PI) * 0.25; const double x2 = x * x;
    double sn = x * (1.0 + x2 * (-1.0 / 6 + x2 * (1.0 / 120 + x2 * (-1.0 / 5040 + x2 * (1.0 / 362880 + x2 * (-1.0 / 39916800 + x2 * (1.0 / 6227020800.0)))))));
    double cs = 1.0 + x2 * (-0.5 + x2 * (1.0 / 24 + x2 * (-1.0 / 720 + x2 * (1.0 / 40320 + x2 * (-1.0 / 3628800 + x2 * (1.0 / 479001600.0))))));
#pragma unroll
    for (int i = 0; i < 2; ++i) { const double s2 = 2.0 * sn * cs, c2 = cs * cs - sn * sn; sn = s2; cs = c2; }
    c = (float)cs; s = (float)sn;
}

DI void rows_first(const Ctx& C, const float* x, bf16* hb, float* rstd) {
    const int gw = C.bid * NWAVES + C.wave, NGW = C.G * NWAVES, lane = fresh_tid() & 63;
    for (int m = gw; m < NTOK; m += NGW) {
        const f32x4* xr = (const f32x4*)(x + (size_t)m * DM) + lane;
        f32x4 v[4]; float s = 0.f;
#pragma unroll
        for (int j = 0; j < 4; ++j) { v[j] = xr[64 * j]; s += (v[j].x * v[j].x + v[j].y * v[j].y) + (v[j].z * v[j].z + v[j].w * v[j].w); }
        const float ri = rsq(wave_sum(s) * (1.f / DM) + EPS);
        u32x2* o8 = (u32x2*)(hb + (size_t)m * DM) + lane;
#pragma unroll
        for (int j = 0; j < 4; ++j) { u32x2 o; o.x = pk2(v[j].x, v[j].y); o.y = pk2(v[j].z, v[j].w); o8[64 * j] = o; }
        if (lane == 0) rstd[m] = ri;
    }
}

struct RowRaw { u32x2 t1[4], t2[4], hb[4]; f32x4 h32[4]; f32x2 gg; };
template <bool MOE, bool HIN32>
DI void row_load(RowRaw& R, int m, int lane_, const float* hin32, const bf16* hb, const bf16* term, const int* toks, const f32x2* tokg) {
    if (MOE) {
        const int s1 = toks[2 * m], s2 = toks[2 * m + 1]; R.gg = tokg[m];
        const u32x2* y1 = (const u32x2*)(term + (size_t)s1 * DM) + lane_; const u32x2* y2 = (const u32x2*)(term + (size_t)s2 * DM) + lane_;
#pragma unroll
        for (int j = 0; j < 4; ++j) { R.t1[j] = y1[64 * j]; R.t2[j] = y2[64 * j]; }
    } else {
        const u32x2* tr = (const u32x2*)(term + (size_t)m * DM) + lane_;
#pragma unroll
        for (int j = 0; j < 4; ++j) R.t1[j] = tr[64 * j];
    }
    if (HIN32) { const f32x4* hr = (const f32x4*)(hin32 + (size_t)m * DM) + lane_;
#pragma unroll
        for (int j = 0; j < 4; ++j) R.h32[j] = hr[64 * j];
    } else { const u32x2* hr = (const u32x2*)(hb + (size_t)m * DM) + lane_;
#pragma unroll
        for (int j = 0; j < 4; ++j) R.hb[j] = hr[64 * j];
    }
}
template <bool MOE, bool NEXT, bool ROUTE, bool HIN32, bool FINAL>
DI void rows_residual(const Ctx& C, const float* hin32, bf16* hb, float* out32, const bf16* term, const float* gpost, const float* gnext, float* rstd,
                      const int* toks, const f32x2* tokg, const float* wrouter, int* toke, f32x2* tokg_out, int* cnt_out) {
    const int gw = C.bid * NWAVES + C.wave, NGW = C.G * NWAVES, tid_ = fresh_tid(), lane_ = tid_ & 63;
    f32x4 gp[4], gn[4];
#pragma unroll
    for (int j = 0; j < 4; ++j) { gp[j] = *((const f32x4*)gpost + lane_ + 64 * j); gn[j] = ROUTE ? *((const f32x4*)gnext + lane_ + 64 * j) : (f32x4){0.f, 0.f, 0.f, 0.f}; }
    LAS int* lcnt = (LAS int*)C.lds;
    if (ROUTE) { if (tid_ < 8) lcnt[tid_] = 0; __syncthreads(); }
    const int rows_per_wave = NTOK / NGW;
    const int nrows = ROUTE ? rows_per_wave : (NTOK - gw + NGW - 1) / NGW;
#define ROW_OF(it_) (ROUTE ? (gw * rows_per_wave + (it_)) : (gw + (it_) * NGW))
    RowRaw cur, nxt;
    if (nrows > 0) row_load<MOE, HIN32>(cur, ROW_OF(0), lane_, hin32, hb, term, toks, tokg);
    for (int it = 0; it < nrows; ++it) {
        const int m = ROW_OF(it);
        if (it + 1 < nrows) row_load<MOE, HIN32>(nxt, ROW_OF(it + 1), lane_, hin32, hb, term, toks, tokg);
        f32x4 t[4], hv[4];
#pragma unroll
        for (int j = 0; j < 4; ++j) { const u32x2 a = cur.t1[j];
            if (MOE) { const u32x2 b = cur.t2[j]; const f32x2 gg = cur.gg;
                t[j].x = gg.x * __uint_as_float(a.x << 16) + gg.y * __uint_as_float(b.x << 16); t[j].y = gg.x * __uint_as_float(a.x & 0xffff0000u) + gg.y * __uint_as_float(b.x & 0xffff0000u);
                t[j].z = gg.x * __uint_as_float(a.y << 16) + gg.y * __uint_as_float(b.y << 16); t[j].w = gg.x * __uint_as_float(a.y & 0xffff0000u) + gg.y * __uint_as_float(b.y & 0xffff0000u); }
            else { t[j].x = __uint_as_float(a.x << 16); t[j].y = __uint_as_float(a.x & 0xffff0000u); t[j].z = __uint_as_float(a.y << 16); t[j].w = __uint_as_float(a.y & 0xffff0000u); }
            if (HIN32) hv[j] = cur.h32[j];
            else { const u32x2 c = cur.hb[j]; hv[j].x = __uint_as_float(c.x << 16); hv[j].y = __uint_as_float(c.x & 0xffff0000u); hv[j].z = __uint_as_float(c.y << 16); hv[j].w = __uint_as_float(c.y & 0xffff0000u); } }
        float s = 0.f;
#pragma unroll
        for (int j = 0; j < 4; ++j) s += (t[j].x * t[j].x + t[j].y * t[j].y) + (t[j].z * t[j].z + t[j].w * t[j].w);
        const float ri = rsq(wave_sum(s) * (1.f / DM) + EPS);
        float s2 = 0.f;
#pragma unroll
        for (int j = 0; j < 4; ++j) { hv[j] = hv[j] + t[j] * ri * gp[j]; s2 += (hv[j].x * hv[j].x + hv[j].y * hv[j].y) + (hv[j].z * hv[j].z + hv[j].w * hv[j].w); }
        if (FINAL) { f32x4* ho = (f32x4*)(out32 + (size_t)m * DM) + lane_;
#pragma unroll
            for (int j = 0; j < 4; ++j) ho[64 * j] = hv[j];
        } else { u32x2* o8 = (u32x2*)(hb + (size_t)m * DM) + lane_;
#pragma unroll
            for (int j = 0; j < 4; ++j) { u32x2 o; o.x = pk2(hv[j].x, hv[j].y); o.y = pk2(hv[j].z, hv[j].w); o8[64 * j] = o; }
        }
        if (NEXT) {
            const float r2 = rsq(wave_sum(s2) * (1.f / DM) + EPS);
            if (lane_ == 0) rstd[m] = r2;
            if (ROUTE) {
#pragma unroll
                for (int j = 0; j < 4; ++j) hv[j] = hv[j] * r2 * gn[j];
                float lg[8];
#pragma unroll
                for (int e = 0; e < 8; ++e) lg[e] = 0.f;
#pragma unroll
                for (int j = 0; j < 4; ++j)
#pragma unroll
                    for (int q = 0; q < 4; ++q) { const f32x4* wp = (const f32x4*)(wrouter + (size_t)(4 * lane_ + 256 * j + q) * 8); const f32x4 w0 = wp[0], w1 = wp[1]; const float a = hv[j][q];
                        lg[0] += a * w0.x; lg[1] += a * w0.y; lg[2] += a * w0.z; lg[3] += a * w0.w; lg[4] += a * w1.x; lg[5] += a * w1.y; lg[6] += a * w1.z; lg[7] += a * w1.w; }
#pragma unroll
                for (int e = 0; e < 8; ++e) lg[e] = wave_sum(lg[e]);
                int e1 = 0; float l1 = lg[0];
#pragma unroll
                for (int e = 1; e < 8; ++e) if (lg[e] > l1) { l1 = lg[e]; e1 = e; }
                int e2 = -1; float l2 = -3.0e38f;
#pragma unroll
                for (int e = 0; e < 8; ++e) if (e != e1 && lg[e] > l2) { l2 = lg[e]; e2 = e; }
                if (lane_ == 0) { const float p2 = 1.0f / (1.0f + ex2((l1 - l2) * LOG2E)); toke[m] = e1 | (e2 << 8); tokg_out[m] = (f32x2){1.0f - p2, p2};
                    atomicAdd((int*)lcnt + e1, 1); atomicAdd((int*)lcnt + e2, 1); }
            }
        }
        cur = nxt;
    }
#undef ROW_OF
    if (ROUTE) { __syncthreads(); if (tid_ < 8) cnt_out[C.bid * 8 + tid_] = lcnt[tid_]; }
}

DI void rows_l0_post(const Ctx& C, const bf16* zin, const float* gq, const float* gk, const float* gcq, const float* gckv, const f32x2* taba,
                     bf16* qa, bf16* ka, bf16* cqn, bf16* ckvn, bf16* kr) {
    const int gw = C.bid * NWAVES + C.wave, NGW = C.G * NWAVES, lane = fresh_tid() & 63;
    const int s8 = lane & 7;
    float gqv[8], gkv[8], gcqv[8], gckvv[8];
#pragma unroll
    for (int j = 0; j < 8; ++j) { gqv[j] = gq[8 * s8 + j]; gkv[j] = gk[8 * s8 + j]; gcqv[j] = gcq[8 * (lane & 31) + j]; gckvv[j] = gckv[8 * (lane & 15) + j]; }
    const int part = s8 >> 2, isx2 = (s8 >> 1) & 1, fb = 8 * (s8 & 1);
    for (int tok = gw; tok < NTOK; tok += NGW) {
        const int t = tok & (SEQ - 1), prow = t >> 6, pcol = t & 63;
        const bf16* z = zin + (size_t)tok * ZW;
        float x[8], y[8], p[8];
        unpack8(*(const u32x4*)(z + 8 * lane), x);
        float ss = 0.f;
#pragma unroll
        for (int j = 0; j < 8; ++j) ss += x[j] * x[j];
        ss += __shfl_xor(ss, 1); ss += __shfl_xor(ss, 2); ss += __shfl_xor(ss, 4);
        float ri = rsq(ss * (1.f / 64) + EPS);
#pragma unroll
        for (int j = 0; j < 8; ++j) y[j] = x[j] * ri * gqv[j];
#pragma unroll
        for (int j = 0; j < 8; ++j) p[j] = __shfl_xor(y[j], 2);
        const f32x2* tp = taba + (size_t)(part ? pcol : prow) * 16 + fb;
#pragma unroll
        for (int j = 0; j < 8; ++j) { const f32x2 cs = tp[j]; y[j] = (isx2 ? (y[j] * cs.x + p[j] * cs.y) : (y[j] * cs.x - p[j] * cs.y)) * C2_64; }
        *(u32x4*)(qa + (size_t)tok * 512 + 8 * lane) = pack8(y);
        unpack8(*(const u32x4*)(z + 512 + 8 * lane), x);
        ss = 0.f;
#pragma unroll
        for (int j = 0; j < 8; ++j) ss += x[j] * x[j];
        float s3 = ss; s3 += __shfl_xor(s3, 1); s3 += __shfl_xor(s3, 2); s3 += __shfl_xor(s3, 4);
        float s5 = s3; s5 += __shfl_xor(s5, 8); s5 += __shfl_xor(s5, 16);
        if (lane < 16) {
            ri = rsq(s3 * (1.f / 64) + EPS);
#pragma unroll
            for (int j = 0; j < 8; ++j) y[j] = x[j] * ri * gkv[j];
        } else {
            ri = rsq(s5 * (1.f / 256) + EPS);
#pragma unroll
            for (int j = 0; j < 8; ++j) y[j] = x[j] * ri * gcqv[j];
        }
#pragma unroll
        for (int j = 0; j < 8; ++j) p[j] = __shfl_xor(y[j], 2);
        if (lane < 16) {
#pragma unroll
            for (int j = 0; j < 8; ++j) { const f32x2 cs = tp[j]; y[j] = isx2 ? (y[j] * cs.x + p[j] * cs.y) : (y[j] * cs.x - p[j] * cs.y); }
            *(u32x4*)(ka + (size_t)tok * 128 + 8 * lane) = pack8(y);
        } else if (lane >= 32) {
            *(u32x4*)(cqn + (size_t)tok * 256 + 8 * (lane - 32)) = pack8(y);
        }
        u32x4 w2 = (u32x4){0u, 0u, 0u, 0u};
        if (lane < 32) w2 = *(const u32x4*)(z + 1024 + 8 * lane);
        unpack8(w2, x);
        ss = 0.f;
#pragma unroll
        for (int j = 0; j < 8; ++j) ss += x[j] * x[j];
        ss += __shfl_xor(ss, 1); ss += __shfl_xor(ss, 2); ss += __shfl_xor(ss, 4); ss += __shfl_xor(ss, 8);
#pragma unroll
        for (int j = 0; j < 8; ++j) p[j] = __shfl_xor(x[j], 2);
        if (lane < 16) {
            ri = rsq(ss * (1.f / 128) + EPS);
#pragma unroll
            for (int j = 0; j < 8; ++j) y[j] = x[j] * ri * gckvv[j];
            *(u32x4*)(ckvn + (size_t)tok * 256 + 8 * lane) = pack8(y);
        } else if (lane < 32) {
            *(u32x4*)(ckvn + (size_t)tok * 256 + 8 * lane) = (u32x4){0u, 0u, 0u, 0u};
            if (lane < 20) {
                const int sl = lane - 16; const f32x2* tq = taba + (size_t)t * 16 + 8 * (sl & 1);
#pragma unroll
                for (int j = 0; j < 8; ++j) { const f32x2 cs = tq[j]; y[j] = (sl >> 1) ? (x[j] * cs.x + p[j] * cs.y) : (x[j] * cs.x - p[j] * cs.y); }
                *(u32x4*)(kr + (size_t)tok * 32 + 8 * sl) = pack8(y);
            }
        }
    }
}

DI void rows_merge(const Ctx& C, const bf16* og, const float* lse, bf16* o1) {
    const int gw = C.bid * NWAVES + C.wave, NGW = C.G * NWAVES, lane = fresh_tid() & 63, head = lane >> 3;
    for (int tok = gw; tok < NTOK; tok += NGW) {
        const float l0 = lse[(size_t)tok * 8 + head], l1 = lse[(size_t)(NTOK + tok) * 8 + head], l2 = lse[(size_t)(2 * NTOK + tok) * 8 + head];
        const float mx = fmaxf(l0, fmaxf(l1, l2));
        float w0 = ex2(l0 - mx), w1 = ex2(l1 - mx), w2 = ex2(l2 - mx); const float inv = 1.0f / (w0 + w1 + w2); w0 *= inv; w1 *= inv; w2 *= inv;
        float a[8], b[8], c[8], o[8];
        unpack8(*(const u32x4*)(og + (size_t)tok * 512 + 8 * lane), a);
        unpack8(*(const u32x4*)(og + (size_t)(NTOK + tok) * 512 + 8 * lane), b);
        unpack8(*(const u32x4*)(og + (size_t)(2 * NTOK + tok) * 512 + 8 * lane), c);
#pragma unroll
        for (int j = 0; j < 8; ++j) o[j] = w0 * a[j] + w1 * b[j] + w2 * c[j];
        *(u32x4*)(o1 + (size_t)tok * 512 + 8 * lane) = pack8(o);
    }
}

DI void moe_assign_gather(const Ctx& C, const int* cnt, const int* toke, int* toks, int* tilee, const bf16* xn, const float* rstd, unsigned char* xs) {
    LAS int* L = (LAS int*)C.lds;
    const int lane = fresh_tid() & 63, w = C.bid;
    if (C.wave == 0) {
        int base[8]; int tot[8];
#pragma unroll
        for (int e = 0; e < 8; ++e) { int below = 0, all = 0;
            for (int i = lane; i < C.G; i += 64) { const int c = cnt[i * 8 + e]; all += c; if (i < w) below += c; }
#pragma unroll
            for (int o = 1; o < 64; o <<= 1) { below += __shfl_xor(below, o); all += __shfl_xor(all, o); }
            base[e] = below; tot[e] = all; }
        int start = 0;
#pragma unroll
        for (int e = 0; e < 8; ++e) { const int padded = (tot[e] + 255) & ~255; base[e] += start;
            if (w == 0) { for (int tix = (start >> 8) + lane; tix < ((start + padded) >> 8); tix += 64) tilee[8 + tix] = e; }
            start += padded; }
        if (w == 0 && lane == 0) tilee[0] = start >> 8;
#pragma unroll
        for (int k = 0; k < 4; ++k) {
            const int pidx = 64 * k + lane, tok = 128 * w + (pidx >> 1), kk = pidx & 1;
            const int e = (toke[tok] >> (8 * kk)) & 0xff; int slot = 0;
#pragma unroll
            for (int ee = 0; ee < 8; ++ee) { const unsigned long long mk = __ballot(e == ee); const int rank = __popcll(mk & ((1ull << lane) - 1ull));
                if (e == ee) slot = base[ee] + rank; base[ee] += __popcll(mk); }
            toks[2 * tok + kk] = slot; L[16 + pidx] = slot;
        }
    }
    __syncthreads();
    for (int i = 0; i < 32; ++i) { const int pidx = 32 * C.wave + i, tok = 128 * w + (pidx >> 1), slot = L[16 + pidx];
        const u32x4* src = (const u32x4*)(xn + (size_t)tok * DM) + 2 * lane; const u32x4 a = src[0], b = src[1]; float x[8], y[8]; unpack8(a, x); unpack8(b, y); const float rs = rstd[tok];
#pragma unroll
        for (int j = 0; j < 8; ++j) { x[j] *= rs; y[j] *= rs; }
        u32x4 o; o.x = pg8::pk4_fp8(x[0], x[1], x[2], x[3]); o.y = pg8::pk4_fp8(x[4], x[5], x[6], x[7]); o.z = pg8::pk4_fp8(y[0], y[1], y[2], y[3]); o.w = pg8::pk4_fp8(y[4], y[5], y[6], y[7]);
        *((u32x4*)(xs + (size_t)slot * DM) + lane) = o; }
    __syncthreads();
}

struct Args { const float* in[27]; float* out; unsigned char* ws; };
enum { I_X = 0, I_P, I_MIXPRE, I_MIXPOST, I_FFNPRE, I_FFNPOST, I_PLEPROJ, I_PLEGN, I_PLEGATE, I_PLEPOST, I_WIN, I_GQ, I_GK, I_GCQ, I_WUQ, I_GCKV, I_WUKV, I_WOUT0,
       I_WG0, I_WU0, I_WD0, I_WQKV1, I_WOUT1, I_WR, I_MWG, I_MWU, I_MWD };

DI const float* arg_in(int i) { const __attribute__((address_space(4))) char* kp = (const __attribute__((address_space(4))) char*)__builtin_amdgcn_kernarg_segment_ptr(); asm volatile("" : "+s"(kp));
    return *(const float* const __attribute__((address_space(4)))*)(kp + 8 * i); }
__global__ void __launch_bounds__(NTHREADS, 2) fwd_kernel(Args a) {
    extern __shared__ __attribute__((aligned(16))) unsigned char lds_raw[];
    LAS unsigned char* lds = (LAS unsigned char*)lds_raw;
    volatile LAS unsigned* MISC = (volatile LAS unsigned*)(lds + MISC_OFF);
    Ctx C; C.wave = __builtin_amdgcn_readfirstlane((int)threadIdx.x >> 6); C.G = gridDim.x; C.bid = blockIdx.x; C.lds = lds;
    unsigned char* ws = a.ws;
#define AIN(i) arg_in(i)
    unsigned* ctl = (unsigned*)(ws + WS_CTL);
    for (int u = threadIdx.x; u < (LDS_BYTES - LDSCTL_OFF) / 4; u += NTHREADS) ((LAS unsigned*)(lds + LDSCTL_OFF))[u] = 0u;
    __syncthreads();
    XcdBarrier bar = xcd_barrier_post(ctl + CW_BAR, MISC + 8);
#define GRID_BAR() xcd_barrier(bar)
    const int gw = C.bid * NWAVES + C.wave, NGW = C.G * NWAVES, NGT = C.G * NTHREADS;
    const f32x2* taba = (const f32x2*)(ws + WS_TABA); const f32x2* tabp = (const f32x2*)(ws + WS_TABP);
    bf16* XN = (bf16*)(ws + WS_XN);
    float* hres = a.out;

    {
        LAS float* scr = (LAS float*)(lds + C.wave * 16384);
        const int tid = fresh_tid(), lane = tid & 63, gtid = C.bid * NTHREADS + tid;
#define TR(Wp, Kd, Nd, dst, ldo, roff, gu, gk) { constexpr int NI_ = ((Kd) / 64) * ((Nd) / 32); if (r < NI_) { transpose_item<false>((Wp), (Kd), (Nd), (bf16*)(dst), (ldo), (roff), (gu), scr, r, lane, (gk)); continue; } r -= NI_; }
        constexpr int NSMALL = 16 * 37 + 4 * 24 + 2 * 32 + 16 * 32 + 3 * 1792 + 2 * 128 + 2 * 512 + 16 * 144 + 8 * 32;
        for (int it = gw; it < NSMALL; it += NGW) {
            int r = it;
            TR(AIN(I_WIN), 1024, 1184, ws + W_IN, 1024, 0, 0, AIN(I_MIXPRE))
            TR(AIN(I_WUQ), 256, 768, ws + W_UQ, 256, 0, 0, nullptr)
            TR(AIN(I_WUKV), 128, 1024, ws + W_UKV, 256, 0, 0, nullptr)
            TR(AIN(I_WOUT0), 1024, 1024, ws + W_OUT0, 1024, 0, 0, nullptr)
            TR(AIN(I_WG0), 1024, 3584, ws + W_GU0, 1024, 0, 1, AIN(I_FFNPRE))
            TR(AIN(I_WU0), 1024, 3584, ws + W_GU0, 1024, 0, 2, AIN(I_FFNPRE))
            TR(AIN(I_WD0), 3584, 1024, ws + W_D0, 3584, 0, 0, nullptr)
            TR(AIN(I_PLEPROJ), 256, 1024, ws + W_PP, 256, 0, 0, nullptr)
            TR(AIN(I_PLEPROJ) + 256 * 1024, 256, 1024, ws + W_PP + 1024 * 256 * 2, 256, 0, 0, nullptr)
            TR(AIN(I_PLEGATE), 1024, 1024, ws + W_PG, 1024, 0, 0, AIN(I_PLEGN))
            TR(AIN(I_PLEGATE) + 1024 * 1024, 1024, 1024, ws + W_PG + 1024 * 1024 * 2, 1024, 0, 0, AIN(I_PLEGN) + DM)
            TR(AIN(I_WQKV1), 1024, 4608, ws + W_QKV1, 1024, 0, 0, AIN(I_MIXPRE) + DM)
            TR(AIN(I_WOUT1), 512, 1024, ws + W_OUT1, 512, 0, 0, nullptr)
        }
        for (int i = gtid; i < 12288; i += NGT) ((u32x4*)(ws + W_IN + (size_t)1184 * 1024 * 2))[i] = (u32x4){0u, 0u, 0u, 0u};
        for (int i = gtid; i < 16384; i += NGT) ((u32x4*)(ws + W_UKV))[(size_t)(i >> 4) * 32 + 16 + (i & 15)] = (u32x4){0u, 0u, 0u, 0u};
        for (int i = gtid; i < 2048 * 16; i += NGT) { const int t = i >> 4, f = i & 15; double iv = 1.0; for (int k = 0; k < f; ++k) iv *= 0.56234132519034907; const float ang = (float)t * (float)iv;
            float c, s; sincos_d((double)ang, c, s); ((f32x2*)(ws + WS_TABA))[i] = (f32x2){c, s}; }
        for (int i = gtid; i < 2048 * 8; i += NGT) { const int t = i >> 3, f = i & 7; double iv = 1.0; for (int k = 0; k < f; ++k) iv *= 0.19392274474868576; const float ang = (float)t * (float)iv;
            float c, s; sincos_d((double)ang, c, s); ((f32x2*)(ws + WS_TABP))[i] = (f32x2){c, s}; }
        for (int i = gtid; i < 2 * NTOK * 256 / 8; i += NGT) { const f32x4 u0 = ((const f32x4*)AIN(I_P))[2 * i], u1 = ((const f32x4*)AIN(I_P))[2 * i + 1];
            u32x4 o; o.x = pk2(u0.x, u0.y); o.y = pk2(u0.z, u0.w); o.z = pk2(u1.x, u1.y); o.w = pk2(u1.z, u1.w); ((u32x4*)(ws + WS_PB))[i] = o; }
        rows_first(C, AIN(I_X), XN, (float*)(ws + WS_RSTD));
    }
    GRID_BAR();

    { pg8::Gemm g{XN, (const bf16*)(ws + W_IN), 1024, 1024, 1024}; pg8::StaticOrder S; S.init(NTOK / 256, ZW / 256, C.G, C.bid);
      pg8::EpiStore E{(bf16*)(ws + B_ZIN), ZW, 1.0f, (const float*)(ws + WS_RSTD)}; pg8::gemm_phase(lds, g, S, E); }
    GRID_BAR();
    rows_l0_post(C, (const bf16*)(ws + B_ZIN), AIN(I_GQ), AIN(I_GK), AIN(I_GCQ), AIN(I_GCKV), taba,
                 (bf16*)(ws + B_QA), (bf16*)(ws + B_KA), (bf16*)(ws + B_CQN), (bf16*)(ws + B_CKVN), (bf16*)(ws + B_KR));
    GRID_BAR();
    { pg8::Gemm g{(const bf16*)(ws + B_CQN), (const bf16*)(ws + W_UQ), 256, 256, 256}; pg8::StaticOrder S; S.init(NTOK / 256, 3, C.G, C.bid);
      pg8::EpiStore E{(bf16*)(ws + B_QM), 768, C2_96, nullptr}; pg8::gemm_phase(lds, g, S, E); }
    { pg8::Gemm g{(const bf16*)(ws + B_CKVN), (const bf16*)(ws + W_UKV), 256, 256, 256}; pg8::StaticOrder S; S.init(NTOK / 256, 4, C.G, C.bid);
      pg8::EpiStore E{(bf16*)(ws + B_KV), 1024, 1.0f, nullptr}; pg8::gemm_phase(lds, g, S, E); }
    GRID_BAR();
    for (int u = C.bid; u < 1024; u += C.G) {
        const int b = u >> 6, head = (u >> 3) & 7, ch = u & 7, kvh = head >> 2; const size_t rb = (size_t)b * SEQ;
        att::dense_unit<64>(lds, (const bf16*)(ws + B_QA) + rb * 512 + head * 64, 512, 256 * ch, (const bf16*)(ws + B_KA) + rb * 128 + kvh * 64, 128, nullptr,
                            (const bf16*)(ws + B_ZIN) + rb * ZW + 640 + kvh * 64, ZW, (bf16*)(ws + B_O0) + rb * 1024 + head * 64, 1024, taba);
    }
    for (int u = C.bid; u < 1024; u += C.G) {
        const int b = u >> 6, head = (u >> 3) & 7, ch = u & 7; const size_t rb = (size_t)b * SEQ;
        att::dense_unit<96>(lds, (const bf16*)(ws + B_QM) + rb * 768 + head * 96, 768, 256 * ch, (const bf16*)(ws + B_KV) + rb * 1024 + head * 128, 1024, (const bf16*)(ws + B_KR) + rb * 32,
                            (const bf16*)(ws + B_KV) + rb * 1024 + head * 128 + 64, 1024, (bf16*)(ws + B_O0) + rb * 1024 + 512 + head * 64, 1024, taba);
    }
    GRID_BAR();
    { pg8::Gemm g{(const bf16*)(ws + B_O0), (const bf16*)(ws + W_OUT0), 1024, 1024, 1024}; pg8::StaticOrder S; S.init(NTOK / 256, 4, C.G, C.bid);
      pg8::EpiStore E{(bf16*)(ws + B_MO0), 1024, 1.0f, nullptr}; pg8::gemm_phase(lds, g, S, E); }
    GRID_BAR();
    rows_residual<false, true, false, true, false>(C, AIN(I_X), XN, nullptr, (const bf16*)(ws + B_MO0), AIN(I_MIXPOST), nullptr, (float*)(ws + WS_RSTD), nullptr, nullptr, nullptr, nullptr, nullptr, nullptr);
    GRID_BAR();
    { pg8::Gemm g{XN, (const bf16*)(ws + W_GU0), 1024, 1024, 1024}; pg8::StaticOrder S; S.init(NTOK / 256, 28, C.G, C.bid);
      pg8::EpiSwiGLU E{(bf16*)(ws + B_HID), DFF, (const float*)(ws + WS_RSTD)}; pg8::gemm_phase(lds, g, S, E); }
    GRID_BAR();
    { pg8::Gemm g{(const bf16*)(ws + B_HID), (const bf16*)(ws + W_D0), DFF, DFF, DFF}; pg8::StaticOrder S; S.init(NTOK / 256, 4, C.G, C.bid);
      pg8::EpiStore E{(bf16*)(ws + B_F), 1024, 1.0f, nullptr}; pg8::gemm_phase(lds, g, S, E); }
    { pg8::Gemm g{(const bf16*)(ws + WS_PB), (const bf16*)(ws + W_PP), 256, 256, 256}; pg8::StaticOrder S; S.init(NTOK / 256, 4, C.G, C.bid);
      pg8::EpiStore E{(bf16*)(ws + B_E0), 1024, 1.0f, nullptr}; pg8::gemm_phase(lds, g, S, E); }
    GRID_BAR();
    rows_residual<false, true, false, false, false>(C, nullptr, XN, nullptr, (const bf16*)(ws + B_F), AIN(I_FFNPOST), nullptr, (float*)(ws + WS_RSTD), nullptr, nullptr, nullptr, nullptr, nullptr, nullptr);
    GRID_BAR();
    { pg8::Gemm g{XN, (const bf16*)(ws + W_PG), 1024, 1024, 1024}; pg8::StaticOrder S; S.init(NTOK / 256, 4, C.G, C.bid);
      pg8::EpiPleGate E{(const bf16*)(ws + B_E0), (bf16*)(ws + B_E), 1024, (const float*)(ws + WS_RSTD)}; pg8::gemm_phase(lds, g, S, E); }
    GRID_BAR();
    rows_residual<false, true, false, false, false>(C, nullptr, XN, nullptr, (const bf16*)(ws + B_E), AIN(I_PLEPOST), nullptr, (float*)(ws + WS_RSTD), nullptr, nullptr, nullptr, nullptr, nullptr, nullptr);
    GRID_BAR();

    { pg8::Gemm g{XN, (const bf16*)(ws + W_QKV1), 1024, 1024, 1024}; pg8::StaticOrder S; S.init(NTOK / 256, 18, C.G, C.bid);
      pg8::EpiQKV1 E{(bf16*)(ws + B_QKV), tabp, (const float*)(ws + WS_RSTD)}; pg8::gemm_phase(lds, g, S, E); }
    GRID_BAR();
    for (int u = C.bid; u < 3072; u += C.G) {
        const int grp = u >> 10, idx = u & 1023, b = idx >> 6, head = (idx >> 3) & 7;
        const int res = grp == 0 ? 0 : (grp == 1 ? ((idx >> 1) & 3) : (idx & 7)), ch = grp == 0 ? (idx & 7) : (grp == 1 ? (idx & 1) : 0);
        att::dil_unit(lds, grp, b, head, res, ch, (const bf16*)(ws + B_QKV), (bf16*)(ws + B_OG) + (size_t)grp * NTOK * 512, (float*)(ws + WS_LSE) + (size_t)grp * NTOK * 8);
    }
    GRID_BAR();
    rows_merge(C, (const bf16*)(ws + B_OG), (const float*)(ws + WS_LSE), (bf16*)(ws + B_O1));
    {
        LAS float* scr = (LAS float*)(lds + C.wave * 16384);
        const int lane = fresh_tid() & 63;
        for (int it = gw; it < 3 * 8 * 1792; it += NGW) {
            const int kind = it / (8 * 1792), e = (it / 1792) & 7, r = it % 1792;
            if (kind == 0) transpose_item<true>(AIN(I_MWG) + (size_t)e * 1024 * DFF, 1024, DFF, ws + B_WGU + (size_t)e * 7168 * 1024, 1024, 0, 1, scr, r, lane, AIN(I_FFNPRE) + DM);
            else if (kind == 1) transpose_item<true>(AIN(I_MWU) + (size_t)e * 1024 * DFF, 1024, DFF, ws + B_WGU + (size_t)e * 7168 * 1024, 1024, 0, 2, scr, r, lane, AIN(I_FFNPRE) + DM);
            else transpose_item<true>(AIN(I_MWD) + (size_t)e * DFF * 1024, DFF, 1024, ws + B_WD + (size_t)e * 1024 * DFF, DFF, 0, 0, scr, r, lane);
        }
    }
    GRID_BAR();
    { pg8::Gemm g{(const bf16*)(ws + B_O1), (const bf16*)(ws + W_OUT1), 512, 512, 512}; pg8::StaticOrder S; S.init(NTOK / 256, 4, C.G, C.bid);
      pg8::EpiStore E{(bf16*)(ws + B_MO1), 1024, 1.0f, nullptr}; pg8::gemm_phase(lds, g, S, E); }
    GRID_BAR();
    rows_residual<false, true, true, false, false>(C, nullptr, XN, nullptr, (const bf16*)(ws + B_MO1), AIN(I_MIXPOST) + DM, AIN(I_FFNPRE) + DM, (float*)(ws + WS_RSTD), nullptr, nullptr, AIN(I_WR),
                                     (int*)(ws + WS_TOKE), (f32x2*)(ws + WS_TOKG), (int*)(ws + WS_CNT));
    GRID_BAR();
    moe_assign_gather(C, (const int*)(ws + WS_CNT), (const int*)(ws + WS_TOKE), (int*)(ws + WS_TOKS), (int*)(ws + WS_TILEE), XN, (const float*)(ws + WS_RSTD), ws + B_XS);
    GRID_BAR();
    {
        const int* tilee = (const int*)(ws + WS_TILEE);
        const int ntiles = __builtin_amdgcn_readfirstlane(tilee[0]);
        for (int c = 0; c < 5; ++c) {
            const int tile0 = 64 * c; int ntl = ntiles - tile0; if (ntl <= 0) break; if (ntl > 64) ntl = 64;
            { pg8::Gemm g{(const bf16*)(ws + B_XS), (const bf16*)(ws + B_WGU), 512, 512, 512};
              pg8::MoeOrder S; S.so.init(ntl, 28, C.G, C.bid); S.tile_e = tilee + 8; S.tile0 = tile0; S.nbt = 28; S.a_global = true;
              pg8::EpiSwiGLU8 E{ws + B_HC, DFF}; pg8::gemm_phase<pg8::EpiSwiGLU8, pg8::MoeOrder, true>(lds, g, S, E, 0x79797979, 0x7f7f7f7f); }
            GRID_BAR();
            { pg8::Gemm g{(const bf16*)(ws + B_HC), (const bf16*)(ws + B_WD), DFF / 2, DFF / 2, DFF / 2};
              pg8::MoeOrder S; S.so.init(ntl, 4, C.G, C.bid); S.tile_e = tilee + 8; S.tile0 = tile0; S.nbt = 4; S.a_global = false;
              pg8::EpiStore E{(bf16*)(ws + B_Y), 1024, 1.0f, nullptr}; pg8::gemm_phase<pg8::EpiStore, pg8::MoeOrder, true>(lds, g, S, E, 0x79797979, 0x7c7c7c7c); }
            GRID_BAR();
        }
    }
    rows_residual<true, true, false, false, false>(C, nullptr, XN, nullptr, (const bf16*)(ws + B_Y), AIN(I_FFNPOST) + DM, nullptr, (float*)(ws + WS_RSTD), (const int*)(ws + WS_TOKS), (const f32x2*)(ws + WS_TOKG),
                                     nullptr, nullptr, nullptr, nullptr);
    { pg8::Gemm g{(const bf16*)(ws + WS_PB) + (size_t)NTOK * 256, (const bf16*)(ws + W_PP) + 1024 * 256, 256, 256, 256}; pg8::StaticOrder S; S.init(NTOK / 256, 4, C.G, C.bid);
      pg8::EpiStore E{(bf16*)(ws + B_E0b), 1024, 1.0f, nullptr}; pg8::gemm_phase(lds, g, S, E); }
    GRID_BAR();
    { pg8::Gemm g{XN, (const bf16*)(ws + W_PG) + 1024 * 1024, 1024, 1024, 1024}; pg8::StaticOrder S; S.init(NTOK / 256, 4, C.G, C.bid);
      pg8::EpiPleGate E{(const bf16*)(ws + B_E0b), (bf16*)(ws + B_Eb), 1024, (const float*)(ws + WS_RSTD)}; pg8::gemm_phase(lds, g, S, E); }
    GRID_BAR();
    rows_residual<false, false, false, false, true>(C, nullptr, XN, hres, (const bf16*)(ws + B_Eb), AIN(I_PLEPOST) + DM, nullptr, nullptr, nullptr, nullptr, nullptr, nullptr, nullptr, nullptr);
#undef TR
#undef GRID_BAR
#undef AIN
}

extern "C" void kernel_launch(void* const* d_in, const int* in_sizes, int n_in, void* d_out, int out_size, void* d_ws, size_t ws_size, hipStream_t stream) {
    static int grid = 0;
    if (grid == 0) {
        if (n_in != 27 || in_sizes[0] != NTOK * DM || out_size != NTOK * DM || ws_size < WS_END) { fprintf(stderr, "kernel_launch: unexpected shapes / workspace (%zu < %zu)\n", ws_size, (size_t)WS_END); grid = -1; return; }
        int dev = 0, cus = 0;
        if (hipGetDevice(&dev) != hipSuccess || hipDeviceGetAttribute(&cus, hipDeviceAttributeMultiprocessorCount, dev) != hipSuccess) { grid = -1; return; }
        if (hipFuncSetAttribute((const void*)fwd_kernel, hipFuncAttributeMaxDynamicSharedMemorySize, LDS_BYTES) != hipSuccess) { fprintf(stderr, "kernel_launch: hipFuncSetAttribute failed\n"); grid = -1; return; }
        int per_cu = 0;
        if (hipOccupancyMaxActiveBlocksPerMultiprocessor(&per_cu, (const void*)fwd_kernel, NTHREADS, LDS_BYTES) != hipSuccess || per_cu < 1) fprintf(stderr, "kernel_launch: occupancy query reports %d\n", per_cu);
        (void)hipGetLastError();
        if (cus != 256) { fprintf(stderr, "kernel_launch: built for 256 CUs, device has %d\n", cus); grid = -1; return; }
        grid = cus;
    }
    if (grid < 0) return;
    (void)hipMemsetAsync((char*)d_ws + WS_CTL, 0, CTL_ZERO_BYTES, stream);
    Args a{};
    for (int i = 0; i < 27; ++i) a.in[i] = (const float*)d_in[i];
    a.out = (float*)d_out; a.ws = (unsigned char*)d_ws;
    hipLaunchKernelGGL(fwd_kernel, dim3(grid), dim3(NTHREADS), LDS_BYTES, stream, a);
}
```

```cpp
#include <hip/hip_runtime.h>
#include <cstdio>
#include <cstdint>

#define DI __device__ __forceinline__
#define LAS __attribute__((address_space(3)))
#define GAS __attribute__((address_space(1)))
typedef unsigned short bf16;
typedef short bf16x8 __attribute__((ext_vector_type(8)));
typedef short s16x4 __attribute__((ext_vector_type(4)));
typedef float f32x2 __attribute__((ext_vector_type(2)));
typedef float f32x4 __attribute__((ext_vector_type(4)));
typedef float f32x16 __attribute__((ext_vector_type(16)));
typedef unsigned u32x2 __attribute__((ext_vector_type(2)));
typedef unsigned u32x4 __attribute__((ext_vector_type(4)));
typedef __bf16 bf16x2_t __attribute__((ext_vector_type(2)));

constexpr int BATCH = 16, SEQ = 2048, DM = 1024, NTOK = BATCH * SEQ;
constexpr int ZW = 1280;
constexpr int DFF = 3584, NEXP = 8;
constexpr int QKVW = 4608;
constexpr float EPS = 1e-6f;
constexpr float LOG2E = 1.4426950408889634f;
constexpr float C2_64 = 0.125f * LOG2E;
constexpr float C2_96 = 0.10206207261596577f * LOG2E;
constexpr int NWAVES = 8, NTHREADS = 512;
constexpr int MAXTILES = 264;
constexpr int NSLOTS = MAXTILES * 256;

constexpr size_t MiB = 1u << 20;
constexpr size_t WS_CTL = 0, CTL_ZERO_BYTES = 64 * 1024;
constexpr size_t WS_TABA = 1 * MiB;
constexpr size_t WS_TABP = WS_TABA + 2048 * 16 * 8;
constexpr size_t WS_TOKE = 2 * MiB;
constexpr size_t WS_TOKG = WS_TOKE + NTOK * 4;
constexpr size_t WS_TOKS = WS_TOKG + NTOK * 8;
constexpr size_t WS_CNT = WS_TOKS + NTOK * 8;
constexpr size_t WS_TILEE = WS_CNT + 256 * 8 * 4;
constexpr size_t WS_RSTD = 2 * MiB + 768 * 1024;
constexpr size_t WS_LSE = 3 * MiB;
constexpr size_t WS_W = 6 * MiB;
constexpr size_t W_IN = WS_W;
constexpr size_t W_UQ = W_IN + (size_t)ZW * 1024 * 2;
constexpr size_t W_UKV = W_UQ + 768 * 256 * 2;
constexpr size_t W_OUT0 = W_UKV + 1024 * 256 * 2;
constexpr size_t W_GU0 = W_OUT0 + 1024 * 1024 * 2;
constexpr size_t W_D0 = W_GU0 + (size_t)7168 * 1024 * 2;
constexpr size_t W_PP = W_D0 + (size_t)1024 * 3584 * 2;
constexpr size_t W_PG = W_PP + 2 * 1024 * 256 * 2;
constexpr size_t W_QKV1 = W_PG + 2 * 1024 * 1024 * 2;
constexpr size_t W_OUT1 = W_QKV1 + (size_t)QKVW * 1024 * 2;
constexpr size_t W_END = W_OUT1 + 1024 * 512 * 2;
constexpr size_t WS_PB = 48 * MiB;
constexpr size_t WS_XN = 80 * MiB;
constexpr size_t WS_BIG = 144 * MiB;
static_assert(W_END <= WS_PB, "weights");
constexpr size_t B_ZIN = WS_BIG;
constexpr size_t B_QA = WS_BIG + 80 * MiB;
constexpr size_t B_KA = WS_BIG + 112 * MiB;
constexpr size_t B_CQN = WS_BIG + 120 * MiB;
constexpr size_t B_CKVN = WS_BIG + 136 * MiB;
constexpr size_t B_KR = WS_BIG + 152 * MiB;
constexpr size_t B_QM = WS_BIG + 154 * MiB;
constexpr size_t B_KV = WS_BIG + 202 * MiB;
constexpr size_t B_O0 = WS_BIG + 266 * MiB;
constexpr size_t B_MO0 = WS_BIG;
constexpr size_t B_HID = WS_BIG;
constexpr size_t B_F = WS_BIG + 224 * MiB;
constexpr size_t B_E0 = WS_BIG + 288 * MiB;
constexpr size_t B_E = WS_BIG;
constexpr size_t B_QKV = WS_BIG;
constexpr size_t B_OG = WS_BIG + 288 * MiB;
constexpr size_t B_O1 = WS_BIG + 388 * MiB;
constexpr size_t B_MO1 = WS_BIG + 288 * MiB;
constexpr size_t B_WGU = WS_BIG;
constexpr size_t B_WD = WS_BIG + 56 * MiB;
constexpr size_t B_XS = WS_BIG + 84 * MiB;
constexpr size_t B_Y = WS_BIG + 152 * MiB;
constexpr size_t B_HC = WS_BIG + 356 * MiB;
constexpr size_t B_E0b = WS_BIG + 356 * MiB;
constexpr size_t B_Eb = WS_BIG;
constexpr size_t WS_END = WS_BIG + 420 * MiB;

constexpr int CW_BAR = 1024;

constexpr int RING_BYTES = 133120;
constexpr int LDSCTL_OFF = RING_BYTES, MISC_OFF = LDSCTL_OFF + 320;
constexpr int LDS_BYTES = 147456;

DI float bf2f(unsigned short v) { return __uint_as_float((unsigned)v << 16); }
DI unsigned pk2(float lo, float hi) { f32x2 v = {lo, hi}; bf16x2_t b = __builtin_convertvector(v, bf16x2_t); return __builtin_bit_cast(unsigned, b); }
DI float wave_sum(float v) {
#pragma unroll
    for (int o = 1; o < 64; o <<= 1) v += __shfl_xor(v, o);
    return v;
}
DI int fresh_tid() { int t = threadIdx.x; asm volatile("" : "+v"(t)); return t; }
DI float ex2(float x) { return __builtin_amdgcn_exp2f(x); }
DI float rsq(float x) { return 1.0f / sqrtf(x); }
DI void unpack8(u32x4 w, float (&x)[8]) {
    x[0] = __uint_as_float(w.x << 16); x[1] = __uint_as_float(w.x & 0xffff0000u);
    x[2] = __uint_as_float(w.y << 16); x[3] = __uint_as_float(w.y & 0xffff0000u);
    x[4] = __uint_as_float(w.z << 16); x[5] = __uint_as_float(w.z & 0xffff0000u);
    x[6] = __uint_as_float(w.w << 16); x[7] = __uint_as_float(w.w & 0xffff0000u);
}
DI u32x4 pack8(const float (&x)[8]) { u32x4 w; w.x = pk2(x[0], x[1]); w.y = pk2(x[2], x[3]); w.z = pk2(x[4], x[5]); w.w = pk2(x[6], x[7]); return w; }

namespace pg8 {
constexpr int BM = 256, BK = 64, HALF = 128, HTB = HALF * BK * 2, STAGE_BYTES = 8 * HTB, NXCD = 8, WGM = 8;
__host__ __device__ __forceinline__ int lds_byte(int r, int c) { const int st = (r >> 4) * 2 + (c >> 5), rr = r & 15, cc = c & 31, ob = rr * 64 + cc * 2; return st * 1024 + (ob ^ (((ob >> 9) & 1) << 5)); }
__host__ __device__ __forceinline__ void stage_rc(int b, int& R, int& C) { const int st = b / 1024, sb = b % 1024, swz = sb ^ (((sb >> 9) & 1) << 5); R = (st >> 1) * 16 + swz / 64; C = (st & 1) * 32 + (swz % 64) / 2; }
__host__ __device__ __forceinline__ int perm32(int rho) { const int n = rho >> 4, i = rho & 15; return 8 * (i >> 2) + 4 * n + (i & 3); }

struct Unit { int pm, pn, pa, pb; };
struct Gemm { const bf16* A; const bf16* Bt; int lda, ldb, K; };

struct StaticOrder {
    int nM, nN, nwg, G, c;
    DI void init(int nM_, int nN_, int G_, int c_) { nM = nM_; nN = nN_; nwg = nM * nN; G = G_; c = c_; }
    DI bool map(int i, int& pm, int& pn) const {
        const long L = (long)i * G + c; if (L >= nwg) return false;
        int wgid = (int)L; { const int q = nwg / NXCD, r = nwg % NXCD, xcd = wgid % NXCD, off = wgid / NXCD; wgid = (xcd < r ? xcd * (q + 1) : r * (q + 1) + (xcd - r) * q) + off; }
        const int nig = WGM * nN, gid = wgid / nig, fm = gid * WGM, gsz = (nM - fm) < WGM ? (nM - fm) : WGM;
        pm = fm + ((wgid % nig) % gsz); pn = (wgid % nig) / gsz; return true;
    }
    DI bool next(int i, Unit& u) const { int pm, pn; if (!map(i, pm, pn)) return false; u.pm = pm; u.pn = pn; u.pa = pm; u.pb = pn; return true; }
};
struct MoeOrder {
    StaticOrder so; const int* tile_e; int tile0, nbt; bool a_global;
    DI bool next(int i, Unit& u) const {
        int pm, pn; if (!so.map(i, pm, pn)) return false;
        const int e = __builtin_amdgcn_readfirstlane(tile_e[tile0 + pm]);
        u.pn = pn; u.pb = e * nbt + pn;
        if (a_global) { u.pa = tile0 + pm; u.pm = pm; } else { u.pa = pm; u.pm = tile0 + pm; }
        return true;
    }
};

struct EpiStore {
    bf16* O; int ldc; float scale; const float* rs;
    DI void operator()(const f32x4 (&acc)[2][2][4][2], const Unit& u, int wr, int wc, int fr, int fq) const {
        const int row0 = u.pm * BM + wr * 64 + fr, col0 = u.pn * BM + wc * 32 + 8 * fq;
#pragma unroll
        for (int ai = 0; ai < 2; ++ai)
#pragma unroll
            for (int m = 0; m < 4; ++m) { bf16* rowp = O + (size_t)(row0 + ai * HALF + m * 16) * ldc + col0; const float sc = rs ? scale * rs[row0 + ai * HALF + m * 16] : scale;
#pragma unroll
                for (int bj = 0; bj < 2; ++bj) { const f32x4 v0 = acc[ai][bj][m][0] * sc, v1 = acc[ai][bj][m][1] * sc;
                    u32x4 w; w.x = pk2(v0[0], v0[1]); w.y = pk2(v0[2], v0[3]); w.z = pk2(v1[0], v1[1]); w.w = pk2(v1[2], v1[3]);
                    *(u32x4*)(rowp + bj * HALF) = w; } }
    }
};
DI float silu_mul(float g, float u) { return g * u * __builtin_amdgcn_rcpf(1.0f + ex2(-g * LOG2E)); }
struct EpiSwiGLU {
    bf16* H; int ldh; const float* rs;
    DI void operator()(const f32x4 (&acc)[2][2][4][2], const Unit& u, int wr, int wc, int fr, int fq) const {
        const int row0 = u.pm * BM + wr * 64 + fr, col0 = u.pn * HALF + wc * 32 + 8 * fq;
#pragma unroll
        for (int ai = 0; ai < 2; ++ai)
#pragma unroll
            for (int m = 0; m < 4; ++m) { bf16* rowp = H + (size_t)(row0 + ai * HALF + m * 16) * ldh + col0; const float sc = rs[row0 + ai * HALF + m * 16];
                const f32x4 g0 = acc[ai][0][m][0] * sc, g1 = acc[ai][0][m][1] * sc, u0 = acc[ai][1][m][0] * sc, u1 = acc[ai][1][m][1] * sc;
                u32x4 w; w.x = pk2(silu_mul(g0[0], u0[0]), silu_mul(g0[1], u0[1])); w.y = pk2(silu_mul(g0[2], u0[2]), silu_mul(g0[3], u0[3]));
                w.z = pk2(silu_mul(g1[0], u1[0]), silu_mul(g1[1], u1[1])); w.w = pk2(silu_mul(g1[2], u1[2]), silu_mul(g1[3], u1[3]));
                *(u32x4*)rowp = w; }
    }
};
DI unsigned pk4_fp8(float a, float b, float c, float d) {
    a = __builtin_amdgcn_fmed3f(a, -448.f, 448.f); b = __builtin_amdgcn_fmed3f(b, -448.f, 448.f); c = __builtin_amdgcn_fmed3f(c, -448.f, 448.f); d = __builtin_amdgcn_fmed3f(d, -448.f, 448.f);
    int w = 0; w = __builtin_amdgcn_cvt_pk_fp8_f32(a, b, w, false); w = __builtin_amdgcn_cvt_pk_fp8_f32(c, d, w, true); return (unsigned)w; }
struct EpiSwiGLU8 {
    unsigned char* H; int ldh;
    DI void operator()(const f32x4 (&acc)[2][2][4][2], const Unit& u, int wr, int wc, int fr, int fq) const {
        const int row0 = u.pm * BM + wr * 64 + fr, col0 = u.pn * HALF + wc * 32 + 8 * fq;
#pragma unroll
        for (int ai = 0; ai < 2; ++ai)
#pragma unroll
            for (int m = 0; m < 4; ++m) { unsigned char* rowp = H + (size_t)(row0 + ai * HALF + m * 16) * ldh + col0;
                const f32x4 g0 = acc[ai][0][m][0], g1 = acc[ai][0][m][1], u0 = acc[ai][1][m][0] * 8.0f, u1 = acc[ai][1][m][1] * 8.0f;
                u32x2 w; w.x = pk4_fp8(silu_mul(g0[0], u0[0]), silu_mul(g0[1], u0[1]), silu_mul(g0[2], u0[2]), silu_mul(g0[3], u0[3]));
                w.y = pk4_fp8(silu_mul(g1[0], u1[0]), silu_mul(g1[1], u1[1]), silu_mul(g1[2], u1[2]), silu_mul(g1[3], u1[3]));
                *(u32x2*)rowp = w; }
    }
};
struct EpiPleGate {
    const bf16* E0; bf16* E; int ldc; const float* rs;
    DI void operator()(const f32x4 (&acc)[2][2][4][2], const Unit& u, int wr, int wc, int fr, int fq) const {
        const int row0 = u.pm * BM + wr * 64 + fr, col0 = u.pn * BM + wc * 32 + 8 * fq;
#pragma unroll
        for (int ai = 0; ai < 2; ++ai)
#pragma unroll
            for (int m = 0; m < 4; ++m) { const size_t off = (size_t)(row0 + ai * HALF + m * 16) * ldc + col0; const float sc = rs[row0 + ai * HALF + m * 16] * LOG2E;
#pragma unroll
                for (int bj = 0; bj < 2; ++bj) { const u32x4 ew = *(const u32x4*)(E0 + off + bj * HALF); float e[8]; unpack8(ew, e);
                    const f32x4 v0 = acc[ai][bj][m][0] * sc, v1 = acc[ai][bj][m][1] * sc; float o[8];
#pragma unroll
                    for (int j = 0; j < 4; ++j) { o[j] = e[j] * __builtin_amdgcn_rcpf(1.0f + ex2(-v0[j])); o[4 + j] = e[4 + j] * __builtin_amdgcn_rcpf(1.0f + ex2(-v1[j])); }
                    *(u32x4*)(E + off + bj * HALF) = pack8(o); } }
    }
};
struct EpiQKV1 {
    bf16* O; const f32x2* tabp; const float* rs;
    DI void operator()(const f32x4 (&acc)[2][2][4][2], const Unit& u, int wr, int wc, int fr, int fq) const {
        const int row0 = u.pm * BM + wr * 64 + fr;
        const int which = ((u.pn * BM) % 1536) / 512;
        const int grp = (u.pn * BM) / 1536, sh = 2 * grp;
        const float sc = which == 0 ? C2_64 : 1.0f;
        const bool rot = which < 2;
        const bool mine = ((wc & 1) == 0) && (fq < 2);
#pragma unroll
        for (int ai = 0; ai < 2; ++ai)
#pragma unroll
            for (int m = 0; m < 4; ++m) { const int row = row0 + ai * HALF + m * 16, bb = row >> 11, t = row & (SEQ - 1);
                const int pos = ((t & ((1 << sh) - 1)) << (11 - sh)) + (t >> sh);
                const f32x2* tp = tabp + (size_t)t * 8; const float scr = sc * rs[row];
#pragma unroll
                for (int bj = 0; bj < 2; ++bj) { float v[8];
                    const int head = ((u.pn * BM + bj * HALF + wc * 32) % 512) / 64, d0 = ((wc & 1) * 32) + 8 * fq;
                    bf16* dst = O + ((size_t)((((bb * 3 + grp) * 3 + which) * 8 + head) * SEQ + pos)) * 64 + d0;
#pragma unroll
                    for (int j = 0; j < 4; ++j) { v[j] = acc[ai][bj][m][0][j]; v[4 + j] = acc[ai][bj][m][1][j]; }
                    if (rot) {
                        float p[8];
#pragma unroll
                        for (int j = 0; j < 8; ++j) p[j] = __shfl_xor(v[j], 16);
                        if (mine) {
#pragma unroll
                            for (int j = 0; j < 8; ++j) { const f32x2 cs = tp[j]; v[j] = (fq == 0) ? (v[j] * cs.x - p[j] * cs.y) : (v[j] * cs.x + p[j] * cs.y); }
                        }
                    }
#pragma unroll
                    for (int j = 0; j < 8; ++j) v[j] *= scr;
                    *(u32x4*)dst = pack8(v); } }
    }
};

typedef int v8i32 __attribute__((ext_vector_type(8)));
typedef int v4i32 __attribute__((ext_vector_type(4)));
DI v8i32 cat8(bf16x8 lo, bf16x8 hi) { const v4i32 a = __builtin_bit_cast(v4i32, lo), b = __builtin_bit_cast(v4i32, hi); return __builtin_shufflevector(a, b, 0, 1, 2, 3, 4, 5, 6, 7); }
template <class Epi, class Sched, bool FP8 = false>
DI void gemm_phase(LAS unsigned char* lds, const Gemm g, const Sched& S, const Epi& E, const int scw = 0x7f7f7f7f, const int sca = 0x7f7f7f7f) {
    const int tid = fresh_tid(), wid = __builtin_amdgcn_readfirstlane(tid >> 6), lane = tid & 63, wr = wid >> 2, wc = wid & 3, fr = lane & 15, fq = lane >> 4;
    const int K = g.K; int nt = K / BK; if constexpr (FP8) asm volatile("" : "+s"(nt));
    unsigned voffA[2], voffB[2];
#pragma unroll
    for (int i = 0; i < 2; ++i) { int R, C; stage_rc(tid * 16 + i * 8192, R, C); const int Rb = (R & ~31) + perm32(R & 31);
        voffA[i] = (unsigned)(R * g.lda + C) * 2u; voffB[i] = (unsigned)(Rb * g.ldb + C) * 2u; }
    const size_t kstep = (size_t)(BK * 2);
    const size_t hstepA = (size_t)HALF * g.lda * 2, hstepB = (size_t)HALF * g.ldb * 2;
    const size_t tstepA = 2 * hstepA, tstepB = 2 * hstepB;
    const unsigned ldsw = (unsigned)wid * 1024u;
    const int aoff = lds_byte(wr * 64 + fr, fq * 8), boff = lds_byte(wc * 32 + fr, fq * 8);
#define PG8_SA(b, h) (((b) * 2 + (h)) * HTB)
#define PG8_SB(b, h) ((4 + (b) * 2 + (h)) * HTB)
#define PG8_STAGE(bufoff, gbase, voff) do { _Pragma("unroll") for (int _i = 0; _i < 2; ++_i) \
        __builtin_amdgcn_global_load_lds((const unsigned*)((const char*)(gbase) + (voff)[_i]), (LAS unsigned*)(lds + (bufoff) + ldsw + _i * 8192), 16, 0, 0); } while (0)
#define PG8_LDA(dst, b, h) do { _Pragma("unroll") for (int m = 0; m < 4; ++m) { \
        if constexpr (FP8) dst##8[m] = cat8(*(const LAS bf16x8*)(lds + PG8_SA(b, h) + aoff + m * 2048), *(const LAS bf16x8*)(lds + PG8_SA(b, h) + aoff + m * 2048 + 1024)); \
        else { _Pragma("unroll") for (int k = 0; k < 2; ++k) dst[m][k] = *(const LAS bf16x8*)(lds + PG8_SA(b, h) + aoff + m * 2048 + k * 1024); } } } while (0)
#define PG8_LDB(dst, b, h) do { _Pragma("unroll") for (int n = 0; n < 2; ++n) { \
        if constexpr (FP8) dst##8[n] = cat8(*(const LAS bf16x8*)(lds + PG8_SB(b, h) + boff + n * 2048), *(const LAS bf16x8*)(lds + PG8_SB(b, h) + boff + n * 2048 + 1024)); \
        else { _Pragma("unroll") for (int k = 0; k < 2; ++k) dst[n][k] = *(const LAS bf16x8*)(lds + PG8_SB(b, h) + boff + n * 2048 + k * 1024); } } } while (0)
#define PG8_MMA(ai, bj, At, Bt) do { __builtin_amdgcn_s_setprio(1); _Pragma("unroll") for (int m = 0; m < 4; ++m) _Pragma("unroll") for (int n = 0; n < 2; ++n) { \
        if constexpr (FP8) asm volatile("s_nop 1\n\tv_mfma_scale_f32_16x16x128_f8f6f4 %0, %1, %2, %0, %3, %4 op_sel_hi:[0,0,0]" : "+v"(acc[ai][bj][m][n]) : "v"(Bt##8[n]), "v"(At##8[m]), "v"(scw), "v"(sca)); \
        else { _Pragma("unroll") for (int k = 0; k < 2; ++k) acc[ai][bj][m][n] = __builtin_amdgcn_mfma_f32_16x16x32_bf16(Bt[n][k], At[m][k], acc[ai][bj][m][n], 0, 0, 0); } } \
        __builtin_amdgcn_s_setprio(0); } while (0)
#define PG8_WAIT_V(n) asm volatile("s_waitcnt vmcnt(" #n ")" ::: "memory")
#define PG8_WAIT_L(n) asm volatile("s_waitcnt lgkmcnt(" #n ")" ::: "memory")
#define PG8_BAR __builtin_amdgcn_s_barrier()
#define PG8_SCHED __builtin_amdgcn_sched_barrier(0)
    Unit cur, nxt; int ui = 0;
    if (!S.next(0, cur)) return;
    f32x4 acc[2][2][4][2];
#pragma unroll
    for (int a = 0; a < 2; ++a)
#pragma unroll
        for (int b = 0; b < 2; ++b)
#pragma unroll
            for (int m = 0; m < 4; ++m)
#pragma unroll
                for (int n = 0; n < 2; ++n) acc[a][b][m][n] = (f32x4){0.f, 0.f, 0.f, 0.f};
    bf16x8 At[4][2], B0[2][2], B1[2][2]; v8i32 At8[4], B08[2], B18[2];
    const char* cA = (const char*)g.A + (size_t)cur.pa * tstepA; const char* cB = (const char*)g.Bt + (size_t)cur.pb * tstepB;
    PG8_STAGE(PG8_SB(0, 0), cB, voffB); PG8_STAGE(PG8_SB(0, 1), cB + hstepB, voffB); PG8_STAGE(PG8_SA(0, 0), cA, voffA); PG8_STAGE(PG8_SA(0, 1), cA + hstepA, voffA);
    if (wr == 1) PG8_BAR;
    PG8_WAIT_V(2); PG8_BAR;
    PG8_STAGE(PG8_SB(1, 0), cB + kstep, voffB); PG8_STAGE(PG8_SA(1, 0), cA + kstep, voffA); PG8_STAGE(PG8_SB(1, 1), cB + hstepB + kstep, voffB);
    PG8_WAIT_V(6); PG8_BAR;
    for (;;) {
        const bool has_next = S.next(ui + 1, nxt);
        const char* nA = has_next ? (const char*)g.A + (size_t)nxt.pa * tstepA : cA; const char* nB = has_next ? (const char*)g.Bt + (size_t)nxt.pb * tstepB : cB;
        for (int t = 0; t < nt; t += 2) {
            const bool last = (t == nt - 2);
            const char* a1 = cA + (size_t)(t + 1) * kstep;
            const char* a2 = last ? nA : cA + (size_t)(t + 2) * kstep; const char* b2 = last ? nB : cB + (size_t)(t + 2) * kstep;
            const char* a3 = a2 + kstep; const char* b3 = b2 + kstep;
            PG8_LDB(B0, 0, 0); PG8_LDB(B1, 0, 1); PG8_SCHED; PG8_LDA(At, 0, 0); PG8_STAGE(PG8_SA(1, 1), a1 + hstepA, voffA);
            PG8_WAIT_V(8); PG8_WAIT_L(0); PG8_BAR; PG8_MMA(0, 0, At, B0); PG8_MMA(0, 1, At, B1); PG8_BAR; PG8_SCHED;
            PG8_LDA(At, 0, 1); PG8_STAGE(PG8_SB(0, 0), b2, voffB); PG8_STAGE(PG8_SB(0, 1), b2 + hstepB, voffB); PG8_STAGE(PG8_SA(0, 0), a2, voffA);
            PG8_WAIT_V(8); PG8_WAIT_L(0); PG8_BAR; PG8_MMA(1, 0, At, B0); PG8_MMA(1, 1, At, B1); PG8_BAR; PG8_SCHED;
            PG8_LDB(B0, 1, 0); PG8_LDB(B1, 1, 1); PG8_SCHED; PG8_LDA(At, 1, 0); PG8_STAGE(PG8_SA(0, 1), a2 + hstepA, voffA);
            PG8_WAIT_V(8); PG8_WAIT_L(0); PG8_BAR; PG8_MMA(0, 0, At, B0); PG8_MMA(0, 1, At, B1); PG8_BAR; PG8_SCHED;
            PG8_LDA(At, 1, 1); PG8_STAGE(PG8_SB(1, 0), b3, voffB); PG8_STAGE(PG8_SB(1, 1), b3 + hstepB, voffB); PG8_STAGE(PG8_SA(1, 0), a3, voffA);
            PG8_WAIT_V(8); PG8_WAIT_L(0); PG8_BAR; PG8_MMA(1, 0, At, B0); PG8_MMA(1, 1, At, B1); PG8_BAR; PG8_SCHED;
        }
        if (wr == 0) PG8_BAR;
        if constexpr (FP8) asm volatile("s_nop 15\n\ts_nop 15" ::: "memory");
        E(acc, cur, wr, wc, fr, fq);
        if (!has_next) break;
#pragma unroll
        for (int a = 0; a < 2; ++a)
#pragma unroll
            for (int b = 0; b < 2; ++b)
#pragma unroll
                for (int m = 0; m < 4; ++m)
#pragma unroll
                    for (int n = 0; n < 2; ++n) acc[a][b][m][n] = (f32x4){0.f, 0.f, 0.f, 0.f};
        cur = nxt; cA = nA; cB = nB; ++ui;
        if (wr == 1) PG8_BAR;
    }
    PG8_WAIT_V(0);
    PG8_BAR;
#undef PG8_SA
#undef PG8_SB
#undef PG8_STAGE
#undef PG8_LDA
#undef PG8_LDB
#undef PG8_MMA
#undef PG8_WAIT_V
#undef PG8_WAIT_L
#undef PG8_BAR
#undef PG8_SCHED
}
}

namespace att {
#define MFMA32(a, b, c) __builtin_amdgcn_mfma_f32_32x32x16_bf16((a), (b), (c), 0, 0, 0)
DI int crow(int i, int h) { return (i & 3) + 8 * (i >> 2) + 4 * h; }
typedef short v4i16_t __attribute__((ext_vector_type(4)));
DI s16x4 vtr(const LAS unsigned char* p) { return __builtin_bit_cast(s16x4, __builtin_amdgcn_ds_read_tr16_b64_v4i16((LAS v4i16_t*)p)); }
DI bf16x8 packp(const f32x16& p, int b) {
    u32x4 w; w.x = pk2(p[b], p[b + 1]); w.y = pk2(p[b + 2], p[b + 3]); w.z = pk2(p[b + 4], p[b + 5]); w.w = pk2(p[b + 6], p[b + 7]);
    return __builtin_bit_cast(bf16x8, w);
}
constexpr float NEGBIG = -1.0e30f;
template <int DK, bool MASK>
DI void tile_step(const LAS unsigned char* Kb, const LAS unsigned char* Vb, const int (&koff)[4], const bf16x8 (&qr)[DK / 16], f32x16& o0, f32x16& o1, float& m, float& l,
                  LAS float* wsf, int r, int h, int lane, int qi, int kj0) {
    f32x16 p0, p1;
#pragma unroll
    for (int i = 0; i < 16; ++i) { p0[i] = 0.f; p1[i] = 0.f; }
#pragma unroll
    for (int ks = 0; ks < DK / 16; ++ks) {
        const bf16x8 a0 = *(const LAS bf16x8*)(Kb + koff[ks]);
        const bf16x8 a1 = *(const LAS bf16x8*)(Kb + koff[ks] + 4096);
        p0 = MFMA32(a0, qr[ks], p0); p1 = MFMA32(a1, qr[ks], p1);
    }
    if (MASK) {
#pragma unroll
        for (int i = 0; i < 16; ++i) { const int d0 = qi - (kj0 + crow(i, h)), d1 = d0 - 32;
            if (d0 > 64 || d0 < -64) p0[i] = NEGBIG; if (d1 > 64 || d1 < -64) p1[i] = NEGBIG; }
    }
    float tm = fmaxf(p0[0], p1[0]);
#pragma unroll
    for (int i = 1; i < 16; ++i) tm = fmaxf(tm, fmaxf(p0[i], p1[i]));
    tm = fmaxf(tm, __shfl_xor(tm, 32));
    const float mn = fmaxf(m, tm);
    if (__any(mn > m)) {
        const float al = ex2(m - mn); l *= al; m = mn;
        if (h == 0) wsf[r] = al;
#pragma unroll
        for (int i = 0; i < 16; ++i) { const float f = wsf[crow(i, h)]; o0[i] *= f; o1[i] *= f; }
    }
    float sum = 0.f;
#pragma unroll
    for (int i = 0; i < 16; ++i) { p0[i] = ex2(p0[i] - m); p1[i] = ex2(p1[i] - m); sum += p0[i] + p1[i]; }
    l += sum;
    const LAS unsigned char* vp = Vb + ((lane >> 4) & 1) * 32 + (lane & 3) * 8 + (4 * h + ((lane & 15) >> 2)) * 64;
#pragma unroll
    for (int s = 0; s < 4; ++s) {
        const bf16x8 pa = (s == 0) ? packp(p0, 0) : (s == 1) ? packp(p0, 8) : (s == 2) ? packp(p1, 0) : packp(p1, 8);
#pragma unroll
        for (int db = 0; db < 2; ++db) {
            const s16x4 lo = vtr(vp + db * 4096 + s * 1024), hi = vtr(vp + db * 4096 + s * 1024 + 512);
            const bf16x8 vf = {lo[0], lo[1], lo[2], lo[3], hi[0], hi[1], hi[2], hi[3]};
            if (db == 0) o0 = MFMA32(pa, vf, o0); else o1 = MFMA32(pa, vf, o1);
        }
    }
}
DI void finish_store(const f32x16& o0, const f32x16& o1, float l, LAS float* wsf, LAS unsigned short* stg, int r, int h, int lane, bf16* orow0, size_t rstride) {
    const float lt = l + __shfl_xor(l, 32);
    if (h == 0) wsf[r] = 1.0f / lt;
#pragma unroll
    for (int i = 0; i < 16; ++i) { const int row = crow(i, h); const float f = wsf[row];
        stg[row * 64 + r] = (unsigned short)(pk2(o0[i] * f, 0.f) & 0xffffu); stg[row * 64 + 32 + r] = (unsigned short)(pk2(o1[i] * f, 0.f) & 0xffffu); }
#pragma unroll
    for (int it = 0; it < 4; ++it) { const int row = it * 8 + (lane >> 3), ch = lane & 7;
        const u32x4 v = *(const LAS u32x4*)(stg + row * 64 + ch * 8);
        *(u32x4*)(orow0 + (size_t)row * rstride + ch * 8) = v; }
}
#define ATT_WAITBAR(N) asm volatile("s_waitcnt vmcnt(" #N ") lgkmcnt(0)\n\ts_barrier" ::: "memory")
DI void dma16(const void* gsrc, LAS unsigned char* ldst) { __builtin_amdgcn_global_load_lds((const unsigned*)gsrc, (LAS unsigned*)ldst, 16, 0, 0); }

template <int DK>
DI void dense_unit(LAS unsigned char* lds, const bf16* qS, int qp, int q0, const bf16* kA, int kpA, const bf16* kB, const bf16* vS, int vpitch, bf16* oS, int op, const f32x2* taba) {
    constexpr int NKC = DK / 8, KSLOT = NKC * 1024, VSLOT = 8192, NS = 3, KS = DK / 16;
    constexpr int OFF_V = NS * KSLOT, OFF_WS = OFF_V + NS * VSLOT, OFF_STG = OFF_WS + NWAVES * 256;
    const int tid = fresh_tid(), lane = tid & 63, r = lane & 31, h = lane >> 5; const int w = __builtin_amdgcn_readfirstlane(tid >> 6);
    LAS float* wsf = (LAS float*)(lds + OFF_WS) + w * 64;
    LAS unsigned short* stg = (LAS unsigned short*)(lds + OFF_STG) + w * 2048;
    const bf16* ksrcA = kA + (size_t)(8 * w + (lane >> 3)) * kpA + ((lane & 7) ^ (lane >> 3)) * 8;
    const bf16* ksrcB = (DK == 96) ? (kB + (size_t)(16 * (w & 3) + (lane >> 2)) * 32 + ((lane & 3) ^ ((lane >> 4) & 3)) * 8) : kA;
    const bf16* vsrc = vS + (size_t)(16 * (w & 3) + (lane >> 2)) * vpitch + (w >> 2) * 32 + (lane & 3) * 8;
    const size_t kstA = (size_t)64 * kpA, kstB = 64 * 32, vst = (size_t)64 * vpitch;
    int koff[KS];
#pragma unroll
    for (int ks = 0; ks < KS; ++ks) koff[ks] = (ks < 4) ? (r * 128 + (((2 * ks + h) ^ (r & 7)) << 4)) : (8192 + r * 64 + (((2 * (ks - 4) + h) ^ ((r >> 2) & 3)) << 4));
#define ISSUE_K(t) do { const int sl_ = (t) % NS; dma16(ksrcA + (size_t)(t) * kstA, lds + sl_ * KSLOT + w * 1024); \
        if (DK == 96) dma16(ksrcB + (size_t)(t) * kstB, lds + sl_ * KSLOT + (8 + (w & 3)) * 1024); } while (0)
#define ISSUE_V(t) do { const int sl_ = (t) % NS; dma16(vsrc + (size_t)(t) * vst, lds + OFF_V + sl_ * VSLOT + w * 1024); } while (0)
    bf16x8 qr[KS];
    const bf16* qrow = qS + (size_t)(q0 + w * 32 + r) * qp + 8 * h;
#pragma unroll
    for (int ks = 0; ks < KS; ++ks) qr[ks] = *(const bf16x8*)(qrow + 16 * ks);
    ISSUE_K(0); ISSUE_K(1); ISSUE_V(0); ISSUE_K(2); ISSUE_V(1);
    if (DK == 96) {
        const f32x2* tp = taba + (size_t)(q0 + w * 32 + r) * 16 + 8 * h;
        bf16x8 a = qr[4], b = qr[5];
#pragma unroll
        for (int j = 0; j < 8; ++j) { const f32x2 cs = tp[j]; const float x1 = bf2f((unsigned short)a[j]), x2 = bf2f((unsigned short)b[j]);
            a[j] = (short)(pk2(x1 * cs.x - x2 * cs.y, 0.f) & 0xffffu); b[j] = (short)(pk2(x2 * cs.x + x1 * cs.y, 0.f) & 0xffffu); }
        qr[4] = a; qr[5] = b;
    }
    f32x16 o0, o1, negm, pA0, pA1, pB0, pB1;
#pragma unroll
    for (int i = 0; i < 16; ++i) { o0[i] = 0.f; o1[i] = 0.f; negm[i] = 0.f; }
    float m = 0.f, l = 0.f;
    const LAS unsigned char* kp0 = lds;
    const LAS unsigned char* vp0 = lds + OFF_V + ((lane >> 4) & 1) * 32 + (lane & 3) * 8 + (4 * h + ((lane & 15) >> 2)) * 64;
#define QK_TILE(P0, P1, kb_) do { _Pragma("unroll") for (int ks = 0; ks < KS; ++ks) { \
        const bf16x8 a0_ = *(const LAS bf16x8*)((kb_) + koff[ks]), a1_ = *(const LAS bf16x8*)((kb_) + koff[ks] + (ks < 4 ? 4096 : 2048)); \
        if (ks == 0) { P0 = MFMA32(a0_, qr[0], negm); P1 = MFMA32(a1_, qr[0], negm); } else { P0 = MFMA32(a0_, qr[ks], P0); P1 = MFMA32(a1_, qr[ks], P1); } } } while (0)
    constexpr int NT = SEQ / 64, G = (DK == 96) ? 3 : 2;
#define ROWMAX(dst, P0, P1) do { float a_ = fmaxf(fmaxf(P0[0], P0[1]), P1[0]), b_ = fmaxf(fmaxf(P0[2], P0[3]), P1[1]); a_ = fmaxf(fmaxf(a_, P1[2]), P1[3]); \
        _Pragma("unroll") for (int i = 4; i < 16; i += 4) { a_ = fmaxf(fmaxf(a_, P0[i]), P0[i + 1]); b_ = fmaxf(fmaxf(b_, P0[i + 2]), P0[i + 3]); a_ = fmaxf(fmaxf(a_, P1[i]), P1[i + 1]); b_ = fmaxf(fmaxf(b_, P1[i + 2]), P1[i + 3]); } \
        const float m_ = fmaxf(a_, b_); const auto rr_ = __builtin_amdgcn_permlane32_swap(__float_as_uint(m_), __float_as_uint(m_), false, false); \
        dst = fmaxf(__uint_as_float(rr_[0]), __uint_as_float(rr_[1])); } while (0)
    if (DK == 96) ATT_WAITBAR(6); else ATT_WAITBAR(4);
    QK_TILE(pA0, pA1, kp0);
    float dl; bool rebase = true;
    ROWMAX(dl, pA0, pA1);
#define STEP(t, P0, P1, Pn0, Pn1) do { \
        if ((t) + 3 <= NT) { if (DK == 96) ATT_WAITBAR(3); else ATT_WAITBAR(2); } else ATT_WAITBAR(0);       \
        if ((t) + 3 < NT) ISSUE_K((t) + 3); if ((t) + 2 < NT) ISSUE_V((t) + 2); \
          \
        if (rebase) { m += dl; const float al = ex2(-dl); l *= al; \
              _Pragma("unroll") for (int i = 0; i < 16; ++i) { P0[i] -= dl; P1[i] -= dl; negm[i] = -m; } \
              if (h == 0) wsf[r] = al; \
              _Pragma("unroll") for (int i = 0; i < 16; ++i) { const float f = wsf[crow(i, h)]; o0[i] *= f; o1[i] *= f; } } \
          \
        if ((t) + 1 < NT) QK_TILE(Pn0, Pn1, kp0 + (((t) + 1) % NS) * KSLOT); \
        _Pragma("unroll") for (int i = 0; i < 16; ++i) { P0[i] = ex2(P0[i]); l += P0[i]; P1[i] = ex2(P1[i]); l += P1[i]; } \
        const bf16x8 pa0_ = packp(P0, 0), pa1_ = packp(P0, 8), pa2_ = packp(P1, 0), pa3_ = packp(P1, 8); \
          \
        { const LAS unsigned char* vp_ = vp0 + ((t) % NS) * VSLOT; \
          _Pragma("unroll") for (int s_ = 0; s_ < 4; ++s_) { const bf16x8 pa_ = (s_ == 0) ? pa0_ : (s_ == 1) ? pa1_ : (s_ == 2) ? pa2_ : pa3_; \
            _Pragma("unroll") for (int db = 0; db < 2; ++db) { const s16x4 lo_ = vtr(vp_ + db * 4096 + s_ * 1024), hi_ = vtr(vp_ + db * 4096 + s_ * 1024 + 512); \
                const bf16x8 vf_ = {lo_[0], lo_[1], lo_[2], lo_[3], hi_[0], hi_[1], hi_[2], hi_[3]}; \
                if (db == 0) o0 = MFMA32(pa_, vf_, o0); else o1 = MFMA32(pa_, vf_, o1); } } } \
        if ((t) + 1 < NT) { float tm_; ROWMAX(tm_, Pn0, Pn1); dl = fmaxf(tm_, 0.f); rebase = __any(tm_ > 0.f); } \
    } while (0)
    for (int t = 0; t < NT; t += 2) {
        STEP(t, pA0, pA1, pB0, pB1);
        STEP(t + 1, pB0, pB1, pA0, pA1);
    }
    finish_store(o0, o1, l, wsf, stg, r, h, lane, oS + (size_t)(q0 + w * 32) * op, (size_t)op);
    ATT_WAITBAR(0);
#undef STEP
#undef ROWMAX
#undef QK_TILE
#undef ISSUE_K
#undef ISSUE_V
}

DI void dil_unit(LAS unsigned char* lds, int grp, int b, int head, int res, int c, const bf16* qkv, bf16* og, float* lse) {
    constexpr int SLOT = 16384, OFF_WS = 6 * SLOT, OFF_STG = OFF_WS + NWAVES * 256;
    const int tid = fresh_tid(), lane = tid & 63, r = lane & 31, h = lane >> 5; const int w = __builtin_amdgcn_readfirstlane(tid >> 6);
    LAS float* wsf = (LAS float*)(lds + OFF_WS) + w * 64;
    LAS unsigned short* stg = (LAS unsigned short*)(lds + OFF_STG) + w * 2048;
    const int dil = grp == 0 ? 1 : (grp == 1 ? 4 : 16), L = SEQ / dil, ntile = L / 64;
    const bf16* qb = qkv + (size_t)((((b * 3 + grp) * 3 + 0) * 8 + head) * SEQ) * 64;
    const bf16* kbp = qb + (size_t)8 * SEQ * 64; const bf16* vbp = qb + (size_t)16 * SEQ * 64;
#pragma unroll
    for (int s = 0; s < 6; ++s) {
        int sres, kb; bool valid;
        if (grp < 2) { sres = res; kb = 4 * c - 1 + s; valid = (kb >= 0) && (kb < ntile); }
        else { sres = 2 * res + (s >> 1); kb = s & 1; valid = s < 4; }
        if (valid) {
            const int krow = 64 * kb + 8 * w + (lane >> 3), vrow = 64 * kb + 16 * (w & 3) + (lane >> 2);
            dma16(kbp + (size_t)(sres * L + krow) * 64 + ((lane & 7) ^ (lane >> 3)) * 8, lds + s * SLOT + w * 1024);
            dma16(vbp + (size_t)(sres * L + vrow) * 64 + (w >> 2) * 32 + (lane & 3) * 8, lds + s * SLOT + 8192 + w * 1024);
        }
    }
    int wres, qi0, s0, kb0, nts;
    if (grp < 2) { wres = res; qi0 = 256 * c + 32 * w; s0 = w >> 1; kb0 = 4 * c + (w >> 1) - 1; nts = 3; }
    else { wres = 2 * res + (w >> 2); qi0 = 32 * (w & 3); s0 = 2 * (w >> 2); kb0 = 0; nts = 2; }
    bf16x8 qr[4]; int koff[4];
#pragma unroll
    for (int ks = 0; ks < 4; ++ks) koff[ks] = r * 128 + (((2 * ks + h) ^ (r & 7)) << 4);
    const bf16* qrow = qb + (size_t)(wres * L + qi0 + r) * 64 + 8 * h;
#pragma unroll
    for (int ks = 0; ks < 4; ++ks) qr[ks] = *(const bf16x8*)(qrow + 16 * ks);
    f32x16 o0, o1;
#pragma unroll
    for (int i = 0; i < 16; ++i) { o0[i] = 0.f; o1[i] = 0.f; }
    float m = NEGBIG, l = 0.f;
    ATT_WAITBAR(0);
    for (int j = 0; j < nts; ++j) {
        const int kb = kb0 + j;
        if (kb >= 0 && kb < ntile) {
            const LAS unsigned char* sp = lds + (s0 + j) * SLOT;
            tile_step<64, true>(sp, sp + 8192, koff, qr, o0, o1, m, l, wsf, r, h, lane, qi0 + r, 64 * kb);
        }
    }
    const size_t tok0 = (size_t)b * SEQ + wres + (size_t)dil * qi0;
    finish_store(o0, o1, l, wsf, stg, r, h, lane, og + tok0 * 512 + head * 64, (size_t)dil * 512);
    const float lt = l + __shfl_xor(l, 32);
    if (h == 0) lse[(tok0 + (size_t)dil * r) * 8 + head] = m + __builtin_amdgcn_logf(lt);
    ATT_WAITBAR(0);
}
}

#define XB_TMO      128
#define XB_XCNT(j)  (256  + 64 * (j))
#define XB_XSUB(j)  (1280 + 64 * (j))
#define XB_XGEN(j)  (2304 + 64 * (j))
#define XB_TOP      3328
#define XB_TOPGEN   3392
#define XCD_BAR_WORDS 3456
#define XB_SPIN_CAP (1u << 18)
DI unsigned xb_ld(unsigned* p)              { return __hip_atomic_load(p, __ATOMIC_RELAXED, __HIP_MEMORY_SCOPE_AGENT); }
DI unsigned xb_add(unsigned* p, unsigned v) { return __hip_atomic_fetch_add(p, v, __ATOMIC_RELAXED, __HIP_MEMORY_SCOPE_AGENT); }
DI unsigned xb_xcc_id() { return (unsigned)__builtin_amdgcn_s_getreg((3 << 11) | 20) & 0xFu; }
#define XB_SPIN(cond, bar) do { unsigned _sp = 0; while (cond) { __builtin_amdgcn_s_sleep(1); \
    if ((++_sp & 255u) == 0u) { if (xb_ld(&(bar)[XB_TMO])) break; if (_sp > XB_SPIN_CAP) { atomicAdd(&(bar)[XB_TMO], 1u); break; } } } } while (0)
struct XcdBarrier { unsigned* bar; unsigned x; volatile LAS unsigned* st; };
DI XcdBarrier xcd_barrier_post(unsigned* bar, volatile LAS unsigned* st) {
    XcdBarrier b; b.bar = bar; b.x = xb_xcc_id(); b.st = st;
    if (threadIdx.x == 0) (void)xb_add(&bar[XB_XCNT(b.x)], 1u);
    return b;
}
DI void xcd_barrier_complete(unsigned* bar, unsigned x, unsigned& nloc, unsigned& nx) {
    const unsigned G = gridDim.x * gridDim.y * gridDim.z;
    unsigned sum, cnt, mine, sp = 0u;
    for (;;) {
        sum = 0u; cnt = 0u; mine = 0u;
#pragma unroll
        for (unsigned j = 0; j < 16; ++j) { const unsigned c = xb_ld(&bar[XB_XCNT(j)]); sum += c; cnt += (c > 0u) ? 1u : 0u; mine = (j == x) ? c : mine; }
        if (sum == G) break;
        __builtin_amdgcn_s_sleep(1);
        if ((++sp & 255u) == 0u) { if (xb_ld(&bar[XB_TMO])) break; if (sp > XB_SPIN_CAP) { atomicAdd(&bar[XB_TMO], 1u); break; } }
    }
    nloc = mine > 0u ? mine : 1u; nx = cnt > 0u ? cnt : 1u;
}
DI void xcd_barrier(const XcdBarrier& b) {
    asm volatile("s_waitcnt vmcnt(0)" ::: "memory");
    __syncthreads();
    if (threadIdx.x == 0) {
        unsigned* bar = b.bar;
        __builtin_amdgcn_s_waitcnt(0);
        unsigned nloc = b.st[0], nx = b.st[1];
        if (nloc == 0u) { xcd_barrier_complete(bar, b.x, nloc, nx); b.st[0] = nloc; b.st[1] = nx; }
        const unsigned old = xb_add(&bar[XB_XSUB(b.x)], 1u);
        const unsigned gen = old / nloc;
        if (old + 1u == (gen + 1u) * nloc) {
            __builtin_amdgcn_fence(__ATOMIC_RELEASE, "agent");
            asm volatile("s_waitcnt vmcnt(0)" ::: "memory");
            const unsigned og = xb_add(&bar[XB_TOP], 1u);
            const unsigned tg = og / nx;
            if (og + 1u == (tg + 1u) * nx) xb_add(&bar[XB_TOPGEN], 1u);
            else XB_SPIN(xb_ld(&bar[XB_TOPGEN]) == tg, bar);
            __builtin_amdgcn_fence(__ATOMIC_ACQUIRE, "agent");
            xb_add(&bar[XB_XGEN(b.x)], 1u);
            asm volatile("s_waitcnt vmcnt(0)" ::: "memory");
        } else {
            XB_SPIN(xb_ld(&bar[XB_XGEN(b.x)]) == gen, bar);
            __builtin_amdgcn_fence(__ATOMIC_ACQUIRE, "agent");
            asm volatile("s_waitcnt vmcnt(0)" ::: "memory");
        }
    }
    __syncthreads();
}

struct Ctx { int wave, G, bid; LAS unsigned char* lds; };

template <bool F8>
DI void transpose_item(const float* W, int K, int N, void* WTv, int ldo, int row_off, int gu, LAS float* scr, int item, int lane, const float* gk = nullptr) {
    const int nblk = N / 32, kb = item / nblk, nb = item % nblk, k0 = 64 * kb, n0 = 32 * nb;
    float v[32];
    const float* src = W + (size_t)(k0 + (lane >> 5)) * N + n0 + (lane & 31);
#pragma unroll
    for (int i = 0; i < 32; ++i) v[i] = src[(size_t)(2 * i) * N];
    if (gk) {
#pragma unroll
        for (int i = 0; i < 32; ++i) v[i] *= gk[k0 + 2 * i + (lane >> 5)];
    }
#pragma unroll
    for (int i = 0; i < 32; ++i) scr[(2 * i + (lane >> 5)) * 33 + (lane & 31)] = v[i];
    asm volatile("s_waitcnt lgkmcnt(0)" ::: "memory");
    const int c = lane & 7;
    const int orow0 = row_off + (gu == 0 ? n0 : ((n0 >> 7) * 256 + (gu - 1) * 128 + (n0 & 127)));
#pragma unroll
    for (int j = 0; j < 4; ++j) { const int n = (lane >> 3) + 8 * j; const LAS float* s = scr + (8 * c) * 33 + n;
        if (F8) { u32x2 o; o.x = pg8::pk4_fp8(64.f * s[0 * 33], 64.f * s[1 * 33], 64.f * s[2 * 33], 64.f * s[3 * 33]); o.y = pg8::pk4_fp8(64.f * s[4 * 33], 64.f * s[5 * 33], 64.f * s[6 * 33], 64.f * s[7 * 33]);
            *(u32x2*)((unsigned char*)WTv + (size_t)(orow0 + n) * ldo + k0 + 8 * c) = o; }
        else { u32x4 o; o.x = pk2(s[0 * 33], s[1 * 33]); o.y = pk2(s[2 * 33], s[3 * 33]); o.z = pk2(s[4 * 33], s[5 * 33]); o.w = pk2(s[6 * 33], s[7 * 33]);
            *(u32x4*)((bf16*)WTv + (size_t)(orow0 + n) * ldo + k0 + 8 * c) = o; } }
    asm volatile("s_waitcnt lgkmcnt(0)" ::: "memory");
}

DI void sincos_d(double a, float& c, float& s) {
    const double TWO_PI = 6.283185307179586476925286766559, INV = 0.15915494309189533576888376337251;
    const double n = __builtin_rint(a * INV); double x = (a - n * TWO_PI) * 0.25; const double x2 = x * x;
    double sn = x * (1.0 + x2 * (-1.0 / 6 + x2 * (1.0 / 120 + x2 * (-1.0 / 5040 + x2 * (1.0 / 362880 + x2 * (-1.0 / 39916800 + x2 * (1.0 / 6227020800.0)))))));
    double cs = 1.0 + x2 * (-0.5 + x2 * (1.0 / 24 + x2 * (-1.0 / 720 + x2 * (1.0 / 40320 + x2 * (-1.0 / 3628800 + x2 * (1.0 / 479001600.0))))));
#pragma unroll
    for (int i = 0; i < 2; ++i) { const double s2 = 2.0 * sn * cs, c2 = cs * cs - sn * sn; sn = s2; cs = c2; }
    c = (float)cs; s = (float)sn;
}

DI void rows_first(const Ctx& C, const float* x, bf16* hb, float* rstd) {
    const int gw = C.bid * NWAVES + C.wave, NGW = C.G * NWAVES, lane = fresh_tid() & 63;
    for (int m = gw; m < NTOK; m += NGW) {
        const f32x4* xr = (const f32x4*)(x + (size_t)m * DM) + lane;
        f32x4 v[4]; float s = 0.f;
#pragma unroll
        for (int j = 0; j < 4; ++j) { v[j] = xr[64 * j]; s += (v[j].x * v[j].x + v[j].y * v[j].y) + (v[j].z * v[j].z + v[j].w * v[j].w); }
        const float ri = rsq(wave_sum(s) * (1.f / DM) + EPS);
        u32x2* o8 = (u32x2*)(hb + (size_t)m * DM) + lane;
#pragma unroll
        for (int j = 0; j < 4; ++j) { u32x2 o; o.x = pk2(v[j].x, v[j].y); o.y = pk2(v[j].z, v[j].w); o8[64 * j] = o; }
        if (lane == 0) rstd[m] = ri;
    }
}

struct RowRaw { u32x2 t1[4], t2[4], hb[4]; f32x4 h32[4]; f32x2 gg; };
template <bool MOE, bool HIN32>
DI void row_load(RowRaw& R, int m, int lane_, const float* hin32, const bf16* hb, const bf16* term, const int* toks, const f32x2* tokg) {
    if (MOE) {
        const int s1 = toks[2 * m], s2 = toks[2 * m + 1]; R.gg = tokg[m];
        const u32x2* y1 = (const u32x2*)(term + (size_t)s1 * DM) + lane_; const u32x2* y2 = (const u32x2*)(term + (size_t)s2 * DM) + lane_;
#pragma unroll
        for (int j = 0; j < 4; ++j) { R.t1[j] = y1[64 * j]; R.t2[j] = y2[64 * j]; }
    } else {
        const u32x2* tr = (const u32x2*)(term + (size_t)m * DM) + lane_;
#pragma unroll
        for (int j = 0; j < 4; ++j) R.t1[j] = tr[64 * j];
    }
    if (HIN32) { const f32x4* hr = (const f32x4*)(hin32 + (size_t)m * DM) + lane_;
#pragma unroll
        for (int j = 0; j < 4; ++j) R.h32[j] = hr[64 * j];
    } else { const u32x2* hr = (const u32x2*)(hb + (size_t)m * DM) + lane_;
#pragma unroll
        for (int j = 0; j < 4; ++j) R.hb[j] = hr[64 * j];
    }
}
template <bool MOE, bool NEXT, bool ROUTE, bool HIN32, bool FINAL>
DI void rows_residual(const Ctx& C, const float* hin32, bf16* hb, float* out32, const bf16* term, const float* gpost, const float* gnext, float* rstd,
                      const int* toks, const f32x2* tokg, const float* wrouter, int* toke, f32x2* tokg_out, int* cnt_out) {
    const int gw = C.bid * NWAVES + C.wave, NGW = C.G * NWAVES, tid_ = fresh_tid(), lane_ = tid_ & 63;
    f32x4 gp[4], gn[4];
#pragma unroll
    for (int j = 0; j < 4; ++j) { gp[j] = *((const f32x4*)gpost + lane_ + 64 * j); gn[j] = ROUTE ? *((const f32x4*)gnext + lane_ + 64 * j) : (f32x4){0.f, 0.f, 0.f, 0.f}; }
    LAS int* lcnt = (LAS int*)C.lds;
    if (ROUTE) { if (tid_ < 8) lcnt[tid_] = 0; __syncthreads(); }
    const int rows_per_wave = NTOK / NGW;
    const int nrows = ROUTE ? rows_per_wave : (NTOK - gw + NGW - 1) / NGW;
#define ROW_OF(it_) (ROUTE ? (gw * rows_per_wave + (it_)) : (gw + (it_) * NGW))
    RowRaw cur, nxt;
    if (nrows > 0) row_load<MOE, HIN32>(cur, ROW_OF(0), lane_, hin32, hb, term, toks, tokg);
    for (int it = 0; it < nrows; ++it) {
        const int m = ROW_OF(it);
        if (it + 1 < nrows) row_load<MOE, HIN32>(nxt, ROW_OF(it + 1), lane_, hin32, hb, term, toks, tokg);
        f32x4 t[4], hv[4];
#pragma unroll
        for (int j = 0; j < 4; ++j) { const u32x2 a = cur.t1[j];
            if (MOE) { const u32x2 b = cur.t2[j]; const f32x2 gg = cur.gg;
                t[j].x = gg.x * __uint_as_float(a.x << 16) + gg.y * __uint_as_float(b.x << 16); t[j].y = gg.x * __uint_as_float(a.x & 0xffff0000u) + gg.y * __uint_as_float(b.x & 0xffff0000u);
                t[j].z = gg.x * __uint_as_float(a.y << 16) + gg.y * __uint_as_float(b.y << 16); t[j].w = gg.x * __uint_as_float(a.y & 0xffff0000u) + gg.y * __uint_as_float(b.y & 0xffff0000u); }
            else { t[j].x = __uint_as_float(a.x << 16); t[j].y = __uint_as_float(a.x & 0xffff0000u); t[j].z = __uint_as_float(a.y << 16); t[j].w = __uint_as_float(a.y & 0xffff0000u); }
            if (HIN32) hv[j] = cur.h32[j];
            else { const u32x2 c = cur.hb[j]; hv[j].x = __uint_as_float(c.x << 16); hv[j].y = __uint_as_float(c.x & 0xffff0000u); hv[j].z = __uint_as_float(c.y << 16); hv[j].w = __uint_as_float(c.y & 0xffff0000u); } }
        float s = 0.f;
#pragma unroll
        for (int j = 0; j < 4; ++j) s += (t[j].x * t[j].x + t[j].y * t[j].y) + (t[j].z * t[j].z + t[j].w * t[j].w);
        const float ri = rsq(wave_sum(s) * (1.f / DM) + EPS);
        float s2 = 0.f;
#pragma unroll
        for (int j = 0; j < 4; ++j) { hv[j] = hv[j] + t[j] * ri * gp[j]; s2 += (hv[j].x * hv[j].x + hv[j].y * hv[j].y) + (hv[j].z * hv[j].z + hv[j].w * hv[j].w); }
        if (FINAL) { f32x4* ho = (f32x4*)(out32 + (size_t)m * DM) + lane_;
#pragma unroll
            for (int j = 0; j < 4; ++j) ho[64 * j] = hv[j];
        } else { u32x2* o8 = (u32x2*)(hb + (size_t)m * DM) + lane_;
#pragma unroll
            for (int j = 0; j < 4; ++j) { u32x2 o; o.x = pk2(hv[j].x, hv[j].y); o.y = pk2(hv[j].z, hv[j].w); o8[64 * j] = o; }
        }
        if (NEXT) {
            const float r2 = rsq(wave_sum(s2) * (1.f / DM) + EPS);
            if (lane_ == 0) rstd[m] = r2;
            if (ROUTE) {
#pragma unroll
                for (int j = 0; j < 4; ++j) hv[j] = hv[j] * r2 * gn[j];
                float lg[8];
#pragma unroll
                for (int e = 0; e < 8; ++e) lg[e] = 0.f;
#pragma unroll
                for (int j = 0; j < 4; ++j)
#pragma unroll
                    for (int q = 0; q < 4; ++q) { const f32x4* wp = (const f32x4*)(wrouter + (size_t)(4 * lane_ + 256 * j + q) * 8); const f32x4 w0 = wp[0], w1 = wp[1]; const float a = hv[j][q];
                        lg[0] += a * w0.x; lg[1] += a * w0.y; lg[2] += a * w0.z; lg[3] += a * w0.w; lg[4] += a * w1.x; lg[5] += a * w1.y; lg[6] += a * w1.z; lg[7] += a * w1.w; }
#pragma unroll
                for (int e = 0; e < 8; ++e) lg[e] = wave_sum(lg[e]);
                int e1 = 0; float l1 = lg[0];
#pragma unroll
                for (int e = 1; e < 8; ++e) if (lg[e] > l1) { l1 = lg[e]; e1 = e; }
                int e2 = -1; float l2 = -3.0e38f;
#pragma unroll
                for (int e = 0; e < 8; ++e) if (e != e1 && lg[e] > l2) { l2 = lg[e]; e2 = e; }
                if (lane_ == 0) { const float p2 = 1.0f / (1.0f + ex2((l1 - l2) * LOG2E)); toke[m] = e1 | (e2 << 8); tokg_out[m] = (f32x2){1.0f - p2, p2};
                    atomicAdd((int*)lcnt + e1, 1); atomicAdd((int*)lcnt + e2, 1); }
            }
        }
        cur = nxt;
    }
#undef ROW_OF
    if (ROUTE) { __syncthreads(); if (tid_ < 8) cnt_out[C.bid * 8 + tid_] = lcnt[tid_]; }
}

DI void rows_l0_post(const Ctx& C, const bf16* zin, const float* gq, const float* gk, const float* gcq, const float* gckv, const f32x2* taba,
                     bf16* qa, bf16* ka, bf16* cqn, bf16* ckvn, bf16* kr) {
    const int gw = C.bid * NWAVES + C.wave, NGW = C.G * NWAVES, lane = fresh_tid() & 63;
    const int s8 = lane & 7;
    float gqv[8], gkv[8], gcqv[8], gckvv[8];
#pragma unroll
    for (int j = 0; j < 8; ++j) { gqv[j] = gq[8 * s8 + j]; gkv[j] = gk[8 * s8 + j]; gcqv[j] = gcq[8 * (lane & 31) + j]; gckvv[j] = gckv[8 * (lane & 15) + j]; }
    const int part = s8 >> 2, isx2 = (s8 >> 1) & 1, fb = 8 * (s8 & 1);
    for (int tok = gw; tok < NTOK; tok += NGW) {
        const int t = tok & (SEQ - 1), prow = t >> 6, pcol = t & 63;
        const bf16* z = zin + (size_t)tok * ZW;
        float x[8], y[8], p[8];
        unpack8(*(const u32x4*)(z + 8 * lane), x);
        float ss = 0.f;
#pragma unroll
        for (int j = 0; j < 8; ++j) ss += x[j] * x[j];
        ss += __shfl_xor(ss, 1); ss += __shfl_xor(ss, 2); ss += __shfl_xor(ss, 4);
        float ri = rsq(ss * (1.f / 64) + EPS);
#pragma unroll
        for (int j = 0; j < 8; ++j) y[j] = x[j] * ri * gqv[j];
#pragma unroll
        for (int j = 0; j < 8; ++j) p[j] = __shfl_xor(y[j], 2);
        const f32x2* tp = taba + (size_t)(part ? pcol : prow) * 16 + fb;
#pragma unroll
        for (int j = 0; j < 8; ++j) { const f32x2 cs = tp[j]; y[j] = (isx2 ? (y[j] * cs.x + p[j] * cs.y) : (y[j] * cs.x - p[j] * cs.y)) * C2_64; }
        *(u32x4*)(qa + (size_t)tok * 512 + 8 * lane) = pack8(y);
        unpack8(*(const u32x4*)(z + 512 + 8 * lane), x);
        ss = 0.f;
#pragma unroll
        for (int j = 0; j < 8; ++j) ss += x[j] * x[j];
        float s3 = ss; s3 += __shfl_xor(s3, 1); s3 += __shfl_xor(s3, 2); s3 += __shfl_xor(s3, 4);
        float s5 = s3; s5 += __shfl_xor(s5, 8); s5 += __shfl_xor(s5, 16);
        if (lane < 16) {
            ri = rsq(s3 * (1.f / 64) + EPS);
#pragma unroll
            for (int j = 0; j < 8; ++j) y[j] = x[j] * ri * gkv[j];
        } else {
            ri = rsq(s5 * (1.f / 256) + EPS);
#pragma unroll
            for (int j = 0; j < 8; ++j) y[j] = x[j] * ri * gcqv[j];
        }
#pragma unroll
        for (int j = 0; j < 8; ++j) p[j] = __shfl_xor(y[j], 2);
        if (lane < 16) {
#pragma unroll
            for (int j = 0; j < 8; ++j) { const f32x2 cs = tp[j]; y[j] = isx2 ? (y[j] * cs.x + p[j] * cs.y) : (y[j] * cs.x - p[j] * cs.y); }
            *(u32x4*)(ka + (size_t)tok * 128 + 8 * lane) = pack8(y);
        } else if (lane >= 32) {
            *(u32x4*)(cqn + (size_t)tok * 256 + 8 * (lane - 32)) = pack8(y);
        }
        u32x4 w2 = (u32x4){0u, 0u, 0u, 0u};
        if (lane < 32) w2 = *(const u32x4*)(z + 1024 + 8 * lane);
        unpack8(w2, x);
        ss = 0.f;
#pragma unroll
        for (int j = 0; j < 8; ++j) ss += x[j] * x[j];
        ss += __shfl_xor(ss, 1); ss += __shfl_xor(ss, 2); ss += __shfl_xor(ss, 4); ss += __shfl_xor(ss, 8);
#pragma unroll
        for (int j = 0; j < 8; ++j) p[j] = __shfl_xor(x[j], 2);
        if (lane < 16) {
            ri = rsq(ss * (1.f / 128) + EPS);
#pragma unroll
            for (int j = 0; j < 8; ++j) y[j] = x[j] * ri * gckvv[j];
            *(u32x4*)(ckvn + (size_t)tok * 256 + 8 * lane) = pack8(y);
        } else if (lane < 32) {
            *(u32x4*)(ckvn + (size_t)tok * 256 + 8 * lane) = (u32x4){0u, 0u, 0u, 0u};
            if (lane < 20) {
                const int sl = lane - 16; const f32x2* tq = taba + (size_t)t * 16 + 8 * (sl & 1);
#pragma unroll
                for (int j = 0; j < 8; ++j) { const f32x2 cs = tq[j]; y[j] = (sl >> 1) ? (x[j] * cs.x + p[j] * cs.y) : (x[j] * cs.x - p[j] * cs.y); }
                *(u32x4*)(kr + (size_t)tok * 32 + 8 * sl) = pack8(y);
            }
        }
    }
}

DI void rows_merge(const Ctx& C, const bf16* og, const float* lse, bf16* o1) {
    const int gw = C.bid * NWAVES + C.wave, NGW = C.G * NWAVES, lane = fresh_tid() & 63, head = lane >> 3;
    for (int tok = gw; tok < NTOK; tok += NGW) {
        const float l0 = lse[(size_t)tok * 8 + head], l1 = lse[(size_t)(NTOK + tok) * 8 + head], l2 = lse[(size_t)(2 * NTOK + tok) * 8 + head];
        const float mx = fmaxf(l0, fmaxf(l1, l2));
        float w0 = ex2(l0 - mx), w1 = ex2(l1 - mx), w2 = ex2(l2 - mx); const float inv = 1.0f / (w0 + w1 + w2); w0 *= inv; w1 *= inv; w2 *= inv;
        float a[8], b[8], c[8], o[8];
        unpack8(*(const u32x4*)(og + (size_t)tok * 512 + 8 * lane), a);
        unpack8(*(const u32x4*)(og + (size_t)(NTOK + tok) * 512 + 8 * lane), b);
        unpack8(*(const u32x4*)(og + (size_t)(2 * NTOK + tok) * 512 + 8 * lane), c);
#pragma unroll
        for (int j = 0; j < 8; ++j) o[j] = w0 * a[j] + w1 * b[j] + w2 * c[j];
        *(u32x4*)(o1 + (size_t)tok * 512 + 8 * lane) = pack8(o);
    }
}

DI void moe_assign_gather(const Ctx& C, const int* cnt, const int* toke, int* toks, int* tilee, const bf16* xn, const float* rstd, unsigned char* xs) {
    LAS int* L = (LAS int*)C.lds;
    const int lane = fresh_tid() & 63, w = C.bid;
    if (C.wave == 0) {
        int base[8]; int tot[8];
#pragma unroll
        for (int e = 0; e < 8; ++e) { int below = 0, all = 0;
            for (int i = lane; i < C.G; i += 64) { const int c = cnt[i * 8 + e]; all += c; if (i < w) below += c; }
#pragma unroll
            for (int o = 1; o < 64; o <<= 1) { below += __shfl_xor(below, o); all += __shfl_xor(all, o); }
            base[e] = below; tot[e] = all; }
        int start = 0;
#pragma unroll
        for (int e = 0; e < 8; ++e) { const int padded = (tot[e] + 255) & ~255; base[e] += start;
            if (w == 0) { for (int tix = (start >> 8) + lane; tix < ((start + padded) >> 8); tix += 64) tilee[8 + tix] = e; }
            start += padded; }
        if (w == 0 && lane == 0) tilee[0] = start >> 8;
#pragma unroll
        for (int k = 0; k < 4; ++k) {
            const int pidx = 64 * k + lane, tok = 128 * w + (pidx >> 1), kk = pidx & 1;
            const int e = (toke[tok] >> (8 * kk)) & 0xff; int slot = 0;
#pragma unroll
            for (int ee = 0; ee < 8; ++ee) { const unsigned long long mk = __ballot(e == ee); const int rank = __popcll(mk & ((1ull << lane) - 1ull));
                if (e == ee) slot = base[ee] + rank; base[ee] += __popcll(mk); }
            toks[2 * tok + kk] = slot; L[16 + pidx] = slot;
        }
    }
    __syncthreads();
    for (int i = 0; i < 32; ++i) { const int pidx = 32 * C.wave + i, tok = 128 * w + (pidx >> 1), slot = L[16 + pidx];
        const u32x4* src = (const u32x4*)(xn + (size_t)tok * DM) + 2 * lane; const u32x4 a = src[0], b = src[1]; float x[8], y[8]; unpack8(a, x); unpack8(b, y); const float rs = rstd[tok];
#pragma unroll
        for (int j = 0; j < 8; ++j) { x[j] *= rs; y[j] *= rs; }
        u32x4 o; o.x = pg8::pk4_fp8(x[0], x[1], x[2], x[3]); o.y = pg8::pk4_fp8(x[4], x[5], x[6], x[7]); o.z = pg8::pk4_fp8(y[0], y[1], y[2], y[3]); o.w = pg8::pk4_fp8(y[4], y[5], y[6], y[7]);
        *((u32x4*)(xs + (size_t)slot * DM) + lane) = o; }
    __syncthreads();
}

struct Args { const float* in[27]; float* out; unsigned char* ws; };
enum { I_X = 0, I_P, I_MIXPRE, I_MIXPOST, I_FFNPRE, I_FFNPOST, I_PLEPROJ, I_PLEGN, I_PLEGATE, I_PLEPOST, I_WIN, I_GQ, I_GK, I_GCQ, I_WUQ, I_GCKV, I_WUKV, I_WOUT0,
       I_WG0, I_WU0, I_WD0, I_WQKV1, I_WOUT1, I_WR, I_MWG, I_MWU, I_MWD };

DI const float* arg_in(int i) { const __attribute__((address_space(4))) char* kp = (const __attribute__((address_space(4))) char*)__builtin_amdgcn_kernarg_segment_ptr(); asm volatile("" : "+s"(kp));
    return *(const float* const __attribute__((address_space(4)))*)(kp + 8 * i); }
__global__ void __launch_bounds__(NTHREADS, 2) fwd_kernel(Args a) {
    extern __shared__ __attribute__((aligned(16))) unsigned char lds_raw[];
    LAS unsigned char* lds = (LAS unsigned char*)lds_raw;
    volatile LAS unsigned* MISC = (volatile LAS unsigned*)(lds + MISC_OFF);
    Ctx C; C.wave = __builtin_amdgcn_readfirstlane((int)threadIdx.x >> 6); C.G = gridDim.x; C.bid = blockIdx.x; C.lds = lds;
    unsigned char* ws = a.ws;
#define AIN(i) arg_in(i)
    unsigned* ctl = (unsigned*)(ws + WS_CTL);
    for (int u = threadIdx.x; u < (LDS_BYTES - LDSCTL_OFF) / 4; u += NTHREADS) ((LAS unsigned*)(lds + LDSCTL_OFF))[u] = 0u;
    __syncthreads();
    XcdBarrier bar = xcd_barrier_post(ctl + CW_BAR, MISC + 8);
#define GRID_BAR() xcd_barrier(bar)
    const int gw = C.bid * NWAVES + C.wave, NGW = C.G * NWAVES, NGT = C.G * NTHREADS;
    const f32x2* taba = (const f32x2*)(ws + WS_TABA); const f32x2* tabp = (const f32x2*)(ws + WS_TABP);
    bf16* XN = (bf16*)(ws + WS_XN);
    float* hres = a.out;

    {
        LAS float* scr = (LAS float*)(lds + C.wave * 16384);
        const int tid = fresh_tid(), lane = tid & 63, gtid = C.bid * NTHREADS + tid;
#define TR(Wp, Kd, Nd, dst, ldo, roff, gu, gk) { constexpr int NI_ = ((Kd) / 64) * ((Nd) / 32); if (r < NI_) { transpose_item<false>((Wp), (Kd), (Nd), (bf16*)(dst), (ldo), (roff), (gu), scr, r, lane, (gk)); continue; } r -= NI_; }
        constexpr int NSMALL = 16 * 37 + 4 * 24 + 2 * 32 + 16 * 32 + 3 * 1792 + 2 * 128 + 2 * 512 + 16 * 144 + 8 * 32;
        for (int it = gw; it < NSMALL; it += NGW) {
            int r = it;
            TR(AIN(I_WIN), 1024, 1184, ws + W_IN, 1024, 0, 0, AIN(I_MIXPRE))
            TR(AIN(I_WUQ), 256, 768, ws + W_UQ, 256, 0, 0, nullptr)
            TR(AIN(I_WUKV), 128, 1024, ws + W_UKV, 256, 0, 0, nullptr)
            TR(AIN(I_WOUT0), 1024, 1024, ws + W_OUT0, 1024, 0, 0, nullptr)
            TR(AIN(I_WG0), 1024, 3584, ws + W_GU0, 1024, 0, 1, AIN(I_FFNPRE))
            TR(AIN(I_WU0), 1024, 3584, ws + W_GU0, 1024, 0, 2, AIN(I_FFNPRE))
            TR(AIN(I_WD0), 3584, 1024, ws + W_D0, 3584, 0, 0, nullptr)
            TR(AIN(I_PLEPROJ), 256, 1024, ws + W_PP, 256, 0, 0, nullptr)
            TR(AIN(I_PLEPROJ) + 256 * 1024, 256, 1024, ws + W_PP + 1024 * 256 * 2, 256, 0, 0, nullptr)
            TR(AIN(I_PLEGATE), 1024, 1024, ws + W_PG, 1024, 0, 0, AIN(I_PLEGN))
            TR(AIN(I_PLEGATE) + 1024 * 1024, 1024, 1024, ws + W_PG + 1024 * 1024 * 2, 1024, 0, 0, AIN(I_PLEGN) + DM)
            TR(AIN(I_WQKV1), 1024, 4608, ws + W_QKV1, 1024, 0, 0, AIN(I_MIXPRE) + DM)
            TR(AIN(I_WOUT1), 512, 1024, ws + W_OUT1, 512, 0, 0, nullptr)
        }
        for (int i = gtid; i < 12288; i += NGT) ((u32x4*)(ws + W_IN + (size_t)1184 * 1024 * 2))[i] = (u32x4){0u, 0u, 0u, 0u};
        for (int i = gtid; i < 16384; i += NGT) ((u32x4*)(ws + W_UKV))[(size_t)(i >> 4) * 32 + 16 + (i & 15)] = (u32x4){0u, 0u, 0u, 0u};
        for (int i = gtid; i < 2048 * 16; i += NGT) { const int t = i >> 4, f = i & 15; double iv = 1.0; for (int k = 0; k < f; ++k) iv *= 0.56234132519034907; const float ang = (float)t * (float)iv;
            float c, s; sincos_d((double)ang, c, s); ((f32x2*)(ws + WS_TABA))[i] = (f32x2){c, s}; }
        for (int i = gtid; i < 2048 * 8; i += NGT) { const int t = i >> 3, f = i & 7; double iv = 1.0; for (int k = 0; k < f; ++k) iv *= 0.19392274474868576; const float ang = (float)t * (float)iv;
            float c, s; sincos_d((double)ang, c, s); ((f32x2*)(ws + WS_TABP))[i] = (f32x2){c, s}; }
        for (int i = gtid; i < 2 * NTOK * 256 / 8; i += NGT) { const f32x4 u0 = ((const f32x4*)AIN(I_P))[2 * i], u1 = ((const f32x4*)AIN(I_P))[2 * i + 1];
            u32x4 o; o.x = pk2(u0.x, u0.y); o.y = pk2(u0.z, u0.w); o.z = pk2(u1.x, u1.y); o.w = pk2(u1.z, u1.w); ((u32x4*)(ws + WS_PB))[i] = o; }
        rows_first(C, AIN(I_X), XN, (float*)(ws + WS_RSTD));
    }
    GRID_BAR();

    { pg8::Gemm g{XN, (const bf16*)(ws + W_IN), 1024, 1024, 1024}; pg8::StaticOrder S; S.init(NTOK / 256, ZW / 256, C.G, C.bid);
      pg8::EpiStore E{(bf16*)(ws + B_ZIN), ZW, 1.0f, (const float*)(ws + WS_RSTD)}; pg8::gemm_phase(lds, g, S, E); }
    GRID_BAR();
    rows_l0_post(C, (const bf16*)(ws + B_ZIN), AIN(I_GQ), AIN(I_GK), AIN(I_GCQ), AIN(I_GCKV), taba,
                 (bf16*)(ws + B_QA), (bf16*)(ws + B_KA), (bf16*)(ws + B_CQN), (bf16*)(ws + B_CKVN), (bf16*)(ws + B_KR));
    GRID_BAR();
    { pg8::Gemm g{(const bf16*)(ws + B_CQN), (const bf16*)(ws + W_UQ), 256, 256, 256}; pg8::StaticOrder S; S.init(NTOK / 256, 3, C.G, C.bid);
      pg8::EpiStore E{(bf16*)(ws + B_QM), 768, C2_96, nullptr}; pg8::gemm_phase(lds, g, S, E); }
    { pg8::Gemm g{(const bf16*)(ws + B_CKVN), (const bf16*)(ws + W_UKV), 256, 256, 256}; pg8::StaticOrder S; S.init(NTOK / 256, 4, C.G, C.bid);
      pg8::EpiStore E{(bf16*)(ws + B_KV), 1024, 1.0f, nullptr}; pg8::gemm_phase(lds, g, S, E); }
    GRID_BAR();
    for (int u = C.bid; u < 1024; u += C.G) {
        const int b = u >> 6, head = (u >> 3) & 7, ch = u & 7, kvh = head >> 2; const size_t rb = (size_t)b * SEQ;
        att::dense_unit<64>(lds, (const bf16*)(ws + B_QA) + rb * 512 + head * 64, 512, 256 * ch, (const bf16*)(ws + B_KA) + rb * 128 + kvh * 64, 128, nullptr,
                            (const bf16*)(ws + B_ZIN) + rb * ZW + 640 + kvh * 64, ZW, (bf16*)(ws + B_O0) + rb * 1024 + head * 64, 1024, taba);
    }
    for (int u = C.bid; u < 1024; u += C.G) {
        const int b = u >> 6, head = (u >> 3) & 7, ch = u & 7; const size_t rb = (size_t)b * SEQ;
        att::dense_unit<96>(lds, (const bf16*)(ws + B_QM) + rb * 768 + head * 96, 768, 256 * ch, (const bf16*)(ws + B_KV) + rb * 1024 + head * 128, 1024, (const bf16*)(ws + B_KR) + rb * 32,
                            (const bf16*)(ws + B_KV) + rb * 1024 + head * 128 + 64, 1024, (bf16*)(ws + B_O0) + rb * 1024 + 512 + head * 64, 1024, taba);
    }
    GRID_BAR();
    { pg8::Gemm g{(const bf16*)(ws + B_O0), (const bf16*)(ws + W_OUT0), 1024, 1024, 1024}; pg8::StaticOrder S; S.init(NTOK / 256, 4, C.G, C.bid);
      pg8::EpiStore E{(bf16*)(ws + B_MO0), 1024, 1.0f, nullptr}; pg8::gemm_phase(lds, g, S, E); }
    GRID_BAR();
    rows_residual<false, true, false, false, false>(C, nullptr, XN, nullptr, (const bf16*)(ws + B_MO0), AIN(I_MIXPOST), nullptr, (float*)(ws + WS_RSTD), nullptr, nullptr, nullptr, nullptr, nullptr, nullptr);
    GRID_BAR();
    { pg8::Gemm g{XN, (const bf16*)(ws + W_GU0), 1024, 1024, 1024}; pg8::StaticOrder S; S.init(NTOK / 256, 28, C.G, C.bid);
      pg8::EpiSwiGLU E{(bf16*)(ws + B_HID), DFF, (const float*)(ws + WS_RSTD)}; pg8::gemm_phase(lds, g, S, E); }
    GRID_BAR();
    { pg8::Gemm g{(const bf16*)(ws + B_HID), (const bf16*)(ws + W_D0), DFF, DFF, DFF}; pg8::StaticOrder S; S.init(NTOK / 256, 4, C.G, C.bid);
      pg8::EpiStore E{(bf16*)(ws + B_F), 1024, 1.0f, nullptr}; pg8::gemm_phase(lds, g, S, E); }
    { pg8::Gemm g{(const bf16*)(ws + WS_PB), (const bf16*)(ws + W_PP), 256, 256, 256}; pg8::StaticOrder S; S.init(NTOK / 256, 4, C.G, C.bid);
      pg8::EpiStore E{(bf16*)(ws + B_E0), 1024, 1.0f, nullptr}; pg8::gemm_phase(lds, g, S, E); }
    GRID_BAR();
    rows_residual<false, true, false, false, false>(C, nullptr, XN, nullptr, (const bf16*)(ws + B_F), AIN(I_FFNPOST), nullptr, (float*)(ws + WS_RSTD), nullptr, nullptr, nullptr, nullptr, nullptr, nullptr);
    GRID_BAR();
    { pg8::Gemm g{XN, (const bf16*)(ws + W_PG), 1024, 1024, 1024}; pg8::StaticOrder S; S.init(NTOK / 256, 4, C.G, C.bid);
      pg8::EpiPleGate E{(const bf16*)(ws + B_E0), (bf16*)(ws + B_E), 1024, (const float*)(ws + WS_RSTD)}; pg8::gemm_phase(lds, g, S, E); }
    GRID_BAR();
    rows_residual<false, true, false, false, false>(C, nullptr, XN, nullptr, (const bf16*)(ws + B_E), AIN(I_PLEPOST), nullptr, (float*)(ws + WS_RSTD), nullptr, nullptr, nullptr, nullptr, nullptr, nullptr);
    GRID_BAR();

    { pg8::Gemm g{XN, (const bf16*)(ws + W_QKV1), 1024, 1024, 1024}; pg8::StaticOrder S; S.init(NTOK / 256, 18, C.G, C.bid);
      pg8::EpiQKV1 E{(bf16*)(ws + B_QKV), tabp, (const float*)(ws + WS_RSTD)}; pg8::gemm_phase(lds, g, S, E); }
    GRID_BAR();
    for (int u = C.bid; u < 3072; u += C.G) {
        const int grp = u >> 10, idx = u & 1023, b = idx >> 6, head = (idx >> 3) & 7;
        const int res = grp == 0 ? 0 : (grp == 1 ? ((idx >> 1) & 3) : (idx & 7)), ch = grp == 0 ? (idx & 7) : (grp == 1 ? (idx & 1) : 0);
        att::dil_unit(lds, grp, b, head, res, ch, (const bf16*)(ws + B_QKV), (bf16*)(ws + B_OG) + (size_t)grp * NTOK * 512, (float*)(ws + WS_LSE) + (size_t)grp * NTOK * 8);
    }
    GRID_BAR();
    rows_merge(C, (const bf16*)(ws + B_OG), (const float*)(ws + WS_LSE), (bf16*)(ws + B_O1));
    {
        LAS float* scr = (LAS float*)(lds + C.wave * 16384);
        const int lane = fresh_tid() & 63;
        for (int it = gw; it < 3 * 8 * 1792; it += NGW) {
            const int kind = it / (8 * 1792), e = (it / 1792) & 7, r = it % 1792;
            if (kind == 0) transpose_item<true>(AIN(I_MWG) + (size_t)e * 1024 * DFF, 1024, DFF, ws + B_WGU + (size_t)e * 7168 * 1024, 1024, 0, 1, scr, r, lane, AIN(I_FFNPRE) + DM);
            else if (kind == 1) transpose_item<true>(AIN(I_MWU) + (size_t)e * 1024 * DFF, 1024, DFF, ws + B_WGU + (size_t)e * 7168 * 1024, 1024, 0, 2, scr, r, lane, AIN(I_FFNPRE) + DM);
            else transpose_item<true>(AIN(I_MWD) + (size_t)e * DFF * 1024, DFF, 1024, ws + B_WD + (size_t)e * 1024 * DFF, DFF, 0, 0, scr, r, lane);
        }
    }
    GRID_BAR();
    { pg8::Gemm g{(const bf16*)(ws + B_O1), (const bf16*)(ws + W_OUT1), 512, 512, 512}; pg8::StaticOrder S; S.init(NTOK / 256, 4, C.G, C.bid);
      pg8::EpiStore E{(bf16*)(ws + B_MO1), 1024, 1.0f, nullptr}; pg8::gemm_phase(lds, g, S, E); }
    GRID_BAR();
    rows_residual<false, true, true, false, false>(C, nullptr, XN, nullptr, (const bf16*)(ws + B_MO1), AIN(I_MIXPOST) + DM, AIN(I_FFNPRE) + DM, (float*)(ws + WS_RSTD), nullptr, nullptr, AIN(I_WR),
                                     (int*)(ws + WS_TOKE), (f32x2*)(ws + WS_TOKG), (int*)(ws + WS_CNT));
    GRID_BAR();
    moe_assign_gather(C, (const int*)(ws + WS_CNT), (const int*)(ws + WS_TOKE), (int*)(ws + WS_TOKS), (int*)(ws + WS_TILEE), XN, (const float*)(ws + WS_RSTD), ws + B_XS);
    GRID_BAR();
    {
        const int* tilee = (const int*)(ws + WS_TILEE);
        const int ntiles = __builtin_amdgcn_readfirstlane(tilee[0]);
        for (int c = 0; c < 5; ++c) {
            const int tile0 = 64 * c; int ntl = ntiles - tile0; if (ntl <= 0) break; if (ntl > 64) ntl = 64;
            { pg8::Gemm g{(const bf16*)(ws + B_XS), (const bf16*)(ws + B_WGU), 512, 512, 512};
              pg8::MoeOrder S; S.so.init(ntl, 28, C.G, C.bid); S.tile_e = tilee + 8; S.tile0 = tile0; S.nbt = 28; S.a_global = true;
              pg8::EpiSwiGLU8 E{ws + B_HC, DFF}; pg8::gemm_phase<pg8::EpiSwiGLU8, pg8::MoeOrder, true>(lds, g, S, E, 0x79797979, 0x7f7f7f7f); }
            GRID_BAR();
            { pg8::Gemm g{(const bf16*)(ws + B_HC), (const bf16*)(ws + B_WD), DFF / 2, DFF / 2, DFF / 2};
              pg8::MoeOrder S; S.so.init(ntl, 4, C.G, C.bid); S.tile_e = tilee + 8; S.tile0 = tile0; S.nbt = 4; S.a_global = false;
              pg8::EpiStore E{(bf16*)(ws + B_Y), 1024, 1.0f, nullptr}; pg8::gemm_phase<pg8::EpiStore, pg8::MoeOrder, true>(lds, g, S, E, 0x79797979, 0x7c7c7c7c); }
            GRID_BAR();
        }
    }
    rows_residual<true, true, false, false, false>(C, nullptr, XN, nullptr, (const bf16*)(ws + B_Y), AIN(I_FFNPOST) + DM, nullptr, (float*)(ws + WS_RSTD), (const int*)(ws + WS_TOKS), (const f32x2*)(ws + WS_TOKG),
                                     nullptr, nullptr, nullptr, nullptr);
    { pg8::Gemm g{(const bf16*)(ws + WS_PB) + (size_t)NTOK * 256, (const bf16*)(ws + W_PP) + 1024 * 256, 256, 256, 256}; pg8::StaticOrder S; S.init(NTOK / 256, 4, C.G, C.bid);
      pg8::EpiStore E{(bf16*)(ws + B_E0b), 1024, 1.0f, nullptr}; pg8::gemm_phase(lds, g, S, E); }
    GRID_BAR();
    { pg8::Gemm g{XN, (const bf16*)(ws + W_PG) + 1024 * 1024, 1024, 1024, 1024}; pg8::StaticOrder S; S.init(NTOK / 256, 4, C.G, C.bid);
      pg8::EpiPleGate E{(const bf16*)(ws + B_E0b), (bf16*)(ws + B_Eb), 1024, (const float*)(ws + WS_RSTD)}; pg8::gemm_phase(lds, g, S, E); }
    GRID_BAR();
    rows_residual<false, false, false, false, true>(C, nullptr, XN, hres, (const bf16*)(ws + B_Eb), AIN(I_PLEPOST) + DM, nullptr, nullptr, nullptr, nullptr, nullptr, nullptr, nullptr, nullptr);
#undef TR
#undef GRID_BAR
#undef AIN
}

extern "C" void kernel_launch(void* const* d_in, const int* in_sizes, int n_in, void* d_out, int out_size, void* d_ws, size_t ws_size, hipStream_t stream) {
    static int grid = 0;
    if (grid == 0) {
        if (n_in != 27 || in_sizes[0] != NTOK * DM || out_size != NTOK * DM || ws_size < WS_END) { fprintf(stderr, "kernel_launch: unexpected shapes / workspace (%zu < %zu)\n", ws_size, (size_t)WS_END); grid = -1; return; }
        int dev = 0, cus = 0;
        if (hipGetDevice(&dev) != hipSuccess || hipDeviceGetAttribute(&cus, hipDeviceAttributeMultiprocessorCount, dev) != hipSuccess) { grid = -1; return; }
        if (hipFuncSetAttribute((const void*)fwd_kernel, hipFuncAttributeMaxDynamicSharedMemorySize, LDS_BYTES) != hipSuccess) { fprintf(stderr, "kernel_launch: hipFuncSetAttribute failed\n"); grid = -1; return; }
        int per_cu = 0;
        if (hipOccupancyMaxActiveBlocksPerMultiprocessor(&per_cu, (const void*)fwd_kernel, NTHREADS, LDS_BYTES) != hipSuccess || per_cu < 1) fprintf(stderr, "kernel_launch: occupancy query reports %d\n", per_cu);
        (void)hipGetLastError();
        if (cus != 256) { fprintf(stderr, "kernel_launch: built for 256 CUs, device has %d\n", cus); grid = -1; return; }
        grid = cus;
    }
    if (grid < 0) return;
    (void)hipMemsetAsync((char*)d_ws + WS_CTL, 0, CTL_ZERO_BYTES, stream);
    Args a{};
    for (int i = 0; i < 27; ++i) a.in[i] = (const float*)d_in[i];
    a.out = (float*)d_out; a.ws = (unsigned char*)d_ws;
    hipLaunchKernelGGL(fwd_kernel, dim3(grid), dim3(NTHREADS), LDS_BYTES, stream, a);
}
```

```cpp
#include <hip/hip_runtime.h>
#include <cstdio>
#include <cstdint>

#define DI __device__ __forceinline__
#define LAS __attribute__((address_space(3)))
#define GAS __attribute__((address_space(1)))
typedef unsigned short bf16;
typedef short bf16x8 __attribute__((ext_vector_type(8)));
typedef short s16x4 __attribute__((ext_vector_type(4)));
typedef float f32x2 __attribute__((ext_vector_type(2)));
typedef float f32x4 __attribute__((ext_vector_type(4)));
typedef float f32x16 __attribute__((ext_vector_type(16)));
typedef unsigned u32x2 __attribute__((ext_vector_type(2)));
typedef unsigned u32x4 __attribute__((ext_vector_type(4)));
typedef __bf16 bf16x2_t __attribute__((ext_vector_type(2)));

constexpr int BATCH = 16, SEQ = 2048, DM = 1024, NTOK = BATCH * SEQ;
constexpr int ZW = 1280;
constexpr int DFF = 3584, NEXP = 8;
constexpr int QKVW = 4608;
constexpr float EPS = 1e-6f;
constexpr float LOG2E = 1.4426950408889634f;
constexpr float C2_64 = 0.125f * LOG2E;
constexpr float C2_96 = 0.10206207261596577f * LOG2E;
constexpr int NWAVES = 8, NTHREADS = 512;
constexpr int MAXTILES = 264;
constexpr int NSLOTS = MAXTILES * 256;

constexpr size_t MiB = 1u << 20;
constexpr size_t WS_CTL = 0, CTL_ZERO_BYTES = 64 * 1024;
constexpr size_t WS_TABA = 1 * MiB;
constexpr size_t WS_TABP = WS_TABA + 2048 * 16 * 8;
constexpr size_t WS_TOKE = 2 * MiB;
constexpr size_t WS_TOKG = WS_TOKE + NTOK * 4;
constexpr size_t WS_TOKS = WS_TOKG + NTOK * 8;
constexpr size_t WS_CNT = WS_TOKS + NTOK * 8;
constexpr size_t WS_TILEE = WS_CNT + 256 * 8 * 4;
constexpr size_t WS_RSTD = 2 * MiB + 768 * 1024;
constexpr size_t WS_LSE = 3 * MiB;
constexpr size_t WS_W = 6 * MiB;
constexpr size_t W_IN = WS_W;
constexpr size_t W_UQ = W_IN + (size_t)ZW * 1024 * 2;
constexpr size_t W_UKV = W_UQ + 768 * 256 * 2;
constexpr size_t W_OUT0 = W_UKV + 1024 * 256 * 2;
constexpr size_t W_GU0 = W_OUT0 + 1024 * 1024 * 2;
constexpr size_t W_D0 = W_GU0 + (size_t)7168 * 1024 * 2;
constexpr size_t W_PP = W_D0 + (size_t)1024 * 3584 * 2;
constexpr size_t W_PG = W_PP + 2 * 1024 * 256 * 2;
constexpr size_t W_QKV1 = W_PG + 2 * 1024 * 1024 * 2;
constexpr size_t W_OUT1 = W_QKV1 + (size_t)QKVW * 1024 * 2;
constexpr size_t W_END = W_OUT1 + 1024 * 512 * 2;
constexpr size_t WS_PB = 48 * MiB;
constexpr size_t WS_XN = 80 * MiB;
constexpr size_t WS_BIG = 144 * MiB;
static_assert(W_END <= WS_PB, "weights");
constexpr size_t B_ZIN = WS_BIG;
constexpr size_t B_QA = WS_BIG + 80 * MiB;
constexpr size_t B_KA = WS_BIG + 112 * MiB;
constexpr size_t B_CQN = WS_BIG + 120 * MiB;
constexpr size_t B_CKVN = WS_BIG + 136 * MiB;
constexpr size_t B_KR = WS_BIG + 152 * MiB;
constexpr size_t B_QM = WS_BIG + 154 * MiB;
constexpr size_t B_KV = WS_BIG + 202 * MiB;
constexpr size_t B_O0 = WS_BIG + 266 * MiB;
constexpr size_t B_MO0 = WS_BIG;
constexpr size_t B_HID = WS_BIG;
constexpr size_t B_F = WS_BIG + 224 * MiB;
constexpr size_t B_E0 = WS_BIG + 288 * MiB;
constexpr size_t B_E = WS_BIG;
constexpr size_t B_QKV = WS_BIG;
constexpr size_t B_OG = WS_BIG + 288 * MiB;
constexpr size_t B_O1 = WS_BIG + 388 * MiB;
constexpr size_t B_XN8 = WS_BIG + 388 * MiB;
constexpr size_t B_MO1 = WS_BIG + 288 * MiB;
constexpr size_t B_WGU = WS_BIG;
constexpr size_t B_WD = WS_BIG + 56 * MiB;
constexpr size_t B_XS = WS_BIG + 84 * MiB;
constexpr size_t B_Y = WS_BIG + 152 * MiB;
constexpr size_t B_HC = WS_BIG + 300 * MiB;
constexpr size_t B_YP = WS_BIG + 84 * MiB;
constexpr size_t YP_STRIDE = (size_t)7 * 256 * 1024 * 2;
constexpr size_t B_E0b = WS_BIG + 356 * MiB;
constexpr size_t B_Eb = WS_BIG;
constexpr size_t B_XN8b = WS_BIG + 96 * MiB;
constexpr size_t WS_END = WS_BIG + 420 * MiB;

constexpr int CW_BAR = 1024;
constexpr int CW_KP = 8192;

constexpr int RING_BYTES = 133120;
constexpr int LDSCTL_OFF = RING_BYTES, MISC_OFF = LDSCTL_OFF + 320;
constexpr int LDS_BYTES = 147456;

DI float bf2f(unsigned short v) { return __uint_as_float((unsigned)v << 16); }
DI unsigned pk2(float lo, float hi) { f32x2 v = {lo, hi}; bf16x2_t b = __builtin_convertvector(v, bf16x2_t); return __builtin_bit_cast(unsigned, b); }
DI float wave_sum(float v) {
#pragma unroll
    for (int o = 1; o < 64; o <<= 1) v += __shfl_xor(v, o);
    return v;
}
DI int fresh_tid() { int t = threadIdx.x; asm volatile("" : "+v"(t)); return t; }
DI float ex2(float x) { return __builtin_amdgcn_exp2f(x); }
DI float rsq(float x) { return 1.0f / sqrtf(x); }
DI void unpack8(u32x4 w, float (&x)[8]) {
    x[0] = __uint_as_float(w.x << 16); x[1] = __uint_as_float(w.x & 0xffff0000u);
    x[2] = __uint_as_float(w.y << 16); x[3] = __uint_as_float(w.y & 0xffff0000u);
    x[4] = __uint_as_float(w.z << 16); x[5] = __uint_as_float(w.z & 0xffff0000u);
    x[6] = __uint_as_float(w.w << 16); x[7] = __uint_as_float(w.w & 0xffff0000u);
}
DI u32x4 pack8(const float (&x)[8]) { u32x4 w; w.x = pk2(x[0], x[1]); w.y = pk2(x[2], x[3]); w.z = pk2(x[4], x[5]); w.w = pk2(x[6], x[7]); return w; }

namespace pg8 {
constexpr int BM = 256, BK = 64, HALF = 128, HTB = HALF * BK * 2, STAGE_BYTES = 8 * HTB, NXCD = 8, WGM = 8;
constexpr int RS_LDS_OFF = STAGE_BYTES;
__host__ __device__ __forceinline__ int lds_byte(int r, int c) { const int st = (r >> 4) * 2 + (c >> 5), rr = r & 15, cc = c & 31, ob = rr * 64 + cc * 2; return st * 1024 + (ob ^ (((ob >> 9) & 1) << 5)); }
__host__ __device__ __forceinline__ void stage_rc(int b, int& R, int& C) { const int st = b / 1024, sb = b % 1024, swz = sb ^ (((sb >> 9) & 1) << 5); R = (st >> 1) * 16 + swz / 64; C = (st & 1) * 32 + (swz % 64) / 2; }
__host__ __device__ __forceinline__ int perm32(int rho) { const int n = rho >> 4, i = rho & 15; return 8 * (i >> 2) + 4 * n + (i & 3); }

struct Unit { int pm, pn, pa, pb; };
struct Gemm { const bf16* A; const bf16* Bt; int lda, ldb, K; };

struct StaticOrder {
    int nM, nN, nwg, G, c;
    DI void init(int nM_, int nN_, int G_, int c_) { nM = nM_; nN = nN_; nwg = nM * nN; G = G_; c = c_; }
    DI bool map(int i, int& pm, int& pn) const {
        const long L = (long)i * G + c; if (L >= nwg) return false;
        int wgid = (int)L; { const int q = nwg / NXCD, r = nwg % NXCD, xcd = wgid % NXCD, off = wgid / NXCD; wgid = (xcd < r ? xcd * (q + 1) : r * (q + 1) + (xcd - r) * q) + off; }
        const int nig = WGM * nN, gid = wgid / nig, fm = gid * WGM, gsz = (nM - fm) < WGM ? (nM - fm) : WGM;
        pm = fm + ((wgid % nig) % gsz); pn = (wgid % nig) / gsz; return true;
    }
    DI bool next(int i, Unit& u) const { int pm, pn; if (!map(i, pm, pn)) return false; u.pm = pm; u.pn = pn; u.pa = pm; u.pb = pn; return true; }
};
struct MoeOrder {
    StaticOrder so; int tend[7]; int tile0, nbt; bool a_global;
    DI bool next(int i, Unit& u) const {
        int pm, pn; if (!so.map(i, pm, pn)) return false;
        const int tl = tile0 + pm; int e = 0;
#pragma unroll
        for (int j = 0; j < 7; ++j) e += (tl >= tend[j]) ? 1 : 0;
        u.pn = pn; u.pb = e * nbt + pn;
        if (a_global) { u.pa = tile0 + pm; u.pm = pm; } else { u.pa = pm; u.pm = tile0 + pm; }
        return true;
    }
};

struct OneUnit { Unit u; bool has; DI bool next(int i, Unit& o) const { if (i != 0 || !has) return false; o = u; return true; } };

struct EpiStore {
    bf16* O; int ldc; float scale; const float* rs;
    static constexpr int NSTORES = 16;
    struct Pre { const LAS float* t; };
    DI Pre pre(const Unit& u, LAS unsigned char* lds, int par, int wid, int lane) const { LAS float* t = (LAS float*)(lds + RS_LDS_OFF + par * 1024);
        return Pre{t}; }
    DI void operator()(const f32x4 (&acc)[2][2][4][2], const Unit& u, int wr, int wc, int fr, int fq, const Pre& P) const {
        const int row0 = u.pm * BM + wr * 64 + fr, col0 = u.pn * BM + wc * 32 + 8 * fq;
#pragma unroll
        for (int ai = 0; ai < 2; ++ai)
#pragma unroll
            for (int m = 0; m < 4; ++m) { bf16* rowp = O + (size_t)(row0 + ai * HALF + m * 16) * ldc + col0; const float sc = rs ? scale * rs[row0 + ai * HALF + m * 16] : scale;
#pragma unroll
                for (int bj = 0; bj < 2; ++bj) { const f32x4 v0 = acc[ai][bj][m][0] * sc, v1 = acc[ai][bj][m][1] * sc;
                    u32x4 w; w.x = pk2(v0[0], v0[1]); w.y = pk2(v0[2], v0[3]); w.z = pk2(v1[0], v1[1]); w.w = pk2(v1[2], v1[3]);
                    *(u32x4*)(rowp + bj * HALF) = w; } }
    }
};
struct EpiStoreKV {
    bf16* O; int ldc; unsigned* kp;
    static constexpr int NSTORES = 16;
    struct Pre { };
    DI Pre pre(const Unit&, LAS unsigned char*, int, int, int) const { return Pre{}; }
    DI void operator()(const f32x4 (&acc)[2][2][4][2], const Unit& u, int wr, int wc, int fr, int fq, const Pre&) const {
        const int row0 = u.pm * BM + wr * 64 + fr, col0 = u.pn * BM + wc * 32 + 8 * fq;
#pragma unroll
        for (int ai = 0; ai < 2; ++ai)
#pragma unroll
            for (int m = 0; m < 4; ++m) { bf16* rowp = O + (size_t)(row0 + ai * HALF + m * 16) * ldc + col0;
#pragma unroll
                for (int bj = 0; bj < 2; ++bj) { const f32x4 v0 = acc[ai][bj][m][0], v1 = acc[ai][bj][m][1];
                    u32x4 w; w.x = pk2(v0[0], v0[1]); w.y = pk2(v0[2], v0[3]); w.z = pk2(v1[0], v1[1]); w.w = pk2(v1[2], v1[3]);
                    *(u32x4*)(rowp + bj * HALF) = w; } }
        if (wc < 2) {
#pragma unroll
            for (int bj = 0; bj < 2; ++bj) { float mx = 0.f;
#pragma unroll
                for (int ai = 0; ai < 2; ++ai)
#pragma unroll
                    for (int m = 0; m < 4; ++m) { const f32x4 v0 = acc[ai][bj][m][0], v1 = acc[ai][bj][m][1];
                        float pq = (v0[0] * v0[0] + v0[1] * v0[1]) + (v0[2] * v0[2] + v0[3] * v0[3]) + (v1[0] * v1[0] + v1[1] * v1[1]) + (v1[2] * v1[2] + v1[3] * v1[3]);
                        pq += __shfl_xor(pq, 16); pq += __shfl_xor(pq, 32); mx = fmaxf(mx, pq); }
                mx = fmaxf(mx, __shfl_xor(mx, 1)); mx = fmaxf(mx, __shfl_xor(mx, 2)); mx = fmaxf(mx, __shfl_xor(mx, 4)); mx = fmaxf(mx, __shfl_xor(mx, 8));
                if (fr == 0 && fq == 0) atomicMax(kp + (((u.pm >> 3) * 8 + 2 * u.pn + bj) * 2 + wc) * 32, __float_as_uint(mx)); }
        }
    }
};
DI float silu_mul(float g, float u) { return g * u * __builtin_amdgcn_rcpf(1.0f + ex2(-g * LOG2E)); }
struct EpiSwiGLU {
    bf16* H; int ldh; const float* rs;
    static constexpr int NSTORES = 8;
    struct Pre { const LAS float* t; };
    DI Pre pre(const Unit& u, LAS unsigned char* lds, int par, int wid, int lane) const { LAS float* t = (LAS float*)(lds + RS_LDS_OFF + par * 1024);
        return Pre{t}; }
    DI void operator()(const f32x4 (&acc)[2][2][4][2], const Unit& u, int wr, int wc, int fr, int fq, const Pre& P) const {
        const int row0 = u.pm * BM + wr * 64 + fr, col0 = u.pn * HALF + wc * 32 + 8 * fq;
#pragma unroll
        for (int ai = 0; ai < 2; ++ai)
#pragma unroll
            for (int m = 0; m < 4; ++m) { bf16* rowp = H + (size_t)(row0 + ai * HALF + m * 16) * ldh + col0; const float sc = rs ? rs[row0 + ai * HALF + m * 16] : 1.0f;
                const f32x4 g0 = acc[ai][0][m][0] * sc, g1 = acc[ai][0][m][1] * sc, u0 = acc[ai][1][m][0] * sc, u1 = acc[ai][1][m][1] * sc;
                u32x4 w; w.x = pk2(silu_mul(g0[0], u0[0]), silu_mul(g0[1], u0[1])); w.y = pk2(silu_mul(g0[2], u0[2]), silu_mul(g0[3], u0[3]));
                w.z = pk2(silu_mul(g1[0], u1[0]), silu_mul(g1[1], u1[1])); w.w = pk2(silu_mul(g1[2], u1[2]), silu_mul(g1[3], u1[3]));
                *(u32x4*)rowp = w; }
    }
};
constexpr float SA8 = 32.0f, SW8 = 1000.0f, ISC8 = 1.0f / (SA8 * SW8);
DI unsigned pk4_i8(float a, float b, float c, float d) {
    const int ia = (int)__builtin_amdgcn_fmed3f(__builtin_rintf(a), -127.f, 127.f), ib = (int)__builtin_amdgcn_fmed3f(__builtin_rintf(b), -127.f, 127.f);
    const int ic = (int)__builtin_amdgcn_fmed3f(__builtin_rintf(c), -127.f, 127.f), id = (int)__builtin_amdgcn_fmed3f(__builtin_rintf(d), -127.f, 127.f);
    return ((unsigned)ia & 0xffu) | (((unsigned)ib & 0xffu) << 8) | (((unsigned)ic & 0xffu) << 16) | ((unsigned)id << 24); }
DI unsigned pk4_fp8(float a, float b, float c, float d) {
    a = __builtin_amdgcn_fmed3f(a, -448.f, 448.f); b = __builtin_amdgcn_fmed3f(b, -448.f, 448.f); c = __builtin_amdgcn_fmed3f(c, -448.f, 448.f); d = __builtin_amdgcn_fmed3f(d, -448.f, 448.f);
    int w = 0; w = __builtin_amdgcn_cvt_pk_fp8_f32(a, b, w, false); w = __builtin_amdgcn_cvt_pk_fp8_f32(c, d, w, true); return (unsigned)w; }
DI float silu_mul_l2(float gl, float ul) { return gl * ul * __builtin_amdgcn_rcpf(1.0f + ex2(-gl)); }
struct EpiSwiGLU8 {
    unsigned char* H; int ldh;
    static constexpr int NSTORES = 8;
    struct Pre { };
    DI Pre pre(const Unit&, LAS unsigned char*, int, int, int) const { return Pre{}; }
    DI void operator()(const f32x4 (&acc)[2][2][4][2], const Unit& u, int wr, int wc, int fr, int fq, const Pre&) const {
        const int row0 = u.pm * BM + wr * 64 + fr, col0 = u.pn * HALF + wc * 32 + 8 * fq;
#pragma unroll
        for (int ai = 0; ai < 2; ++ai)
#pragma unroll
            for (int m = 0; m < 4; ++m) { unsigned char* rowp = H + (size_t)(row0 + ai * HALF + m * 16) * ldh + col0;
                const f32x4 g0 = acc[ai][0][m][0], g1 = acc[ai][0][m][1], u0 = acc[ai][1][m][0], u1 = acc[ai][1][m][1];
                u32x2 w; w.x = pk4_fp8(silu_mul_l2(g0[0], u0[0]), silu_mul_l2(g0[1], u0[1]), silu_mul_l2(g0[2], u0[2]), silu_mul_l2(g0[3], u0[3]));
                w.y = pk4_fp8(silu_mul_l2(g1[0], u1[0]), silu_mul_l2(g1[1], u1[1]), silu_mul_l2(g1[2], u1[2]), silu_mul_l2(g1[3], u1[3]));
                *(u32x2*)rowp = w; }
    }
};
struct EpiPleGate {
    const bf16* E0; bf16* E; int ldc; const float* rs;
    static constexpr int NSTORES = 16;
    struct Pre { const LAS float* t; };
    DI Pre pre(const Unit& u, LAS unsigned char* lds, int par, int wid, int lane) const { LAS float* t = (LAS float*)(lds + RS_LDS_OFF + par * 1024);
        return Pre{t}; }
    DI void operator()(const f32x4 (&acc)[2][2][4][2], const Unit& u, int wr, int wc, int fr, int fq, const Pre& P) const {
        const int row0 = u.pm * BM + wr * 64 + fr, col0 = u.pn * BM + wc * 32 + 8 * fq;
#pragma unroll
        for (int ai = 0; ai < 2; ++ai)
#pragma unroll
            for (int m = 0; m < 4; ++m) { const size_t off = (size_t)(row0 + ai * HALF + m * 16) * ldc + col0; const float sc = rs ? rs[row0 + ai * HALF + m * 16] * LOG2E : LOG2E;
#pragma unroll
                for (int bj = 0; bj < 2; ++bj) { const u32x4 ew = *(const u32x4*)(E0 + off + bj * HALF); float e[8]; unpack8(ew, e);
                    const f32x4 v0 = acc[ai][bj][m][0] * sc, v1 = acc[ai][bj][m][1] * sc; float o[8];
#pragma unroll
                    for (int j = 0; j < 4; ++j) { o[j] = e[j] * __builtin_amdgcn_rcpf(1.0f + ex2(-v0[j])); o[4 + j] = e[4 + j] * __builtin_amdgcn_rcpf(1.0f + ex2(-v1[j])); }
                    *(u32x4*)(E + off + bj * HALF) = pack8(o); } }
    }
};
struct EpiQKV1 {
    bf16* O; const f32x2* tabp; const float* rs;
    static constexpr int NSTORES = 16;
    struct Pre { const LAS float* t; };
    DI Pre pre(const Unit& u, LAS unsigned char* lds, int par, int wid, int lane) const { LAS float* t = (LAS float*)(lds + RS_LDS_OFF + par * 1024);
        return Pre{t}; }
    DI void operator()(const f32x4 (&acc)[2][2][4][2], const Unit& u, int wr, int wc, int fr, int fq, const Pre& P) const {
        const int row0 = u.pm * BM + wr * 64 + fr;
        const int which = ((u.pn * BM) % 1536) / 512;
        const int grp = (u.pn * BM) / 1536, sh = 2 * grp;
        const float sc = which == 0 ? C2_64 : 1.0f;
        const bool rot = which < 2;
        const bool mine = ((wc & 1) == 0) && (fq < 2);
#pragma unroll
        for (int ai = 0; ai < 2; ++ai)
#pragma unroll
            for (int m = 0; m < 4; ++m) { const int row = row0 + ai * HALF + m * 16, bb = row >> 11, t = row & (SEQ - 1);
                const int pos = ((t & ((1 << sh) - 1)) << (11 - sh)) + (t >> sh);
                const float scr = rs ? sc * rs[row] : sc;
                f32x4 cs4[4];
                if (rot && mine) {
#pragma unroll
                    for (int q = 0; q < 4; ++q) cs4[q] = ((const f32x4*)(tabp + (size_t)t * 8))[q];
                }
#pragma unroll
                for (int bj = 0; bj < 2; ++bj) { float v[8];
                    const int head = ((u.pn * BM + bj * HALF + wc * 32) % 512) / 64, d0 = ((wc & 1) * 32) + 8 * fq;
                    bf16* dst = O + ((size_t)((((bb * 3 + grp) * 3 + which) * 8 + head) * SEQ + pos)) * 64 + d0;
#pragma unroll
                    for (int j = 0; j < 4; ++j) { v[j] = acc[ai][bj][m][0][j]; v[4 + j] = acc[ai][bj][m][1][j]; }
                    if (rot) {
                        float p[8];
#pragma unroll
                        for (int j = 0; j < 8; ++j) p[j] = __shfl_xor(v[j], 16);
                        if (mine) {
#pragma unroll
                            for (int j = 0; j < 8; ++j) { const float cx = cs4[j >> 1][(j & 1) * 2], sy = cs4[j >> 1][(j & 1) * 2 + 1]; v[j] = (fq == 0) ? (v[j] * cx - p[j] * sy) : (v[j] * cx + p[j] * sy); }
                        }
                    }
#pragma unroll
                    for (int j = 0; j < 8; ++j) v[j] *= scr;
                    *(u32x4*)dst = pack8(v); } }
    }
};

typedef int v8i32 __attribute__((ext_vector_type(8)));
typedef int v4i32 __attribute__((ext_vector_type(4)));
DI v8i32 cat8(bf16x8 lo, bf16x8 hi) { const v4i32 a = __builtin_bit_cast(v4i32, lo), b = __builtin_bit_cast(v4i32, hi); return __builtin_shufflevector(a, b, 0, 1, 2, 3, 4, 5, 6, 7); }
template <class Epi, class Sched, bool FP8 = false, bool I8 = false>
DI void gemm_phase(LAS unsigned char* lds, const Gemm g, const Sched& S, const Epi& E, const int scw = 0x7f7f7f7f, const int sca = 0x7f7f7f7f, const float isc0 = 1.f, const float isc1 = 1.f, const int scw1 = 0) {
    const int tid = fresh_tid(), wid = __builtin_amdgcn_readfirstlane(tid >> 6), lane = tid & 63, wr = wid >> 2, wc = wid & 3, fr = lane & 15, fq = lane >> 4;
    const int scwb = scw1 ? scw1 : scw;
    const int K = g.K; int nt = K / BK; if constexpr (FP8 || I8) asm volatile("" : "+s"(nt));
    unsigned voffA[2], voffB[2];
#pragma unroll
    for (int i = 0; i < 2; ++i) { int R, C; stage_rc(tid * 16 + i * 8192, R, C); const int Rb = (R & ~31) + perm32(R & 31);
        voffA[i] = (unsigned)(R * g.lda + C) * 2u; voffB[i] = (unsigned)(Rb * g.ldb + C) * 2u; }
    const size_t kstep = (size_t)(BK * 2);
    const size_t hstepA = (size_t)HALF * g.lda * 2, hstepB = (size_t)HALF * g.ldb * 2;
    const size_t tstepA = 2 * hstepA, tstepB = 2 * hstepB;
    const unsigned ldsw = (unsigned)wid * 1024u;
    const int aoff = lds_byte(wr * 64 + fr, fq * 8), boff = lds_byte(wc * 32 + fr, fq * 8);
#define PG8_SA(b, h) (((b) * 2 + (h)) * HTB)
#define PG8_SB(b, h) ((4 + (b) * 2 + (h)) * HTB)
#define PG8_STAGE(bufoff, gbase, voff) do { _Pragma("unroll") for (int _i = 0; _i < 2; ++_i) \
        __builtin_amdgcn_global_load_lds((const unsigned*)((const char*)(gbase) + (voff)[_i]), (LAS unsigned*)(lds + (bufoff) + ldsw + _i * 8192), 16, 0, 0); } while (0)
#define PG8_LDA(dst, b, h) do { _Pragma("unroll") for (int m = 0; m < 4; ++m) { \
        if constexpr (FP8) dst##8[m] = cat8(*(const LAS bf16x8*)(lds + PG8_SA(b, h) + aoff + m * 2048), *(const LAS bf16x8*)(lds + PG8_SA(b, h) + aoff + m * 2048 + 1024)); \
        else { _Pragma("unroll") for (int k = 0; k < 2; ++k) dst[m][k] = *(const LAS bf16x8*)(lds + PG8_SA(b, h) + aoff + m * 2048 + k * 1024); } } } while (0)
#define PG8_LDB(dst, b, h) do { _Pragma("unroll") for (int n = 0; n < 2; ++n) { \
        if constexpr (FP8) dst##8[n] = cat8(*(const LAS bf16x8*)(lds + PG8_SB(b, h) + boff + n * 2048), *(const LAS bf16x8*)(lds + PG8_SB(b, h) + boff + n * 2048 + 1024)); \
        else { _Pragma("unroll") for (int k = 0; k < 2; ++k) dst[n][k] = *(const LAS bf16x8*)(lds + PG8_SB(b, h) + boff + n * 2048 + k * 1024); } } } while (0)
#define PG8_MMA(ai, bj, At, Bt) do { __builtin_amdgcn_s_setprio(1); \
        if constexpr (FP8) { _Pragma("unroll") for (int m = 0; m < 4; ++m) _Pragma("unroll") for (int n = 0; n < 2; ++n) \
            asm volatile("s_nop 1\n\tv_mfma_scale_f32_16x16x128_f8f6f4 %0, %1, %2, %0, %3, %4 op_sel_hi:[0,0,0]" : "+v"(acc[ai][bj][m][n]) : "v"(Bt##8[n]), "v"(At##8[m]), "v"((bj) == 1 ? scwb : scw), "v"(sca)); } \
        else if constexpr (I8) { _Pragma("unroll") for (int k = 0; k < 2; ++k) _Pragma("unroll") for (int m = 0; m < 4; ++m) _Pragma("unroll") for (int n = 0; n < 2; ++n) \
            asm volatile("v_mfma_i32_16x16x64_i8 %0, %1, %2, %0" : "+v"(acc[ai][bj][m][n]) : "v"(Bt[n][k]), "v"(At[m][k])); } \
        else { _Pragma("unroll") for (int k = 0; k < 2; ++k) _Pragma("unroll") for (int m = 0; m < 4; ++m) _Pragma("unroll") for (int n = 0; n < 2; ++n)     \
            asm volatile("v_mfma_f32_16x16x32_bf16 %0, %1, %2, %0" : "+v"(acc[ai][bj][m][n]) : "v"(Bt[n][k]), "v"(At[m][k])); } \
        __builtin_amdgcn_s_setprio(0); } while (0)
#define PG8_MMA0(ai, bj, At, Bt) do { __builtin_amdgcn_s_setprio(1); \
        if constexpr (FP8) { _Pragma("unroll") for (int m = 0; m < 4; ++m) _Pragma("unroll") for (int n = 0; n < 2; ++n) \
            asm volatile("s_nop 1\n\tv_mfma_scale_f32_16x16x128_f8f6f4 %0, %1, %2, 0, %3, %4 op_sel_hi:[0,0,0]" : "=&v"(acc[ai][bj][m][n]) : "v"(Bt##8[n]), "v"(At##8[m]), "v"((bj) == 1 ? scwb : scw), "v"(sca)); } \
        else if constexpr (I8) { _Pragma("unroll") for (int m = 0; m < 4; ++m) _Pragma("unroll") for (int n = 0; n < 2; ++n) \
            asm volatile("v_mfma_i32_16x16x64_i8 %0, %1, %2, 0" : "=&v"(acc[ai][bj][m][n]) : "v"(Bt[n][0]), "v"(At[m][0])); \
          _Pragma("unroll") for (int m = 0; m < 4; ++m) _Pragma("unroll") for (int n = 0; n < 2; ++n) \
            asm volatile("v_mfma_i32_16x16x64_i8 %0, %1, %2, %0" : "+v"(acc[ai][bj][m][n]) : "v"(Bt[n][1]), "v"(At[m][1])); } \
        else { _Pragma("unroll") for (int m = 0; m < 4; ++m) _Pragma("unroll") for (int n = 0; n < 2; ++n) \
            asm volatile("v_mfma_f32_16x16x32_bf16 %0, %1, %2, 0" : "=&v"(acc[ai][bj][m][n]) : "v"(Bt[n][0]), "v"(At[m][0])); \
          _Pragma("unroll") for (int m = 0; m < 4; ++m) _Pragma("unroll") for (int n = 0; n < 2; ++n) \
            asm volatile("v_mfma_f32_16x16x32_bf16 %0, %1, %2, %0" : "+v"(acc[ai][bj][m][n]) : "v"(Bt[n][1]), "v"(At[m][1])); } \
        __builtin_amdgcn_s_setprio(0); } while (0)
#define PG8_TIE_ACC(NOPS) do { \
        asm volatile(NOPS : "+v"(acc[0][0][0][0]), "+v"(acc[0][0][0][1]), "+v"(acc[0][0][1][0]), "+v"(acc[0][0][1][1]), "+v"(acc[0][0][2][0]), "+v"(acc[0][0][2][1]), "+v"(acc[0][0][3][0]), "+v"(acc[0][0][3][1]), \
                            "+v"(acc[0][1][0][0]), "+v"(acc[0][1][0][1]), "+v"(acc[0][1][1][0]), "+v"(acc[0][1][1][1]), "+v"(acc[0][1][2][0]), "+v"(acc[0][1][2][1]), "+v"(acc[0][1][3][0]), "+v"(acc[0][1][3][1])); \
        asm volatile("" : "+v"(acc[1][0][0][0]), "+v"(acc[1][0][0][1]), "+v"(acc[1][0][1][0]), "+v"(acc[1][0][1][1]), "+v"(acc[1][0][2][0]), "+v"(acc[1][0][2][1]), "+v"(acc[1][0][3][0]), "+v"(acc[1][0][3][1]), \
                          "+v"(acc[1][1][0][0]), "+v"(acc[1][1][0][1]), "+v"(acc[1][1][1][0]), "+v"(acc[1][1][1][1]), "+v"(acc[1][1][2][0]), "+v"(acc[1][1][2][1]), "+v"(acc[1][1][3][0]), "+v"(acc[1][1][3][1])); } while (0)
#define PG8_WAIT_V(n) asm volatile("s_waitcnt vmcnt(" #n ")" ::: "memory")
#define PG8_WAIT_L(n) asm volatile("s_waitcnt lgkmcnt(" #n ")" ::: "memory")
#define PG8_BAR __builtin_amdgcn_s_barrier()
#define PG8_SCHED __builtin_amdgcn_sched_barrier(0)
    Unit cur, nxt; int ui = 0;
    if (!S.next(0, cur)) return;
    f32x4 acc[2][2][4][2];
    bf16x8 At[4][2], B0[2][2], B1[2][2]; v8i32 At8[4], B08[2], B18[2];
    const char* cA = (const char*)g.A + (size_t)cur.pa * tstepA; const char* cB = (const char*)g.Bt + (size_t)cur.pb * tstepB;
    PG8_STAGE(PG8_SB(0, 0), cB, voffB); PG8_STAGE(PG8_SB(0, 1), cB + hstepB, voffB); PG8_STAGE(PG8_SA(0, 0), cA, voffA); PG8_STAGE(PG8_SA(0, 1), cA + hstepA, voffA);
    if (wr == 1) PG8_BAR;
    PG8_WAIT_V(2); PG8_BAR;
    PG8_STAGE(PG8_SB(1, 0), cB + kstep, voffB); PG8_STAGE(PG8_SA(1, 0), cA + kstep, voffA); PG8_STAGE(PG8_SB(1, 1), cB + hstepB + kstep, voffB);
    PG8_WAIT_V(0); PG8_BAR;
    for (;;) {
        const bool has_next = S.next(ui + 1, nxt);
        const typename Epi::Pre epre = E.pre(cur, lds, ui & 1, wid, lane);
        const char* nA = has_next ? (const char*)g.A + (size_t)nxt.pa * tstepA : cA; const char* nB = has_next ? (const char*)g.Bt + (size_t)nxt.pb * tstepB : cB;
#define PG8_WAITX(R) PG8_WAIT_V(8)
#define PG8_KBODY(t, R, LASTX) do { \
            const bool last = (LASTX); \
            const char* a1 = cA + (size_t)((t) + 1) * kstep; \
            const char* a2 = last ? nA : cA + (size_t)((t) + 2) * kstep; const char* b2 = last ? nB : cB + (size_t)((t) + 2) * kstep; \
            const char* a3 = a2 + kstep; const char* b3 = b2 + kstep; \
              \
            PG8_LDB(B0, 0, 0); PG8_LDB(B1, 0, 1); PG8_SCHED; PG8_LDA(At, 0, 0); PG8_STAGE(PG8_SA(1, 1), a1 + hstepA, voffA); \
            PG8_WAITX(R); PG8_WAIT_L(0); PG8_BAR; if ((t) == 0) { PG8_MMA0(0, 0, At, B0); PG8_MMA0(0, 1, At, B1); } else { PG8_MMA(0, 0, At, B0); PG8_MMA(0, 1, At, B1); } PG8_BAR; PG8_SCHED; \
              \
            PG8_LDA(At, 0, 1); PG8_STAGE(PG8_SB(0, 0), b2, voffB); PG8_STAGE(PG8_SB(0, 1), b2 + hstepB, voffB); PG8_STAGE(PG8_SA(0, 0), a2, voffA); \
            PG8_WAITX(R); PG8_WAIT_L(0); PG8_BAR; if ((t) == 0) { PG8_MMA0(1, 0, At, B0); PG8_MMA0(1, 1, At, B1); } else { PG8_MMA(1, 0, At, B0); PG8_MMA(1, 1, At, B1); } PG8_BAR; PG8_SCHED; \
              \
            PG8_LDB(B0, 1, 0); PG8_LDB(B1, 1, 1); PG8_SCHED; PG8_LDA(At, 1, 0); PG8_STAGE(PG8_SA(0, 1), a2 + hstepA, voffA); \
            PG8_WAIT_V(8); PG8_WAIT_L(0); PG8_BAR; PG8_MMA(0, 0, At, B0); PG8_MMA(0, 1, At, B1); PG8_BAR; PG8_SCHED; \
              \
            PG8_LDA(At, 1, 1); PG8_STAGE(PG8_SB(1, 0), b3, voffB); PG8_STAGE(PG8_SB(1, 1), b3 + hstepB, voffB); PG8_STAGE(PG8_SA(1, 0), a3, voffA); \
            PG8_WAIT_V(8); PG8_WAIT_L(0); PG8_BAR; PG8_MMA(1, 0, At, B0); PG8_MMA(1, 1, At, B1); PG8_BAR; PG8_SCHED; \
        } while (0)
        for (int t = 0; t < nt; t += 2) PG8_KBODY(t, false, t == nt - 2);
        if (wr == 0) PG8_BAR;
        PG8_TIE_ACC("s_nop 15\n\ts_nop 15");
        if constexpr (I8) {
#pragma unroll
            for (int a_ = 0; a_ < 2; ++a_)
#pragma unroll
                for (int b_ = 0; b_ < 2; ++b_)
#pragma unroll
                    for (int m_ = 0; m_ < 4; ++m_)
#pragma unroll
                        for (int n_ = 0; n_ < 2; ++n_)
#pragma unroll
                            for (int j_ = 0; j_ < 4; ++j_) { const float t_ = acc[a_][b_][m_][n_][j_]; acc[a_][b_][m_][n_][j_] = (float)__float_as_int(t_) * (b_ == 1 ? isc1 : isc0); }
        }
        E(acc, cur, wr, wc, fr, fq, epre);
        if (!has_next) break;
        cur = nxt; cA = nA; cB = nB; ++ui;
        if (wr == 1) PG8_BAR;
    }
    PG8_WAIT_V(0);
    PG8_BAR;
#undef PG8_SA
#undef PG8_SB
#undef PG8_STAGE
#undef PG8_LDA
#undef PG8_LDB
#undef PG8_MMA
#undef PG8_MMA0
#undef PG8_WAIT_V
#undef PG8_TIE_ACC
#undef PG8_WAITX
#undef PG8_KBODY
#undef PG8_WAIT_L
#undef PG8_BAR
#undef PG8_SCHED
}
}

namespace att {
#define MFMA32(a, b, c) __builtin_amdgcn_mfma_f32_32x32x16_bf16((a), (b), (c), 0, 0, 0)
DI int crow(int i, int h) { return (i & 3) + 8 * (i >> 2) + 4 * h; }
typedef short v4i16_t __attribute__((ext_vector_type(4)));
DI s16x4 vtr(const LAS unsigned char* p) { return __builtin_bit_cast(s16x4, __builtin_amdgcn_ds_read_tr16_b64_v4i16((LAS v4i16_t*)p)); }
DI bf16x8 packp(const f32x16& p, int b) {
    u32x4 w; w.x = pk2(p[b], p[b + 1]); w.y = pk2(p[b + 2], p[b + 3]); w.z = pk2(p[b + 4], p[b + 5]); w.w = pk2(p[b + 6], p[b + 7]);
    return __builtin_bit_cast(bf16x8, w);
}
constexpr float NEGBIG = -1.0e30f;
constexpr float DEFER_THR = 8.0f;
template <int DK, int MASK>
DI void tile_step(const LAS unsigned char* Kb, const LAS unsigned char* Vb, const int (&koff)[4], const bf16x8 (&qr)[DK / 16], f32x16& o0, f32x16& o1, float& m, float& l,
                  LAS float* wsf, int r, int h, int lane, int qi, int kj0, const bool first) {
    f32x16 p0, p1;
#pragma unroll
    for (int i = 0; i < 16; ++i) { p0[i] = 0.f; p1[i] = 0.f; }
#pragma unroll
    for (int ks = 0; ks < DK / 16; ++ks) {
        const bf16x8 a0 = *(const LAS bf16x8*)(Kb + koff[ks]);
        const bf16x8 a1 = *(const LAS bf16x8*)(Kb + koff[ks] + 4096);
        p0 = MFMA32(a0, qr[ks], p0); p1 = MFMA32(a1, qr[ks], p1);
    }
    if (MASK) {
        const int D = qi - kj0 - 4 * h;
#pragma unroll
        for (int i = 0; i < 16; ++i) { const int c0 = (i & 3) + 8 * (i >> 2);
            if (MASK == 1) { if (D > 64 + c0) p0[i] = NEGBIG; if (D > 96 + c0) p1[i] = NEGBIG; }
            else if (MASK == 2) { if (D < -64 + c0) p0[i] = NEGBIG; if (D < -32 + c0) p1[i] = NEGBIG; }
            else { if (D > 64 + c0 || D < -64 + c0) p0[i] = NEGBIG; if (D > 96 + c0 || D < -32 + c0) p1[i] = NEGBIG; } }
    }
    float tm = fmaxf(p0[0], p1[0]);
#pragma unroll
    for (int i = 1; i < 16; ++i) tm = fmaxf(tm, fmaxf(p0[i], p1[i]));
    tm = fmaxf(tm, __shfl_xor(tm, 32));
    if (first) m = tm;
    else if (__any(tm > m + DEFER_THR)) {
        const float mn = fmaxf(m, tm), al = ex2(m - mn); l *= al; m = mn;
        if (h == 0) wsf[r] = al;
#pragma unroll
        for (int i = 0; i < 16; ++i) { const float f = wsf[crow(i, h)]; o0[i] *= f; o1[i] *= f; }
    }
    float sum = 0.f;
#pragma unroll
    for (int i = 0; i < 16; ++i) { p0[i] = ex2(p0[i] - m); p1[i] = ex2(p1[i] - m); sum += p0[i] + p1[i]; }
    l += sum;
    const LAS unsigned char* vp = Vb + ((lane >> 4) & 1) * 32 + (lane & 3) * 8 + (4 * h + ((lane & 15) >> 2)) * 64;
#pragma unroll
    for (int s = 0; s < 4; ++s) {
        const bf16x8 pa = (s == 0) ? packp(p0, 0) : (s == 1) ? packp(p0, 8) : (s == 2) ? packp(p1, 0) : packp(p1, 8);
#pragma unroll
        for (int db = 0; db < 2; ++db) {
            const s16x4 lo = vtr(vp + db * 4096 + s * 1024), hi = vtr(vp + db * 4096 + s * 1024 + 512);
            const bf16x8 vf = {lo[0], lo[1], lo[2], lo[3], hi[0], hi[1], hi[2], hi[3]};
            if (db == 0) o0 = MFMA32(pa, vf, o0); else o1 = MFMA32(pa, vf, o1);
        }
    }
}
DI void finish_store(const f32x16& o0, const f32x16& o1, float l, LAS float* wsf, LAS unsigned short* stg, int r, int h, int lane, bf16* orow0, size_t rstride) {
    const float lt = l + __shfl_xor(l, 32);
    if (h == 0) wsf[r] = 1.0f / lt;
#pragma unroll
    for (int i = 0; i < 16; ++i) { const int row = crow(i, h); const float f = wsf[row];
        stg[row * 64 + r] = (unsigned short)(pk2(o0[i] * f, 0.f) & 0xffffu); stg[row * 64 + 32 + r] = (unsigned short)(pk2(o1[i] * f, 0.f) & 0xffffu); }
#pragma unroll
    for (int it = 0; it < 4; ++it) { const int row = it * 8 + (lane >> 3), ch = lane & 7;
        const u32x4 v = *(const LAS u32x4*)(stg + row * 64 + ch * 8);
        *(u32x4*)(orow0 + (size_t)row * rstride + ch * 8) = v; }
}
#define ATT_WAITBAR(N) asm volatile("s_waitcnt vmcnt(" #N ") lgkmcnt(0)\n\ts_barrier" ::: "memory")
DI void dma16(const void* gsrc, LAS unsigned char* ldst) { __builtin_amdgcn_global_load_lds((const unsigned*)gsrc, (LAS unsigned*)ldst, 16, 0, 0); }

template <int DK, bool MF = false>
DI void dense_unit(LAS unsigned char* lds, const bf16* qS, int qp, int q0, const bf16* kA, int kpA, const bf16* kB, const bf16* vS, int vpitch, bf16* oS, int op, const f32x2* taba,
                   const bool pre, const bf16* nkA, const bf16* nkB, const bf16* nvS) {
    constexpr int NKC = DK / 8, KSLOT = NKC * 1024, VSLOT = 8192, NS = 4, KS = DK / 16;
    constexpr int OFF_V = NS * KSLOT, OFF_WS = OFF_V + NS * VSLOT, OFF_STG = OFF_WS + NWAVES * 256;
    const int tid = fresh_tid(), lane = tid & 63, r = lane & 31, h = lane >> 5; const int w = __builtin_amdgcn_readfirstlane(tid >> 6);
    LAS float* wsf = (LAS float*)(lds + OFF_WS) + w * 64;
    LAS unsigned short* stg = (LAS unsigned short*)(lds + OFF_STG) + w * 2048;
    const bf16* ksrcA = kA + (size_t)(8 * w + (lane >> 3)) * kpA + ((lane & 7) ^ ((4 * w + (lane >> 4)) & 7)) * 8;
    const bf16* ksrcB = (DK == 96) ? (kB + (size_t)(16 * (w & 3) + (lane >> 2)) * 32 + ((lane & 3) ^ ((lane >> 4) & 3)) * 8) : kA;
    const bf16* vsrc = vS + (size_t)(16 * (w & 3) + (lane >> 2)) * vpitch + (w >> 2) * 32 + (lane & 3) * 8;
    const size_t kstA = (size_t)64 * kpA, kstB = 64 * 32, vst = (size_t)64 * vpitch;
    int koff[KS];
#pragma unroll
    for (int ks = 0; ks < KS; ++ks) koff[ks] = (ks < 4) ? (r * 128 + (((2 * ks + h) ^ ((r >> 1) & 7)) << 4)) : (8192 + r * 64 + (((2 * (ks - 4) + h) ^ ((r >> 2) & 3)) << 4));
#define ISSUE_K(t) do { const int sl_ = (t) % NS; dma16(ksrcA + (size_t)(t) * kstA, lds + sl_ * KSLOT + w * 1024); \
        if (DK == 96) dma16(ksrcB + (size_t)(t) * kstB, lds + sl_ * KSLOT + (8 + (w & 3)) * 1024); } while (0)
#define ISSUE_V(t) do { const int sl_ = (t) % NS; dma16(vsrc + (size_t)(t) * vst, lds + OFF_V + sl_ * VSLOT + w * 1024); } while (0)
    bf16x8 qr[KS];
    const bf16* qrow = qS + (size_t)(q0 + w * 32 + r) * qp + 8 * h;
#pragma unroll
    for (int ks = 0; ks < KS; ++ks) qr[ks] = *(const bf16x8*)(qrow + 16 * ks);
    if (!pre) { ISSUE_K(0); ISSUE_K(1); ISSUE_V(0); ISSUE_K(2); ISSUE_V(1); }
    if (DK == 96) {
        const f32x2* tp = taba + (size_t)(q0 + w * 32 + r) * 16 + 8 * h;
        bf16x8 a = qr[4], b = qr[5];
#pragma unroll
        for (int j = 0; j < 8; ++j) { const f32x2 cs = tp[j]; const float x1 = bf2f((unsigned short)a[j]), x2 = bf2f((unsigned short)b[j]);
            a[j] = (short)(pk2(x1 * cs.x - x2 * cs.y, 0.f) & 0xffffu); b[j] = (short)(pk2(x2 * cs.x + x1 * cs.y, 0.f) & 0xffffu); }
        qr[4] = a; qr[5] = b;
    }
    f32x16 o0, o1, negm, pA0, pA1, pB0, pB1;
#pragma unroll
    for (int i = 0; i < 16; ++i) { o0[i] = 0.f; o1[i] = 0.f; negm[i] = 0.f; }
    float m = 0.f, l = 0.f;
    const LAS unsigned char* kp0 = lds;
    const LAS unsigned char* vp0 = lds + OFF_V + ((lane >> 4) & 1) * 32 + (lane & 3) * 8 + (4 * h + ((lane & 15) >> 2)) * 64;
#define QK_TILE(P0, P1, kb_) do { _Pragma("unroll") for (int ks = 0; ks < KS; ++ks) { \
        const bf16x8 a0_ = *(const LAS bf16x8*)((kb_) + koff[ks]), a1_ = *(const LAS bf16x8*)((kb_) + koff[ks] + (ks < 4 ? 4096 : 2048)); \
        if (ks == 0) { P0 = MFMA32(a0_, qr[0], negm); P1 = MFMA32(a1_, qr[0], negm); } else { P0 = MFMA32(a0_, qr[ks], P0); P1 = MFMA32(a1_, qr[ks], P1); } } } while (0)
    constexpr int NT = SEQ / 64, G = (DK == 96) ? 3 : 2;
#define ROWMAX(dst, P0, P1) do { float a_ = fmaxf(fmaxf(P0[0], P0[1]), P1[0]), b_ = fmaxf(fmaxf(P0[2], P0[3]), P1[1]); a_ = fmaxf(fmaxf(a_, P1[2]), P1[3]); \
        _Pragma("unroll") for (int i = 4; i < 16; i += 4) { a_ = fmaxf(fmaxf(a_, P0[i]), P0[i + 1]); b_ = fmaxf(fmaxf(b_, P0[i + 2]), P0[i + 3]); a_ = fmaxf(fmaxf(a_, P1[i]), P1[i + 1]); b_ = fmaxf(fmaxf(b_, P1[i + 2]), P1[i + 3]); } \
        const float m_ = fmaxf(a_, b_); const auto rr_ = __builtin_amdgcn_permlane32_swap(__float_as_uint(m_), __float_as_uint(m_), false, false); \
        dst = fmaxf(__uint_as_float(rr_[0]), __uint_as_float(rr_[1])); } while (0)
    if (DK == 96) ATT_WAITBAR(6); else ATT_WAITBAR(4);
    QK_TILE(pA0, pA1, kp0);
    float dl = 0.f; bool rebase = !MF;
    if constexpr (!MF) ROWMAX(dl, pA0, pA1);
#define STEP(t, P0, P1, Pn0, Pn1) do { \
        if ((t) + 3 <= NT) { if (DK == 96) ATT_WAITBAR(3); else ATT_WAITBAR(2); } else ATT_WAITBAR(0);       \
        if ((t) + 3 < NT) ISSUE_K((t) + 3); if ((t) + 2 < NT) ISSUE_V((t) + 2); \
          \
        if (!MF && rebase) { m += dl; const float al = ex2(-dl); l *= al; \
              _Pragma("unroll") for (int i = 0; i < 16; ++i) { P0[i] -= dl; P1[i] -= dl; negm[i] = -m; } \
              if (h == 0) wsf[r] = al; \
              _Pragma("unroll") for (int i = 0; i < 16; ++i) { const float f = wsf[crow(i, h)]; o0[i] *= f; o1[i] *= f; } } \
          \
        if ((t) + 1 < NT) QK_TILE(Pn0, Pn1, kp0 + (((t) + 1) % NS) * KSLOT); \
        _Pragma("unroll") for (int i = 0; i < 16; ++i) { P0[i] = ex2(P0[i]); l += P0[i]; P1[i] = ex2(P1[i]); l += P1[i]; } \
        const bf16x8 pa0_ = packp(P0, 0), pa1_ = packp(P0, 8), pa2_ = packp(P1, 0), pa3_ = packp(P1, 8); \
          \
        { const LAS unsigned char* vp_ = vp0 + ((t) % NS) * VSLOT; \
          _Pragma("unroll") for (int s_ = 0; s_ < 4; ++s_) { const bf16x8 pa_ = (s_ == 0) ? pa0_ : (s_ == 1) ? pa1_ : (s_ == 2) ? pa2_ : pa3_; \
            _Pragma("unroll") for (int db = 0; db < 2; ++db) { const s16x4 lo_ = vtr(vp_ + db * 4096 + s_ * 1024), hi_ = vtr(vp_ + db * 4096 + s_ * 1024 + 512); \
                const bf16x8 vf_ = {lo_[0], lo_[1], lo_[2], lo_[3], hi_[0], hi_[1], hi_[2], hi_[3]}; \
                if (db == 0) o0 = MFMA32(pa_, vf_, o0); else o1 = MFMA32(pa_, vf_, o1); } } } \
        if constexpr (!MF) { if ((t) + 1 < NT) { float tm_; ROWMAX(tm_, Pn0, Pn1); dl = fmaxf(tm_, 0.f); rebase = __any(tm_ > DEFER_THR); } } \
    } while (0)
    for (int t = 0; t < NT; t += 2) {
        STEP(t, pA0, pA1, pB0, pB1);
        STEP(t + 1, pB0, pB1, pA0, pA1);
    }
    if (nkA) {
        asm volatile("s_waitcnt lgkmcnt(0)\n\ts_barrier" ::: "memory");
        const bf16* nA_ = nkA + (size_t)(8 * w + (lane >> 3)) * kpA + ((lane & 7) ^ ((4 * w + (lane >> 4)) & 7)) * 8;
        const bf16* nB_ = (DK == 96) ? (nkB + (size_t)(16 * (w & 3) + (lane >> 2)) * 32 + ((lane & 3) ^ ((lane >> 4) & 3)) * 8) : nkA;
        const bf16* nV_ = nvS + (size_t)(16 * (w & 3) + (lane >> 2)) * vpitch + (w >> 2) * 32 + (lane & 3) * 8;
#define NISSUE_K(t) do { dma16(nA_ + (size_t)(t) * kstA, lds + (t) * KSLOT + w * 1024); if (DK == 96) dma16(nB_ + (size_t)(t) * kstB, lds + (t) * KSLOT + (8 + (w & 3)) * 1024); } while (0)
#define NISSUE_V(t) dma16(nV_ + (size_t)(t) * vst, lds + OFF_V + (t) * VSLOT + w * 1024)
        NISSUE_K(0); NISSUE_K(1); NISSUE_V(0); NISSUE_K(2); NISSUE_V(1);
#undef NISSUE_K
#undef NISSUE_V
    }
    finish_store(o0, o1, l, wsf, stg, r, h, lane, oS + (size_t)(q0 + w * 32) * op, (size_t)op);
    if (!nkA) ATT_WAITBAR(0);
#undef STEP
#undef ROWMAX
#undef QK_TILE
#undef ISSUE_K
#undef ISSUE_V
}

DI void dil_decode(int u, int& grp, int& b, int& head, int& res, int& c) {
    grp = u >> 10; const int idx = u & 1023; b = idx >> 6; head = (idx >> 3) & 7;
    res = grp == 0 ? 0 : (grp == 1 ? ((idx >> 1) & 3) : (idx & 7)); c = grp == 0 ? (idx & 7) : (grp == 1 ? (idx & 1) : 0);
}
DI void dil_issue(LAS unsigned char* lds, int u, const bf16* qkv) {
    constexpr int SLOT = 16384;
    int grp, b, head, res, c; dil_decode(u, grp, b, head, res, c);
    const int tid = fresh_tid(), lane = tid & 63; const int w = __builtin_amdgcn_readfirstlane(tid >> 6);
    const int dil = grp == 0 ? 1 : (grp == 1 ? 4 : 16), L = SEQ / dil, ntile = L / 64;
    const bf16* qb = qkv + (size_t)((((b * 3 + grp) * 3 + 0) * 8 + head) * SEQ) * 64;
    const bf16* kbp = qb + (size_t)8 * SEQ * 64; const bf16* vbp = qb + (size_t)16 * SEQ * 64;
#pragma unroll
    for (int s = 0; s < 6; ++s) {
        int sres, kb; bool valid;
        if (grp < 2) { sres = res; kb = 4 * c - 1 + s; valid = (kb >= 0) && (kb < ntile); }
        else { sres = 2 * res + (s >> 1); kb = s & 1; valid = s < 4; }
        if (valid) {
            const int krow = 64 * kb + 8 * w + (lane >> 3), vrow = 64 * kb + 16 * (w & 3) + (lane >> 2);
            dma16(kbp + (size_t)(sres * L + krow) * 64 + ((lane & 7) ^ ((4 * w + (lane >> 4)) & 7)) * 8, lds + s * SLOT + w * 1024);
            dma16(vbp + (size_t)(sres * L + vrow) * 64 + (w >> 2) * 32 + (lane & 3) * 8, lds + s * SLOT + 8192 + w * 1024);
        }
    }
}
DI void dil_qload(int u, const bf16* qkv, bf16x8 (&qr)[4]) {
    int grp, b, head, res, c; dil_decode(u, grp, b, head, res, c);
    const int tid = fresh_tid(), lane = tid & 63, r = lane & 31, h = lane >> 5; const int w = __builtin_amdgcn_readfirstlane(tid >> 6);
    const int dil = grp == 0 ? 1 : (grp == 1 ? 4 : 16), L = SEQ / dil;
    const bf16* qb = qkv + (size_t)((((b * 3 + grp) * 3 + 0) * 8 + head) * SEQ) * 64;
    int wres, qi0;
    if (grp < 2) { wres = res; qi0 = 256 * c + 32 * w; } else { wres = 2 * res + (w >> 2); qi0 = 32 * (w & 3); }
    const bf16* qrow = qb + (size_t)(wres * L + qi0 + r) * 64 + 8 * h;
#pragma unroll
    for (int ks = 0; ks < 4; ++ks) qr[ks] = *(const bf16x8*)(qrow + 16 * ks);
}
DI void dil_unit(LAS unsigned char* lds, int u, int unext, const bf16* qkv, bf16* og, float* lse, const bf16x8 (&qr)[4], bf16x8 (&qn)[4]) {
    constexpr int SLOT = 16384, OFF_WS = 6 * SLOT, OFF_STG = OFF_WS + NWAVES * 256;
    int grp, b, head, res, c; dil_decode(u, grp, b, head, res, c);
    const int tid = fresh_tid(), lane = tid & 63, r = lane & 31, h = lane >> 5; const int w = __builtin_amdgcn_readfirstlane(tid >> 6);
    LAS float* wsf = (LAS float*)(lds + OFF_WS) + w * 64;
    LAS unsigned short* stg = (LAS unsigned short*)(lds + OFF_STG) + w * 2048;
    const int dil = grp == 0 ? 1 : (grp == 1 ? 4 : 16), L = SEQ / dil, ntile = L / 64;
    const bf16* qb = qkv + (size_t)((((b * 3 + grp) * 3 + 0) * 8 + head) * SEQ) * 64;
    int wres, qi0, s0, kb0, nts;
    if (grp < 2) { wres = res; qi0 = 256 * c + 32 * w; s0 = w >> 1; kb0 = 4 * c + (w >> 1) - 1; nts = 3; }
    else { wres = 2 * res + (w >> 2); qi0 = 32 * (w & 3); s0 = 2 * (w >> 2); kb0 = 0; nts = 2; }
    int koff[4];
#pragma unroll
    for (int ks = 0; ks < 4; ++ks) koff[ks] = r * 128 + (((2 * ks + h) ^ ((r >> 1) & 7)) << 4);
    f32x16 o0, o1;
#pragma unroll
    for (int i = 0; i < 16; ++i) { o0[i] = 0.f; o1[i] = 0.f; }
    float m = NEGBIG, l = 0.f;
    ATT_WAITBAR(0);
    bool first = true;
    for (int j = 0; j < nts; ++j) {
        const int kb = kb0 + j;
        if (kb >= 0 && kb < ntile) {
            const LAS unsigned char* sp = lds + (s0 + j) * SLOT;
            const int rel = (grp < 2) ? j - 1 : j - ((w & 3) >> 1);
            if (rel == 0) tile_step<64, 0>(sp, sp + 8192, koff, qr, o0, o1, m, l, wsf, r, h, lane, qi0 + r, 64 * kb, first);
            else if (rel < 0) tile_step<64, 1>(sp, sp + 8192, koff, qr, o0, o1, m, l, wsf, r, h, lane, qi0 + r, 64 * kb, first);
            else tile_step<64, 2>(sp, sp + 8192, koff, qr, o0, o1, m, l, wsf, r, h, lane, qi0 + r, 64 * kb, first);
            first = false;
        }
    }
    asm volatile("s_waitcnt lgkmcnt(0)\n\ts_barrier" ::: "memory");
    if (unext >= 0) { dil_issue(lds, unext, qkv); dil_qload(unext, qkv, qn); }
    const size_t tok0 = (size_t)b * SEQ + wres + (size_t)dil * qi0;
    finish_store(o0, o1, l, wsf, stg, r, h, lane, og + tok0 * 512 + head * 64, (size_t)dil * 512);
    const float lt = l + __shfl_xor(l, 32);
    if (h == 0) lse[(tok0 + (size_t)dil * r) * 8 + head] = m + __builtin_amdgcn_logf(lt);
}
}

#define XB_TMO      128
#define XB_XCNT(j)  (256  + 64 * (j))
#define XB_XSUB(j)  (1280 + 64 * (j))
#define XB_XGEN(j)  (2304 + 64 * (j))
#define XB_TOP      3328
#define XB_TOPGEN   3392
#define XCD_BAR_WORDS 3456
#define XB_SPIN_CAP (1u << 18)
DI unsigned xb_ld(unsigned* p)              { return __hip_atomic_load(p, __ATOMIC_RELAXED, __HIP_MEMORY_SCOPE_AGENT); }
DI unsigned xb_add(unsigned* p, unsigned v) { return __hip_atomic_fetch_add(p, v, __ATOMIC_RELAXED, __HIP_MEMORY_SCOPE_AGENT); }
DI unsigned xb_xcc_id() { return (unsigned)__builtin_amdgcn_s_getreg((3 << 11) | 20) & 0xFu; }
#define XB_SPIN(cond, bar) do { unsigned _sp = 0; while (cond) { __builtin_amdgcn_s_sleep(1); \
    if ((++_sp & 255u) == 0u) { if (xb_ld(&(bar)[XB_TMO])) break; if (_sp > XB_SPIN_CAP) { atomicAdd(&(bar)[XB_TMO], 1u); break; } } } } while (0)
struct XcdBarrier { unsigned* bar; unsigned x; volatile LAS unsigned* st; };
DI XcdBarrier xcd_barrier_post(unsigned* bar, volatile LAS unsigned* st) {
    XcdBarrier b; b.bar = bar; b.x = xb_xcc_id(); b.st = st;
    if (threadIdx.x == 0) (void)xb_add(&bar[XB_XCNT(b.x)], 1u);
    return b;
}
DI void xcd_barrier_complete(unsigned* bar, unsigned x, unsigned& nloc, unsigned& nx) {
    const unsigned G = gridDim.x * gridDim.y * gridDim.z;
    unsigned sum, cnt, mine, sp = 0u;
    for (;;) {
        sum = 0u; cnt = 0u; mine = 0u;
#pragma unroll
        for (unsigned j = 0; j < 16; ++j) { const unsigned c = xb_ld(&bar[XB_XCNT(j)]); sum += c; cnt += (c > 0u) ? 1u : 0u; mine = (j == x) ? c : mine; }
        if (sum == G) break;
        __builtin_amdgcn_s_sleep(1);
        if ((++sp & 255u) == 0u) { if (xb_ld(&bar[XB_TMO])) break; if (sp > XB_SPIN_CAP) { atomicAdd(&bar[XB_TMO], 1u); break; } }
    }
    nloc = mine > 0u ? mine : 1u; nx = cnt > 0u ? cnt : 1u;
}
DI void xcd_barrier(const XcdBarrier& b) {
    asm volatile("s_waitcnt vmcnt(0)" ::: "memory");
    __syncthreads();
    if (threadIdx.x == 0) {
        unsigned* bar = b.bar;
        __builtin_amdgcn_s_waitcnt(0);
        unsigned nloc = b.st[0], nx = b.st[1];
        if (nloc == 0u) { xcd_barrier_complete(bar, b.x, nloc, nx); b.st[0] = nloc; b.st[1] = nx; }
        const unsigned old = xb_add(&bar[XB_XSUB(b.x)], 1u);
        const unsigned gen = old / nloc;
        if (old + 1u == (gen + 1u) * nloc) {
            __builtin_amdgcn_fence(__ATOMIC_RELEASE, "agent");
            asm volatile("s_waitcnt vmcnt(0)" ::: "memory");
            const unsigned og = xb_add(&bar[XB_TOP], 1u);
            const unsigned tg = og / nx;
            if (og + 1u == (tg + 1u) * nx) xb_add(&bar[XB_TOPGEN], 1u);
            else XB_SPIN(xb_ld(&bar[XB_TOPGEN]) == tg, bar);
            __builtin_amdgcn_fence(__ATOMIC_ACQUIRE, "agent");
            xb_add(&bar[XB_XGEN(b.x)], 1u);
            asm volatile("s_waitcnt vmcnt(0)" ::: "memory");
        } else {
            XB_SPIN(xb_ld(&bar[XB_XGEN(b.x)]) == gen, bar);
            __builtin_amdgcn_fence(__ATOMIC_ACQUIRE, "agent");
            asm volatile("s_waitcnt vmcnt(0)" ::: "memory");
        }
    }
    __syncthreads();
}

struct Ctx { int wave, G, bid; LAS unsigned char* lds; };

template <int F8>
DI void transpose_item(const float* W, int K, int N, void* WTv, int ldo, int row_off, int gu, LAS float* scr, int item, int lane, const float* gk = nullptr, const float wscale = 0.f) {
    const float sw8 = wscale != 0.f ? wscale : pg8::SW8, sw4 = wscale != 0.f ? wscale : 64.f;
    const int nblk = N / 32, kb = item / nblk, nb = item % nblk, k0 = 64 * kb, n0 = 32 * nb;
    float v[32];
    const float* src = W + (size_t)(k0 + (lane >> 5)) * N + n0 + (lane & 31);
#pragma unroll
    for (int i = 0; i < 32; ++i) v[i] = __builtin_nontemporal_load(src + (size_t)(2 * i) * N);
    if (gk) {
#pragma unroll
        for (int i = 0; i < 32; ++i) v[i] *= gk[k0 + 2 * i + (lane >> 5)];
    }
#pragma unroll
    for (int i = 0; i < 32; ++i) scr[(2 * i + (lane >> 5)) * 33 + (lane & 31)] = v[i];
    asm volatile("s_waitcnt lgkmcnt(0)" ::: "memory");
    const int c = lane & 7;
    const int orow0 = row_off + (gu == 0 ? n0 : ((n0 >> 7) * 256 + (gu - 1) * 128 + (n0 & 127)));
#pragma unroll
    for (int j = 0; j < 4; ++j) { const int n = (lane >> 3) + 8 * j; const LAS float* s = scr + (8 * c) * 33 + n;
        if (F8 == 2) { u32x2 o; o.x = pg8::pk4_i8(sw8 * s[0 * 33], sw8 * s[1 * 33], sw8 * s[2 * 33], sw8 * s[3 * 33]); o.y = pg8::pk4_i8(sw8 * s[4 * 33], sw8 * s[5 * 33], sw8 * s[6 * 33], sw8 * s[7 * 33]);
            *(u32x2*)((unsigned char*)WTv + (size_t)(orow0 + n) * ldo + k0 + 8 * c) = o; }
        else if (F8 == 1) { u32x2 o; o.x = pg8::pk4_fp8(sw4 * s[0 * 33], sw4 * s[1 * 33], sw4 * s[2 * 33], sw4 * s[3 * 33]); o.y = pg8::pk4_fp8(sw4 * s[4 * 33], sw4 * s[5 * 33], sw4 * s[6 * 33], sw4 * s[7 * 33]);
            *(u32x2*)((unsigned char*)WTv + (size_t)(orow0 + n) * ldo + k0 + 8 * c) = o; }
        else { u32x4 o; o.x = pk2(s[0 * 33], s[1 * 33]); o.y = pk2(s[2 * 33], s[3 * 33]); o.z = pk2(s[4 * 33], s[5 * 33]); o.w = pk2(s[6 * 33], s[7 * 33]);
            *(u32x4*)((bf16*)WTv + (size_t)(orow0 + n) * ldo + k0 + 8 * c) = o; } }
    asm volatile("s_waitcnt lgkmcnt(0)" ::: "memory");
}

DI void sincos_d(double a, float& c, float& s) {
    const double TWO_PI = 6.283185307179586476925286766559, INV = 0.15915494309189533576888376337251;
    const double n = __builtin_rint(a * INV); double x = (a - n * TWO_PI) * 0.25; const double x2 = x * x;
    double sn = x * (1.0 + x2 * (-1.0 / 6 + x2 * (1.0 / 120 + x2 * (-1.0 / 5040 + x2 * (1.0 / 362880 + x2 * (-1.0 / 39916800 + x2 * (1.0 / 6227020800.0)))))));
    double cs = 1.0 + x2 * (-0.5 + x2 * (1.0 / 24 + x2 * (-1.0 / 720 + x2 * (1.0 / 40320 + x2 * (-1.0 / 3628800 + x2 * (1.0 / 479001600.0))))));
#pragma unroll
    for (int i = 0; i < 2; ++i) { const double s2 = 2.0 * sn * cs, c2 = cs * cs - sn * sn; sn = s2; cs = c2; }
    c = (float)cs; s = (float)sn;
}

constexpr float SA1 = 32.0f, SW1 = 1000.0f;
DI void rows_first(const Ctx& C, const float* x, bf16* hb, float* rstd, unsigned char* x8) {
    const int gw = C.bid * NWAVES + C.wave, NGW = C.G * NWAVES, lane = fresh_tid() & 63;
    for (int m = gw; m < NTOK; m += 2 * NGW) {
        const f32x4* xr0 = (const f32x4*)(x + (size_t)m * DM) + lane; const f32x4* xr1 = (const f32x4*)(x + (size_t)(m + NGW) * DM) + lane;
        f32x4 v[4], w[4]; float s0 = 0.f, s1 = 0.f;
#pragma unroll
        for (int j = 0; j < 4; ++j) { v[j] = __builtin_nontemporal_load(xr0 + 64 * j); w[j] = __builtin_nontemporal_load(xr1 + 64 * j); }
#pragma unroll
        for (int j = 0; j < 4; ++j) { s0 += (v[j].x * v[j].x + v[j].y * v[j].y) + (v[j].z * v[j].z + v[j].w * v[j].w); s1 += (w[j].x * w[j].x + w[j].y * w[j].y) + (w[j].z * w[j].z + w[j].w * w[j].w); }
        const float r0 = rsq(wave_sum(s0) * (1.f / DM) + EPS), r1 = rsq(wave_sum(s1) * (1.f / DM) + EPS);
        u32x2* o0 = (u32x2*)(hb + (size_t)m * DM) + lane; u32x2* o1 = (u32x2*)(hb + (size_t)(m + NGW) * DM) + lane;
#pragma unroll
        for (int j = 0; j < 4; ++j) { u32x2 a, b; a.x = pk2(v[j].x, v[j].y); a.y = pk2(v[j].z, v[j].w); b.x = pk2(w[j].x, w[j].y); b.y = pk2(w[j].z, w[j].w); o0[64 * j] = a; o1[64 * j] = b; }
        { unsigned* q0 = (unsigned*)(x8 + (size_t)m * DM) + lane; unsigned* q1 = (unsigned*)(x8 + (size_t)(m + NGW) * DM) + lane; const float a0 = r0 * SA1, a1 = r1 * SA1;
#pragma unroll
          for (int j = 0; j < 4; ++j) { q0[64 * j] = pg8::pk4_i8(v[j].x * a0, v[j].y * a0, v[j].z * a0, v[j].w * a0); q1[64 * j] = pg8::pk4_i8(w[j].x * a1, w[j].y * a1, w[j].z * a1, w[j].w * a1); } }
        if (lane == 0) { rstd[m] = r0; rstd[m + NGW] = r1; }
    }
}

struct RowRaw { u32x2 t1[4], t2[4], hb[4]; f32x4 h32[4]; f32x2 gg; };
template <bool MOE, bool HIN32>
DI void row_load(RowRaw& R, int m, int lane_, const float* hin32, const bf16* hb, const bf16* term, const int* toks, const f32x2* tokg) {
    if (MOE) {
        const int s1 = toks[2 * m], s2 = toks[2 * m + 1]; R.gg = tokg[m];
        const u32x2* y1 = (const u32x2*)(term + (size_t)s1 * DM) + lane_; const u32x2* y2 = (const u32x2*)(term + (size_t)s2 * DM) + lane_;
#pragma unroll
        for (int j = 0; j < 4; ++j) { R.t1[j] = __builtin_nontemporal_load(y1 + 64 * j); R.t2[j] = __builtin_nontemporal_load(y2 + 64 * j); }
    } else {
        const u32x2* tr = (const u32x2*)(term + (size_t)m * DM) + lane_;
#pragma unroll
        for (int j = 0; j < 4; ++j) R.t1[j] = __builtin_nontemporal_load(tr + 64 * j);
    }
    if (HIN32) { const f32x4* hr = (const f32x4*)(hin32 + (size_t)m * DM) + lane_;
#pragma unroll
        for (int j = 0; j < 4; ++j) R.h32[j] = hr[64 * j];
    } else { const u32x2* hr = (const u32x2*)(hb + (size_t)m * DM) + lane_;
#pragma unroll
        for (int j = 0; j < 4; ++j) R.hb[j] = hr[64 * j];
    }
}
template <bool MOE, bool NEXT, bool ROUTE, bool HIN32, bool FINAL, int X8 = 0>
DI void rows_residual(const Ctx& C, const float* hin32, bf16* hb, float* out32, const bf16* term, const float* gpost, const float* gnext, float* rstd,
                      const int* toks, const f32x2* tokg, const float* wrouter, int* toke, f32x2* tokg_out, int* cnt_out, unsigned char* xn8 = nullptr) {
    const int gw = C.bid * NWAVES + C.wave, NGW = C.G * NWAVES, tid_ = fresh_tid(), lane_ = tid_ & 63;
    f32x4 gp[4], gn[4];
#pragma unroll
    for (int j = 0; j < 4; ++j) { gp[j] = *((const f32x4*)gpost + lane_ + 64 * j); gn[j] = ROUTE ? *((const f32x4*)gnext + lane_ + 64 * j) : (f32x4){0.f, 0.f, 0.f, 0.f}; }
    LAS int* lcnt = (LAS int*)C.lds;
    if (ROUTE) { if (tid_ < 8) lcnt[tid_] = 0; __syncthreads(); }
    const int rows_per_wave = NTOK / NGW;
    const int nrows = ROUTE ? rows_per_wave : (NTOK - gw + NGW - 1) / NGW;
#define ROW_OF(it_) (ROUTE ? (gw * rows_per_wave + (it_)) : (gw + (it_) * NGW))
    RowRaw cur, nxt;
    if (nrows > 0) row_load<MOE, HIN32>(cur, ROW_OF(0), lane_, hin32, hb, term, toks, tokg);
    for (int it = 0; it < nrows; ++it) {
        const int m = ROW_OF(it);
        if (it + 1 < nrows) row_load<MOE, HIN32>(nxt, ROW_OF(it + 1), lane_, hin32, hb, term, toks, tokg);
        f32x4 t[4], hv[4];
#pragma unroll
        for (int j = 0; j < 4; ++j) { const u32x2 a = cur.t1[j];
            if (MOE) { const u32x2 b = cur.t2[j]; const f32x2 gg = cur.gg;
                t[j].x = gg.x * __uint_as_float(a.x << 16) + gg.y * __uint_as_float(b.x << 16); t[j].y = gg.x * __uint_as_float(a.x & 0xffff0000u) + gg.y * __uint_as_float(b.x & 0xffff0000u);
                t[j].z = gg.x * __uint_as_float(a.y << 16) + gg.y * __uint_as_float(b.y << 16); t[j].w = gg.x * __uint_as_float(a.y & 0xffff0000u) + gg.y * __uint_as_float(b.y & 0xffff0000u); }
            else { t[j].x = __uint_as_float(a.x << 16); t[j].y = __uint_as_float(a.x & 0xffff0000u); t[j].z = __uint_as_float(a.y << 16); t[j].w = __uint_as_float(a.y & 0xffff0000u); }
            if (HIN32) hv[j] = cur.h32[j];
            else { const u32x2 c = cur.hb[j]; hv[j].x = __uint_as_float(c.x << 16); hv[j].y = __uint_as_float(c.x & 0xffff0000u); hv[j].z = __uint_as_float(c.y << 16); hv[j].w = __uint_as_float(c.y & 0xffff0000u); } }
        float s = 0.f;
#pragma unroll
        for (int j = 0; j < 4; ++j) s += (t[j].x * t[j].x + t[j].y * t[j].y) + (t[j].z * t[j].z + t[j].w * t[j].w);
        const float ri = rsq(wave_sum(s) * (1.f / DM) + EPS);
        float s2 = 0.f;
#pragma unroll
        for (int j = 0; j < 4; ++j) { hv[j] = hv[j] + t[j] * ri * gp[j]; s2 += (hv[j].x * hv[j].x + hv[j].y * hv[j].y) + (hv[j].z * hv[j].z + hv[j].w * hv[j].w); }
        if (FINAL) { f32x4* ho = (f32x4*)(out32 + (size_t)m * DM) + lane_;
#pragma unroll
            for (int j = 0; j < 4; ++j) ho[64 * j] = hv[j];
        } else { u32x2* o8 = (u32x2*)(hb + (size_t)m * DM) + lane_;
#pragma unroll
            for (int j = 0; j < 4; ++j) { u32x2 o; o.x = pk2(hv[j].x, hv[j].y); o.y = pk2(hv[j].z, hv[j].w); o8[64 * j] = o; }
        }
        if (NEXT) {
            const float r2 = rsq(wave_sum(s2) * (1.f / DM) + EPS);
            if (lane_ == 0) rstd[m] = r2;
            if (X8) { unsigned* o4 = (unsigned*)(xn8 + (size_t)m * DM) + lane_;
#pragma unroll
                for (int j = 0; j < 4; ++j) { const float q_ = (X8 == 2) ? r2 * pg8::SA8 : r2; o4[64 * j] = (X8 == 2) ? pg8::pk4_i8(hv[j].x * q_, hv[j].y * q_, hv[j].z * q_, hv[j].w * q_) : pg8::pk4_fp8(hv[j].x * q_, hv[j].y * q_, hv[j].z * q_, hv[j].w * q_); } }
            if (ROUTE) {
#pragma unroll
                for (int j = 0; j < 4; ++j) hv[j] = hv[j] * r2 * gn[j];
                float lg[8];
#pragma unroll
                for (int e = 0; e < 8; ++e) lg[e] = 0.f;
#pragma unroll
                for (int j = 0; j < 4; ++j)
#pragma unroll
                    for (int q = 0; q < 4; ++q) { const f32x4* wp = (const f32x4*)(wrouter + (size_t)(4 * lane_ + 256 * j + q) * 8); const f32x4 w0 = wp[0], w1 = wp[1]; const float a = hv[j][q];
                        lg[0] += a * w0.x; lg[1] += a * w0.y; lg[2] += a * w0.z; lg[3] += a * w0.w; lg[4] += a * w1.x; lg[5] += a * w1.y; lg[6] += a * w1.z; lg[7] += a * w1.w; }
#pragma unroll
                for (int e = 0; e < 8; ++e) lg[e] = wave_sum(lg[e]);
                int e1 = 0; float l1 = lg[0];
#pragma unroll
                for (int e = 1; e < 8; ++e) if (lg[e] > l1) { l1 = lg[e]; e1 = e; }
                int e2 = -1; float l2 = -3.0e38f;
#pragma unroll
                for (int e = 0; e < 8; ++e) if (e != e1 && lg[e] > l2) { l2 = lg[e]; e2 = e; }
                if (lane_ == 0) { const float p2 = 1.0f / (1.0f + ex2((l1 - l2) * LOG2E)); toke[m] = e1 | (e2 << 8); tokg_out[m] = (f32x2){1.0f - p2, p2};
                    atomicAdd((int*)lcnt + e1, 1); atomicAdd((int*)lcnt + e2, 1); }
            }
        }
        cur = nxt;
    }
#undef ROW_OF
    if (ROUTE) { __syncthreads(); if (tid_ < 8) cnt_out[C.bid * 8 + tid_] = lcnt[tid_]; }
}

DI void rows_l0_post(const Ctx& C, const bf16* zin, const float* gq, const float* gk, const float* gcq, const float* gckv, const f32x2* taba,
                     bf16* qa, bf16* ka, bf16* cqn, bf16* ckvn, bf16* kr, float* krn) {
    const int gw = C.bid * NWAVES + C.wave, NGW = C.G * NWAVES, lane = fresh_tid() & 63;
    const int s8 = lane & 7;
    float gqv[8], gkv[8], gcqv[8], gckvv[8];
#pragma unroll
    for (int j = 0; j < 8; ++j) { gqv[j] = gq[8 * s8 + j]; gkv[j] = gk[8 * s8 + j]; gcqv[j] = gcq[8 * (lane & 31) + j]; gckvv[j] = gckv[8 * (lane & 15) + j]; }
    const int part = s8 >> 2, isx2 = (s8 >> 1) & 1, fb = 8 * (s8 & 1);
    u32x4 c0 = (u32x4){0u, 0u, 0u, 0u}, c1 = c0, c2 = c0;
    if (gw < NTOK) { const bf16* z0 = zin + (size_t)gw * ZW; c0 = __builtin_nontemporal_load((const u32x4*)(z0 + 8 * lane)); c1 = __builtin_nontemporal_load((const u32x4*)(z0 + 512 + 8 * lane));
        if (lane < 32) c2 = __builtin_nontemporal_load((const u32x4*)(z0 + 1024 + 8 * lane)); }
    for (int tok = gw; tok < NTOK; tok += NGW) {
        const int t = tok & (SEQ - 1), prow = t >> 6, pcol = t & 63;
        u32x4 n0 = (u32x4){0u, 0u, 0u, 0u}, n1 = n0, n2 = n0;
        if (tok + NGW < NTOK) { const bf16* zn = zin + (size_t)(tok + NGW) * ZW; n0 = __builtin_nontemporal_load((const u32x4*)(zn + 8 * lane)); n1 = __builtin_nontemporal_load((const u32x4*)(zn + 512 + 8 * lane));
            if (lane < 32) n2 = __builtin_nontemporal_load((const u32x4*)(zn + 1024 + 8 * lane)); }
        float x[8], y[8], p[8];
        unpack8(c0, x);
        float ss = 0.f;
#pragma unroll
        for (int j = 0; j < 8; ++j) ss += x[j] * x[j];
        ss += __shfl_xor(ss, 1); ss += __shfl_xor(ss, 2); ss += __shfl_xor(ss, 4);
        float ri = rsq(ss * (1.f / 64) + EPS);
#pragma unroll
        for (int j = 0; j < 8; ++j) y[j] = x[j] * ri * gqv[j];
#pragma unroll
        for (int j = 0; j < 8; ++j) p[j] = __shfl_xor(y[j], 2);
        const f32x2* tp = taba + (size_t)(part ? pcol : prow) * 16 + fb;
#pragma unroll
        for (int j = 0; j < 8; ++j) { const f32x2 cs = tp[j]; y[j] = (isx2 ? (y[j] * cs.x + p[j] * cs.y) : (y[j] * cs.x - p[j] * cs.y)) * C2_64; }
        *(u32x4*)(qa + (size_t)tok * 512 + 8 * lane) = pack8(y);
        unpack8(c1, x);
        ss = 0.f;
#pragma unroll
        for (int j = 0; j < 8; ++j) ss += x[j] * x[j];
        float s3 = ss; s3 += __shfl_xor(s3, 1); s3 += __shfl_xor(s3, 2); s3 += __shfl_xor(s3, 4);
        float s5 = s3; s5 += __shfl_xor(s5, 8); s5 += __shfl_xor(s5, 16);
        if (lane < 16) {
            ri = rsq(s3 * (1.f / 64) + EPS);
#pragma unroll
            for (int j = 0; j < 8; ++j) y[j] = x[j] * ri * gkv[j];
        } else {
            ri = rsq(s5 * (1.f / 256) + EPS);
#pragma unroll
            for (int j = 0; j < 8; ++j) y[j] = x[j] * ri * gcqv[j];
        }
#pragma unroll
        for (int j = 0; j < 8; ++j) p[j] = __shfl_xor(y[j], 2);
        if (lane < 16) {
#pragma unroll
            for (int j = 0; j < 8; ++j) { const f32x2 cs = tp[j]; y[j] = isx2 ? (y[j] * cs.x + p[j] * cs.y) : (y[j] * cs.x - p[j] * cs.y); }
            *(u32x4*)(ka + (size_t)tok * 128 + 8 * lane) = pack8(y);
        } else if (lane >= 32) {
            *(u32x4*)(cqn + (size_t)tok * 256 + 8 * (lane - 32)) = pack8(y);
        }
        unpack8(c2, x);
        ss = 0.f;
#pragma unroll
        for (int j = 0; j < 8; ++j) ss += x[j] * x[j];
        ss += __shfl_xor(ss, 1); ss += __shfl_xor(ss, 2); ss += __shfl_xor(ss, 4); ss += __shfl_xor(ss, 8);
        if (lane == 16) krn[tok] = ss;
#pragma unroll
        for (int j = 0; j < 8; ++j) p[j] = __shfl_xor(x[j], 2);
        if (lane < 16) {
            ri = rsq(ss * (1.f / 128) + EPS);
#pragma unroll
            for (int j = 0; j < 8; ++j) y[j] = x[j] * ri * gckvv[j];
            *(u32x4*)(ckvn + (size_t)tok * 256 + 8 * lane) = pack8(y);
        } else if (lane < 32) {
            *(u32x4*)(ckvn + (size_t)tok * 256 + 8 * lane) = (u32x4){0u, 0u, 0u, 0u};
            if (lane < 20) {
                const int sl = lane - 16; const f32x2* tq = taba + (size_t)t * 16 + 8 * (sl & 1);
#pragma unroll
                for (int j = 0; j < 8; ++j) { const f32x2 cs = tq[j]; y[j] = (sl >> 1) ? (x[j] * cs.x + p[j] * cs.y) : (x[j] * cs.x - p[j] * cs.y); }
                *(u32x4*)(kr + (size_t)tok * 32 + 8 * sl) = pack8(y);
            }
        }
        c0 = n0; c1 = n1; c2 = n2;
    }
}

constexpr float SWO1 = 700.0f;
DI void rows_merge(const Ctx& C, const bf16* og, const float* lse, unsigned char* o1, float* rowsc) {
    const int gw = C.bid * NWAVES + C.wave, NGW = C.G * NWAVES, lane = fresh_tid() & 63, head = lane >> 3;
    u32x4 ra = (u32x4){0u, 0u, 0u, 0u}, rb = ra, rc = ra; float l0 = 0.f, l1 = 0.f, l2 = 0.f;
#define MERGE_LOAD(A, B, Cc, L0, L1, L2, tk) do { A = __builtin_nontemporal_load((const u32x4*)(og + (size_t)(tk) * 512 + 8 * lane)); B = __builtin_nontemporal_load((const u32x4*)(og + (size_t)(NTOK + (tk)) * 512 + 8 * lane)); \
        Cc = __builtin_nontemporal_load((const u32x4*)(og + (size_t)(2 * NTOK + (tk)) * 512 + 8 * lane)); L0 = lse[(size_t)(tk) * 8 + head]; L1 = lse[(size_t)(NTOK + (tk)) * 8 + head]; L2 = lse[(size_t)(2 * NTOK + (tk)) * 8 + head]; } while (0)
    if (gw < NTOK) MERGE_LOAD(ra, rb, rc, l0, l1, l2, gw);
    for (int tok = gw; tok < NTOK; tok += NGW) {
        u32x4 na = ra, nb = rb, nc = rc; float m0 = 0.f, m1 = 0.f, m2 = 0.f;
        if (tok + NGW < NTOK) MERGE_LOAD(na, nb, nc, m0, m1, m2, tok + NGW);
        const float mx = fmaxf(l0, fmaxf(l1, l2));
        float w0 = ex2(l0 - mx), w1 = ex2(l1 - mx), w2 = ex2(l2 - mx); const float inv = 1.0f / (w0 + w1 + w2); w0 *= inv; w1 *= inv; w2 *= inv;
        float a[8], b[8], c[8], o[8];
        unpack8(ra, a); unpack8(rb, b); unpack8(rc, c);
#pragma unroll
        for (int j = 0; j < 8; ++j) o[j] = w0 * a[j] + w1 * b[j] + w2 * c[j];
        float am = 0.f;
#pragma unroll
        for (int j = 0; j < 8; ++j) am = fmaxf(am, fabsf(o[j]));
#pragma unroll
        for (int x = 1; x < 64; x <<= 1) am = fmaxf(am, __shfl_xor(am, x));
        am = fmaxf(am, 1.0e-30f); const float qs = 127.0f / am;
        u32x2 q; q.x = pg8::pk4_i8(o[0] * qs, o[1] * qs, o[2] * qs, o[3] * qs); q.y = pg8::pk4_i8(o[4] * qs, o[5] * qs, o[6] * qs, o[7] * qs);
        *(u32x2*)(o1 + (size_t)tok * 512 + 8 * lane) = q;
        if (lane == 0) rowsc[tok] = am * (1.0f / (127.0f * SWO1));
        ra = na; rb = nb; rc = nc; l0 = m0; l1 = m1; l2 = m2;
    }
#undef MERGE_LOAD
}

DI void moe_assign_gather(const Ctx& C, const int* cnt, const int* toke, int* toks, int* tilee, const bf16* xn, const float* rstd, unsigned char* xs) {
    LAS int* L = (LAS int*)C.lds;
    const int lane = fresh_tid() & 63, w = C.bid;
    if (C.wave == 0) {
        int base[8]; int tot[8];
#pragma unroll
        for (int e = 0; e < 8; ++e) { int below = 0, all = 0;
            for (int i = lane; i < C.G; i += 64) { const int c = cnt[i * 8 + e]; all += c; if (i < w) below += c; }
#pragma unroll
            for (int o = 1; o < 64; o <<= 1) { below += __shfl_xor(below, o); all += __shfl_xor(all, o); }
            base[e] = below; tot[e] = all; }
        int start = 0;
#pragma unroll
        for (int e = 0; e < 8; ++e) { const int padded = (tot[e] + 255) & ~255; base[e] += start;
            if (w == 0) { for (int tix = (start >> 8) + lane; tix < ((start + padded) >> 8); tix += 64) tilee[8 + tix] = e; }
            start += padded;
            if (w == 0 && lane == 0 && e < 7) tilee[1 + e] = start >> 8; }
        if (w == 0 && lane == 0) tilee[0] = start >> 8;
#pragma unroll
        for (int k = 0; k < 4; ++k) {
            const int pidx = 64 * k + lane, tok = 128 * w + (pidx >> 1), kk = pidx & 1;
            const int e = (toke[tok] >> (8 * kk)) & 0xff; int slot = 0;
#pragma unroll
            for (int ee = 0; ee < 8; ++ee) { const unsigned long long mk = __ballot(e == ee); const int rank = __popcll(mk & ((1ull << lane) - 1ull));
                if (e == ee) slot = base[ee] + rank; base[ee] += __popcll(mk); }
            toks[2 * tok + kk] = slot; L[16 + pidx] = slot;
        }
    }
    __syncthreads();
    for (int i0 = 0; i0 < 32; i0 += 4) {
        u32x4 ra[4], rb[4]; float rs[4]; int sl[4];
#pragma unroll
        for (int q = 0; q < 4; ++q) { const int pidx = 32 * C.wave + i0 + q, tok = 128 * w + (pidx >> 1); sl[q] = L[16 + pidx];
            const u32x4* src = (const u32x4*)(xn + (size_t)tok * DM) + 2 * lane; ra[q] = src[0]; rb[q] = src[1]; rs[q] = rstd[tok]; }
#pragma unroll
        for (int q = 0; q < 4; ++q) { float x[8], y[8]; unpack8(ra[q], x); unpack8(rb[q], y);
#pragma unroll
            for (int j = 0; j < 8; ++j) { x[j] *= rs[q]; y[j] *= rs[q]; }
            u32x4 o; o.x = pg8::pk4_fp8(x[0], x[1], x[2], x[3]); o.y = pg8::pk4_fp8(x[4], x[5], x[6], x[7]); o.z = pg8::pk4_fp8(y[0], y[1], y[2], y[3]); o.w = pg8::pk4_fp8(y[4], y[5], y[6], y[7]);
            *((u32x4*)(xs + (size_t)sl[q] * DM) + lane) = o; }
    }
    __syncthreads();
}

struct Args { const float* in[27]; float* out; unsigned char* ws; };
enum { I_X = 0, I_P, I_MIXPRE, I_MIXPOST, I_FFNPRE, I_FFNPOST, I_PLEPROJ, I_PLEGN, I_PLEGATE, I_PLEPOST, I_WIN, I_GQ, I_GK, I_GCQ, I_WUQ, I_GCKV, I_WUKV, I_WOUT0,
       I_WG0, I_WU0, I_WD0, I_WQKV1, I_WOUT1, I_WR, I_MWG, I_MWU, I_MWD };

DI const float* arg_in(int i) { const __attribute__((address_space(4))) char* kp = (const __attribute__((address_space(4))) char*)__builtin_amdgcn_kernarg_segment_ptr(); asm volatile("" : "+s"(kp));
    return *(const float* const __attribute__((address_space(4)))*)(kp + 8 * i); }
__global__ void __launch_bounds__(NTHREADS, 2) fwd_kernel(Args a) {
    extern __shared__ __attribute__((aligned(16))) unsigned char lds_raw[];
    LAS unsigned char* lds = (LAS unsigned char*)lds_raw;
    volatile LAS unsigned* MISC = (volatile LAS unsigned*)(lds + MISC_OFF);
    Ctx C; C.wave = __builtin_amdgcn_readfirstlane((int)threadIdx.x >> 6); C.G = gridDim.x; C.bid = blockIdx.x; C.lds = lds;
    unsigned char* ws = a.ws;
#define AIN(i) arg_in(i)
    unsigned* ctl = (unsigned*)(ws + WS_CTL);
    for (int u = threadIdx.x; u < (LDS_BYTES - LDSCTL_OFF) / 4; u += NTHREADS) ((LAS unsigned*)(lds + LDSCTL_OFF))[u] = 0u;
    __syncthreads();
    XcdBarrier bar = xcd_barrier_post(ctl + CW_BAR, MISC + 8);
#define GRID_BAR() xcd_barrier(bar)
    const int gw = C.bid * NWAVES + C.wave, NGW = C.G * NWAVES, NGT = C.G * NTHREADS;
    const f32x2* taba = (const f32x2*)(ws + WS_TABA); const f32x2* tabp = (const f32x2*)(ws + WS_TABP);
    bf16* XN = (bf16*)(ws + WS_XN);
    float* hres = a.out;

    {
        LAS float* scr = (LAS float*)(lds + C.wave * 16384);
        const int tid = fresh_tid(), lane = tid & 63, gtid = C.bid * NTHREADS + tid;
#define TR(Wp, Kd, Nd, dst, ldo, roff, gu, gk) { constexpr int NI_ = ((Kd) / 64) * ((Nd) / 32); if (r < NI_) { transpose_item<0>((Wp), (Kd), (Nd), (bf16*)(dst), (ldo), (roff), (gu), scr, r, lane, (gk)); continue; } r -= NI_; }
        constexpr int NSMALL = 16 * 37 + 4 * 24 + 2 * 32 + 16 * 32 + 3 * 1792 + 2 * 128 + 2 * 512 + 16 * 144 + 8 * 32;
        for (int it = gw; it < NSMALL; it += NGW) {
            int r = it;
            { constexpr int NI_ = (1024 / 64) * (1184 / 32); if (r < NI_) { transpose_item<2>(AIN(I_WIN), 1024, 1184, ws + W_IN, 1024, 0, 0, scr, r, lane, AIN(I_MIXPRE), SW1); continue; } r -= NI_; }
            TR(AIN(I_WUQ), 256, 768, ws + W_UQ, 256, 0, 0, nullptr)
            TR(AIN(I_WUKV), 128, 1024, ws + W_UKV, 256, 0, 0, nullptr)
            TR(AIN(I_WOUT0), 1024, 1024, ws + W_OUT0, 1024, 0, 0, nullptr)
            { constexpr int NI_ = (1024 / 64) * (3584 / 32); if (r < NI_) { transpose_item<2>(AIN(I_WG0), 1024, 3584, ws + W_GU0, 1024, 0, 1, scr, r, lane, AIN(I_FFNPRE)); continue; } r -= NI_; }
            { constexpr int NI_ = (1024 / 64) * (3584 / 32); if (r < NI_) { transpose_item<2>(AIN(I_WU0), 1024, 3584, ws + W_GU0, 1024, 0, 2, scr, r, lane, AIN(I_FFNPRE)); continue; } r -= NI_; }
            { constexpr int NI_ = (3584 / 64) * (1024 / 32); if (r < NI_) { transpose_item<1>(AIN(I_WD0), 3584, 1024, ws + W_D0, 3584, 0, 0, scr, r, lane); continue; } r -= NI_; }
            TR(AIN(I_PLEPROJ), 256, 1024, ws + W_PP, 256, 0, 0, nullptr)
            TR(AIN(I_PLEPROJ) + 256 * 1024, 256, 1024, ws + W_PP + 1024 * 256 * 2, 256, 0, 0, nullptr)
            { constexpr int NI_ = (1024 / 64) * (1024 / 32); if (r < NI_) { transpose_item<2>(AIN(I_PLEGATE), 1024, 1024, ws + W_PG, 1024, 0, 0, scr, r, lane, AIN(I_PLEGN)); continue; } r -= NI_; }
            { constexpr int NI_ = (1024 / 64) * (1024 / 32); if (r < NI_) { transpose_item<1>(AIN(I_PLEGATE) + 1024 * 1024, 1024, 1024, ws + W_PG + 1024 * 1024 * 2, 1024, 0, 0, scr, r, lane, AIN(I_PLEGN) + DM); continue; } r -= NI_; }
            { constexpr int NI_ = (1024 / 64) * (4608 / 32); if (r < NI_) { transpose_item<2>(AIN(I_WQKV1), 1024, 4608, ws + W_QKV1, 1024, 0, 0, scr, r, lane, AIN(I_MIXPRE) + DM); continue; } r -= NI_; }
            { constexpr int NI_ = (512 / 64) * (1024 / 32); if (r < NI_) { transpose_item<2>(AIN(I_WOUT1), 512, 1024, ws + W_OUT1, 512, 0, 0, scr, r, lane, nullptr, SWO1); continue; } r -= NI_; }
        }
        for (int i = gtid; i < 6144; i += NGT) ((u32x4*)(ws + W_IN + (size_t)1184 * 1024))[i] = (u32x4){0u, 0u, 0u, 0u};
        for (int i = gtid; i < 16384; i += NGT) ((u32x4*)(ws + W_UKV))[(size_t)(i >> 4) * 32 + 16 + (i & 15)] = (u32x4){0u, 0u, 0u, 0u};
        for (int i = gtid; i < 2048 * 16; i += NGT) { const int t = i >> 4, f = i & 15; double iv = 1.0; for (int k = 0; k < f; ++k) iv *= 0.56234132519034907; const float ang = (float)t * (float)iv;
            float c, s; sincos_d((double)ang, c, s); ((f32x2*)(ws + WS_TABA))[i] = (f32x2){c, s}; }
        for (int i = gtid; i < 2048 * 8; i += NGT) { const int t = i >> 3, f = i & 7; double iv = 1.0; for (int k = 0; k < f; ++k) iv *= 0.19392274474868576; const float ang = (float)t * (float)iv;
            float c, s; sincos_d((double)ang, c, s); ((f32x2*)(ws + WS_TABP))[i] = (f32x2){c, s}; }
        { const f32x4* psrc = (const f32x4*)AIN(I_P); u32x4* pdst = (u32x4*)(ws + WS_PB);
          for (int i = gtid; i < 2 * NTOK * 256 / 8; i += 4 * NGT) {
              f32x4 u0[4], u1[4];
#pragma unroll
              for (int q = 0; q < 4; ++q) { u0[q] = __builtin_nontemporal_load(psrc + 2 * (i + q * NGT)); u1[q] = __builtin_nontemporal_load(psrc + 2 * (i + q * NGT) + 1); }
#pragma unroll
              for (int q = 0; q < 4; ++q) { u32x4 o; o.x = pk2(u0[q].x, u0[q].y); o.y = pk2(u0[q].z, u0[q].w); o.z = pk2(u1[q].x, u1[q].y); o.w = pk2(u1[q].z, u1[q].w); pdst[i + q * NGT] = o; } } }
        rows_first(C, AIN(I_X), XN, (float*)(ws + WS_RSTD), ws + B_XN8);
    }
    GRID_BAR();

    { pg8::Gemm g{(const bf16*)(ws + B_XN8), (const bf16*)(ws + W_IN), 512, 512, 512}; pg8::StaticOrder S; S.init(NTOK / 256, ZW / 256, C.G, C.bid);
      pg8::EpiStore E{(bf16*)(ws + B_ZIN), ZW, 1.0f, nullptr}; pg8::gemm_phase<pg8::EpiStore, pg8::StaticOrder, false, true>(lds, g, S, E, 0, 0, 1.0f / (SA1 * SW1), 1.0f / (SA1 * SW1)); }
    GRID_BAR();
    rows_l0_post(C, (const bf16*)(ws + B_ZIN), AIN(I_GQ), AIN(I_GK), AIN(I_GCQ), AIN(I_GCKV), taba,
                 (bf16*)(ws + B_QA), (bf16*)(ws + B_KA), (bf16*)(ws + B_CQN), (bf16*)(ws + B_CKVN), (bf16*)(ws + B_KR), (float*)(ws + WS_LSE));
    GRID_BAR();
    { pg8::Gemm g{(const bf16*)(ws + B_CQN), (const bf16*)(ws + W_UQ), 256, 256, 256}; pg8::StaticOrder S; S.init(NTOK / 256, 3, C.G, C.bid);
      pg8::EpiStore E{(bf16*)(ws + B_QM), 768, C2_96, nullptr}; pg8::gemm_phase(lds, g, S, E); }
    { pg8::Gemm g{(const bf16*)(ws + B_CKVN), (const bf16*)(ws + W_UKV), 256, 256, 256}; pg8::StaticOrder S; S.init(NTOK / 256, 4, C.G, C.bid);
      pg8::EpiStoreKV E{(bf16*)(ws + B_KV), 1024, ctl + CW_KP}; pg8::gemm_phase(lds, g, S, E); }
    GRID_BAR();
    bool gqa_mf;
    { const int lane = fresh_tid() & 63; float mq = fabsf(AIN(I_GQ)[lane]), mk = fabsf(AIN(I_GK)[lane]);
#pragma unroll
      for (int o = 1; o < 64; o <<= 1) { mq = fmaxf(mq, __shfl_xor(mq, o)); mk = fmaxf(mk, __shfl_xor(mk, o)); }
      gqa_mf = __builtin_amdgcn_readfirstlane((64.0f * C2_64 * mq * mk <= 100.0f) ? 1 : 0) != 0; }
    for (int u = C.bid; u < 1024; u += C.G) {
        const int b = u >> 6, head = (u >> 3) & 7, ch = u & 7, kvh = head >> 2; const size_t rb = (size_t)b * SEQ;
        const int un = u + C.G; const bool hn = un < 1024; const int bn = un >> 6, kvhn = ((un >> 3) & 7) >> 2; const size_t rbn = (size_t)bn * SEQ;
        const bf16* nk = hn ? (const bf16*)(ws + B_KA) + rbn * 128 + kvhn * 64 : nullptr; const bf16* nv = (const bf16*)(ws + B_ZIN) + rbn * ZW + 640 + kvhn * 64;
        if (gqa_mf) att::dense_unit<64, true>(lds, (const bf16*)(ws + B_QA) + rb * 512 + head * 64, 512, 256 * ch, (const bf16*)(ws + B_KA) + rb * 128 + kvh * 64, 128, nullptr,
                            (const bf16*)(ws + B_ZIN) + rb * ZW + 640 + kvh * 64, ZW, (bf16*)(ws + B_O0) + rb * 1024 + head * 64, 1024, taba, u != C.bid, nk, nullptr, nv);
        else att::dense_unit<64, false>(lds, (const bf16*)(ws + B_QA) + rb * 512 + head * 64, 512, 256 * ch, (const bf16*)(ws + B_KA) + rb * 128 + kvh * 64, 128, nullptr,
                            (const bf16*)(ws + B_ZIN) + rb * ZW + 640 + kvh * 64, ZW, (bf16*)(ws + B_O0) + rb * 1024 + head * 64, 1024, taba, u != C.bid, nk, nullptr, nv);
    }
    unsigned mla_mf = 0u;
    { const int tid = fresh_tid(), lane = tid & 63, r = lane & 31, h = lane >> 5; LAS float* xq = (LAS float*)lds; int ui = 0;
      __syncthreads();
      for (int u = C.bid; u < 1024 && ui < 8; u += C.G, ++ui) {
          const int b = u >> 6, head = (u >> 3) & 7, ch = u & 7;
          const bf16* qrow = (const bf16*)(ws + B_QM) + ((size_t)b * SEQ + 256 * ch + C.wave * 32 + r) * 768 + head * 96 + 8 * h; float nq = 0.f;
#pragma unroll
          for (int ks = 0; ks < 6; ++ks) { const bf16x8 q8 = *(const bf16x8*)(qrow + 16 * ks);
#pragma unroll
              for (int j = 0; j < 8; ++j) { const float f = bf2f((unsigned short)q8[j]); nq += f * f; } }
          nq += __shfl_xor(nq, 32);
#pragma unroll
          for (int o = 1; o < 32; o <<= 1) nq = fmaxf(nq, __shfl_xor(nq, o));
          const f32x4 kv4 = *((const f32x4*)((const float*)(ws + WS_LSE) + (size_t)b * SEQ) + tid);
          float km = fmaxf(fmaxf(kv4.x, kv4.y), fmaxf(kv4.z, kv4.w));
#pragma unroll
          for (int o = 1; o < 64; o <<= 1) km = fmaxf(km, __shfl_xor(km, o));
          if (lane == 0) { xq[ui * 8 + C.wave] = nq; xq[64 + ui * 8 + C.wave] = km; } }
      __syncthreads();
      ui = 0;
      for (int u = C.bid; u < 1024 && ui < 8; u += C.G, ++ui) {
          const int b = u >> 6, head = (u >> 3) & 7; float qm2 = 0.f;
#pragma unroll
          for (int i = 0; i < 8; ++i) qm2 = fmaxf(qm2, xq[ui * 8 + i]);
          const unsigned* kp = ctl + CW_KP + (b * 8 + head) * 64; float krm = 0.f;
#pragma unroll
          for (int i = 0; i < 8; ++i) krm = fmaxf(krm, xq[64 + ui * 8 + i]);
          const float kb2 = (__uint_as_float(__hip_atomic_load(kp, __ATOMIC_RELAXED, __HIP_MEMORY_SCOPE_AGENT)) + __uint_as_float(__hip_atomic_load(kp + 32, __ATOMIC_RELAXED, __HIP_MEMORY_SCOPE_AGENT)) + krm) * 1.02f;
          if (qm2 * kb2 <= 1.0e4f) mla_mf |= 1u << ui; }
      mla_mf = (unsigned)__builtin_amdgcn_readfirstlane((int)mla_mf);
      __syncthreads(); }
    { int ui = 0;
      for (int u = C.bid; u < 1024; u += C.G, ++ui) {
        const int b = u >> 6, head = (u >> 3) & 7, ch = u & 7; const size_t rb = (size_t)b * SEQ;
        const int un = u + C.G; const bool hn = un < 1024; const int bn = un >> 6, headn = (un >> 3) & 7; const size_t rbn = (size_t)bn * SEQ;
        const bf16* nk = hn ? (const bf16*)(ws + B_KV) + rbn * 1024 + headn * 128 : nullptr; const bf16* nkr = (const bf16*)(ws + B_KR) + rbn * 32; const bf16* nv = (const bf16*)(ws + B_KV) + rbn * 1024 + headn * 128 + 64;
        if (ui < 8 && ((mla_mf >> ui) & 1u))
            att::dense_unit<96, true>(lds, (const bf16*)(ws + B_QM) + rb * 768 + head * 96, 768, 256 * ch, (const bf16*)(ws + B_KV) + rb * 1024 + head * 128, 1024, (const bf16*)(ws + B_KR) + rb * 32,
                                (const bf16*)(ws + B_KV) + rb * 1024 + head * 128 + 64, 1024, (bf16*)(ws + B_O0) + rb * 1024 + 512 + head * 64, 1024, taba, u != C.bid, nk, nkr, nv);
        else
            att::dense_unit<96, false>(lds, (const bf16*)(ws + B_QM) + rb * 768 + head * 96, 768, 256 * ch, (const bf16*)(ws + B_KV) + rb * 1024 + head * 128, 1024, (const bf16*)(ws + B_KR) + rb * 32,
                                (const bf16*)(ws + B_KV) + rb * 1024 + head * 128 + 64, 1024, (bf16*)(ws + B_O0) + rb * 1024 + 512 + head * 64, 1024, taba, u != C.bid, nk, nkr, nv);
      } }
    GRID_BAR();
    { pg8::Gemm g{(const bf16*)(ws + B_O0), (const bf16*)(ws + W_OUT0), 1024, 1024, 1024}; pg8::StaticOrder S; S.init(NTOK / 256, 4, C.G, C.bid);
      pg8::EpiStore E{(bf16*)(ws + B_MO0), 1024, 1.0f, nullptr}; pg8::gemm_phase(lds, g, S, E); }
    GRID_BAR();
    rows_residual<false, true, false, false, false, 2>(C, nullptr, XN, nullptr, (const bf16*)(ws + B_MO0), AIN(I_MIXPOST), nullptr, (float*)(ws + WS_RSTD), nullptr, nullptr, nullptr, nullptr, nullptr, nullptr, ws + B_XN8);
    GRID_BAR();
    { pg8::Gemm g{(const bf16*)(ws + B_XN8), (const bf16*)(ws + W_GU0), 512, 512, 512}; pg8::StaticOrder S; S.init(NTOK / 256, 28, C.G, C.bid);
      pg8::EpiSwiGLU8 E{ws + B_HID, DFF}; pg8::gemm_phase<pg8::EpiSwiGLU8, pg8::StaticOrder, false, true>(lds, g, S, E, 0, 0, pg8::ISC8 * LOG2E, pg8::ISC8 * 8.f / LOG2E); }
    GRID_BAR();
    { pg8::Gemm g{(const bf16*)(ws + B_HID), (const bf16*)(ws + W_D0), DFF / 2, DFF / 2, DFF / 2}; pg8::StaticOrder S; S.init(NTOK / 256, 4, C.G, C.bid);
      pg8::EpiStore E{(bf16*)(ws + B_F), 1024, 1.0f, nullptr}; pg8::gemm_phase<pg8::EpiStore, pg8::StaticOrder, true>(lds, g, S, E, 0x79797979, 0x7c7c7c7c); }
    { pg8::Gemm g{(const bf16*)(ws + WS_PB), (const bf16*)(ws + W_PP), 256, 256, 256}; pg8::StaticOrder S; S.init(NTOK / 256, 4, C.G, C.bid);
      pg8::EpiStore E{(bf16*)(ws + B_E0), 1024, 1.0f, nullptr}; pg8::gemm_phase(lds, g, S, E); }
    GRID_BAR();
    rows_residual<false, true, false, false, false, 2>(C, nullptr, XN, nullptr, (const bf16*)(ws + B_F), AIN(I_FFNPOST), nullptr, (float*)(ws + WS_RSTD), nullptr, nullptr, nullptr, nullptr, nullptr, nullptr, ws + B_XN8);
    GRID_BAR();
    { pg8::Gemm g{(const bf16*)(ws + B_XN8), (const bf16*)(ws + W_PG), 512, 512, 512}; pg8::StaticOrder S; S.init(NTOK / 256, 4, C.G, C.bid);
      pg8::EpiPleGate E{(const bf16*)(ws + B_E0), (bf16*)(ws + B_E), 1024, nullptr}; pg8::gemm_phase<pg8::EpiPleGate, pg8::StaticOrder, false, true>(lds, g, S, E, 0, 0, pg8::ISC8, pg8::ISC8); }
    GRID_BAR();
    rows_residual<false, true, false, false, false, 2>(C, nullptr, XN, nullptr, (const bf16*)(ws + B_E), AIN(I_PLEPOST), nullptr, (float*)(ws + WS_RSTD), nullptr, nullptr, nullptr, nullptr, nullptr, nullptr, ws + B_XN8);
    GRID_BAR();

    { pg8::Gemm g{(const bf16*)(ws + B_XN8), (const bf16*)(ws + W_QKV1), 512, 512, 512}; pg8::StaticOrder S; S.init(NTOK / 256, 18, C.G, C.bid);
      pg8::EpiQKV1 E{(bf16*)(ws + B_QKV), tabp, nullptr}; pg8::gemm_phase<pg8::EpiQKV1, pg8::StaticOrder, false, true>(lds, g, S, E, 0, 0, pg8::ISC8, pg8::ISC8); }
    GRID_BAR();
    __syncthreads();
    { bf16x8 qA[4], qB[4];
      if (C.bid < 3072) { att::dil_issue(lds, C.bid, (const bf16*)(ws + B_QKV)); att::dil_qload(C.bid, (const bf16*)(ws + B_QKV), qA); }
      for (int u = C.bid; u < 3072; u += 2 * C.G) {
        { const int grp = u >> 10;
          att::dil_unit(lds, u, (u + C.G < 3072) ? u + C.G : -1, (const bf16*)(ws + B_QKV), (bf16*)(ws + B_OG) + (size_t)grp * NTOK * 512, (float*)(ws + WS_LSE) + (size_t)grp * NTOK * 8, qA, qB); }
        if (u + C.G < 3072) { const int u2 = u + C.G, grp = u2 >> 10;
          att::dil_unit(lds, u2, (u2 + C.G < 3072) ? u2 + C.G : -1, (const bf16*)(ws + B_QKV), (bf16*)(ws + B_OG) + (size_t)grp * NTOK * 512, (float*)(ws + WS_LSE) + (size_t)grp * NTOK * 8, qB, qA); }
      } }
    asm volatile("s_waitcnt vmcnt(0) lgkmcnt(0)\n\ts_barrier" ::: "memory");
    GRID_BAR();
    rows_merge(C, (const bf16*)(ws + B_OG), (const float*)(ws + WS_LSE), ws + B_O1, (float*)(ws + WS_TOKG));
    {
        LAS float* scr = (LAS float*)(lds + C.wave * 16384);
        const int lane = fresh_tid() & 63;
        for (int it = gw; it < 3 * 8 * 1792; it += NGW) {
            const int kind = it / (8 * 1792), e = (it / 1792) & 7, r = it % 1792;
            if (kind == 0) transpose_item<1>(AIN(I_MWG) + (size_t)e * 1024 * DFF, 1024, DFF, ws + B_WGU + (size_t)e * 7168 * 1024, 1024, 0, 1, scr, r, lane, AIN(I_FFNPRE) + DM, 64.f * LOG2E);
            else if (kind == 1) transpose_item<1>(AIN(I_MWU) + (size_t)e * 1024 * DFF, 1024, DFF, ws + B_WGU + (size_t)e * 7168 * 1024, 1024, 0, 2, scr, r, lane, AIN(I_FFNPRE) + DM, 64.f / LOG2E);
            else transpose_item<1>(AIN(I_MWD) + (size_t)e * DFF * 1024, DFF, 1024, ws + B_WD + (size_t)e * 1024 * DFF, DFF, 0, 0, scr, r, lane);
        }
    }
    GRID_BAR();
    { pg8::Gemm g{(const bf16*)(ws + B_O1), (const bf16*)(ws + W_OUT1), 256, 256, 256}; pg8::StaticOrder S; S.init(NTOK / 256, 4, C.G, C.bid);
      pg8::EpiStore E{(bf16*)(ws + B_MO1), 1024, 1.0f, (const float*)(ws + WS_TOKG)}; pg8::gemm_phase<pg8::EpiStore, pg8::StaticOrder, false, true>(lds, g, S, E, 0, 0, 1.0f, 1.0f); }
    GRID_BAR();
    rows_residual<false, true, true, false, false>(C, nullptr, XN, nullptr, (const bf16*)(ws + B_MO1), AIN(I_MIXPOST) + DM, AIN(I_FFNPRE) + DM, (float*)(ws + WS_RSTD), nullptr, nullptr, AIN(I_WR),
                                     (int*)(ws + WS_TOKE), (f32x2*)(ws + WS_TOKG), (int*)(ws + WS_CNT));
    GRID_BAR();
    moe_assign_gather(C, (const int*)(ws + WS_CNT), (const int*)(ws + WS_TOKE), (int*)(ws + WS_TOKS), (int*)(ws + WS_TILEE), XN, (const float*)(ws + WS_RSTD), ws + B_XS);
    GRID_BAR();
    int ntail = 0, tailrow0 = 0;
    {
        const int* tilee = (const int*)(ws + WS_TILEE);
        const int ntiles = __builtin_amdgcn_readfirstlane(tilee[0]);
        int tend[7];
#pragma unroll
        for (int j = 0; j < 7; ++j) tend[j] = __builtin_amdgcn_readfirstlane(tilee[1 + j]);
        for (int c = 0; c < 2; ++c) {
            const int tile0 = 128 * c; int ntl = ntiles - tile0; if (ntl <= 0) break; if (c == 0 && ntl > 128) ntl = 128;
            { pg8::Gemm g{(const bf16*)(ws + B_XS), (const bf16*)(ws + B_WGU), 512, 512, 512};
              pg8::MoeOrder S; S.so.init(ntl, 28, C.G, C.bid); for (int j = 0; j < 7; ++j) S.tend[j] = tend[j]; S.tile0 = tile0; S.nbt = 28; S.a_global = true;
              pg8::EpiSwiGLU8 E{ws + B_HC, DFF}; pg8::gemm_phase<pg8::EpiSwiGLU8, pg8::MoeOrder, true>(lds, g, S, E, 0x79797979, 0x7f7f7f7f, 1.f, 1.f, 0x7c7c7c7c); }
            GRID_BAR();
            const int ntm = (c == 1 && ntl >= 128 && ntl <= 135) ? 128 : ntl; ntail = ntl - ntm; tailrow0 = (tile0 + ntm) * 256;
            { pg8::Gemm g{(const bf16*)(ws + B_HC), (const bf16*)(ws + B_WD), DFF / 2, DFF / 2, DFF / 2};
              pg8::MoeOrder S; S.so.init(ntm, 4, C.G, C.bid); for (int j = 0; j < 7; ++j) S.tend[j] = tend[j]; S.tile0 = tile0; S.nbt = 4; S.a_global = false;
              pg8::EpiStore E{(bf16*)(ws + B_Y), 1024, 1.0f, nullptr}; pg8::gemm_phase<pg8::EpiStore, pg8::MoeOrder, true>(lds, g, S, E, 0x79797979, 0x7c7c7c7c); }
            for (int u = C.bid; u < ntail * 28; u += C.G) {
                const int sl = u % 7, t = u / 7, pn = t & 3, tm = t >> 2, tl = tile0 + ntm + tm; int e = 0;
#pragma unroll
                for (int j = 0; j < 7; ++j) e += (tl >= tend[j]) ? 1 : 0;
                pg8::Gemm g{(const bf16*)(ws + B_HC + sl * 512), (const bf16*)(ws + B_WD + sl * 512), DFF / 2, DFF / 2, 256};
                pg8::OneUnit S; S.u.pm = tm; S.u.pn = pn; S.u.pa = ntm + tm; S.u.pb = e * 4 + pn; S.has = true;
                pg8::EpiStore E{(bf16*)(ws + B_YP + sl * YP_STRIDE), 1024, 1.0f, nullptr}; pg8::gemm_phase<pg8::EpiStore, pg8::OneUnit, true>(lds, g, S, E, 0x79797979, 0x7c7c7c7c); }
            GRID_BAR();
        }
    }
    { const int gw = C.bid * NWAVES + C.wave, NGW = C.G * NWAVES, lane = fresh_tid() & 63;
      for (int r = gw; r < ntail * 256; r += NGW) {
          float a[16];
#pragma unroll
          for (int i = 0; i < 16; ++i) a[i] = 0.f;
#pragma unroll
          for (int sl = 0; sl < 7; ++sl) { const u32x4* src = (const u32x4*)(ws + B_YP + sl * YP_STRIDE + (size_t)r * 2048); const u32x4 v0 = src[lane], v1 = src[64 + lane];
              a[0] += __uint_as_float(v0.x << 16); a[1] += __uint_as_float(v0.x & 0xffff0000u); a[2] += __uint_as_float(v0.y << 16); a[3] += __uint_as_float(v0.y & 0xffff0000u);
              a[4] += __uint_as_float(v0.z << 16); a[5] += __uint_as_float(v0.z & 0xffff0000u); a[6] += __uint_as_float(v0.w << 16); a[7] += __uint_as_float(v0.w & 0xffff0000u);
              a[8] += __uint_as_float(v1.x << 16); a[9] += __uint_as_float(v1.x & 0xffff0000u); a[10] += __uint_as_float(v1.y << 16); a[11] += __uint_as_float(v1.y & 0xffff0000u);
              a[12] += __uint_as_float(v1.z << 16); a[13] += __uint_as_float(v1.z & 0xffff0000u); a[14] += __uint_as_float(v1.w << 16); a[15] += __uint_as_float(v1.w & 0xffff0000u); }
          u32x4 o0, o1; o0.x = pk2(a[0], a[1]); o0.y = pk2(a[2], a[3]); o0.z = pk2(a[4], a[5]); o0.w = pk2(a[6], a[7]); o1.x = pk2(a[8], a[9]); o1.y = pk2(a[10], a[11]); o1.z = pk2(a[12], a[13]); o1.w = pk2(a[14], a[15]);
          u32x4* dst = (u32x4*)(ws + B_Y + (size_t)(tailrow0 + r) * 2048); dst[lane] = o0; dst[64 + lane] = o1; } }
    { pg8::Gemm g{(const bf16*)(ws + WS_PB) + (size_t)NTOK * 256, (const bf16*)(ws + W_PP) + 1024 * 256, 256, 256, 256}; pg8::StaticOrder S; S.init(NTOK / 256, 4, C.G, C.bid);
      pg8::EpiStore E{(bf16*)(ws + B_E0b), 1024, 1.0f, nullptr}; pg8::gemm_phase(lds, g, S, E); }
    GRID_BAR();
    rows_residual<true, true, false, false, false, 1>(C, nullptr, XN, nullptr, (const bf16*)(ws + B_Y), AIN(I_FFNPOST) + DM, nullptr, (float*)(ws + WS_RSTD), (const int*)(ws + WS_TOKS), (const f32x2*)(ws + WS_TOKG),
                                     nullptr, nullptr, nullptr, nullptr, ws + B_XN8b);
    GRID_BAR();
    { pg8::Gemm g{(const bf16*)(ws + B_XN8b), (const bf16*)(ws + W_PG) + 1024 * 1024, 512, 512, 512}; pg8::StaticOrder S; S.init(NTOK / 256, 4, C.G, C.bid);
      pg8::EpiPleGate E{(const bf16*)(ws + B_E0b), (bf16*)(ws + B_Eb), 1024, nullptr}; pg8::gemm_phase<pg8::EpiPleGate, pg8::StaticOrder, true>(lds, g, S, E, 0x79797979, 0x7f7f7f7f); }
    GRID_BAR();
    rows_residual<false, false, false, false, true>(C, nullptr, XN, hres, (const bf16*)(ws + B_Eb), AIN(I_PLEPOST) + DM, nullptr, nullptr, nullptr, nullptr, nullptr, nullptr, nullptr, nullptr);
#undef TR
#undef GRID_BAR
#undef AIN
}

extern "C" void kernel_launch(void* const* d_in, const int* in_sizes, int n_in, void* d_out, int out_size, void* d_ws, size_t ws_size, hipStream_t stream) {
    static int grid = 0;
    if (grid == 0) {
        if (n_in != 27 || in_sizes[0] != NTOK * DM || out_size != NTOK * DM || ws_size < WS_END) { fprintf(stderr, "kernel_launch: unexpected shapes / workspace (%zu < %zu)\n", ws_size, (size_t)WS_END); grid = -1; return; }
        int dev = 0, cus = 0;
        if (hipGetDevice(&dev) != hipSuccess || hipDeviceGetAttribute(&cus, hipDeviceAttributeMultiprocessorCount, dev) != hipSuccess) { grid = -1; return; }
        if (hipFuncSetAttribute((const void*)fwd_kernel, hipFuncAttributeMaxDynamicSharedMemorySize, LDS_BYTES) != hipSuccess) { fprintf(stderr, "kernel_launch: hipFuncSetAttribute failed\n"); grid = -1; return; }
        int per_cu = 0;
        if (hipOccupancyMaxActiveBlocksPerMultiprocessor(&per_cu, (const void*)fwd_kernel, NTHREADS, LDS_BYTES) != hipSuccess || per_cu < 1) fprintf(stderr, "kernel_launch: occupancy query reports %d\n", per_cu);
        (void)hipGetLastError();
        if (cus != 256) { fprintf(stderr, "kernel_launch: built for 256 CUs, device has %d\n", cus); grid = -1; return; }
        grid = cus;
    }
    if (grid < 0) return;
    (void)hipMemsetAsync((char*)d_ws + WS_CTL, 0, CTL_ZERO_BYTES, stream);
    Args a{};
    for (int i = 0; i < 27; ++i) a.in[i] = (const float*)d_in[i];
    a.out = (float*)d_out; a.ws = (unsigned char*)d_ws;
    hipLaunchKernelGGL(fwd_kernel, dim3(grid), dim3(NTHREADS), LDS_BYTES, stream, a);
}
```

```cpp
#include <hip/hip_runtime.h>
#include <cstdio>
#include <cstdint>

#define DI __device__ __forceinline__
#define LAS __attribute__((address_space(3)))
#define GAS __attribute__((address_space(1)))
typedef unsigned short bf16;
typedef short bf16x8 __attribute__((ext_vector_type(8)));
typedef short s16x4 __attribute__((ext_vector_type(4)));
typedef float f32x2 __attribute__((ext_vector_type(2)));
typedef float f32x4 __attribute__((ext_vector_type(4)));
typedef float f32x16 __attribute__((ext_vector_type(16)));
typedef unsigned u32x2 __attribute__((ext_vector_type(2)));
typedef unsigned u32x4 __attribute__((ext_vector_type(4)));
typedef __bf16 bf16x2_t __attribute__((ext_vector_type(2)));

constexpr int BATCH = 16, SEQ = 2048, DM = 1024, NTOK = BATCH * SEQ;
constexpr int ZW = 1280;
constexpr int DFF = 3584, NEXP = 8;
constexpr int QKVW = 4608;
constexpr float EPS = 1e-6f;
constexpr float LOG2E = 1.4426950408889634f;
constexpr float C2_64 = 0.125f * LOG2E;
constexpr float C2_96 = 0.10206207261596577f * LOG2E;
constexpr int NWAVES = 8, NTHREADS = 512;
constexpr int MAXTILES = 264;
constexpr int NSLOTS = MAXTILES * 256;

constexpr size_t MiB = 1u << 20;
constexpr size_t WS_CTL = 0, CTL_ZERO_BYTES = 64 * 1024;
constexpr size_t WS_TABA = 1 * MiB;
constexpr size_t WS_TABP = WS_TABA + 2048 * 16 * 8;
constexpr size_t WS_TOKE = 2 * MiB;
constexpr size_t WS_TOKG = WS_TOKE + NTOK * 4;
constexpr size_t WS_TOKS = WS_TOKG + NTOK * 8;
constexpr size_t WS_CNT = WS_TOKS + NTOK * 8;
constexpr size_t WS_TILEE = WS_CNT + 256 * 8 * 4;
constexpr size_t WS_RSTD = 2 * MiB + 768 * 1024;
constexpr size_t WS_LSE = 3 * MiB;
constexpr size_t WS_W = 6 * MiB;
constexpr size_t W_IN = WS_W;
constexpr size_t W_UQ = W_IN + (size_t)ZW * 1024 * 2;
constexpr size_t W_UKV = W_UQ + 768 * 256 * 2;
constexpr size_t W_OUT0 = W_UKV + 1024 * 256 * 2;
constexpr size_t W_GU0 = W_OUT0 + 1024 * 1024 * 2;
constexpr size_t W_D0 = W_GU0 + (size_t)7168 * 1024 * 2;
constexpr size_t W_PP = W_D0 + (size_t)1024 * 3584 * 2;
constexpr size_t W_PG = W_PP + 2 * 1024 * 256 * 2;
constexpr size_t W_QKV1 = W_PG + 2 * 1024 * 1024 * 2;
constexpr size_t W_OUT1 = W_QKV1 + (size_t)QKVW * 1024 * 2;
constexpr size_t W_END = W_OUT1 + 1024 * 512 * 2;
constexpr size_t WS_PB = 48 * MiB;
constexpr size_t WS_XN = 80 * MiB;
constexpr size_t WS_BIG = 144 * MiB;
static_assert(W_END <= WS_PB, "weights");
constexpr size_t B_ZIN = WS_BIG;
constexpr size_t B_QA = WS_BIG + 80 * MiB;
constexpr size_t B_KA = WS_BIG + 112 * MiB;
constexpr size_t B_CQN = WS_BIG + 120 * MiB;
constexpr size_t B_CKVN = WS_BIG + 136 * MiB;
constexpr size_t B_KR = WS_BIG + 152 * MiB;
constexpr size_t B_QM = WS_BIG + 154 * MiB;
constexpr size_t B_KV = WS_BIG + 202 * MiB;
constexpr size_t B_O0 = WS_BIG + 266 * MiB;
constexpr size_t B_MO0 = WS_BIG;
constexpr size_t B_HID = WS_BIG;
constexpr size_t B_F = WS_BIG + 224 * MiB;
constexpr size_t B_E0 = WS_BIG + 288 * MiB;
constexpr size_t B_E = WS_BIG;
constexpr size_t B_QKV = WS_BIG;
constexpr size_t B_OG = WS_BIG + 288 * MiB;
constexpr size_t B_O1 = WS_BIG + 388 * MiB;
constexpr size_t B_XN8 = WS_BIG + 388 * MiB;
constexpr size_t B_MO1 = WS_BIG + 288 * MiB;
constexpr size_t B_WGU = WS_BIG;
constexpr size_t B_WD = WS_BIG + 56 * MiB;
constexpr size_t B_XS = WS_BIG + 84 * MiB;
constexpr size_t B_Y = WS_BIG + 152 * MiB;
constexpr size_t B_HC = WS_BIG + 300 * MiB;
constexpr size_t B_YP = WS_BIG + 84 * MiB;
constexpr size_t YP_STRIDE = (size_t)7 * 256 * 1024 * 2;
constexpr size_t B_E0b = WS_BIG + 356 * MiB;
constexpr size_t B_Eb = WS_BIG;
constexpr size_t B_XN8b = WS_BIG + 96 * MiB;
constexpr size_t WS_END = WS_BIG + 420 * MiB;

constexpr int CW_BAR = 1024;
constexpr int CW_KP = 8192;

constexpr int RING_BYTES = 133120;
constexpr int LDSCTL_OFF = RING_BYTES, MISC_OFF = LDSCTL_OFF + 320;
constexpr int LDS_BYTES = 147456;

DI float bf2f(unsigned short v) { return __uint_as_float((unsigned)v << 16); }
DI unsigned pk2(float lo, float hi) { f32x2 v = {lo, hi}; bf16x2_t b = __builtin_convertvector(v, bf16x2_t); return __builtin_bit_cast(unsigned, b); }
DI float wave_sum(float v) {
#pragma unroll
    for (int o = 1; o < 64; o <<= 1) v += __shfl_xor(v, o);
    return v;
}
DI int fresh_tid() { int t = threadIdx.x; asm volatile("" : "+v"(t)); return t; }
DI float ex2(float x) { return __builtin_amdgcn_exp2f(x); }
DI float rsq(float x) { return 1.0f / sqrtf(x); }
DI void unpack8(u32x4 w, float (&x)[8]) {
    x[0] = __uint_as_float(w.x << 16); x[1] = __uint_as_float(w.x & 0xffff0000u);
    x[2] = __uint_as_float(w.y << 16); x[3] = __uint_as_float(w.y & 0xffff0000u);
    x[4] = __uint_as_float(w.z << 16); x[5] = __uint_as_float(w.z & 0xffff0000u);
    x[6] = __uint_as_float(w.w << 16); x[7] = __uint_as_float(w.w & 0xffff0000u);
}
DI u32x4 pack8(const float (&x)[8]) { u32x4 w; w.x = pk2(x[0], x[1]); w.y = pk2(x[2], x[3]); w.z = pk2(x[4], x[5]); w.w = pk2(x[6], x[7]); return w; }

namespace pg8 {
constexpr int BM = 256, BK = 64, HALF = 128, HTB = HALF * BK * 2, STAGE_BYTES = 8 * HTB, NXCD = 8, WGM = 8;
constexpr int RS_LDS_OFF = STAGE_BYTES;
__host__ __device__ __forceinline__ int lds_byte(int r, int c) { const int st = (r >> 4) * 2 + (c >> 5), rr = r & 15, cc = c & 31, ob = rr * 64 + cc * 2; return st * 1024 + (ob ^ (((ob >> 9) & 1) << 5)); }
__host__ __device__ __forceinline__ void stage_rc(int b, int& R, int& C) { const int st = b / 1024, sb = b % 1024, swz = sb ^ (((sb >> 9) & 1) << 5); R = (st >> 1) * 16 + swz / 64; C = (st & 1) * 32 + (swz % 64) / 2; }
__host__ __device__ __forceinline__ int perm32(int rho) { const int n = rho >> 4, i = rho & 15; return 8 * (i >> 2) + 4 * n + (i & 3); }

struct Unit { int pm, pn, pa, pb; };
struct Gemm { const bf16* A; const bf16* Bt; int lda, ldb, K; };

struct StaticOrder {
    int nM, nN, nwg, G, c;
    DI void init(int nM_, int nN_, int G_, int c_) { nM = nM_; nN = nN_; nwg = nM * nN; G = G_; c = c_; }
    DI bool map(int i, int& pm, int& pn) const {
        const long L = (long)i * G + c; if (L >= nwg) return false;
        int wgid = (int)L; { const int q = nwg / NXCD, r = nwg % NXCD, xcd = wgid % NXCD, off = wgid / NXCD; wgid = (xcd < r ? xcd * (q + 1) : r * (q + 1) + (xcd - r) * q) + off; }
        const int nig = WGM * nN, gid = wgid / nig, fm = gid * WGM, gsz = (nM - fm) < WGM ? (nM - fm) : WGM;
        pm = fm + ((wgid % nig) % gsz); pn = (wgid % nig) / gsz; return true;
    }
    DI bool next(int i, Unit& u) const { int pm, pn; if (!map(i, pm, pn)) return false; u.pm = pm; u.pn = pn; u.pa = pm; u.pb = pn; return true; }
};
struct MoeOrder {
    StaticOrder so; int tend[7]; int tile0, nbt; bool a_global;
    DI bool next(int i, Unit& u) const {
        int pm, pn; if (!so.map(i, pm, pn)) return false;
        const int tl = tile0 + pm; int e = 0;
#pragma unroll
        for (int j = 0; j < 7; ++j) e += (tl >= tend[j]) ? 1 : 0;
        u.pn = pn; u.pb = e * nbt + pn;
        if (a_global) { u.pa = tile0 + pm; u.pm = pm; } else { u.pa = pm; u.pm = tile0 + pm; }
        return true;
    }
};

struct OneUnit { Unit u; bool has; DI bool next(int i, Unit& o) const { if (i != 0 || !has) return false; o = u; return true; } };

struct EpiStore {
    bf16* O; int ldc; float scale; const float* rs;
    static constexpr int NSTORES = 16;
    struct Pre { const LAS float* t; };
    DI Pre pre(const Unit& u, LAS unsigned char* lds, int par, int wid, int lane) const { LAS float* t = (LAS float*)(lds + RS_LDS_OFF + par * 1024);
        return Pre{t}; }
    DI void operator()(const f32x4 (&acc)[2][2][4][2], const Unit& u, int wr, int wc, int fr, int fq, const Pre& P) const {
        const int row0 = u.pm * BM + wr * 64 + fr, col0 = u.pn * BM + wc * 32 + 8 * fq;
#pragma unroll
        for (int ai = 0; ai < 2; ++ai)
#pragma unroll
            for (int m = 0; m < 4; ++m) { bf16* rowp = O + (size_t)(row0 + ai * HALF + m * 16) * ldc + col0; const float sc = rs ? scale * rs[row0 + ai * HALF + m * 16] : scale;
#pragma unroll
                for (int bj = 0; bj < 2; ++bj) { const f32x4 v0 = acc[ai][bj][m][0] * sc, v1 = acc[ai][bj][m][1] * sc;
                    u32x4 w; w.x = pk2(v0[0], v0[1]); w.y = pk2(v0[2], v0[3]); w.z = pk2(v1[0], v1[1]); w.w = pk2(v1[2], v1[3]);
                    *(u32x4*)(rowp + bj * HALF) = w; } }
    }
};
struct EpiStoreKV {
    bf16* O; int ldc; unsigned* kp;
    static constexpr int NSTORES = 16;
    struct Pre { };
    DI Pre pre(const Unit&, LAS unsigned char*, int, int, int) const { return Pre{}; }
    DI void operator()(const f32x4 (&acc)[2][2][4][2], const Unit& u, int wr, int wc, int fr, int fq, const Pre&) const {
        const int row0 = u.pm * BM + wr * 64 + fr, col0 = u.pn * BM + wc * 32 + 8 * fq;
#pragma unroll
        for (int ai = 0; ai < 2; ++ai)
#pragma unroll
            for (int m = 0; m < 4; ++m) { bf16* rowp = O + (size_t)(row0 + ai * HALF + m * 16) * ldc + col0;
#pragma unroll
                for (int bj = 0; bj < 2; ++bj) { const f32x4 v0 = acc[ai][bj][m][0], v1 = acc[ai][bj][m][1];
                    u32x4 w; w.x = pk2(v0[0], v0[1]); w.y = pk2(v0[2], v0[3]); w.z = pk2(v1[0], v1[1]); w.w = pk2(v1[2], v1[3]);
                    *(u32x4*)(rowp + bj * HALF) = w; } }
        if (wc < 2) {
#pragma unroll
            for (int bj = 0; bj < 2; ++bj) { float mx = 0.f;
#pragma unroll
                for (int ai = 0; ai < 2; ++ai)
#pragma unroll
                    for (int m = 0; m < 4; ++m) { const f32x4 v0 = acc[ai][bj][m][0], v1 = acc[ai][bj][m][1];
                        float pq = (v0[0] * v0[0] + v0[1] * v0[1]) + (v0[2] * v0[2] + v0[3] * v0[3]) + (v1[0] * v1[0] + v1[1] * v1[1]) + (v1[2] * v1[2] + v1[3] * v1[3]);
                        pq += __shfl_xor(pq, 16); pq += __shfl_xor(pq, 32); mx = fmaxf(mx, pq); }
                mx = fmaxf(mx, __shfl_xor(mx, 1)); mx = fmaxf(mx, __shfl_xor(mx, 2)); mx = fmaxf(mx, __shfl_xor(mx, 4)); mx = fmaxf(mx, __shfl_xor(mx, 8));
                if (fr == 0 && fq == 0) atomicMax(kp + (((u.pm >> 3) * 8 + 2 * u.pn + bj) * 2 + wc) * 32, __float_as_uint(mx)); }
        }
    }
};
DI float silu_mul(float g, float u) { return g * u * __builtin_amdgcn_rcpf(1.0f + ex2(-g * LOG2E)); }
struct EpiSwiGLU {
    bf16* H; int ldh; const float* rs;
    static constexpr int NSTORES = 8;
    struct Pre { const LAS float* t; };
    DI Pre pre(const Unit& u, LAS unsigned char* lds, int par, int wid, int lane) const { LAS float* t = (LAS float*)(lds + RS_LDS_OFF + par * 1024);
        return Pre{t}; }
    DI void operator()(const f32x4 (&acc)[2][2][4][2], const Unit& u, int wr, int wc, int fr, int fq, const Pre& P) const {
        const int row0 = u.pm * BM + wr * 64 + fr, col0 = u.pn * HALF + wc * 32 + 8 * fq;
#pragma unroll
        for (int ai = 0; ai < 2; ++ai)
#pragma unroll
            for (int m = 0; m < 4; ++m) { bf16* rowp = H + (size_t)(row0 + ai * HALF + m * 16) * ldh + col0; const float sc = rs ? rs[row0 + ai * HALF + m * 16] : 1.0f;
                const f32x4 g0 = acc[ai][0][m][0] * sc, g1 = acc[ai][0][m][1] * sc, u0 = acc[ai][1][m][0] * sc, u1 = acc[ai][1][m][1] * sc;
                u32x4 w; w.x = pk2(silu_mul(g0[0], u0[0]), silu_mul(g0[1], u0[1])); w.y = pk2(silu_mul(g0[2], u0[2]), silu_mul(g0[3], u0[3]));
                w.z = pk2(silu_mul(g1[0], u1[0]), silu_mul(g1[1], u1[1])); w.w = pk2(silu_mul(g1[2], u1[2]), silu_mul(g1[3], u1[3]));
                *(u32x4*)rowp = w; }
    }
};
constexpr float SA8 = 32.0f, SW8 = 1000.0f, ISC8 = 1.0f / (SA8 * SW8);
DI unsigned pk4_i8(float a, float b, float c, float d) {
    const int ia = (int)__builtin_amdgcn_fmed3f(__builtin_rintf(a), -127.f, 127.f), ib = (int)__builtin_amdgcn_fmed3f(__builtin_rintf(b), -127.f, 127.f);
    const int ic = (int)__builtin_amdgcn_fmed3f(__builtin_rintf(c), -127.f, 127.f), id = (int)__builtin_amdgcn_fmed3f(__builtin_rintf(d), -127.f, 127.f);
    return ((unsigned)ia & 0xffu) | (((unsigned)ib & 0xffu) << 8) | (((unsigned)ic & 0xffu) << 16) | ((unsigned)id << 24); }
DI unsigned pk4_fp8(float a, float b, float c, float d) {
    a = __builtin_amdgcn_fmed3f(a, -448.f, 448.f); b = __builtin_amdgcn_fmed3f(b, -448.f, 448.f); c = __builtin_amdgcn_fmed3f(c, -448.f, 448.f); d = __builtin_amdgcn_fmed3f(d, -448.f, 448.f);
    int w = 0; w = __builtin_amdgcn_cvt_pk_fp8_f32(a, b, w, false); w = __builtin_amdgcn_cvt_pk_fp8_f32(c, d, w, true); return (unsigned)w; }
DI float silu_mul_l2(float gl, float ul) { return gl * ul * __builtin_amdgcn_rcpf(1.0f + ex2(-gl)); }
struct EpiSwiGLU8 {
    unsigned char* H; int ldh;
    static constexpr int NSTORES = 8;
    struct Pre { };
    DI Pre pre(const Unit&, LAS unsigned char*, int, int, int) const { return Pre{}; }
    DI void operator()(const f32x4 (&acc)[2][2][4][2], const Unit& u, int wr, int wc, int fr, int fq, const Pre&) const {
        const int row0 = u.pm * BM + wr * 64 + fr, col0 = u.pn * HALF + wc * 32 + 8 * fq;
#pragma unroll
        for (int ai = 0; ai < 2; ++ai)
#pragma unroll
            for (int m = 0; m < 4; ++m) { unsigned char* rowp = H + (size_t)(row0 + ai * HALF + m * 16) * ldh + col0;
                const f32x4 g0 = acc[ai][0][m][0], g1 = acc[ai][0][m][1], u0 = acc[ai][1][m][0], u1 = acc[ai][1][m][1];
                u32x2 w; w.x = pk4_fp8(silu_mul_l2(g0[0], u0[0]), silu_mul_l2(g0[1], u0[1]), silu_mul_l2(g0[2], u0[2]), silu_mul_l2(g0[3], u0[3]));
                w.y = pk4_fp8(silu_mul_l2(g1[0], u1[0]), silu_mul_l2(g1[1], u1[1]), silu_mul_l2(g1[2], u1[2]), silu_mul_l2(g1[3], u1[3]));
                *(u32x2*)rowp = w; }
    }
};
struct EpiPleGate {
    const bf16* E0; bf16* E; int ldc; const float* rs;
    static constexpr int NSTORES = 16;
    struct Pre { const LAS float* t; };
    DI Pre pre(const Unit& u, LAS unsigned char* lds, int par, int wid, int lane) const { LAS float* t = (LAS float*)(lds + RS_LDS_OFF + par * 1024);
        return Pre{t}; }
    DI void operator()(const f32x4 (&acc)[2][2][4][2], const Unit& u, int wr, int wc, int fr, int fq, const Pre& P) const {
        const int row0 = u.pm * BM + wr * 64 + fr, col0 = u.pn * BM + wc * 32 + 8 * fq;
#pragma unroll
        for (int ai = 0; ai < 2; ++ai)
#pragma unroll
            for (int m = 0; m < 4; ++m) { const size_t off = (size_t)(row0 + ai * HALF + m * 16) * ldc + col0; const float sc = rs ? rs[row0 + ai * HALF + m * 16] * LOG2E : LOG2E;
#pragma unroll
                for (int bj = 0; bj < 2; ++bj) { const u32x4 ew = *(const u32x4*)(E0 + off + bj * HALF); float e[8]; unpack8(ew, e);
                    const f32x4 v0 = acc[ai][bj][m][0] * sc, v1 = acc[ai][bj][m][1] * sc; float o[8];
#pragma unroll
                    for (int j = 0; j < 4; ++j) { o[j] = e[j] * __builtin_amdgcn_rcpf(1.0f + ex2(-v0[j])); o[4 + j] = e[4 + j] * __builtin_amdgcn_rcpf(1.0f + ex2(-v1[j])); }
                    *(u32x4*)(E + off + bj * HALF) = pack8(o); } }
    }
};
struct EpiQKV1 {
    bf16* O; const f32x2* tabp; const float* rs;
    static constexpr int NSTORES = 16;
    struct Pre { const LAS float* t; };
    DI Pre pre(const Unit& u, LAS unsigned char* lds, int par, int wid, int lane) const { LAS float* t = (LAS float*)(lds + RS_LDS_OFF + par * 1024);
        return Pre{t}; }
    DI void operator()(const f32x4 (&acc)[2][2][4][2], const Unit& u, int wr, int wc, int fr, int fq, const Pre& P) const {
        const int row0 = u.pm * BM + wr * 64 + fr;
        const int which = ((u.pn * BM) % 1536) / 512;
        const int grp = (u.pn * BM) / 1536, sh = 2 * grp;
        const float sc = which == 0 ? C2_64 : 1.0f;
        const bool rot = which < 2;
        const bool mine = ((wc & 1) == 0) && (fq < 2);
#pragma unroll
        for (int ai = 0; ai < 2; ++ai)
#pragma unroll
            for (int m = 0; m < 4; ++m) { const int row = row0 + ai * HALF + m * 16, bb = row >> 11, t = row & (SEQ - 1);
                const int pos = ((t & ((1 << sh) - 1)) << (11 - sh)) + (t >> sh);
                const float scr = rs ? sc * rs[row] : sc;
                f32x4 cs4[4];
                if (rot && mine) {
#pragma unroll
                    for (int q = 0; q < 4; ++q) cs4[q] = ((const f32x4*)(tabp + (size_t)t * 8))[q];
                }
#pragma unroll
                for (int bj = 0; bj < 2; ++bj) { float v[8];
                    const int head = ((u.pn * BM + bj * HALF + wc * 32) % 512) / 64, d0 = ((wc & 1) * 32) + 8 * fq;
                    bf16* dst = O + ((size_t)((((bb * 3 + grp) * 3 + which) * 8 + head) * SEQ + pos)) * 64 + d0;
#pragma unroll
                    for (int j = 0; j < 4; ++j) { v[j] = acc[ai][bj][m][0][j]; v[4 + j] = acc[ai][bj][m][1][j]; }
                    if (rot) {
                        float p[8];
#pragma unroll
                        for (int j = 0; j < 8; ++j) p[j] = __shfl_xor(v[j], 16);
                        if (mine) {
#pragma unroll
                            for (int j = 0; j < 8; ++j) { const float cx = cs4[j >> 1][(j & 1) * 2], sy = cs4[j >> 1][(j & 1) * 2 + 1]; v[j] = (fq == 0) ? (v[j] * cx - p[j] * sy) : (v[j] * cx + p[j] * sy); }
                        }
                    }
#pragma unroll
                    for (int j = 0; j < 8; ++j) v[j] *= scr;
                    *(u32x4*)dst = pack8(v); } }
    }
};

typedef int v8i32 __attribute__((ext_vector_type(8)));
typedef int v4i32 __attribute__((ext_vector_type(4)));
DI v8i32 cat8(bf16x8 lo, bf16x8 hi) { const v4i32 a = __builtin_bit_cast(v4i32, lo), b = __builtin_bit_cast(v4i32, hi); return __builtin_shufflevector(a, b, 0, 1, 2, 3, 4, 5, 6, 7); }
template <class Epi, class Sched, bool FP8 = false, bool I8 = false>
DI void gemm_phase(LAS unsigned char* lds, const Gemm g, const Sched& S, const Epi& E, const int scw = 0x7f7f7f7f, const int sca = 0x7f7f7f7f, const float isc0 = 1.f, const float isc1 = 1.f, const int scw1 = 0) {
    const int tid = fresh_tid(), wid = __builtin_amdgcn_readfirstlane(tid >> 6), lane = tid & 63, wr = wid >> 2, wc = wid & 3, fr = lane & 15, fq = lane >> 4;
    const int scwb = scw1 ? scw1 : scw;
    const int K = g.K; int nt = K / BK; if constexpr (FP8 || I8) asm volatile("" : "+s"(nt));
    unsigned voffA[2], voffB[2];
#pragma unroll
    for (int i = 0; i < 2; ++i) { int R, C; stage_rc(tid * 16 + i * 8192, R, C); const int Rb = (R & ~31) + perm32(R & 31);
        voffA[i] = (unsigned)(R * g.lda + C) * 2u; voffB[i] = (unsigned)(Rb * g.ldb + C) * 2u; }
    const size_t kstep = (size_t)(BK * 2);
    const size_t hstepA = (size_t)HALF * g.lda * 2, hstepB = (size_t)HALF * g.ldb * 2;
    const size_t tstepA = 2 * hstepA, tstepB = 2 * hstepB;
    const unsigned ldsw = (unsigned)wid * 1024u;
    const int aoff = lds_byte(wr * 64 + fr, fq * 8), boff = lds_byte(wc * 32 + fr, fq * 8);
#define PG8_SA(b, h) (((b) * 2 + (h)) * HTB)
#define PG8_SB(b, h) ((4 + (b) * 2 + (h)) * HTB)
#define PG8_STAGE(bufoff, gbase, voff) do { _Pragma("unroll") for (int _i = 0; _i < 2; ++_i) \
        __builtin_amdgcn_global_load_lds((const unsigned*)((const char*)(gbase) + (voff)[_i]), (LAS unsigned*)(lds + (bufoff) + ldsw + _i * 8192), 16, 0, 0); } while (0)
#define PG8_LDA(dst, b, h) do { _Pragma("unroll") for (int m = 0; m < 4; ++m) { \
        if constexpr (FP8) dst##8[m] = cat8(*(const LAS bf16x8*)(lds + PG8_SA(b, h) + aoff + m * 2048), *(const LAS bf16x8*)(lds + PG8_SA(b, h) + aoff + m * 2048 + 1024)); \
        else { _Pragma("unroll") for (int k = 0; k < 2; ++k) dst[m][k] = *(const LAS bf16x8*)(lds + PG8_SA(b, h) + aoff + m * 2048 + k * 1024); } } } while (0)
#define PG8_LDB(dst, b, h) do { _Pragma("unroll") for (int n = 0; n < 2; ++n) { \
        if constexpr (FP8) dst##8[n] = cat8(*(const LAS bf16x8*)(lds + PG8_SB(b, h) + boff + n * 2048), *(const LAS bf16x8*)(lds + PG8_SB(b, h) + boff + n * 2048 + 1024)); \
        else { _Pragma("unroll") for (int k = 0; k < 2; ++k) dst[n][k] = *(const LAS bf16x8*)(lds + PG8_SB(b, h) + boff + n * 2048 + k * 1024); } } } while (0)
#define PG8_MMA(ai, bj, At, Bt) do { __builtin_amdgcn_s_setprio(1); \
        if constexpr (FP8) { _Pragma("unroll") for (int m = 0; m < 4; ++m) _Pragma("unroll") for (int n = 0; n < 2; ++n) \
            asm volatile("s_nop 1\n\tv_mfma_scale_f32_16x16x128_f8f6f4 %0, %1, %2, %0, %3, %4 op_sel_hi:[0,0,0]" : "+v"(acc[ai][bj][m][n]) : "v"(Bt##8[n]), "v"(At##8[m]), "v"((bj) == 1 ? scwb : scw), "v"(sca)); } \
        else if constexpr (I8) { _Pragma("unroll") for (int k = 0; k < 2; ++k) _Pragma("unroll") for (int m = 0; m < 4; ++m) _Pragma("unroll") for (int n = 0; n < 2; ++n) \
            asm volatile("v_mfma_i32_16x16x64_i8 %0, %1, %2, %0" : "+v"(acc[ai][bj][m][n]) : "v"(Bt[n][k]), "v"(At[m][k])); } \
        else { _Pragma("unroll") for (int k = 0; k < 2; ++k) _Pragma("unroll") for (int m = 0; m < 4; ++m) _Pragma("unroll") for (int n = 0; n < 2; ++n)     \
            asm volatile("v_mfma_f32_16x16x32_bf16 %0, %1, %2, %0" : "+v"(acc[ai][bj][m][n]) : "v"(Bt[n][k]), "v"(At[m][k])); } \
        __builtin_amdgcn_s_setprio(0); } while (0)
#define PG8_MMA0(ai, bj, At, Bt) do { __builtin_amdgcn_s_setprio(1); \
        if constexpr (FP8) { _Pragma("unroll") for (int m = 0; m < 4; ++m) _Pragma("unroll") for (int n = 0; n < 2; ++n) \
            asm volatile("s_nop 1\n\tv_mfma_scale_f32_16x16x128_f8f6f4 %0, %1, %2, 0, %3, %4 op_sel_hi:[0,0,0]" : "=&v"(acc[ai][bj][m][n]) : "v"(Bt##8[n]), "v"(At##8[m]), "v"((bj) == 1 ? scwb : scw), "v"(sca)); } \
        else if constexpr (I8) { _Pragma("unroll") for (int m = 0; m < 4; ++m) _Pragma("unroll") for (int n = 0; n < 2; ++n) \
            asm volatile("v_mfma_i32_16x16x64_i8 %0, %1, %2, 0" : "=&v"(acc[ai][bj][m][n]) : "v"(Bt[n][0]), "v"(At[m][0])); \
          _Pragma("unroll") for (int m = 0; m < 4; ++m) _Pragma("unroll") for (int n = 0; n < 2; ++n) \
            asm volatile("v_mfma_i32_16x16x64_i8 %0, %1, %2, %0" : "+v"(acc[ai][bj][m][n]) : "v"(Bt[n][1]), "v"(At[m][1])); } \
        else { _Pragma("unroll") for (int m = 0; m < 4; ++m) _Pragma("unroll") for (int n = 0; n < 2; ++n) \
            asm volatile("v_mfma_f32_16x16x32_bf16 %0, %1, %2, 0" : "=&v"(acc[ai][bj][m][n]) : "v"(Bt[n][0]), "v"(At[m][0])); \
          _Pragma("unroll") for (int m = 0; m < 4; ++m) _Pragma("unroll") for (int n = 0; n < 2; ++n) \
            asm volatile("v_mfma_f32_16x16x32_bf16 %0, %1, %2, %0" : "+v"(acc[ai][bj][m][n]) : "v"(Bt[n][1]), "v"(At[m][1])); } \
        __builtin_amdgcn_s_setprio(0); } while (0)
#define PG8_TIE_ACC(NOPS) do { \
        asm volatile(NOPS : "+v"(acc[0][0][0][0]), "+v"(acc[0][0][0][1]), "+v"(acc[0][0][1][0]), "+v"(acc[0][0][1][1]), "+v"(acc[0][0][2][0]), "+v"(acc[0][0][2][1]), "+v"(acc[0][0][3][0]), "+v"(acc[0][0][3][1]), \
                            "+v"(acc[0][1][0][0]), "+v"(acc[0][1][0][1]), "+v"(acc[0][1][1][0]), "+v"(acc[0][1][1][1]), "+v"(acc[0][1][2][0]), "+v"(acc[0][1][2][1]), "+v"(acc[0][1][3][0]), "+v"(acc[0][1][3][1])); \
        asm volatile("" : "+v"(acc[1][0][0][0]), "+v"(acc[1][0][0][1]), "+v"(acc[1][0][1][0]), "+v"(acc[1][0][1][1]), "+v"(acc[1][0][2][0]), "+v"(acc[1][0][2][1]), "+v"(acc[1][0][3][0]), "+v"(acc[1][0][3][1]), \
                          "+v"(acc[1][1][0][0]), "+v"(acc[1][1][0][1]), "+v"(acc[1][1][1][0]), "+v"(acc[1][1][1][1]), "+v"(acc[1][1][2][0]), "+v"(acc[1][1][2][1]), "+v"(acc[1][1][3][0]), "+v"(acc[1][1][3][1])); } while (0)
#define PG8_WAIT_V(n) asm volatile("s_waitcnt vmcnt(" #n ")" ::: "memory")
#define PG8_WAIT_L(n) asm volatile("s_waitcnt lgkmcnt(" #n ")" ::: "memory")
#define PG8_BAR __builtin_amdgcn_s_barrier()
#define PG8_SCHED __builtin_amdgcn_sched_barrier(0)
    Unit cur, nxt; int ui = 0;
    if (!S.next(0, cur)) return;
    f32x4 acc[2][2][4][2];
    bf16x8 At[4][2], B0[2][2], B1[2][2]; v8i32 At8[4], B08[2], B18[2];
    const char* cA = (const char*)g.A + (size_t)cur.pa * tstepA; const char* cB = (const char*)g.Bt + (size_t)cur.pb * tstepB;
    PG8_STAGE(PG8_SB(0, 0), cB, voffB); PG8_STAGE(PG8_SB(0, 1), cB + hstepB, voffB); PG8_STAGE(PG8_SA(0, 0), cA, voffA); PG8_STAGE(PG8_SA(0, 1), cA + hstepA, voffA);
    if (wr == 1) PG8_BAR;
    PG8_WAIT_V(2); PG8_BAR;
    PG8_STAGE(PG8_SB(1, 0), cB + kstep, voffB); PG8_STAGE(PG8_SA(1, 0), cA + kstep, voffA); PG8_STAGE(PG8_SB(1, 1), cB + hstepB + kstep, voffB);
    PG8_WAIT_V(0); PG8_BAR;
    for (;;) {
        const bool has_next = S.next(ui + 1, nxt);
        const typename Epi::Pre epre = E.pre(cur, lds, ui & 1, wid, lane);
        const char* nA = has_next ? (const char*)g.A + (size_t)nxt.pa * tstepA : cA; const char* nB = has_next ? (const char*)g.Bt + (size_t)nxt.pb * tstepB : cB;
#define PG8_WAITX(R) PG8_WAIT_V(8)
#define PG8_KBODY(t, R, LASTX) do { \
            const bool last = (LASTX); \
            const char* a1 = cA + (size_t)((t) + 1) * kstep; \
            const char* a2 = last ? nA : cA + (size_t)((t) + 2) * kstep; const char* b2 = last ? nB : cB + (size_t)((t) + 2) * kstep; \
            const char* a3 = a2 + kstep; const char* b3 = b2 + kstep; \
              \
            PG8_LDB(B0, 0, 0); PG8_LDB(B1, 0, 1); PG8_SCHED; PG8_LDA(At, 0, 0); PG8_STAGE(PG8_SA(1, 1), a1 + hstepA, voffA); \
            PG8_WAITX(R); PG8_WAIT_L(0); PG8_BAR; if ((t) == 0) { PG8_MMA0(0, 0, At, B0); PG8_MMA0(0, 1, At, B1); } else { PG8_MMA(0, 0, At, B0); PG8_MMA(0, 1, At, B1); } PG8_BAR; PG8_SCHED; \
              \
            PG8_LDA(At, 0, 1); PG8_STAGE(PG8_SB(0, 0), b2, voffB); PG8_STAGE(PG8_SB(0, 1), b2 + hstepB, voffB); PG8_STAGE(PG8_SA(0, 0), a2, voffA); \
            PG8_WAITX(R); PG8_WAIT_L(0); PG8_BAR; if ((t) == 0) { PG8_MMA0(1, 0, At, B0); PG8_MMA0(1, 1, At, B1); } else { PG8_MMA(1, 0, At, B0); PG8_MMA(1, 1, At, B1); } PG8_BAR; PG8_SCHED; \
              \
            PG8_LDB(B0, 1, 0); PG8_LDB(B1, 1, 1); PG8_SCHED; PG8_LDA(At, 1, 0); PG8_STAGE(PG8_SA(0, 1), a2 + hstepA, voffA); \
            PG8_WAIT_V(8); PG8_WAIT_L(0); PG8_BAR; PG8_MMA(0, 0, At, B0); PG8_MMA(0, 1, At, B1); PG8_BAR; PG8_SCHED; \
              \
            PG8_LDA(At, 1, 1); PG8_STAGE(PG8_SB(1, 0), b3, voffB); PG8_STAGE(PG8_SB(1, 1), b3 + hstepB, voffB); PG8_STAGE(PG8_SA(1, 0), a3, voffA); \
            PG8_WAIT_V(8); PG8_WAIT_L(0); PG8_BAR; PG8_MMA(1, 0, At, B0); PG8_MMA(1, 1, At, B1); PG8_BAR; PG8_SCHED; \
        } while (0)
        for (int t = 0; t < nt; t += 2) PG8_KBODY(t, false, t == nt - 2);
        if (wr == 0) PG8_BAR;
        PG8_TIE_ACC("s_nop 15\n\ts_nop 15");
        if constexpr (I8) {
#pragma unroll
            for (int a_ = 0; a_ < 2; ++a_)
#pragma unroll
                for (int b_ = 0; b_ < 2; ++b_)
#pragma unroll
                    for (int m_ = 0; m_ < 4; ++m_)
#pragma unroll
                        for (int n_ = 0; n_ < 2; ++n_)
#pragma unroll
                            for (int j_ = 0; j_ < 4; ++j_) { const float t_ = acc[a_][b_][m_][n_][j_]; acc[a_][b_][m_][n_][j_] = (float)__float_as_int(t_) * (b_ == 1 ? isc1 : isc0); }
        }
        E(acc, cur, wr, wc, fr, fq, epre);
        if (!has_next) break;
        cur = nxt; cA = nA; cB = nB; ++ui;
        if (wr == 1) PG8_BAR;
    }
    PG8_WAIT_V(0);
    PG8_BAR;
#undef PG8_SA
#undef PG8_SB
#undef PG8_STAGE
#undef PG8_LDA
#undef PG8_LDB
#undef PG8_MMA
#undef PG8_MMA0
#undef PG8_WAIT_V
#undef PG8_TIE_ACC
#undef PG8_WAITX
#undef PG8_KBODY
#undef PG8_WAIT_L
#undef PG8_BAR
#undef PG8_SCHED
}
}

namespace att {
#define MFMA32(a, b, c) __builtin_amdgcn_mfma_f32_32x32x16_bf16((a), (b), (c), 0, 0, 0)
DI int crow(int i, int h) { return (i & 3) + 8 * (i >> 2) + 4 * h; }
typedef short v4i16_t __attribute__((ext_vector_type(4)));
DI s16x4 vtr(const LAS unsigned char* p) { return __builtin_bit_cast(s16x4, __builtin_amdgcn_ds_read_tr16_b64_v4i16((LAS v4i16_t*)p)); }
DI bf16x8 packp(const f32x16& p, int b) {
    u32x4 w; w.x = pk2(p[b], p[b + 1]); w.y = pk2(p[b + 2], p[b + 3]); w.z = pk2(p[b + 4], p[b + 5]); w.w = pk2(p[b + 6], p[b + 7]);
    return __builtin_bit_cast(bf16x8, w);
}
constexpr float NEGBIG = -1.0e30f;
constexpr float DEFER_THR = 8.0f;
template <int DK, int MASK>
DI void tile_step(const LAS unsigned char* Kb, const LAS unsigned char* Vb, const int (&koff)[4], const bf16x8 (&qr)[DK / 16], f32x16& o0, f32x16& o1, float& m, float& l,
                  LAS float* wsf, int r, int h, int lane, int qi, int kj0, const bool first) {
    f32x16 p0, p1;
#pragma unroll
    for (int i = 0; i < 16; ++i) { p0[i] = 0.f; p1[i] = 0.f; }
#pragma unroll
    for (int ks = 0; ks < DK / 16; ++ks) {
        const bf16x8 a0 = *(const LAS bf16x8*)(Kb + koff[ks]);
        const bf16x8 a1 = *(const LAS bf16x8*)(Kb + koff[ks] + 4096);
        p0 = MFMA32(a0, qr[ks], p0); p1 = MFMA32(a1, qr[ks], p1);
    }
    if (MASK) {
        const int D = qi - kj0 - 4 * h;
#pragma unroll
        for (int i = 0; i < 16; ++i) { const int c0 = (i & 3) + 8 * (i >> 2);
            if (MASK == 1) { if (D > 64 + c0) p0[i] = NEGBIG; if (D > 96 + c0) p1[i] = NEGBIG; }
            else if (MASK == 2) { if (D < -64 + c0) p0[i] = NEGBIG; if (D < -32 + c0) p1[i] = NEGBIG; }
            else { if (D > 64 + c0 || D < -64 + c0) p0[i] = NEGBIG; if (D > 96 + c0 || D < -32 + c0) p1[i] = NEGBIG; } }
    }
    float tm = fmaxf(p0[0], p1[0]);
#pragma unroll
    for (int i = 1; i < 16; ++i) tm = fmaxf(tm, fmaxf(p0[i], p1[i]));
    tm = fmaxf(tm, __shfl_xor(tm, 32));
    if (first) m = tm;
    else if (__any(tm > m + DEFER_THR)) {
        const float mn = fmaxf(m, tm), al = ex2(m - mn); l *= al; m = mn;
        if (h == 0) wsf[r] = al;
#pragma unroll
        for (int i = 0; i < 16; ++i) { const float f = wsf[crow(i, h)]; o0[i] *= f; o1[i] *= f; }
    }
    float sum = 0.f;
#pragma unroll
    for (int i = 0; i < 16; ++i) { p0[i] = ex2(p0[i] - m); p1[i] = ex2(p1[i] - m); sum += p0[i] + p1[i]; }
    l += sum;
    const LAS unsigned char* vp = Vb + ((lane >> 4) & 1) * 32 + (lane & 3) * 8 + (4 * h + ((lane & 15) >> 2)) * 64;
#pragma unroll
    for (int s = 0; s < 4; ++s) {
        const bf16x8 pa = (s == 0) ? packp(p0, 0) : (s == 1) ? packp(p0, 8) : (s == 2) ? packp(p1, 0) : packp(p1, 8);
#pragma unroll
        for (int db = 0; db < 2; ++db) {
            const s16x4 lo = vtr(vp + db * 4096 + s * 1024), hi = vtr(vp + db * 4096 + s * 1024 + 512);
            const bf16x8 vf = {lo[0], lo[1], lo[2], lo[3], hi[0], hi[1], hi[2], hi[3]};
            if (db == 0) o0 = MFMA32(pa, vf, o0); else o1 = MFMA32(pa, vf, o1);
        }
    }
}
DI void finish_store(const f32x16& o0, const f32x16& o1, float l, LAS float* wsf, LAS unsigned short* stg, int r, int h, int lane, bf16* orow0, size_t rstride) {
    const float lt = l + __shfl_xor(l, 32);
    if (h == 0) wsf[r] = 1.0f / lt;
#pragma unroll
    for (int i = 0; i < 16; ++i) { const int row = crow(i, h); const float f = wsf[row];
        stg[row * 64 + r] = (unsigned short)(pk2(o0[i] * f, 0.f) & 0xffffu); stg[row * 64 + 32 + r] = (unsigned short)(pk2(o1[i] * f, 0.f) & 0xffffu); }
#pragma unroll
    for (int it = 0; it < 4; ++it) { const int row = it * 8 + (lane >> 3), ch = lane & 7;
        const u32x4 v = *(const LAS u32x4*)(stg + row * 64 + ch * 8);
        *(u32x4*)(orow0 + (size_t)row * rstride + ch * 8) = v; }
}
#define ATT_WAITBAR(N) asm volatile("s_waitcnt vmcnt(" #N ") lgkmcnt(0)\n\ts_barrier" ::: "memory")
DI void dma16(const void* gsrc, LAS unsigned char* ldst) { __builtin_amdgcn_global_load_lds((const unsigned*)gsrc, (LAS unsigned*)ldst, 16, 0, 0); }

template <int DK, bool MF = false>
DI void dense_unit(LAS unsigned char* lds, const bf16* qS, int qp, int q0, const bf16* kA, int kpA, const bf16* kB, const bf16* vS, int vpitch, bf16* oS, int op, const f32x2* taba,
                   const bool pre, const bf16* nkA, const bf16* nkB, const bf16* nvS) {
    constexpr int NKC = DK / 8, KSLOT = NKC * 1024, VSLOT = 8192, NS = 4, KS = DK / 16;
    constexpr int OFF_V = NS * KSLOT, OFF_WS = OFF_V + NS * VSLOT, OFF_STG = OFF_WS + NWAVES * 256;
    const int tid = fresh_tid(), lane = tid & 63, r = lane & 31, h = lane >> 5; const int w = __builtin_amdgcn_readfirstlane(tid >> 6);
    LAS float* wsf = (LAS float*)(lds + OFF_WS) + w * 64;
    LAS unsigned short* stg = (LAS unsigned short*)(lds + OFF_STG) + w * 2048;
    const bf16* ksrcA = kA + (size_t)(8 * w + (lane >> 3)) * kpA + ((lane & 7) ^ ((4 * w + (lane >> 4)) & 7)) * 8;
    const bf16* ksrcB = (DK == 96) ? (kB + (size_t)(16 * (w & 3) + (lane >> 2)) * 32 + ((lane & 3) ^ ((lane >> 4) & 3)) * 8) : kA;
    const bf16* vsrc = vS + (size_t)(16 * (w & 3) + (lane >> 2)) * vpitch + (w >> 2) * 32 + (lane & 3) * 8;
    const size_t kstA = (size_t)64 * kpA, kstB = 64 * 32, vst = (size_t)64 * vpitch;
    int koff[KS];
#pragma unroll
    for (int ks = 0; ks < KS; ++ks) koff[ks] = (ks < 4) ? (r * 128 + (((2 * ks + h) ^ ((r >> 1) & 7)) << 4)) : (8192 + r * 64 + (((2 * (ks - 4) + h) ^ ((r >> 2) & 3)) << 4));
#define ISSUE_K(t) do { const int sl_ = (t) % NS; dma16(ksrcA + (size_t)(t) * kstA, lds + sl_ * KSLOT + w * 1024); \
        if (DK == 96) dma16(ksrcB + (size_t)(t) * kstB, lds + sl_ * KSLOT + (8 + (w & 3)) * 1024); } while (0)
#define ISSUE_V(t) do { const int sl_ = (t) % NS; dma16(vsrc + (size_t)(t) * vst, lds + OFF_V + sl_ * VSLOT + w * 1024); } while (0)
    bf16x8 qr[KS];
    const bf16* qrow = qS + (size_t)(q0 + w * 32 + r) * qp + 8 * h;
#pragma unroll
    for (int ks = 0; ks < KS; ++ks) qr[ks] = *(const bf16x8*)(qrow + 16 * ks);
    if (!pre) { ISSUE_K(0); ISSUE_K(1); ISSUE_V(0); ISSUE_K(2); ISSUE_V(1); }
    if (DK == 96) {
        const f32x2* tp = taba + (size_t)(q0 + w * 32 + r) * 16 + 8 * h;
        bf16x8 a = qr[4], b = qr[5];
#pragma unroll
        for (int j = 0; j < 8; ++j) { const f32x2 cs = tp[j]; const float x1 = bf2f((unsigned short)a[j]), x2 = bf2f((unsigned short)b[j]);
            a[j] = (short)(pk2(x1 * cs.x - x2 * cs.y, 0.f) & 0xffffu); b[j] = (short)(pk2(x2 * cs.x + x1 * cs.y, 0.f) & 0xffffu); }
        qr[4] = a; qr[5] = b;
    }
    f32x16 o0, o1, negm, pA0, pA1, pB0, pB1;
#pragma unroll
    for (int i = 0; i < 16; ++i) { o0[i] = 0.f; o1[i] = 0.f; negm[i] = 0.f; }
    float m = 0.f, l = 0.f;
    const LAS unsigned char* kp0 = lds;
    const LAS unsigned char* vp0 = lds + OFF_V + ((lane >> 4) & 1) * 32 + (lane & 3) * 8 + (4 * h + ((lane & 15) >> 2)) * 64;
#define QK_TILE(P0, P1, kb_) do { _Pragma("unroll") for (int ks = 0; ks < KS; ++ks) { \
        const bf16x8 a0_ = *(const LAS bf16x8*)((kb_) + koff[ks]), a1_ = *(const LAS bf16x8*)((kb_) + koff[ks] + (ks < 4 ? 4096 : 2048)); \
        if (ks == 0) { P0 = MFMA32(a0_, qr[0], negm); P1 = MFMA32(a1_, qr[0], negm); } else { P0 = MFMA32(a0_, qr[ks], P0); P1 = MFMA32(a1_, qr[ks], P1); } } } while (0)
    constexpr int NT = SEQ / 64, G = (DK == 96) ? 3 : 2;
#define ROWMAX(dst, P0, P1) do { float a_ = fmaxf(fmaxf(P0[0], P0[1]), P1[0]), b_ = fmaxf(fmaxf(P0[2], P0[3]), P1[1]); a_ = fmaxf(fmaxf(a_, P1[2]), P1[3]); \
        _Pragma("unroll") for (int i = 4; i < 16; i += 4) { a_ = fmaxf(fmaxf(a_, P0[i]), P0[i + 1]); b_ = fmaxf(fmaxf(b_, P0[i + 2]), P0[i + 3]); a_ = fmaxf(fmaxf(a_, P1[i]), P1[i + 1]); b_ = fmaxf(fmaxf(b_, P1[i + 2]), P1[i + 3]); } \
        const float m_ = fmaxf(a_, b_); const auto rr_ = __builtin_amdgcn_permlane32_swap(__float_as_uint(m_), __float_as_uint(m_), false, false); \
        dst = fmaxf(__uint_as_float(rr_[0]), __uint_as_float(rr_[1])); } while (0)
    if (DK == 96) ATT_WAITBAR(6); else ATT_WAITBAR(4);
    QK_TILE(pA0, pA1, kp0);
    float dl = 0.f; bool rebase = !MF;
    if constexpr (!MF) ROWMAX(dl, pA0, pA1);
#define STEP(t, P0, P1, Pn0, Pn1) do { \
        if ((t) + 3 <= NT) { if (DK == 96) ATT_WAITBAR(3); else ATT_WAITBAR(2); } else ATT_WAITBAR(0);       \
        if ((t) + 3 < NT) ISSUE_K((t) + 3); if ((t) + 2 < NT) ISSUE_V((t) + 2); \
          \
        if (!MF && rebase) { m += dl; const float al = ex2(-dl); l *= al; \
              _Pragma("unroll") for (int i = 0; i < 16; ++i) { P0[i] -= dl; P1[i] -= dl; negm[i] = -m; } \
              if (h == 0) wsf[r] = al; \
              _Pragma("unroll") for (int i = 0; i < 16; ++i) { const float f = wsf[crow(i, h)]; o0[i] *= f; o1[i] *= f; } } \
          \
        if ((t) + 1 < NT) QK_TILE(Pn0, Pn1, kp0 + (((t) + 1) % NS) * KSLOT); \
        _Pragma("unroll") for (int i = 0; i < 16; ++i) { P0[i] = ex2(P0[i]); l += P0[i]; P1[i] = ex2(P1[i]); l += P1[i]; } \
        const bf16x8 pa0_ = packp(P0, 0), pa1_ = packp(P0, 8), pa2_ = packp(P1, 0), pa3_ = packp(P1, 8); \
          \
        { const LAS unsigned char* vp_ = vp0 + ((t) % NS) * VSLOT; \
          _Pragma("unroll") for (int s_ = 0; s_ < 4; ++s_) { const bf16x8 pa_ = (s_ == 0) ? pa0_ : (s_ == 1) ? pa1_ : (s_ == 2) ? pa2_ : pa3_; \
            _Pragma("unroll") for (int db = 0; db < 2; ++db) { const s16x4 lo_ = vtr(vp_ + db * 4096 + s_ * 1024), hi_ = vtr(vp_ + db * 4096 + s_ * 1024 + 512); \
                const bf16x8 vf_ = {lo_[0], lo_[1], lo_[2], lo_[3], hi_[0], hi_[1], hi_[2], hi_[3]}; \
                if (db == 0) o0 = MFMA32(pa_, vf_, o0); else o1 = MFMA32(pa_, vf_, o1); } } } \
        if constexpr (!MF) { if ((t) + 1 < NT) { float tm_; ROWMAX(tm_, Pn0, Pn1); dl = fmaxf(tm_, 0.f); rebase = __any(tm_ > DEFER_THR); } } \
    } while (0)
    if (w >= 4) __builtin_amdgcn_s_setprio(1);
    for (int t = 0; t < NT; t += 2) {
        STEP(t, pA0, pA1, pB0, pB1);
        STEP(t + 1, pB0, pB1, pA0, pA1);
    }
    __builtin_amdgcn_s_setprio(0);
    if (nkA) {
        asm volatile("s_waitcnt lgkmcnt(0)\n\ts_barrier" ::: "memory");
        const bf16* nA_ = nkA + (size_t)(8 * w + (lane >> 3)) * kpA + ((lane & 7) ^ ((4 * w + (lane >> 4)) & 7)) * 8;
        const bf16* nB_ = (DK == 96) ? (nkB + (size_t)(16 * (w & 3) + (lane >> 2)) * 32 + ((lane & 3) ^ ((lane >> 4) & 3)) * 8) : nkA;
        const bf16* nV_ = nvS + (size_t)(16 * (w & 3) + (lane >> 2)) * vpitch + (w >> 2) * 32 + (lane & 3) * 8;
#define NISSUE_K(t) do { dma16(nA_ + (size_t)(t) * kstA, lds + (t) * KSLOT + w * 1024); if (DK == 96) dma16(nB_ + (size_t)(t) * kstB, lds + (t) * KSLOT + (8 + (w & 3)) * 1024); } while (0)
#define NISSUE_V(t) dma16(nV_ + (size_t)(t) * vst, lds + OFF_V + (t) * VSLOT + w * 1024)
        NISSUE_K(0); NISSUE_K(1); NISSUE_V(0); NISSUE_K(2); NISSUE_V(1);
#undef NISSUE_K
#undef NISSUE_V
    }
    finish_store(o0, o1, l, wsf, stg, r, h, lane, oS + (size_t)(q0 + w * 32) * op, (size_t)op);
    if (!nkA) ATT_WAITBAR(0);
#undef STEP
#undef ROWMAX
#undef QK_TILE
#undef ISSUE_K
#undef ISSUE_V
}

DI void dil_decode(int u, int& grp, int& b, int& head, int& res, int& c) {
    grp = u >> 10; const int idx = u & 1023; b = idx >> 6; head = (idx >> 3) & 7;
    res = grp == 0 ? 0 : (grp == 1 ? ((idx >> 1) & 3) : (idx & 7)); c = grp == 0 ? (idx & 7) : (grp == 1 ? (idx & 1) : 0);
}
DI void dil_issue(LAS unsigned char* lds, int u, const bf16* qkv) {
    constexpr int SLOT = 16384;
    int grp, b, head, res, c; dil_decode(u, grp, b, head, res, c);
    const int tid = fresh_tid(), lane = tid & 63; const int w = __builtin_amdgcn_readfirstlane(tid >> 6);
    const int dil = grp == 0 ? 1 : (grp == 1 ? 4 : 16), L = SEQ / dil, ntile = L / 64;
    const bf16* qb = qkv + (size_t)((((b * 3 + grp) * 3 + 0) * 8 + head) * SEQ) * 64;
    const bf16* kbp = qb + (size_t)8 * SEQ * 64; const bf16* vbp = qb + (size_t)16 * SEQ * 64;
#pragma unroll
    for (int s = 0; s < 6; ++s) {
        int sres, kb; bool valid;
        if (grp < 2) { sres = res; kb = 4 * c - 1 + s; valid = (kb >= 0) && (kb < ntile); }
        else { sres = 2 * res + (s >> 1); kb = s & 1; valid = s < 4; }
        if (valid) {
            const int krow = 64 * kb + 8 * w + (lane >> 3), vrow = 64 * kb + 16 * (w & 3) + (lane >> 2);
            dma16(kbp + (size_t)(sres * L + krow) * 64 + ((lane & 7) ^ ((4 * w + (lane >> 4)) & 7)) * 8, lds + s * SLOT + w * 1024);
            dma16(vbp + (size_t)(sres * L + vrow) * 64 + (w >> 2) * 32 + (lane & 3) * 8, lds + s * SLOT + 8192 + w * 1024);
        }
    }
}
DI void dil_qload(int u, const bf16* qkv, bf16x8 (&qr)[4]) {
    int grp, b, head, res, c; dil_decode(u, grp, b, head, res, c);
    const int tid = fresh_tid(), lane = tid & 63, r = lane & 31, h = lane >> 5; const int w = __builtin_amdgcn_readfirstlane(tid >> 6);
    const int dil = grp == 0 ? 1 : (grp == 1 ? 4 : 16), L = SEQ / dil;
    const bf16* qb = qkv + (size_t)((((b * 3 + grp) * 3 + 0) * 8 + head) * SEQ) * 64;
    int wres, qi0;
    if (grp < 2) { wres = res; qi0 = 256 * c + 32 * w; } else { wres = 2 * res + (w >> 2); qi0 = 32 * (w & 3); }
    const bf16* qrow = qb + (size_t)(wres * L + qi0 + r) * 64 + 8 * h;
#pragma unroll
    for (int ks = 0; ks < 4; ++ks) qr[ks] = *(const bf16x8*)(qrow + 16 * ks);
}
DI void dil_unit(LAS unsigned char* lds, int u, int unext, const bf16* qkv, bf16* og, float* lse, const bf16x8 (&qr)[4], bf16x8 (&qn)[4]) {
    constexpr int SLOT = 16384, OFF_WS = 6 * SLOT, OFF_STG = OFF_WS + NWAVES * 256;
    int grp, b, head, res, c; dil_decode(u, grp, b, head, res, c);
    const int tid = fresh_tid(), lane = tid & 63, r = lane & 31, h = lane >> 5; const int w = __builtin_amdgcn_readfirstlane(tid >> 6);
    LAS float* wsf = (LAS float*)(lds + OFF_WS) + w * 64;
    LAS unsigned short* stg = (LAS unsigned short*)(lds + OFF_STG) + w * 2048;
    const int dil = grp == 0 ? 1 : (grp == 1 ? 4 : 16), L = SEQ / dil, ntile = L / 64;
    const bf16* qb = qkv + (size_t)((((b * 3 + grp) * 3 + 0) * 8 + head) * SEQ) * 64;
    int wres, qi0, s0, kb0, nts;
    if (grp < 2) { wres = res; qi0 = 256 * c + 32 * w; s0 = w >> 1; kb0 = 4 * c + (w >> 1) - 1; nts = 3; }
    else { wres = 2 * res + (w >> 2); qi0 = 32 * (w & 3); s0 = 2 * (w >> 2); kb0 = 0; nts = 2; }
    int koff[4];
#pragma unroll
    for (int ks = 0; ks < 4; ++ks) koff[ks] = r * 128 + (((2 * ks + h) ^ ((r >> 1) & 7)) << 4);
    f32x16 o0, o1;
#pragma unroll
    for (int i = 0; i < 16; ++i) { o0[i] = 0.f; o1[i] = 0.f; }
    float m = NEGBIG, l = 0.f;
    ATT_WAITBAR(0);
    bool first = true;
    for (int j = 0; j < nts; ++j) {
        const int kb = kb0 + j;
        if (kb >= 0 && kb < ntile) {
            const LAS unsigned char* sp = lds + (s0 + j) * SLOT;
            const int rel = (grp < 2) ? j - 1 : j - ((w & 3) >> 1);
            if (rel == 0) tile_step<64, 0>(sp, sp + 8192, koff, qr, o0, o1, m, l, wsf, r, h, lane, qi0 + r, 64 * kb, first);
            else if (rel < 0) tile_step<64, 1>(sp, sp + 8192, koff, qr, o0, o1, m, l, wsf, r, h, lane, qi0 + r, 64 * kb, first);
            else tile_step<64, 2>(sp, sp + 8192, koff, qr, o0, o1, m, l, wsf, r, h, lane, qi0 + r, 64 * kb, first);
            first = false;
        }
    }
    asm volatile("s_waitcnt lgkmcnt(0)\n\ts_barrier" ::: "memory");
    if (unext >= 0) { dil_issue(lds, unext, qkv); dil_qload(unext, qkv, qn); }
    const size_t tok0 = (size_t)b * SEQ + wres + (size_t)dil * qi0;
    finish_store(o0, o1, l, wsf, stg, r, h, lane, og + tok0 * 512 + head * 64, (size_t)dil * 512);
    const float lt = l + __shfl_xor(l, 32);
    if (h == 0) lse[(tok0 + (size_t)dil * r) * 8 + head] = m + __builtin_amdgcn_logf(lt);
}
}

#define XB_TMO      128
#define XB_XCNT(j)  (256  + 64 * (j))
#define XB_XSUB(j)  (1280 + 64 * (j))
#define XB_XGEN(j)  (2304 + 64 * (j))
#define XB_TOP      3328
#define XB_TOPGEN   3392
#define XCD_BAR_WORDS 3456
#define XB_SPIN_CAP (1u << 18)
DI unsigned xb_ld(unsigned* p)              { return __hip_atomic_load(p, __ATOMIC_RELAXED, __HIP_MEMORY_SCOPE_AGENT); }
DI unsigned xb_add(unsigned* p, unsigned v) { return __hip_atomic_fetch_add(p, v, __ATOMIC_RELAXED, __HIP_MEMORY_SCOPE_AGENT); }
DI unsigned xb_xcc_id() { return (unsigned)__builtin_amdgcn_s_getreg((3 << 11) | 20) & 0xFu; }
#define XB_SPIN(cond, bar) do { unsigned _sp = 0; while (cond) { __builtin_amdgcn_s_sleep(1); \
    if ((++_sp & 255u) == 0u) { if (xb_ld(&(bar)[XB_TMO])) break; if (_sp > XB_SPIN_CAP) { atomicAdd(&(bar)[XB_TMO], 1u); break; } } } } while (0)
struct XcdBarrier { unsigned* bar; unsigned x; volatile LAS unsigned* st; };
DI XcdBarrier xcd_barrier_post(unsigned* bar, volatile LAS unsigned* st) {
    XcdBarrier b; b.bar = bar; b.x = xb_xcc_id(); b.st = st;
    if (threadIdx.x == 0) (void)xb_add(&bar[XB_XCNT(b.x)], 1u);
    return b;
}
DI void xcd_barrier_complete(unsigned* bar, unsigned x, unsigned& nloc, unsigned& nx) {
    const unsigned G = gridDim.x * gridDim.y * gridDim.z;
    unsigned sum, cnt, mine, sp = 0u;
    for (;;) {
        sum = 0u; cnt = 0u; mine = 0u;
#pragma unroll
        for (unsigned j = 0; j < 16; ++j) { const unsigned c = xb_ld(&bar[XB_XCNT(j)]); sum += c; cnt += (c > 0u) ? 1u : 0u; mine = (j == x) ? c : mine; }
        if (sum == G) break;
        __builtin_amdgcn_s_sleep(1);
        if ((++sp & 255u) == 0u) { if (xb_ld(&bar[XB_TMO])) break; if (sp > XB_SPIN_CAP) { atomicAdd(&bar[XB_TMO], 1u); break; } }
    }
    nloc = mine > 0u ? mine : 1u; nx = cnt > 0u ? cnt : 1u;
}
DI void xcd_barrier(const XcdBarrier& b) {
    asm volatile("s_waitcnt vmcnt(0)" ::: "memory");
    __syncthreads();
    if (threadIdx.x == 0) {
        unsigned* bar = b.bar;
        __builtin_amdgcn_s_waitcnt(0);
        unsigned nloc = b.st[0], nx = b.st[1];
        if (nloc == 0u) { xcd_barrier_complete(bar, b.x, nloc, nx); b.st[0] = nloc; b.st[1] = nx; }
        const unsigned old = xb_add(&bar[XB_XSUB(b.x)], 1u);
        const unsigned gen = old / nloc;
        if (old + 1u == (gen + 1u) * nloc) {
            __builtin_amdgcn_fence(__ATOMIC_RELEASE, "agent");
            asm volatile("s_waitcnt vmcnt(0)" ::: "memory");
            const unsigned og = xb_add(&bar[XB_TOP], 1u);
            const unsigned tg = og / nx;
            if (og + 1u == (tg + 1u) * nx) xb_add(&bar[XB_TOPGEN], 1u);
            else XB_SPIN(xb_ld(&bar[XB_TOPGEN]) == tg, bar);
            __builtin_amdgcn_fence(__ATOMIC_ACQUIRE, "agent");
            xb_add(&bar[XB_XGEN(b.x)], 1u);
            asm volatile("s_waitcnt vmcnt(0)" ::: "memory");
        } else {
            XB_SPIN(xb_ld(&bar[XB_XGEN(b.x)]) == gen, bar);
            __builtin_amdgcn_fence(__ATOMIC_ACQUIRE, "agent");
            asm volatile("s_waitcnt vmcnt(0)" ::: "memory");
        }
    }
    __syncthreads();
}

struct Ctx { int wave, G, bid; LAS unsigned char* lds; };

template <int F8>
DI void transpose_item(const float* W, int K, int N, void* WTv, int ldo, int row_off, int gu, LAS float* scr, int item, int lane, const float* gk = nullptr, const float wscale = 0.f) {
    const float sw8 = wscale != 0.f ? wscale : pg8::SW8, sw4 = wscale != 0.f ? wscale : 64.f;
    const int nblk = N / 32, kb = item / nblk, nb = item % nblk, k0 = 64 * kb, n0 = 32 * nb;
    float v[32];
    const float* src = W + (size_t)(k0 + (lane >> 5)) * N + n0 + (lane & 31);
#pragma unroll
    for (int i = 0; i < 32; ++i) v[i] = __builtin_nontemporal_load(src + (size_t)(2 * i) * N);
    if (gk) {
#pragma unroll
        for (int i = 0; i < 32; ++i) v[i] *= gk[k0 + 2 * i + (lane >> 5)];
    }
#pragma unroll
    for (int i = 0; i < 32; ++i) scr[(2 * i + (lane >> 5)) * 33 + (lane & 31)] = v[i];
    asm volatile("s_waitcnt lgkmcnt(0)" ::: "memory");
    const int c = lane & 7;
    const int orow0 = row_off + (gu == 0 ? n0 : ((n0 >> 7) * 256 + (gu - 1) * 128 + (n0 & 127)));
#pragma unroll
    for (int j = 0; j < 4; ++j) { const int n = (lane >> 3) + 8 * j; const LAS float* s = scr + (8 * c) * 33 + n;
        if (F8 == 2) { u32x2 o; o.x = pg8::pk4_i8(sw8 * s[0 * 33], sw8 * s[1 * 33], sw8 * s[2 * 33], sw8 * s[3 * 33]); o.y = pg8::pk4_i8(sw8 * s[4 * 33], sw8 * s[5 * 33], sw8 * s[6 * 33], sw8 * s[7 * 33]);
            *(u32x2*)((unsigned char*)WTv + (size_t)(orow0 + n) * ldo + k0 + 8 * c) = o; }
        else if (F8 == 1) { u32x2 o; o.x = pg8::pk4_fp8(sw4 * s[0 * 33], sw4 * s[1 * 33], sw4 * s[2 * 33], sw4 * s[3 * 33]); o.y = pg8::pk4_fp8(sw4 * s[4 * 33], sw4 * s[5 * 33], sw4 * s[6 * 33], sw4 * s[7 * 33]);
            *(u32x2*)((unsigned char*)WTv + (size_t)(orow0 + n) * ldo + k0 + 8 * c) = o; }
        else { u32x4 o; o.x = pk2(s[0 * 33], s[1 * 33]); o.y = pk2(s[2 * 33], s[3 * 33]); o.z = pk2(s[4 * 33], s[5 * 33]); o.w = pk2(s[6 * 33], s[7 * 33]);
            *(u32x4*)((bf16*)WTv + (size_t)(orow0 + n) * ldo + k0 + 8 * c) = o; } }
    asm volatile("s_waitcnt lgkmcnt(0)" ::: "memory");
}

DI void sincos_d(double a, float& c, float& s) {
    const double TWO_PI = 6.283185307179586476925286766559, INV = 0.15915494309189533576888376337251;
    const double n = __builtin_rint(a * INV); double x = (a - n * TWO_PI) * 0.25; const double x2 = x * x;
    double sn = x * (1.0 + x2 * (-1.0 / 6 + x2 * (1.0 / 120 + x2 * (-1.0 / 5040 + x2 * (1.0 / 362880 + x2 * (-1.0 / 39916800 + x2 * (1.0 / 6227020800.0)))))));
    double cs = 1.0 + x2 * (-0.5 + x2 * (1.0 / 24 + x2 * (-1.0 / 720 + x2 * (1.0 / 40320 + x2 * (-1.0 / 3628800 + x2 * (1.0 / 479001600.0))))));
#pragma unroll
    for (int i = 0; i < 2; ++i) { const double s2 = 2.0 * sn * cs, c2 = cs * cs - sn * sn; sn = s2; cs = c2; }
    c = (float)cs; s = (float)sn;
}

constexpr float SA1 = 32.0f, SW1 = 1000.0f;
DI void rows_first(const Ctx& C, const float* x, bf16* hb, float* rstd, unsigned char* x8) {
    const int gw = C.bid * NWAVES + C.wave, NGW = C.G * NWAVES, lane = fresh_tid() & 63;
    for (int m = gw; m < NTOK; m += 2 * NGW) {
        const f32x4* xr0 = (const f32x4*)(x + (size_t)m * DM) + lane; const f32x4* xr1 = (const f32x4*)(x + (size_t)(m + NGW) * DM) + lane;
        f32x4 v[4], w[4]; float s0 = 0.f, s1 = 0.f;
#pragma unroll
        for (int j = 0; j < 4; ++j) { v[j] = __builtin_nontemporal_load(xr0 + 64 * j); w[j] = __builtin_nontemporal_load(xr1 + 64 * j); }
#pragma unroll
        for (int j = 0; j < 4; ++j) { s0 += (v[j].x * v[j].x + v[j].y * v[j].y) + (v[j].z * v[j].z + v[j].w * v[j].w); s1 += (w[j].x * w[j].x + w[j].y * w[j].y) + (w[j].z * w[j].z + w[j].w * w[j].w); }
        const float r0 = rsq(wave_sum(s0) * (1.f / DM) + EPS), r1 = rsq(wave_sum(s1) * (1.f / DM) + EPS);
        u32x2* o0 = (u32x2*)(hb + (size_t)m * DM) + lane; u32x2* o1 = (u32x2*)(hb + (size_t)(m + NGW) * DM) + lane;
#pragma unroll
        for (int j = 0; j < 4; ++j) { u32x2 a, b; a.x = pk2(v[j].x, v[j].y); a.y = pk2(v[j].z, v[j].w); b.x = pk2(w[j].x, w[j].y); b.y = pk2(w[j].z, w[j].w); o0[64 * j] = a; o1[64 * j] = b; }
        { unsigned* q0 = (unsigned*)(x8 + (size_t)m * DM) + lane; unsigned* q1 = (unsigned*)(x8 + (size_t)(m + NGW) * DM) + lane; const float a0 = r0 * SA1, a1 = r1 * SA1;
#pragma unroll
          for (int j = 0; j < 4; ++j) { q0[64 * j] = pg8::pk4_i8(v[j].x * a0, v[j].y * a0, v[j].z * a0, v[j].w * a0); q1[64 * j] = pg8::pk4_i8(w[j].x * a1, w[j].y * a1, w[j].z * a1, w[j].w * a1); } }
        if (lane == 0) { rstd[m] = r0; rstd[m + NGW] = r1; }
    }
}

struct RowRaw { u32x2 t1[4], t2[4], hb[4]; f32x4 h32[4]; f32x2 gg; };
template <bool MOE, bool HIN32>
DI void row_load(RowRaw& R, int m, int lane_, const float* hin32, const bf16* hb, const bf16* term, const int* toks, const f32x2* tokg) {
    if (MOE) {
        const int s1 = toks[2 * m], s2 = toks[2 * m + 1]; R.gg = tokg[m];
        const u32x2* y1 = (const u32x2*)(term + (size_t)s1 * DM) + lane_; const u32x2* y2 = (const u32x2*)(term + (size_t)s2 * DM) + lane_;
#pragma unroll
        for (int j = 0; j < 4; ++j) { R.t1[j] = __builtin_nontemporal_load(y1 + 64 * j); R.t2[j] = __builtin_nontemporal_load(y2 + 64 * j); }
    } else {
        const u32x2* tr = (const u32x2*)(term + (size_t)m * DM) + lane_;
#pragma unroll
        for (int j = 0; j < 4; ++j) R.t1[j] = __builtin_nontemporal_load(tr + 64 * j);
    }
    if (HIN32) { const f32x4* hr = (const f32x4*)(hin32 + (size_t)m * DM) + lane_;
#pragma unroll
        for (int j = 0; j < 4; ++j) R.h32[j] = hr[64 * j];
    } else { const u32x2* hr = (const u32x2*)(hb + (size_t)m * DM) + lane_;
#pragma unroll
        for (int j = 0; j < 4; ++j) R.hb[j] = hr[64 * j];
    }
}
template <bool MOE, bool NEXT, bool ROUTE, bool HIN32, bool FINAL, int X8 = 0>
DI void rows_residual(const Ctx& C, const float* hin32, bf16* hb, float* out32, const bf16* term, const float* gpost, const float* gnext, float* rstd,
                      const int* toks, const f32x2* tokg, const float* wrouter, int* toke, f32x2* tokg_out, int* cnt_out, unsigned char* xn8 = nullptr) {
    const int gw = C.bid * NWAVES + C.wave, NGW = C.G * NWAVES, tid_ = fresh_tid(), lane_ = tid_ & 63;
    f32x4 gp[4], gn[4];
#pragma unroll
    for (int j = 0; j < 4; ++j) { gp[j] = *((const f32x4*)gpost + lane_ + 64 * j); gn[j] = ROUTE ? *((const f32x4*)gnext + lane_ + 64 * j) : (f32x4){0.f, 0.f, 0.f, 0.f}; }
    LAS int* lcnt = (LAS int*)C.lds;
    if (ROUTE) { if (tid_ < 8) lcnt[tid_] = 0; __syncthreads(); }
    const int rows_per_wave = NTOK / NGW;
    const int nrows = ROUTE ? rows_per_wave : (NTOK - gw + NGW - 1) / NGW;
#define ROW_OF(it_) (ROUTE ? (gw * rows_per_wave + (it_)) : (gw + (it_) * NGW))
    RowRaw cur, nxt;
    if (nrows > 0) row_load<MOE, HIN32>(cur, ROW_OF(0), lane_, hin32, hb, term, toks, tokg);
    for (int it = 0; it < nrows; ++it) {
        const int m = ROW_OF(it);
        if (it + 1 < nrows) row_load<MOE, HIN32>(nxt, ROW_OF(it + 1), lane_, hin32, hb, term, toks, tokg);
        f32x4 t[4], hv[4];
#pragma unroll
        for (int j = 0; j < 4; ++j) { const u32x2 a = cur.t1[j];
            if (MOE) { const u32x2 b = cur.t2[j]; const f32x2 gg = cur.gg;
                t[j].x = gg.x * __uint_as_float(a.x << 16) + gg.y * __uint_as_float(b.x << 16); t[j].y = gg.x * __uint_as_float(a.x & 0xffff0000u) + gg.y * __uint_as_float(b.x & 0xffff0000u);
                t[j].z = gg.x * __uint_as_float(a.y << 16) + gg.y * __uint_as_float(b.y << 16); t[j].w = gg.x * __uint_as_float(a.y & 0xffff0000u) + gg.y * __uint_as_float(b.y & 0xffff0000u); }
            else { t[j].x = __uint_as_float(a.x << 16); t[j].y = __uint_as_float(a.x & 0xffff0000u); t[j].z = __uint_as_float(a.y << 16); t[j].w = __uint_as_float(a.y & 0xffff0000u); }
            if (HIN32) hv[j] = cur.h32[j];
            else { const u32x2 c = cur.hb[j]; hv[j].x = __uint_as_float(c.x << 16); hv[j].y = __uint_as_float(c.x & 0xffff0000u); hv[j].z = __uint_as_float(c.y << 16); hv[j].w = __uint_as_float(c.y & 0xffff0000u); } }
        float s = 0.f;
#pragma unroll
        for (int j = 0; j < 4; ++j) s += (t[j].x * t[j].x + t[j].y * t[j].y) + (t[j].z * t[j].z + t[j].w * t[j].w);
        const float ri = rsq(wave_sum(s) * (1.f / DM) + EPS);
        float s2 = 0.f;
#pragma unroll
        for (int j = 0; j < 4; ++j) { hv[j] = hv[j] + t[j] * ri * gp[j]; s2 += (hv[j].x * hv[j].x + hv[j].y * hv[j].y) + (hv[j].z * hv[j].z + hv[j].w * hv[j].w); }
        if (FINAL) { f32x4* ho = (f32x4*)(out32 + (size_t)m * DM) + lane_;
#pragma unroll
            for (int j = 0; j < 4; ++j) ho[64 * j] = hv[j];
        } else { u32x2* o8 = (u32x2*)(hb + (size_t)m * DM) + lane_;
#pragma unroll
            for (int j = 0; j < 4; ++j) { u32x2 o; o.x = pk2(hv[j].x, hv[j].y); o.y = pk2(hv[j].z, hv[j].w); o8[64 * j] = o; }
        }
        if (NEXT) {
            const float r2 = rsq(wave_sum(s2) * (1.f / DM) + EPS);
            if (lane_ == 0) rstd[m] = r2;
            if (X8) { unsigned* o4 = (unsigned*)(xn8 + (size_t)m * DM) + lane_;
#pragma unroll
                for (int j = 0; j < 4; ++j) { const float q_ = (X8 == 2) ? r2 * pg8::SA8 : r2; o4[64 * j] = (X8 == 2) ? pg8::pk4_i8(hv[j].x * q_, hv[j].y * q_, hv[j].z * q_, hv[j].w * q_) : pg8::pk4_fp8(hv[j].x * q_, hv[j].y * q_, hv[j].z * q_, hv[j].w * q_); } }
            if (ROUTE) {
#pragma unroll
                for (int j = 0; j < 4; ++j) hv[j] = hv[j] * r2 * gn[j];
                float lg[8];
#pragma unroll
                for (int e = 0; e < 8; ++e) lg[e] = 0.f;
#pragma unroll
                for (int j = 0; j < 4; ++j)
#pragma unroll
                    for (int q = 0; q < 4; ++q) { const f32x4* wp = (const f32x4*)(wrouter + (size_t)(4 * lane_ + 256 * j + q) * 8); const f32x4 w0 = wp[0], w1 = wp[1]; const float a = hv[j][q];
                        lg[0] += a * w0.x; lg[1] += a * w0.y; lg[2] += a * w0.z; lg[3] += a * w0.w; lg[4] += a * w1.x; lg[5] += a * w1.y; lg[6] += a * w1.z; lg[7] += a * w1.w; }
#pragma unroll
                for (int e = 0; e < 8; ++e) lg[e] = wave_sum(lg[e]);
                int e1 = 0; float l1 = lg[0];
#pragma unroll
                for (int e = 1; e < 8; ++e) if (lg[e] > l1) { l1 = lg[e]; e1 = e; }
                int e2 = -1; float l2 = -3.0e38f;
#pragma unroll
                for (int e = 0; e < 8; ++e) if (e != e1 && lg[e] > l2) { l2 = lg[e]; e2 = e; }
                if (lane_ == 0) { const float p2 = 1.0f / (1.0f + ex2((l1 - l2) * LOG2E)); toke[m] = e1 | (e2 << 8); tokg_out[m] = (f32x2){1.0f - p2, p2};
                    atomicAdd((int*)lcnt + e1, 1); atomicAdd((int*)lcnt + e2, 1); }
            }
        }
        cur = nxt;
    }
#undef ROW_OF
    if (ROUTE) { __syncthreads(); if (tid_ < 8) cnt_out[C.bid * 8 + tid_] = lcnt[tid_]; }
}

DI void rows_l0_post(const Ctx& C, const bf16* zin, const float* gq, const float* gk, const float* gcq, const float* gckv, const f32x2* taba,
                     bf16* qa, bf16* ka, bf16* cqn, bf16* ckvn, bf16* kr, float* krn) {
    const int gw = C.bid * NWAVES + C.wave, NGW = C.G * NWAVES, lane = fresh_tid() & 63;
    const int s8 = lane & 7;
    float gqv[8], gkv[8], gcqv[8], gckvv[8];
#pragma unroll
    for (int j = 0; j < 8; ++j) { gqv[j] = gq[8 * s8 + j]; gkv[j] = gk[8 * s8 + j]; gcqv[j] = gcq[8 * (lane & 31) + j]; gckvv[j] = gckv[8 * (lane & 15) + j]; }
    const int part = s8 >> 2, isx2 = (s8 >> 1) & 1, fb = 8 * (s8 & 1);
    u32x4 c0 = (u32x4){0u, 0u, 0u, 0u}, c1 = c0, c2 = c0;
    if (gw < NTOK) { const bf16* z0 = zin + (size_t)gw * ZW; c0 = __builtin_nontemporal_load((const u32x4*)(z0 + 8 * lane)); c1 = __builtin_nontemporal_load((const u32x4*)(z0 + 512 + 8 * lane));
        if (lane < 32) c2 = __builtin_nontemporal_load((const u32x4*)(z0 + 1024 + 8 * lane)); }
    for (int tok = gw; tok < NTOK; tok += NGW) {
        const int t = tok & (SEQ - 1), prow = t >> 6, pcol = t & 63;
        u32x4 n0 = (u32x4){0u, 0u, 0u, 0u}, n1 = n0, n2 = n0;
        if (tok + NGW < NTOK) { const bf16* zn = zin + (size_t)(tok + NGW) * ZW; n0 = __builtin_nontemporal_load((const u32x4*)(zn + 8 * lane)); n1 = __builtin_nontemporal_load((const u32x4*)(zn + 512 + 8 * lane));
            if (lane < 32) n2 = __builtin_nontemporal_load((const u32x4*)(zn + 1024 + 8 * lane)); }
        float x[8], y[8], p[8];
        unpack8(c0, x);
        float ss = 0.f;
#pragma unroll
        for (int j = 0; j < 8; ++j) ss += x[j] * x[j];
        ss += __shfl_xor(ss, 1); ss += __shfl_xor(ss, 2); ss += __shfl_xor(ss, 4);
        float ri = rsq(ss * (1.f / 64) + EPS);
#pragma unroll
        for (int j = 0; j < 8; ++j) y[j] = x[j] * ri * gqv[j];
#pragma unroll
        for (int j = 0; j < 8; ++j) p[j] = __shfl_xor(y[j], 2);
        const f32x2* tp = taba + (size_t)(part ? pcol : prow) * 16 + fb;
#pragma unroll
        for (int j = 0; j < 8; ++j) { const f32x2 cs = tp[j]; y[j] = (isx2 ? (y[j] * cs.x + p[j] * cs.y) : (y[j] * cs.x - p[j] * cs.y)) * C2_64; }
        *(u32x4*)(qa + (size_t)tok * 512 + 8 * lane) = pack8(y);
        unpack8(c1, x);
        ss = 0.f;
#pragma unroll
        for (int j = 0; j < 8; ++j) ss += x[j] * x[j];
        float s3 = ss; s3 += __shfl_xor(s3, 1); s3 += __shfl_xor(s3, 2); s3 += __shfl_xor(s3, 4);
        float s5 = s3; s5 += __shfl_xor(s5, 8); s5 += __shfl_xor(s5, 16);
        if (lane < 16) {
            ri = rsq(s3 * (1.f / 64) + EPS);
#pragma unroll
            for (int j = 0; j < 8; ++j) y[j] = x[j] * ri * gkv[j];
        } else {
            ri = rsq(s5 * (1.f / 256) + EPS);
#pragma unroll
            for (int j = 0; j < 8; ++j) y[j] = x[j] * ri * gcqv[j];
        }
#pragma unroll
        for (int j = 0; j < 8; ++j) p[j] = __shfl_xor(y[j], 2);
        if (lane < 16) {
#pragma unroll
            for (int j = 0; j < 8; ++j) { const f32x2 cs = tp[j]; y[j] = isx2 ? (y[j] * cs.x + p[j] * cs.y) : (y[j] * cs.x - p[j] * cs.y); }
            *(u32x4*)(ka + (size_t)tok * 128 + 8 * lane) = pack8(y);
        } else if (lane >= 32) {
            *(u32x4*)(cqn + (size_t)tok * 256 + 8 * (lane - 32)) = pack8(y);
        }
        unpack8(c2, x);
        ss = 0.f;
#pragma unroll
        for (int j = 0; j < 8; ++j) ss += x[j] * x[j];
        ss += __shfl_xor(ss, 1); ss += __shfl_xor(ss, 2); ss += __shfl_xor(ss, 4); ss += __shfl_xor(ss, 8);
        if (lane == 16) krn[tok] = ss;
#pragma unroll
        for (int j = 0; j < 8; ++j) p[j] = __shfl_xor(x[j], 2);
        if (lane < 16) {
            ri = rsq(ss * (1.f / 128) + EPS);
#pragma unroll
            for (int j = 0; j < 8; ++j) y[j] = x[j] * ri * gckvv[j];
            *(u32x4*)(ckvn + (size_t)tok * 256 + 8 * lane) = pack8(y);
        } else if (lane < 32) {
            *(u32x4*)(ckvn + (size_t)tok * 256 + 8 * lane) = (u32x4){0u, 0u, 0u, 0u};
            if (lane < 20) {
                const int sl = lane - 16; const f32x2* tq = taba + (size_t)t * 16 + 8 * (sl & 1);
#pragma unroll
                for (int j = 0; j < 8; ++j) { const f32x2 cs = tq[j]; y[j] = (sl >> 1) ? (x[j] * cs.x + p[j] * cs.y) : (x[j] * cs.x - p[j] * cs.y); }
                *(u32x4*)(kr + (size_t)tok * 32 + 8 * sl) = pack8(y);
            }
        }
        c0 = n0; c1 = n1; c2 = n2;
    }
}

DI void rows_merge(const Ctx& C, const bf16* og, const float* lse, bf16* o1) {
    const int gw = C.bid * NWAVES + C.wave, NGW = C.G * NWAVES, lane = fresh_tid() & 63, head = lane >> 3;
    u32x4 ra = (u32x4){0u, 0u, 0u, 0u}, rb = ra, rc = ra; float l0 = 0.f, l1 = 0.f, l2 = 0.f;
#define MERGE_LOAD(A, B, Cc, L0, L1, L2, tk) do { A = __builtin_nontemporal_load((const u32x4*)(og + (size_t)(tk) * 512 + 8 * lane)); B = __builtin_nontemporal_load((const u32x4*)(og + (size_t)(NTOK + (tk)) * 512 + 8 * lane)); \
        Cc = __builtin_nontemporal_load((const u32x4*)(og + (size_t)(2 * NTOK + (tk)) * 512 + 8 * lane)); L0 = lse[(size_t)(tk) * 8 + head]; L1 = lse[(size_t)(NTOK + (tk)) * 8 + head]; L2 = lse[(size_t)(2 * NTOK + (tk)) * 8 + head]; } while (0)
    if (gw < NTOK) MERGE_LOAD(ra, rb, rc, l0, l1, l2, gw);
    for (int tok = gw; tok < NTOK; tok += NGW) {
        u32x4 na = ra, nb = rb, nc = rc; float m0 = 0.f, m1 = 0.f, m2 = 0.f;
        if (tok + NGW < NTOK) MERGE_LOAD(na, nb, nc, m0, m1, m2, tok + NGW);
        const float mx = fmaxf(l0, fmaxf(l1, l2));
        float w0 = ex2(l0 - mx), w1 = ex2(l1 - mx), w2 = ex2(l2 - mx); const float inv = 1.0f / (w0 + w1 + w2); w0 *= inv; w1 *= inv; w2 *= inv;
        float a[8], b[8], c[8], o[8];
        unpack8(ra, a); unpack8(rb, b); unpack8(rc, c);
#pragma unroll
        for (int j = 0; j < 8; ++j) o[j] = w0 * a[j] + w1 * b[j] + w2 * c[j];
        *(u32x4*)(o1 + (size_t)tok * 512 + 8 * lane) = pack8(o);
        ra = na; rb = nb; rc = nc; l0 = m0; l1 = m1; l2 = m2;
    }
#undef MERGE_LOAD
}

DI void moe_assign_gather(const Ctx& C, const int* cnt, const int* toke, int* toks, int* tilee, const bf16* xn, const float* rstd, unsigned char* xs) {
    LAS int* L = (LAS int*)C.lds;
    const int lane = fresh_tid() & 63, w = C.bid;
    if (C.wave == 0) {
        int base[8]; int tot[8];
#pragma unroll
        for (int e = 0; e < 8; ++e) { int below = 0, all = 0;
            for (int i = lane; i < C.G; i += 64) { const int c = cnt[i * 8 + e]; all += c; if (i < w) below += c; }
#pragma unroll
            for (int o = 1; o < 64; o <<= 1) { below += __shfl_xor(below, o); all += __shfl_xor(all, o); }
            base[e] = below; tot[e] = all; }
        int start = 0;
#pragma unroll
        for (int e = 0; e < 8; ++e) { const int padded = (tot[e] + 255) & ~255; base[e] += start;
            if (w == 0) { for (int tix = (start >> 8) + lane; tix < ((start + padded) >> 8); tix += 64) tilee[8 + tix] = e; }
            start += padded;
            if (w == 0 && lane == 0 && e < 7) tilee[1 + e] = start >> 8; }
        if (w == 0 && lane == 0) tilee[0] = start >> 8;
#pragma unroll
        for (int k = 0; k < 4; ++k) {
            const int pidx = 64 * k + lane, tok = 128 * w + (pidx >> 1), kk = pidx & 1;
            const int e = (toke[tok] >> (8 * kk)) & 0xff; int slot = 0;
#pragma unroll
            for (int ee = 0; ee < 8; ++ee) { const unsigned long long mk = __ballot(e == ee); const int rank = __popcll(mk & ((1ull << lane) - 1ull));
                if (e == ee) slot = base[ee] + rank; base[ee] += __popcll(mk); }
            toks[2 * tok + kk] = slot; L[16 + pidx] = slot;
        }
    }
    __syncthreads();
    for (int i0 = 0; i0 < 32; i0 += 4) {
        u32x4 ra[4], rb[4]; float rs[4]; int sl[4];
#pragma unroll
        for (int q = 0; q < 4; ++q) { const int pidx = 32 * C.wave + i0 + q, tok = 128 * w + (pidx >> 1); sl[q] = L[16 + pidx];
            const u32x4* src = (const u32x4*)(xn + (size_t)tok * DM) + 2 * lane; ra[q] = src[0]; rb[q] = src[1]; rs[q] = rstd[tok]; }
#pragma unroll
        for (int q = 0; q < 4; ++q) { float x[8], y[8]; unpack8(ra[q], x); unpack8(rb[q], y);
#pragma unroll
            for (int j = 0; j < 8; ++j) { x[j] *= rs[q]; y[j] *= rs[q]; }
            u32x4 o; o.x = pg8::pk4_fp8(x[0], x[1], x[2], x[3]); o.y = pg8::pk4_fp8(x[4], x[5], x[6], x[7]); o.z = pg8::pk4_fp8(y[0], y[1], y[2], y[3]); o.w = pg8::pk4_fp8(y[4], y[5], y[6], y[7]);
            *((u32x4*)(xs + (size_t)sl[q] * DM) + lane) = o; }
    }
    __syncthreads();
}

struct Args { const float* in[27]; float* out; unsigned char* ws; };
enum { I_X = 0, I_P, I_MIXPRE, I_MIXPOST, I_FFNPRE, I_FFNPOST, I_PLEPROJ, I_PLEGN, I_PLEGATE, I_PLEPOST, I_WIN, I_GQ, I_GK, I_GCQ, I_WUQ, I_GCKV, I_WUKV, I_WOUT0,
       I_WG0, I_WU0, I_WD0, I_WQKV1, I_WOUT1, I_WR, I_MWG, I_MWU, I_MWD };

DI const float* arg_in(int i) { const __attribute__((address_space(4))) char* kp = (const __attribute__((address_space(4))) char*)__builtin_amdgcn_kernarg_segment_ptr(); asm volatile("" : "+s"(kp));
    return *(const float* const __attribute__((address_space(4)))*)(kp + 8 * i); }
__global__ void __launch_bounds__(NTHREADS, 2) fwd_kernel(Args a) {
    extern __shared__ __attribute__((aligned(16))) unsigned char lds_raw[];
    LAS unsigned char* lds = (LAS unsigned char*)lds_raw;
    volatile LAS unsigned* MISC = (volatile LAS unsigned*)(lds + MISC_OFF);
    Ctx C; C.wave = __builtin_amdgcn_readfirstlane((int)threadIdx.x >> 6); C.G = gridDim.x; C.bid = blockIdx.x; C.lds = lds;
    unsigned char* ws = a.ws;
#define AIN(i) arg_in(i)
    unsigned* ctl = (unsigned*)(ws + WS_CTL);
    for (int u = threadIdx.x; u < (LDS_BYTES - LDSCTL_OFF) / 4; u += NTHREADS) ((LAS unsigned*)(lds + LDSCTL_OFF))[u] = 0u;
    __syncthreads();
    XcdBarrier bar = xcd_barrier_post(ctl + CW_BAR, MISC + 8);
#define GRID_BAR() xcd_barrier(bar)
    const int gw = C.bid * NWAVES + C.wave, NGW = C.G * NWAVES, NGT = C.G * NTHREADS;
    const f32x2* taba = (const f32x2*)(ws + WS_TABA); const f32x2* tabp = (const f32x2*)(ws + WS_TABP);
    bf16* XN = (bf16*)(ws + WS_XN);
    float* hres = a.out;

    {
        LAS float* scr = (LAS float*)(lds + C.wave * 16384);
        const int tid = fresh_tid(), lane = tid & 63, gtid = C.bid * NTHREADS + tid;
#define TR(Wp, Kd, Nd, dst, ldo, roff, gu, gk) { constexpr int NI_ = ((Kd) / 64) * ((Nd) / 32); if (r < NI_) { transpose_item<0>((Wp), (Kd), (Nd), (bf16*)(dst), (ldo), (roff), (gu), scr, r, lane, (gk)); continue; } r -= NI_; }
        constexpr int NSMALL = 16 * 37 + 4 * 24 + 2 * 32 + 16 * 32 + 3 * 1792 + 2 * 128 + 2 * 512 + 16 * 144 + 8 * 32;
        for (int it = gw; it < NSMALL; it += NGW) {
            int r = it;
            { constexpr int NI_ = (1024 / 64) * (1184 / 32); if (r < NI_) { transpose_item<2>(AIN(I_WIN), 1024, 1184, ws + W_IN, 1024, 0, 0, scr, r, lane, AIN(I_MIXPRE), SW1); continue; } r -= NI_; }
            TR(AIN(I_WUQ), 256, 768, ws + W_UQ, 256, 0, 0, nullptr)
            TR(AIN(I_WUKV), 128, 1024, ws + W_UKV, 256, 0, 0, nullptr)
            TR(AIN(I_WOUT0), 1024, 1024, ws + W_OUT0, 1024, 0, 0, nullptr)
            { constexpr int NI_ = (1024 / 64) * (3584 / 32); if (r < NI_) { transpose_item<2>(AIN(I_WG0), 1024, 3584, ws + W_GU0, 1024, 0, 1, scr, r, lane, AIN(I_FFNPRE)); continue; } r -= NI_; }
            { constexpr int NI_ = (1024 / 64) * (3584 / 32); if (r < NI_) { transpose_item<2>(AIN(I_WU0), 1024, 3584, ws + W_GU0, 1024, 0, 2, scr, r, lane, AIN(I_FFNPRE)); continue; } r -= NI_; }
            { constexpr int NI_ = (3584 / 64) * (1024 / 32); if (r < NI_) { transpose_item<1>(AIN(I_WD0), 3584, 1024, ws + W_D0, 3584, 0, 0, scr, r, lane); continue; } r -= NI_; }
            TR(AIN(I_PLEPROJ), 256, 1024, ws + W_PP, 256, 0, 0, nullptr)
            TR(AIN(I_PLEPROJ) + 256 * 1024, 256, 1024, ws + W_PP + 1024 * 256 * 2, 256, 0, 0, nullptr)
            { constexpr int NI_ = (1024 / 64) * (1024 / 32); if (r < NI_) { transpose_item<2>(AIN(I_PLEGATE), 1024, 1024, ws + W_PG, 1024, 0, 0, scr, r, lane, AIN(I_PLEGN)); continue; } r -= NI_; }
            { constexpr int NI_ = (1024 / 64) * (1024 / 32); if (r < NI_) { transpose_item<1>(AIN(I_PLEGATE) + 1024 * 1024, 1024, 1024, ws + W_PG + 1024 * 1024 * 2, 1024, 0, 0, scr, r, lane, AIN(I_PLEGN) + DM); continue; } r -= NI_; }
            { constexpr int NI_ = (1024 / 64) * (4608 / 32); if (r < NI_) { transpose_item<2>(AIN(I_WQKV1), 1024, 4608, ws + W_QKV1, 1024, 0, 0, scr, r, lane, AIN(I_MIXPRE) + DM); continue; } r -= NI_; }
            TR(AIN(I_WOUT1), 512, 1024, ws + W_OUT1, 512, 0, 0, nullptr)
        }
        for (int i = gtid; i < 6144; i += NGT) ((u32x4*)(ws + W_IN + (size_t)1184 * 1024))[i] = (u32x4){0u, 0u, 0u, 0u};
        for (int i = gtid; i < 16384; i += NGT) ((u32x4*)(ws + W_UKV))[(size_t)(i >> 4) * 32 + 16 + (i & 15)] = (u32x4){0u, 0u, 0u, 0u};
        for (int i = gtid; i < 2048 * 16; i += NGT) { const int t = i >> 4, f = i & 15; double iv = 1.0; for (int k = 0; k < f; ++k) iv *= 0.56234132519034907; const float ang = (float)t * (float)iv;
            float c, s; sincos_d((double)ang, c, s); ((f32x2*)(ws + WS_TABA))[i] = (f32x2){c, s}; }
        for (int i = gtid; i < 2048 * 8; i += NGT) { const int t = i >> 3, f = i & 7; double iv = 1.0; for (int k = 0; k < f; ++k) iv *= 0.19392274474868576; const float ang = (float)t * (float)iv;
            float c, s; sincos_d((double)ang, c, s); ((f32x2*)(ws + WS_TABP))[i] = (f32x2){c, s}; }
        { const f32x4* psrc = (const f32x4*)AIN(I_P); u32x4* pdst = (u32x4*)(ws + WS_PB);
          for (int i = gtid; i < 2 * NTOK * 256 / 8; i += 4 * NGT) {
              f32x4 u0[4], u1[4];
#pragma unroll
              for (int q = 0; q < 4; ++q) { u0[q] = __builtin_nontemporal_load(psrc + 2 * (i + q * NGT)); u1[q] = __builtin_nontemporal_load(psrc + 2 * (i + q * NGT) + 1); }
#pragma unroll
              for (int q = 0; q < 4; ++q) { u32x4 o; o.x = pk2(u0[q].x, u0[q].y); o.y = pk2(u0[q].z, u0[q].w); o.z = pk2(u1[q].x, u1[q].y); o.w = pk2(u1[q].z, u1[q].w); pdst[i + q * NGT] = o; } } }
        rows_first(C, AIN(I_X), XN, (float*)(ws + WS_RSTD), ws + B_XN8);
    }
    GRID_BAR();

    { pg8::Gemm g{(const bf16*)(ws + B_XN8), (const bf16*)(ws + W_IN), 512, 512, 512}; pg8::StaticOrder S; S.init(NTOK / 256, ZW / 256, C.G, C.bid);
      pg8::EpiStore E{(bf16*)(ws + B_ZIN), ZW, 1.0f, nullptr}; pg8::gemm_phase<pg8::EpiStore, pg8::StaticOrder, false, true>(lds, g, S, E, 0, 0, 1.0f / (SA1 * SW1), 1.0f / (SA1 * SW1)); }
    GRID_BAR();
    rows_l0_post(C, (const bf16*)(ws + B_ZIN), AIN(I_GQ), AIN(I_GK), AIN(I_GCQ), AIN(I_GCKV), taba,
                 (bf16*)(ws + B_QA), (bf16*)(ws + B_KA), (bf16*)(ws + B_CQN), (bf16*)(ws + B_CKVN), (bf16*)(ws + B_KR), (float*)(ws + WS_LSE));
    GRID_BAR();
    { pg8::Gemm g{(const bf16*)(ws + B_CQN), (const bf16*)(ws + W_UQ), 256, 256, 256}; pg8::StaticOrder S; S.init(NTOK / 256, 3, C.G, C.bid);
      pg8::EpiStore E{(bf16*)(ws + B_QM), 768, C2_96, nullptr}; pg8::gemm_phase(lds, g, S, E); }
    { pg8::Gemm g{(const bf16*)(ws + B_CKVN), (const bf16*)(ws + W_UKV), 256, 256, 256}; pg8::StaticOrder S; S.init(NTOK / 256, 4, C.G, C.bid);
      pg8::EpiStoreKV E{(bf16*)(ws + B_KV), 1024, ctl + CW_KP}; pg8::gemm_phase(lds, g, S, E); }
    GRID_BAR();
    bool gqa_mf;
    { const int lane = fresh_tid() & 63; float mq = fabsf(AIN(I_GQ)[lane]), mk = fabsf(AIN(I_GK)[lane]);
#pragma unroll
      for (int o = 1; o < 64; o <<= 1) { mq = fmaxf(mq, __shfl_xor(mq, o)); mk = fmaxf(mk, __shfl_xor(mk, o)); }
      gqa_mf = __builtin_amdgcn_readfirstlane((64.0f * C2_64 * mq * mk <= 100.0f) ? 1 : 0) != 0; }
    for (int u = C.bid; u < 1024; u += C.G) {
        const int b = u >> 6, head = (u >> 3) & 7, ch = u & 7, kvh = head >> 2; const size_t rb = (size_t)b * SEQ;
        const int un = u + C.G; const bool hn = un < 1024; const int bn = un >> 6, kvhn = ((un >> 3) & 7) >> 2; const size_t rbn = (size_t)bn * SEQ;
        const bf16* nk = hn ? (const bf16*)(ws + B_KA) + rbn * 128 + kvhn * 64 : nullptr; const bf16* nv = (const bf16*)(ws + B_ZIN) + rbn * ZW + 640 + kvhn * 64;
        if (gqa_mf) att::dense_unit<64, true>(lds, (const bf16*)(ws + B_QA) + rb * 512 + head * 64, 512, 256 * ch, (const bf16*)(ws + B_KA) + rb * 128 + kvh * 64, 128, nullptr,
                            (const bf16*)(ws + B_ZIN) + rb * ZW + 640 + kvh * 64, ZW, (bf16*)(ws + B_O0) + rb * 1024 + head * 64, 1024, taba, u != C.bid, nk, nullptr, nv);
        else att::dense_unit<64, false>(lds, (const bf16*)(ws + B_QA) + rb * 512 + head * 64, 512, 256 * ch, (const bf16*)(ws + B_KA) + rb * 128 + kvh * 64, 128, nullptr,
                            (const bf16*)(ws + B_ZIN) + rb * ZW + 640 + kvh * 64, ZW, (bf16*)(ws + B_O0) + rb * 1024 + head * 64, 1024, taba, u != C.bid, nk, nullptr, nv);
    }
    unsigned mla_mf = 0u;
    { const int tid = fresh_tid(), lane = tid & 63, r = lane & 31, h = lane >> 5; LAS float* xq = (LAS float*)lds; int ui = 0;
      __syncthreads();
      for (int u = C.bid; u < 1024 && ui < 8; u += C.G, ++ui) {
          const int b = u >> 6, head = (u >> 3) & 7, ch = u & 7;
          const bf16* qrow = (const bf16*)(ws + B_QM) + ((size_t)b * SEQ + 256 * ch + C.wave * 32 + r) * 768 + head * 96 + 8 * h; float nq = 0.f;
#pragma unroll
          for (int ks = 0; ks < 6; ++ks) { const bf16x8 q8 = *(const bf16x8*)(qrow + 16 * ks);
#pragma unroll
              for (int j = 0; j < 8; ++j) { const float f = bf2f((unsigned short)q8[j]); nq += f * f; } }
          nq += __shfl_xor(nq, 32);
#pragma unroll
          for (int o = 1; o < 32; o <<= 1) nq = fmaxf(nq, __shfl_xor(nq, o));
          const f32x4 kv4 = *((const f32x4*)((const float*)(ws + WS_LSE) + (size_t)b * SEQ) + tid);
          float km = fmaxf(fmaxf(kv4.x, kv4.y), fmaxf(kv4.z, kv4.w));
#pragma unroll
          for (int o = 1; o < 64; o <<= 1) km = fmaxf(km, __shfl_xor(km, o));
          if (lane == 0) { xq[ui * 8 + C.wave] = nq; xq[64 + ui * 8 + C.wave] = km; } }
      __syncthreads();
      ui = 0;
      for (int u = C.bid; u < 1024 && ui < 8; u += C.G, ++ui) {
          const int b = u >> 6, head = (u >> 3) & 7; float qm2 = 0.f;
#pragma unroll
          for (int i = 0; i < 8; ++i) qm2 = fmaxf(qm2, xq[ui * 8 + i]);
          const unsigned* kp = ctl + CW_KP + (b * 8 + head) * 64; float krm = 0.f;
#pragma unroll
          for (int i = 0; i < 8; ++i) krm = fmaxf(krm, xq[64 + ui * 8 + i]);
          const float kb2 = (__uint_as_float(__hip_atomic_load(kp, __ATOMIC_RELAXED, __HIP_MEMORY_SCOPE_AGENT)) + __uint_as_float(__hip_atomic_load(kp + 32, __ATOMIC_RELAXED, __HIP_MEMORY_SCOPE_AGENT)) + krm) * 1.02f;
          if (qm2 * kb2 <= 1.0e4f) mla_mf |= 1u << ui; }
      mla_mf = (unsigned)__builtin_amdgcn_readfirstlane((int)mla_mf);
      __syncthreads(); }
    { int ui = 0;
      for (int u = C.bid; u < 1024; u += C.G, ++ui) {
        const int b = u >> 6, head = (u >> 3) & 7, ch = u & 7; const size_t rb = (size_t)b * SEQ;
        const int un = u + C.G; const bool hn = un < 1024; const int bn = un >> 6, headn = (un >> 3) & 7; const size_t rbn = (size_t)bn * SEQ;
        const bf16* nk = hn ? (const bf16*)(ws + B_KV) + rbn * 1024 + headn * 128 : nullptr; const bf16* nkr = (const bf16*)(ws + B_KR) + rbn * 32; const bf16* nv = (const bf16*)(ws + B_KV) + rbn * 1024 + headn * 128 + 64;
        if (ui < 8 && ((mla_mf >> ui) & 1u))
            att::dense_unit<96, true>(lds, (const bf16*)(ws + B_QM) + rb * 768 + head * 96, 768, 256 * ch, (const bf16*)(ws + B_KV) + rb * 1024 + head * 128, 1024, (const bf16*)(ws + B_KR) + rb * 32,
                                (const bf16*)(ws + B_KV) + rb * 1024 + head * 128 + 64, 1024, (bf16*)(ws + B_O0) + rb * 1024 + 512 + head * 64, 1024, taba, u != C.bid, nk, nkr, nv);
        else
            att::dense_unit<96, false>(lds, (const bf16*)(ws + B_QM) + rb * 768 + head * 96, 768, 256 * ch, (const bf16*)(ws + B_KV) + rb * 1024 + head * 128, 1024, (const bf16*)(ws + B_KR) + rb * 32,
                                (const bf16*)(ws + B_KV) + rb * 1024 + head * 128 + 64, 1024, (bf16*)(ws + B_O0) + rb * 1024 + 512 + head * 64, 1024, taba, u != C.bid, nk, nkr, nv);
      } }
    GRID_BAR();
    { pg8::Gemm g{(const bf16*)(ws + B_O0), (const bf16*)(ws + W_OUT0), 1024, 1024, 1024}; pg8::StaticOrder S; S.init(NTOK / 256, 4, C.G, C.bid);
      pg8::EpiStore E{(bf16*)(ws + B_MO0), 1024, 1.0f, nullptr}; pg8::gemm_phase(lds, g, S, E); }
    GRID_BAR();
    rows_residual<false, true, false, false, false, 2>(C, nullptr, XN, nullptr, (const bf16*)(ws + B_MO0), AIN(I_MIXPOST), nullptr, (float*)(ws + WS_RSTD), nullptr, nullptr, nullptr, nullptr, nullptr, nullptr, ws + B_XN8);
    GRID_BAR();
    { pg8::Gemm g{(const bf16*)(ws + B_XN8), (const bf16*)(ws + W_GU0), 512, 512, 512}; pg8::StaticOrder S; S.init(NTOK / 256, 28, C.G, C.bid);
      pg8::EpiSwiGLU8 E{ws + B_HID, DFF}; pg8::gemm_phase<pg8::EpiSwiGLU8, pg8::StaticOrder, false, true>(lds, g, S, E, 0, 0, pg8::ISC8 * LOG2E, pg8::ISC8 * 8.f / LOG2E); }
    GRID_BAR();
    { pg8::Gemm g{(const bf16*)(ws + B_HID), (const bf16*)(ws + W_D0), DFF / 2, DFF / 2, DFF / 2}; pg8::StaticOrder S; S.init(NTOK / 256, 4, C.G, C.bid);
      pg8::EpiStore E{(bf16*)(ws + B_F), 1024, 1.0f, nullptr}; pg8::gemm_phase<pg8::EpiStore, pg8::StaticOrder, true>(lds, g, S, E, 0x79797979, 0x7c7c7c7c); }
    { pg8::Gemm g{(const bf16*)(ws + WS_PB), (const bf16*)(ws + W_PP), 256, 256, 256}; pg8::StaticOrder S; S.init(NTOK / 256, 4, C.G, C.bid);
      pg8::EpiStore E{(bf16*)(ws + B_E0), 1024, 1.0f, nullptr}; pg8::gemm_phase(lds, g, S, E); }
    GRID_BAR();
    rows_residual<false, true, false, false, false, 2>(C, nullptr, XN, nullptr, (const bf16*)(ws + B_F), AIN(I_FFNPOST), nullptr, (float*)(ws + WS_RSTD), nullptr, nullptr, nullptr, nullptr, nullptr, nullptr, ws + B_XN8);
    GRID_BAR();
    { pg8::Gemm g{(const bf16*)(ws + B_XN8), (const bf16*)(ws + W_PG), 512, 512, 512}; pg8::StaticOrder S; S.init(NTOK / 256, 4, C.G, C.bid);
      pg8::EpiPleGate E{(const bf16*)(ws + B_E0), (bf16*)(ws + B_E), 1024, nullptr}; pg8::gemm_phase<pg8::EpiPleGate, pg8::StaticOrder, false, true>(lds, g, S, E, 0, 0, pg8::ISC8, pg8::ISC8); }
    GRID_BAR();
    rows_residual<false, true, false, false, false, 2>(C, nullptr, XN, nullptr, (const bf16*)(ws + B_E), AIN(I_PLEPOST), nullptr, (float*)(ws + WS_RSTD), nullptr, nullptr, nullptr, nullptr, nullptr, nullptr, ws + B_XN8);
    GRID_BAR();

    { pg8::Gemm g{(const bf16*)(ws + B_XN8), (const bf16*)(ws + W_QKV1), 512, 512, 512}; pg8::StaticOrder S; S.init(NTOK / 256, 18, C.G, C.bid);
      pg8::EpiQKV1 E{(bf16*)(ws + B_QKV), tabp, nullptr}; pg8::gemm_phase<pg8::EpiQKV1, pg8::StaticOrder, false, true>(lds, g, S, E, 0, 0, pg8::ISC8, pg8::ISC8); }
    GRID_BAR();
    __syncthreads();
    { bf16x8 qA[4], qB[4];
      if (C.bid < 3072) { att::dil_issue(lds, C.bid, (const bf16*)(ws + B_QKV)); att::dil_qload(C.bid, (const bf16*)(ws + B_QKV), qA); }
      for (int u = C.bid; u < 3072; u += 2 * C.G) {
        { const int grp = u >> 10;
          att::dil_unit(lds, u, (u + C.G < 3072) ? u + C.G : -1, (const bf16*)(ws + B_QKV), (bf16*)(ws + B_OG) + (size_t)grp * NTOK * 512, (float*)(ws + WS_LSE) + (size_t)grp * NTOK * 8, qA, qB); }
        if (u + C.G < 3072) { const int u2 = u + C.G, grp = u2 >> 10;
          att::dil_unit(lds, u2, (u2 + C.G < 3072) ? u2 + C.G : -1, (const bf16*)(ws + B_QKV), (bf16*)(ws + B_OG) + (size_t)grp * NTOK * 512, (float*)(ws + WS_LSE) + (size_t)grp * NTOK * 8, qB, qA); }
      } }
    asm volatile("s_waitcnt vmcnt(0) lgkmcnt(0)\n\ts_barrier" ::: "memory");
    GRID_BAR();
    rows_merge(C, (const bf16*)(ws + B_OG), (const float*)(ws + WS_LSE), (bf16*)(ws + B_O1));
    {
        LAS float* scr = (LAS float*)(lds + C.wave * 16384);
        const int lane = fresh_tid() & 63;
        for (int it = gw; it < 3 * 8 * 1792; it += NGW) {
            const int kind = it / (8 * 1792), e = (it / 1792) & 7, r = it % 1792;
            if (kind == 0) transpose_item<1>(AIN(I_MWG) + (size_t)e * 1024 * DFF, 1024, DFF, ws + B_WGU + (size_t)e * 7168 * 1024, 1024, 0, 1, scr, r, lane, AIN(I_FFNPRE) + DM, 64.f * LOG2E);
            else if (kind == 1) transpose_item<1>(AIN(I_MWU) + (size_t)e * 1024 * DFF, 1024, DFF, ws + B_WGU + (size_t)e * 7168 * 1024, 1024, 0, 2, scr, r, lane, AIN(I_FFNPRE) + DM, 64.f / LOG2E);
            else transpose_item<1>(AIN(I_MWD) + (size_t)e * DFF * 1024, DFF, 1024, ws + B_WD + (size_t)e * 1024 * DFF, DFF, 0, 0, scr, r, lane);
        }
    }
    GRID_BAR();
    { pg8::Gemm g{(const bf16*)(ws + B_O1), (const bf16*)(ws + W_OUT1), 512, 512, 512}; pg8::StaticOrder S; S.init(NTOK / 256, 4, C.G, C.bid);
      pg8::EpiStore E{(bf16*)(ws + B_MO1), 1024, 1.0f, nullptr}; pg8::gemm_phase(lds, g, S, E); }
    GRID_BAR();
    rows_residual<false, true, true, false, false>(C, nullptr, XN, nullptr, (const bf16*)(ws + B_MO1), AIN(I_MIXPOST) + DM, AIN(I_FFNPRE) + DM, (float*)(ws + WS_RSTD), nullptr, nullptr, AIN(I_WR),
                                     (int*)(ws + WS_TOKE), (f32x2*)(ws + WS_TOKG), (int*)(ws + WS_CNT));
    GRID_BAR();
    moe_assign_gather(C, (const int*)(ws + WS_CNT), (const int*)(ws + WS_TOKE), (int*)(ws + WS_TOKS), (int*)(ws + WS_TILEE), XN, (const float*)(ws + WS_RSTD), ws + B_XS);
    GRID_BAR();
    int ntail = 0, tailrow0 = 0;
    {
        const int* tilee = (const int*)(ws + WS_TILEE);
        const int ntiles = __builtin_amdgcn_readfirstlane(tilee[0]);
        int tend[7];
#pragma unroll
        for (int j = 0; j < 7; ++j) tend[j] = __builtin_amdgcn_readfirstlane(tilee[1 + j]);
        for (int c = 0; c < 2; ++c) {
            const int tile0 = 128 * c; int ntl = ntiles - tile0; if (ntl <= 0) break; if (c == 0 && ntl > 128) ntl = 128;
            { pg8::Gemm g{(const bf16*)(ws + B_XS), (const bf16*)(ws + B_WGU), 512, 512, 512};
              pg8::MoeOrder S; S.so.init(ntl, 28, C.G, C.bid); for (int j = 0; j < 7; ++j) S.tend[j] = tend[j]; S.tile0 = tile0; S.nbt = 28; S.a_global = true;
              pg8::EpiSwiGLU8 E{ws + B_HC, DFF}; pg8::gemm_phase<pg8::EpiSwiGLU8, pg8::MoeOrder, true>(lds, g, S, E, 0x79797979, 0x7f7f7f7f, 1.f, 1.f, 0x7c7c7c7c); }
            GRID_BAR();
            const int ntm = (c == 1 && ntl >= 128 && ntl <= 135) ? 128 : ntl; ntail = ntl - ntm; tailrow0 = (tile0 + ntm) * 256;
            { pg8::Gemm g{(const bf16*)(ws + B_HC), (const bf16*)(ws + B_WD), DFF / 2, DFF / 2, DFF / 2};
              pg8::MoeOrder S; S.so.init(ntm, 4, C.G, C.bid); for (int j = 0; j < 7; ++j) S.tend[j] = tend[j]; S.tile0 = tile0; S.nbt = 4; S.a_global = false;
              pg8::EpiStore E{(bf16*)(ws + B_Y), 1024, 1.0f, nullptr}; pg8::gemm_phase<pg8::EpiStore, pg8::MoeOrder, true>(lds, g, S, E, 0x79797979, 0x7c7c7c7c); }
            for (int u = C.bid; u < ntail * 28; u += C.G) {
                const int sl = u % 7, t = u / 7, pn = t & 3, tm = t >> 2, tl = tile0 + ntm + tm; int e = 0;
#pragma unroll
                for (int j = 0; j < 7; ++j) e += (tl >= tend[j]) ? 1 : 0;
                pg8::Gemm g{(const bf16*)(ws + B_HC + sl * 512), (const bf16*)(ws + B_WD + sl * 512), DFF / 2, DFF / 2, 256};
                pg8::OneUnit S; S.u.pm = tm; S.u.pn = pn; S.u.pa = ntm + tm; S.u.pb = e * 4 + pn; S.has = true;
                pg8::EpiStore E{(bf16*)(ws + B_YP + sl * YP_STRIDE), 1024, 1.0f, nullptr}; pg8::gemm_phase<pg8::EpiStore, pg8::OneUnit, true>(lds, g, S, E, 0x79797979, 0x7c7c7c7c); }
            GRID_BAR();
        }
    }
    { const int gw = C.bid * NWAVES + C.wave, NGW = C.G * NWAVES, lane = fresh_tid() & 63;
      for (int r = gw; r < ntail * 256; r += NGW) {
          float a[16];
#pragma unroll
          for (int i = 0; i < 16; ++i) a[i] = 0.f;
#pragma unroll
          for (int sl = 0; sl < 7; ++sl) { const u32x4* src = (const u32x4*)(ws + B_YP + sl * YP_STRIDE + (size_t)r * 2048); const u32x4 v0 = src[lane], v1 = src[64 + lane];
              a[0] += __uint_as_float(v0.x << 16); a[1] += __uint_as_float(v0.x & 0xffff0000u); a[2] += __uint_as_float(v0.y << 16); a[3] += __uint_as_float(v0.y & 0xffff0000u);
              a[4] += __uint_as_float(v0.z << 16); a[5] += __uint_as_float(v0.z & 0xffff0000u); a[6] += __uint_as_float(v0.w << 16); a[7] += __uint_as_float(v0.w & 0xffff0000u);
              a[8] += __uint_as_float(v1.x << 16); a[9] += __uint_as_float(v1.x & 0xffff0000u); a[10] += __uint_as_float(v1.y << 16); a[11] += __uint_as_float(v1.y & 0xffff0000u);
              a[12] += __uint_as_float(v1.z << 16); a[13] += __uint_as_float(v1.z & 0xffff0000u); a[14] += __uint_as_float(v1.w << 16); a[15] += __uint_as_float(v1.w & 0xffff0000u); }
          u32x4 o0, o1; o0.x = pk2(a[0], a[1]); o0.y = pk2(a[2], a[3]); o0.z = pk2(a[4], a[5]); o0.w = pk2(a[6], a[7]); o1.x = pk2(a[8], a[9]); o1.y = pk2(a[10], a[11]); o1.z = pk2(a[12], a[13]); o1.w = pk2(a[14], a[15]);
          u32x4* dst = (u32x4*)(ws + B_Y + (size_t)(tailrow0 + r) * 2048); dst[lane] = o0; dst[64 + lane] = o1; } }
    { pg8::Gemm g{(const bf16*)(ws + WS_PB) + (size_t)NTOK * 256, (const bf16*)(ws + W_PP) + 1024 * 256, 256, 256, 256}; pg8::StaticOrder S; S.init(NTOK / 256, 4, C.G, C.bid);
      pg8::EpiStore E{(bf16*)(ws + B_E0b), 1024, 1.0f, nullptr}; pg8::gemm_phase(lds, g, S, E); }
    GRID_BAR();
    rows_residual<true, true, false, false, false, 1>(C, nullptr, XN, nullptr, (const bf16*)(ws + B_Y), AIN(I_FFNPOST) + DM, nullptr, (float*)(ws + WS_RSTD), (const int*)(ws + WS_TOKS), (const f32x2*)(ws + WS_TOKG),
                                     nullptr, nullptr, nullptr, nullptr, ws + B_XN8b);
    GRID_BAR();
    { pg8::Gemm g{(const bf16*)(ws + B_XN8b), (const bf16*)(ws + W_PG) + 1024 * 1024, 512, 512, 512}; pg8::StaticOrder S; S.init(NTOK / 256, 4, C.G, C.bid);
      pg8::EpiPleGate E{(const bf16*)(ws + B_E0b), (bf16*)(ws + B_Eb), 1024, nullptr}; pg8::gemm_phase<pg8::EpiPleGate, pg8::StaticOrder, true>(lds, g, S, E, 0x79797979, 0x7f7f7f7f); }
    GRID_BAR();
    rows_residual<false, false, false, false, true>(C, nullptr, XN, hres, (const bf16*)(ws + B_Eb), AIN(I_PLEPOST) + DM, nullptr, nullptr, nullptr, nullptr, nullptr, nullptr, nullptr, nullptr);
#undef TR
#undef GRID_BAR
#undef AIN
}

extern "C" void kernel_launch(void* const* d_in, const int* in_sizes, int n_in, void* d_out, int out_size, void* d_ws, size_t ws_size, hipStream_t stream) {
    static int grid = 0;
    if (grid == 0) {
        if (n_in != 27 || in_sizes[0] != NTOK * DM || out_size != NTOK * DM || ws_size < WS_END) { fprintf(stderr, "kernel_launch: unexpected shapes / workspace (%zu < %zu)\n", ws_size, (size_t)WS_END); grid = -1; return; }
        int dev = 0, cus = 0;
        if (hipGetDevice(&dev) != hipSuccess || hipDeviceGetAttribute(&cus, hipDeviceAttributeMultiprocessorCount, dev) != hipSuccess) { grid = -1; return; }
        if (hipFuncSetAttribute((const void*)fwd_kernel, hipFuncAttributeMaxDynamicSharedMemorySize, LDS_BYTES) != hipSuccess) { fprintf(stderr, "kernel_launch: hipFuncSetAttribute failed\n"); grid = -1; return; }
        int per_cu = 0;
        if (hipOccupancyMaxActiveBlocksPerMultiprocessor(&per_cu, (const void*)fwd_kernel, NTHREADS, LDS_BYTES) != hipSuccess || per_cu < 1) fprintf(stderr, "kernel_launch: occupancy query reports %d\n", per_cu);
        (void)hipGetLastError();
        if (cus != 256) { fprintf(stderr, "kernel_launch: built for 256 CUs, device has %d\n", cus); grid = -1; return; }
        grid = cus;
    }
    if (grid < 0) return;
    (void)hipMemsetAsync((char*)d_ws + WS_CTL, 0, CTL_ZERO_BYTES, stream);
    Args a{};
    for (int i = 0; i < 27; ++i) a.in[i] = (const float*)d_in[i];
    a.out = (float*)d_out; a.ws = (unsigned char*)d_ws;
    hipLaunchKernelGGL(fwd_kernel, dim3(grid), dim3(NTHREADS), LDS_BYTES, stream, a);
}
```

```cpp
#include <hip/hip_runtime.h>
#include <cstdio>
#include <cstdint>

#define DI __device__ __forceinline__
#define LAS __attribute__((address_space(3)))
#define GAS __attribute__((address_space(1)))
typedef unsigned short bf16;
typedef short bf16x8 __attribute__((ext_vector_type(8)));
typedef short s16x4 __attribute__((ext_vector_type(4)));
typedef float f32x2 __attribute__((ext_vector_type(2)));
typedef float f32x4 __attribute__((ext_vector_type(4)));
typedef float f32x16 __attribute__((ext_vector_type(16)));
typedef unsigned u32x2 __attribute__((ext_vector_type(2)));
typedef unsigned u32x4 __attribute__((ext_vector_type(4)));
typedef __bf16 bf16x2_t __attribute__((ext_vector_type(2)));

constexpr int BATCH = 16, SEQ = 2048, DM = 1024, NTOK = BATCH * SEQ;
constexpr int ZW = 1280;
constexpr int DFF = 3584, NEXP = 8;
constexpr int QKVW = 4608;
constexpr float EPS = 1e-6f;
constexpr float LOG2E = 1.4426950408889634f;
constexpr float C2_64 = 0.125f * LOG2E;
constexpr float C2_96 = 0.10206207261596577f * LOG2E;
constexpr int NWAVES = 8, NTHREADS = 512;
constexpr int MAXTILES = 264;
constexpr int NSLOTS = MAXTILES * 256;

constexpr size_t MiB = 1u << 20;
constexpr size_t WS_CTL = 0, CTL_ZERO_BYTES = 64 * 1024;
constexpr size_t WS_TABA = 1 * MiB;
constexpr size_t WS_TABP = WS_TABA + 2048 * 16 * 8;
constexpr size_t WS_TOKE = 2 * MiB;
constexpr size_t WS_TOKG = WS_TOKE + NTOK * 4;
constexpr size_t WS_TOKS = WS_TOKG + NTOK * 8;
constexpr size_t WS_CNT = WS_TOKS + NTOK * 8;
constexpr size_t WS_TILEE = WS_CNT + 256 * 8 * 4;
constexpr size_t WS_RSTD = 2 * MiB + 768 * 1024;
constexpr size_t WS_LSE = 3 * MiB;
constexpr size_t WS_W = 6 * MiB;
constexpr size_t W_IN = WS_W;
constexpr size_t W_UQ = W_IN + (size_t)ZW * 1024 * 2;
constexpr size_t W_UKV = W_UQ + 768 * 256 * 2;
constexpr size_t W_OUT0 = W_UKV + 1024 * 256 * 2;
constexpr size_t W_GU0 = W_OUT0 + 1024 * 1024 * 2;
constexpr size_t W_D0 = W_GU0 + (size_t)7168 * 1024 * 2;
constexpr size_t W_PP = W_D0 + (size_t)1024 * 3584 * 2;
constexpr size_t W_PG = W_PP + 2 * 1024 * 256 * 2;
constexpr size_t W_QKV1 = W_PG + 2 * 1024 * 1024 * 2;
constexpr size_t W_OUT1 = W_QKV1 + (size_t)QKVW * 1024 * 2;
constexpr size_t W_END = W_OUT1 + 1024 * 512 * 2;
constexpr size_t WS_PB = 48 * MiB;
constexpr size_t WS_XN = 80 * MiB;
constexpr size_t WS_BIG = 144 * MiB;
static_assert(W_END <= WS_PB, "weights");
constexpr size_t B_ZIN = WS_BIG;
constexpr size_t B_QA = WS_BIG + 80 * MiB;
constexpr size_t B_KA = WS_BIG + 112 * MiB;
constexpr size_t B_CQN = WS_BIG + 120 * MiB;
constexpr size_t B_CKVN = WS_BIG + 136 * MiB;
constexpr size_t B_KR = WS_BIG + 152 * MiB;
constexpr size_t B_QM = WS_BIG + 154 * MiB;
constexpr size_t B_KV = WS_BIG + 202 * MiB;
constexpr size_t B_O0 = WS_BIG + 266 * MiB;
constexpr size_t B_MO0 = WS_BIG;
constexpr size_t B_HID = WS_BIG;
constexpr size_t B_F = WS_BIG + 224 * MiB;
constexpr size_t B_E0 = WS_BIG + 288 * MiB;
constexpr size_t B_E = WS_BIG;
constexpr size_t B_QKV = WS_BIG;
constexpr size_t B_OG = WS_BIG + 288 * MiB;
constexpr size_t B_O1 = WS_BIG + 388 * MiB;
constexpr size_t B_XN8 = WS_BIG + 388 * MiB;
constexpr size_t B_MO1 = WS_BIG + 288 * MiB;
constexpr size_t B_WGU = WS_BIG;
constexpr size_t B_WD = WS_BIG + 56 * MiB;
constexpr size_t B_XS = WS_BIG + 84 * MiB;
constexpr size_t B_Y = WS_BIG + 152 * MiB;
constexpr size_t B_HC = WS_BIG + 300 * MiB;
constexpr size_t B_YP = WS_BIG + 84 * MiB;
constexpr size_t YP_STRIDE = (size_t)7 * 256 * 1024 * 2;
constexpr size_t B_E0b = WS_BIG + 356 * MiB;
constexpr size_t B_Eb = WS_BIG;
constexpr size_t B_XN8b = WS_BIG + 96 * MiB;
constexpr size_t WS_END = WS_BIG + 420 * MiB;

constexpr int CW_BAR = 1024;
constexpr int CW_KP = 8192;

constexpr int RING_BYTES = 133120;
constexpr int LDSCTL_OFF = RING_BYTES, MISC_OFF = LDSCTL_OFF + 320;
constexpr int LDS_BYTES = 147456;

DI float bf2f(unsigned short v) { return __uint_as_float((unsigned)v << 16); }
DI unsigned pk2(float lo, float hi) { f32x2 v = {lo, hi}; bf16x2_t b = __builtin_convertvector(v, bf16x2_t); return __builtin_bit_cast(unsigned, b); }
DI float wave_sum(float v) {
#pragma unroll
    for (int o = 1; o < 64; o <<= 1) v += __shfl_xor(v, o);
    return v;
}
DI int fresh_tid() { int t = threadIdx.x; asm volatile("" : "+v"(t)); return t; }
DI float ex2(float x) { return __builtin_amdgcn_exp2f(x); }
DI float rsq(float x) { return 1.0f / sqrtf(x); }
DI void unpack8(u32x4 w, float (&x)[8]) {
    x[0] = __uint_as_float(w.x << 16); x[1] = __uint_as_float(w.x & 0xffff0000u);
    x[2] = __uint_as_float(w.y << 16); x[3] = __uint_as_float(w.y & 0xffff0000u);
    x[4] = __uint_as_float(w.z << 16); x[5] = __uint_as_float(w.z & 0xffff0000u);
    x[6] = __uint_as_float(w.w << 16); x[7] = __uint_as_float(w.w & 0xffff0000u);
}
DI u32x4 pack8(const float (&x)[8]) { u32x4 w; w.x = pk2(x[0], x[1]); w.y = pk2(x[2], x[3]); w.z = pk2(x[4], x[5]); w.w = pk2(x[6], x[7]); return w; }

namespace pg8 {
constexpr int BM = 256, BK = 64, HALF = 128, HTB = HALF * BK * 2, STAGE_BYTES = 8 * HTB, NXCD = 8, WGM = 8;
constexpr int RS_LDS_OFF = STAGE_BYTES;
__host__ __device__ __forceinline__ int lds_byte(int r, int c) { const int st = (r >> 4) * 2 + (c >> 5), rr = r & 15, cc = c & 31, ob = rr * 64 + cc * 2; return st * 1024 + (ob ^ (((ob >> 9) & 1) << 5)); }
__host__ __device__ __forceinline__ void stage_rc(int b, int& R, int& C) { const int st = b / 1024, sb = b % 1024, swz = sb ^ (((sb >> 9) & 1) << 5); R = (st >> 1) * 16 + swz / 64; C = (st & 1) * 32 + (swz % 64) / 2; }
__host__ __device__ __forceinline__ int perm32(int rho) { const int n = rho >> 4, i = rho & 15; return 8 * (i >> 2) + 4 * n + (i & 3); }

struct Unit { int pm, pn, pa, pb; };
struct Gemm { const bf16* A; const bf16* Bt; int lda, ldb, K; };

struct StaticOrder {
    int nM, nN, nwg, G, c;
    DI void init(int nM_, int nN_, int G_, int c_) { nM = nM_; nN = nN_; nwg = nM * nN; G = G_; c = c_; }
    DI bool map(int i, int& pm, int& pn) const {
        const long L = (long)i * G + c; if (L >= nwg) return false;
        int wgid = (int)L; { const int q = nwg / NXCD, r = nwg % NXCD, xcd = wgid % NXCD, off = wgid / NXCD; wgid = (xcd < r ? xcd * (q + 1) : r * (q + 1) + (xcd - r) * q) + off; }
        const int nig = WGM * nN, gid = wgid / nig, fm = gid * WGM, gsz = (nM - fm) < WGM ? (nM - fm) : WGM;
        pm = fm + ((wgid % nig) % gsz); pn = (wgid % nig) / gsz; return true;
    }
    DI bool next(int i, Unit& u) const { int pm, pn; if (!map(i, pm, pn)) return false; u.pm = pm; u.pn = pn; u.pa = pm; u.pb = pn; return true; }
};
struct MoeOrder {
    StaticOrder so; int tend[7]; int tile0, nbt; bool a_global;
    DI bool next(int i, Unit& u) const {
        int pm, pn; if (!so.map(i, pm, pn)) return false;
        const int tl = tile0 + pm; int e = 0;
#pragma unroll
        for (int j = 0; j < 7; ++j) e += (tl >= tend[j]) ? 1 : 0;
        u.pn = pn; u.pb = e * nbt + pn;
        if (a_global) { u.pa = tile0 + pm; u.pm = pm; } else { u.pa = pm; u.pm = tile0 + pm; }
        return true;
    }
};

struct OneUnit { Unit u; bool has; DI bool next(int i, Unit& o) const { if (i != 0 || !has) return false; o = u; return true; } };

struct EpiStore {
    bf16* O; int ldc; float scale; const float* rs;
    static constexpr int NSTORES = 16;
    struct Pre { const LAS float* t; };
    DI Pre pre(const Unit& u, LAS unsigned char* lds, int par, int wid, int lane) const { LAS float* t = (LAS float*)(lds + RS_LDS_OFF + par * 1024);
        return Pre{t}; }
    DI void operator()(const f32x4 (&acc)[2][2][4][2], const Unit& u, int wr, int wc, int fr, int fq, const Pre& P) const {
        const int row0 = u.pm * BM + wr * 64 + fr, col0 = u.pn * BM + wc * 32 + 8 * fq;
#pragma unroll
        for (int ai = 0; ai < 2; ++ai)
#pragma unroll
            for (int m = 0; m < 4; ++m) { bf16* rowp = O + (size_t)(row0 + ai * HALF + m * 16) * ldc + col0; const float sc = rs ? scale * rs[row0 + ai * HALF + m * 16] : scale;
#pragma unroll
                for (int bj = 0; bj < 2; ++bj) { const f32x4 v0 = acc[ai][bj][m][0] * sc, v1 = acc[ai][bj][m][1] * sc;
                    u32x4 w; w.x = pk2(v0[0], v0[1]); w.y = pk2(v0[2], v0[3]); w.z = pk2(v1[0], v1[1]); w.w = pk2(v1[2], v1[3]);
                    *(u32x4*)(rowp + bj * HALF) = w; } }
    }
};
struct EpiStoreKV {
    bf16* O; int ldc; unsigned* kp;
    static constexpr int NSTORES = 16;
    struct Pre { };
    DI Pre pre(const Unit&, LAS unsigned char*, int, int, int) const { return Pre{}; }
    DI void operator()(const f32x4 (&acc)[2][2][4][2], const Unit& u, int wr, int wc, int fr, int fq, const Pre&) const {
        const int row0 = u.pm * BM + wr * 64 + fr, col0 = u.pn * BM + wc * 32 + 8 * fq;
#pragma unroll
        for (int ai = 0; ai < 2; ++ai)
#pragma unroll
            for (int m = 0; m < 4; ++m) { bf16* rowp = O + (size_t)(row0 + ai * HALF + m * 16) * ldc + col0;
#pragma unroll
                for (int bj = 0; bj < 2; ++bj) { const f32x4 v0 = acc[ai][bj][m][0], v1 = acc[ai][bj][m][1];
                    u32x4 w; w.x = pk2(v0[0], v0[1]); w.y = pk2(v0[2], v0[3]); w.z = pk2(v1[0], v1[1]); w.w = pk2(v1[2], v1[3]);
                    *(u32x4*)(rowp + bj * HALF) = w; } }
        if (wc < 2) {
#pragma unroll
            for (int bj = 0; bj < 2; ++bj) { float mx = 0.f;
#pragma unroll
                for (int ai = 0; ai < 2; ++ai)
#pragma unroll
                    for (int m = 0; m < 4; ++m) { const f32x4 v0 = acc[ai][bj][m][0], v1 = acc[ai][bj][m][1];
                        float pq = (v0[0] * v0[0] + v0[1] * v0[1]) + (v0[2] * v0[2] + v0[3] * v0[3]) + (v1[0] * v1[0] + v1[1] * v1[1]) + (v1[2] * v1[2] + v1[3] * v1[3]);
                        pq += __shfl_xor(pq, 16); pq += __shfl_xor(pq, 32); mx = fmaxf(mx, pq); }
                mx = fmaxf(mx, __shfl_xor(mx, 1)); mx = fmaxf(mx, __shfl_xor(mx, 2)); mx = fmaxf(mx, __shfl_xor(mx, 4)); mx = fmaxf(mx, __shfl_xor(mx, 8));
                if (fr == 0 && fq == 0) atomicMax(kp + (((u.pm >> 3) * 8 + 2 * u.pn + bj) * 2 + wc) * 32, __float_as_uint(mx)); }
        }
    }
};
DI float silu_mul(float g, float u) { return g * u * __builtin_amdgcn_rcpf(1.0f + ex2(-g * LOG2E)); }
struct EpiSwiGLU {
    bf16* H; int ldh; const float* rs;
    static constexpr int NSTORES = 8;
    struct Pre { const LAS float* t; };
    DI Pre pre(const Unit& u, LAS unsigned char* lds, int par, int wid, int lane) const { LAS float* t = (LAS float*)(lds + RS_LDS_OFF + par * 1024);
        return Pre{t}; }
    DI void operator()(const f32x4 (&acc)[2][2][4][2], const Unit& u, int wr, int wc, int fr, int fq, const Pre& P) const {
        const int row0 = u.pm * BM + wr * 64 + fr, col0 = u.pn * HALF + wc * 32 + 8 * fq;
#pragma unroll
        for (int ai = 0; ai < 2; ++ai)
#pragma unroll
            for (int m = 0; m < 4; ++m) { bf16* rowp = H + (size_t)(row0 + ai * HALF + m * 16) * ldh + col0; const float sc = rs ? rs[row0 + ai * HALF + m * 16] : 1.0f;
                const f32x4 g0 = acc[ai][0][m][0] * sc, g1 = acc[ai][0][m][1] * sc, u0 = acc[ai][1][m][0] * sc, u1 = acc[ai][1][m][1] * sc;
                u32x4 w; w.x = pk2(silu_mul(g0[0], u0[0]), silu_mul(g0[1], u0[1])); w.y = pk2(silu_mul(g0[2], u0[2]), silu_mul(g0[3], u0[3]));
                w.z = pk2(silu_mul(g1[0], u1[0]), silu_mul(g1[1], u1[1])); w.w = pk2(silu_mul(g1[2], u1[2]), silu_mul(g1[3], u1[3]));
                *(u32x4*)rowp = w; }
    }
};
constexpr float SA8 = 32.0f, SW8 = 1000.0f, ISC8 = 1.0f / (SA8 * SW8);
DI unsigned pk4_i8(float a, float b, float c, float d) {
    const int ia = (int)__builtin_amdgcn_fmed3f(__builtin_rintf(a), -127.f, 127.f), ib = (int)__builtin_amdgcn_fmed3f(__builtin_rintf(b), -127.f, 127.f);
    const int ic = (int)__builtin_amdgcn_fmed3f(__builtin_rintf(c), -127.f, 127.f), id = (int)__builtin_amdgcn_fmed3f(__builtin_rintf(d), -127.f, 127.f);
    return ((unsigned)ia & 0xffu) | (((unsigned)ib & 0xffu) << 8) | (((unsigned)ic & 0xffu) << 16) | ((unsigned)id << 24); }
DI unsigned pk4_fp8(float a, float b, float c, float d) {
    a = __builtin_amdgcn_fmed3f(a, -448.f, 448.f); b = __builtin_amdgcn_fmed3f(b, -448.f, 448.f); c = __builtin_amdgcn_fmed3f(c, -448.f, 448.f); d = __builtin_amdgcn_fmed3f(d, -448.f, 448.f);
    int w = 0; w = __builtin_amdgcn_cvt_pk_fp8_f32(a, b, w, false); w = __builtin_amdgcn_cvt_pk_fp8_f32(c, d, w, true); return (unsigned)w; }
DI float silu_mul_l2(float gl, float ul) { return gl * ul * __builtin_amdgcn_rcpf(1.0f + ex2(-gl)); }
struct EpiSwiGLU8 {
    unsigned char* H; int ldh;
    static constexpr int NSTORES = 8;
    struct Pre { };
    DI Pre pre(const Unit&, LAS unsigned char*, int, int, int) const { return Pre{}; }
    DI void operator()(const f32x4 (&acc)[2][2][4][2], const Unit& u, int wr, int wc, int fr, int fq, const Pre&) const {
        const int row0 = u.pm * BM + wr * 64 + fr, col0 = u.pn * HALF + wc * 32 + 8 * fq;
#pragma unroll
        for (int ai = 0; ai < 2; ++ai)
#pragma unroll
            for (int m = 0; m < 4; ++m) { unsigned char* rowp = H + (size_t)(row0 + ai * HALF + m * 16) * ldh + col0;
                const f32x4 g0 = acc[ai][0][m][0], g1 = acc[ai][0][m][1], u0 = acc[ai][1][m][0], u1 = acc[ai][1][m][1];
                u32x2 w; w.x = pk4_fp8(silu_mul_l2(g0[0], u0[0]), silu_mul_l2(g0[1], u0[1]), silu_mul_l2(g0[2], u0[2]), silu_mul_l2(g0[3], u0[3]));
                w.y = pk4_fp8(silu_mul_l2(g1[0], u1[0]), silu_mul_l2(g1[1], u1[1]), silu_mul_l2(g1[2], u1[2]), silu_mul_l2(g1[3], u1[3]));
                *(u32x2*)rowp = w; }
    }
};
struct EpiPleGate {
    const bf16* E0; bf16* E; int ldc; const float* rs;
    static constexpr int NSTORES = 16;
    struct Pre { const LAS float* t; };
    DI Pre pre(const Unit& u, LAS unsigned char* lds, int par, int wid, int lane) const { LAS float* t = (LAS float*)(lds + RS_LDS_OFF + par * 1024);
        return Pre{t}; }
    DI void operator()(const f32x4 (&acc)[2][2][4][2], const Unit& u, int wr, int wc, int fr, int fq, const Pre& P) const {
        const int row0 = u.pm * BM + wr * 64 + fr, col0 = u.pn * BM + wc * 32 + 8 * fq;
#pragma unroll
        for (int ai = 0; ai < 2; ++ai)
#pragma unroll
            for (int m = 0; m < 4; ++m) { const size_t off = (size_t)(row0 + ai * HALF + m * 16) * ldc + col0; const float sc = rs ? rs[row0 + ai * HALF + m * 16] * LOG2E : LOG2E;
#pragma unroll
                for (int bj = 0; bj < 2; ++bj) { const u32x4 ew = *(const u32x4*)(E0 + off + bj * HALF); float e[8]; unpack8(ew, e);
                    const f32x4 v0 = acc[ai][bj][m][0] * sc, v1 = acc[ai][bj][m][1] * sc; float o[8];
#pragma unroll
                    for (int j = 0; j < 4; ++j) { o[j] = e[j] * __builtin_amdgcn_rcpf(1.0f + ex2(-v0[j])); o[4 + j] = e[4 + j] * __builtin_amdgcn_rcpf(1.0f + ex2(-v1[j])); }
                    *(u32x4*)(E + off + bj * HALF) = pack8(o); } }
    }
};
struct EpiQKV1 {
    bf16* O; const f32x2* tabp; const float* rs;
    static constexpr int NSTORES = 16;
    struct Pre { const LAS float* t; };
    DI Pre pre(const Unit& u, LAS unsigned char* lds, int par, int wid, int lane) const { LAS float* t = (LAS float*)(lds + RS_LDS_OFF + par * 1024);
        return Pre{t}; }
    DI void operator()(const f32x4 (&acc)[2][2][4][2], const Unit& u, int wr, int wc, int fr, int fq, const Pre& P) const {
        const int row0 = u.pm * BM + wr * 64 + fr;
        const int which = ((u.pn * BM) % 1536) / 512;
        const int grp = (u.pn * BM) / 1536, sh = 2 * grp;
        const float sc = which == 0 ? C2_64 : 1.0f;
        const bool rot = which < 2;
        const bool mine = ((wc & 1) == 0) && (fq < 2);
#pragma unroll
        for (int ai = 0; ai < 2; ++ai)
#pragma unroll
            for (int m = 0; m < 4; ++m) { const int row = row0 + ai * HALF + m * 16, bb = row >> 11, t = row & (SEQ - 1);
                const int pos = ((t & ((1 << sh) - 1)) << (11 - sh)) + (t >> sh);
                const float scr = rs ? sc * rs[row] : sc;
                f32x4 cs4[4];
                if (rot && mine) {
#pragma unroll
                    for (int q = 0; q < 4; ++q) cs4[q] = ((const f32x4*)(tabp + (size_t)t * 8))[q];
                }
#pragma unroll
                for (int bj = 0; bj < 2; ++bj) { float v[8];
                    const int head = ((u.pn * BM + bj * HALF + wc * 32) % 512) / 64, d0 = ((wc & 1) * 32) + 8 * fq;
                    bf16* dst = O + ((size_t)((((bb * 3 + grp) * 3 + which) * 8 + head) * SEQ + pos)) * 64 + d0;
#pragma unroll
                    for (int j = 0; j < 4; ++j) { v[j] = acc[ai][bj][m][0][j]; v[4 + j] = acc[ai][bj][m][1][j]; }
                    if (rot) {
                        float p[8];
#pragma unroll
                        for (int j = 0; j < 8; ++j) p[j] = __shfl_xor(v[j], 16);
                        if (mine) {
#pragma unroll
                            for (int j = 0; j < 8; ++j) { const float cx = cs4[j >> 1][(j & 1) * 2], sy = cs4[j >> 1][(j & 1) * 2 + 1]; v[j] = (fq == 0) ? (v[j] * cx - p[j] * sy) : (v[j] * cx + p[j] * sy); }
                        }
                    }
#pragma unroll
                    for (int j = 0; j < 8; ++j) v[j] *= scr;
                    *(u32x4*)dst = pack8(v); } }
    }
};

typedef int v8i32 __attribute__((ext_vector_type(8)));
typedef int v4i32 __attribute__((ext_vector_type(4)));
DI v8i32 cat8(bf16x8 lo, bf16x8 hi) { const v4i32 a = __builtin_bit_cast(v4i32, lo), b = __builtin_bit_cast(v4i32, hi); return __builtin_shufflevector(a, b, 0, 1, 2, 3, 4, 5, 6, 7); }
template <class Epi, class Sched, bool FP8 = false, bool I8 = false>
DI void gemm_phase(LAS unsigned char* lds, const Gemm g, const Sched& S, const Epi& E, const int scw = 0x7f7f7f7f, const int sca = 0x7f7f7f7f, const float isc0 = 1.f, const float isc1 = 1.f, const int scw1 = 0) {
    const int tid = fresh_tid(), wid = __builtin_amdgcn_readfirstlane(tid >> 6), lane = tid & 63, wr = wid >> 2, wc = wid & 3, fr = lane & 15, fq = lane >> 4;
    const int scwb = scw1 ? scw1 : scw;
    const int K = g.K; int nt = K / BK; if constexpr (FP8 || I8) asm volatile("" : "+s"(nt));
    unsigned voffA[2], voffB[2];
#pragma unroll
    for (int i = 0; i < 2; ++i) { int R, C; stage_rc(tid * 16 + i * 8192, R, C); const int Rb = (R & ~31) + perm32(R & 31);
        voffA[i] = (unsigned)(R * g.lda + C) * 2u; voffB[i] = (unsigned)(Rb * g.ldb + C) * 2u; }
    const size_t kstep = (size_t)(BK * 2);
    const size_t hstepA = (size_t)HALF * g.lda * 2, hstepB = (size_t)HALF * g.ldb * 2;
    const size_t tstepA = 2 * hstepA, tstepB = 2 * hstepB;
    const unsigned ldsw = (unsigned)wid * 1024u;
    const int aoff = lds_byte(wr * 64 + fr, fq * 8), boff = lds_byte(wc * 32 + fr, fq * 8);
#define PG8_SA(b, h) (((b) * 2 + (h)) * HTB)
#define PG8_SB(b, h) ((4 + (b) * 2 + (h)) * HTB)
#define PG8_STAGE(bufoff, gbase, voff) do { _Pragma("unroll") for (int _i = 0; _i < 2; ++_i) \
        __builtin_amdgcn_global_load_lds((const unsigned*)((const char*)(gbase) + (voff)[_i]), (LAS unsigned*)(lds + (bufoff) + ldsw + _i * 8192), 16, 0, 0); } while (0)
#define PG8_LDA(dst, b, h) do { _Pragma("unroll") for (int m = 0; m < 4; ++m) { \
        if constexpr (FP8) dst##8[m] = cat8(*(const LAS bf16x8*)(lds + PG8_SA(b, h) + aoff + m * 2048), *(const LAS bf16x8*)(lds + PG8_SA(b, h) + aoff + m * 2048 + 1024)); \
        else { _Pragma("unroll") for (int k = 0; k < 2; ++k) dst[m][k] = *(const LAS bf16x8*)(lds + PG8_SA(b, h) + aoff + m * 2048 + k * 1024); } } } while (0)
#define PG8_LDB(dst, b, h) do { _Pragma("unroll") for (int n = 0; n < 2; ++n) { \
        if constexpr (FP8) dst##8[n] = cat8(*(const LAS bf16x8*)(lds + PG8_SB(b, h) + boff + n * 2048), *(const LAS bf16x8*)(lds + PG8_SB(b, h) + boff + n * 2048 + 1024)); \
        else { _Pragma("unroll") for (int k = 0; k < 2; ++k) dst[n][k] = *(const LAS bf16x8*)(lds + PG8_SB(b, h) + boff + n * 2048 + k * 1024); } } } while (0)
#define PG8_MMA(ai, bj, At, Bt) do { __builtin_amdgcn_s_setprio(1); \
        if constexpr (FP8) { _Pragma("unroll") for (int m = 0; m < 4; ++m) _Pragma("unroll") for (int n = 0; n < 2; ++n) \
            asm volatile("s_nop 1\n\tv_mfma_scale_f32_16x16x128_f8f6f4 %0, %1, %2, %0, %3, %4 op_sel_hi:[0,0,0]" : "+v"(acc[ai][bj][m][n]) : "v"(Bt##8[n]), "v"(At##8[m]), "v"((bj) == 1 ? scwb : scw), "v"(sca)); } \
        else if constexpr (I8) { _Pragma("unroll") for (int k = 0; k < 2; ++k) _Pragma("unroll") for (int m = 0; m < 4; ++m) _Pragma("unroll") for (int n = 0; n < 2; ++n) \
            asm volatile("v_mfma_i32_16x16x64_i8 %0, %1, %2, %0" : "+v"(acc[ai][bj][m][n]) : "v"(Bt[n][k]), "v"(At[m][k])); } \
        else { _Pragma("unroll") for (int k = 0; k < 2; ++k) _Pragma("unroll") for (int m = 0; m < 4; ++m) _Pragma("unroll") for (int n = 0; n < 2; ++n)     \
            asm volatile("v_mfma_f32_16x16x32_bf16 %0, %1, %2, %0" : "+v"(acc[ai][bj][m][n]) : "v"(Bt[n][k]), "v"(At[m][k])); } \
        __builtin_amdgcn_s_setprio(0); } while (0)
#define PG8_MMA0(ai, bj, At, Bt) do { __builtin_amdgcn_s_setprio(1); \
        if constexpr (FP8) { _Pragma("unroll") for (int m = 0; m < 4; ++m) _Pragma("unroll") for (int n = 0; n < 2; ++n) \
            asm volatile("s_nop 1\n\tv_mfma_scale_f32_16x16x128_f8f6f4 %0, %1, %2, 0, %3, %4 op_sel_hi:[0,0,0]" : "=&v"(acc[ai][bj][m][n]) : "v"(Bt##8[n]), "v"(At##8[m]), "v"((bj) == 1 ? scwb : scw), "v"(sca)); } \
        else if constexpr (I8) { _Pragma("unroll") for (int m = 0; m < 4; ++m) _Pragma("unroll") for (int n = 0; n < 2; ++n) \
            asm volatile("v_mfma_i32_16x16x64_i8 %0, %1, %2, 0" : "=&v"(acc[ai][bj][m][n]) : "v"(Bt[n][0]), "v"(At[m][0])); \
          _Pragma("unroll") for (int m = 0; m < 4; ++m) _Pragma("unroll") for (int n = 0; n < 2; ++n) \
            asm volatile("v_mfma_i32_16x16x64_i8 %0, %1, %2, %0" : "+v"(acc[ai][bj][m][n]) : "v"(Bt[n][1]), "v"(At[m][1])); } \
        else { _Pragma("unroll") for (int m = 0; m < 4; ++m) _Pragma("unroll") for (int n = 0; n < 2; ++n) \
            asm volatile("v_mfma_f32_16x16x32_bf16 %0, %1, %2, 0" : "=&v"(acc[ai][bj][m][n]) : "v"(Bt[n][0]), "v"(At[m][0])); \
          _Pragma("unroll") for (int m = 0; m < 4; ++m) _Pragma("unroll") for (int n = 0; n < 2; ++n) \
            asm volatile("v_mfma_f32_16x16x32_bf16 %0, %1, %2, %0" : "+v"(acc[ai][bj][m][n]) : "v"(Bt[n][1]), "v"(At[m][1])); } \
        __builtin_amdgcn_s_setprio(0); } while (0)
#define PG8_TIE_ACC(NOPS) do { \
        asm volatile(NOPS : "+v"(acc[0][0][0][0]), "+v"(acc[0][0][0][1]), "+v"(acc[0][0][1][0]), "+v"(acc[0][0][1][1]), "+v"(acc[0][0][2][0]), "+v"(acc[0][0][2][1]), "+v"(acc[0][0][3][0]), "+v"(acc[0][0][3][1]), \
                            "+v"(acc[0][1][0][0]), "+v"(acc[0][1][0][1]), "+v"(acc[0][1][1][0]), "+v"(acc[0][1][1][1]), "+v"(acc[0][1][2][0]), "+v"(acc[0][1][2][1]), "+v"(acc[0][1][3][0]), "+v"(acc[0][1][3][1])); \
        asm volatile("" : "+v"(acc[1][0][0][0]), "+v"(acc[1][0][0][1]), "+v"(acc[1][0][1][0]), "+v"(acc[1][0][1][1]), "+v"(acc[1][0][2][0]), "+v"(acc[1][0][2][1]), "+v"(acc[1][0][3][0]), "+v"(acc[1][0][3][1]), \
                          "+v"(acc[1][1][0][0]), "+v"(acc[1][1][0][1]), "+v"(acc[1][1][1][0]), "+v"(acc[1][1][1][1]), "+v"(acc[1][1][2][0]), "+v"(acc[1][1][2][1]), "+v"(acc[1][1][3][0]), "+v"(acc[1][1][3][1])); } while (0)
#define PG8_WAIT_V(n) asm volatile("s_waitcnt vmcnt(" #n ")" ::: "memory")
#define PG8_WAIT_L(n) asm volatile("s_waitcnt lgkmcnt(" #n ")" ::: "memory")
#define PG8_BAR __builtin_amdgcn_s_barrier()
#define PG8_SCHED __builtin_amdgcn_sched_barrier(0)
    Unit cur, nxt; int ui = 0;
    if (!S.next(0, cur)) return;
    f32x4 acc[2][2][4][2];
    bf16x8 At[4][2], B0[2][2], B1[2][2]; v8i32 At8[4], B08[2], B18[2];
    const char* cA = (const char*)g.A + (size_t)cur.pa * tstepA; const char* cB = (const char*)g.Bt + (size_t)cur.pb * tstepB;
    PG8_STAGE(PG8_SB(0, 0), cB, voffB); PG8_STAGE(PG8_SB(0, 1), cB + hstepB, voffB); PG8_STAGE(PG8_SA(0, 0), cA, voffA); PG8_STAGE(PG8_SA(0, 1), cA + hstepA, voffA);
    if (wr == 1) PG8_BAR;
    PG8_WAIT_V(2); PG8_BAR;
    PG8_STAGE(PG8_SB(1, 0), cB + kstep, voffB); PG8_STAGE(PG8_SA(1, 0), cA + kstep, voffA); PG8_STAGE(PG8_SB(1, 1), cB + hstepB + kstep, voffB);
    PG8_WAIT_V(0); PG8_BAR;
    for (;;) {
        const bool has_next = S.next(ui + 1, nxt);
        const typename Epi::Pre epre = E.pre(cur, lds, ui & 1, wid, lane);
        const char* nA = has_next ? (const char*)g.A + (size_t)nxt.pa * tstepA : cA; const char* nB = has_next ? (const char*)g.Bt + (size_t)nxt.pb * tstepB : cB;
#define PG8_WAITX(R) PG8_WAIT_V(8)
#define PG8_KBODY(t, R, LASTX) do { \
            const bool last = (LASTX); \
            const char* a1 = cA + (size_t)((t) + 1) * kstep; \
            const char* a2 = last ? nA : cA + (size_t)((t) + 2) * kstep; const char* b2 = last ? nB : cB + (size_t)((t) + 2) * kstep; \
            const char* a3 = a2 + kstep; const char* b3 = b2 + kstep; \
              \
            PG8_LDB(B0, 0, 0); PG8_LDB(B1, 0, 1); PG8_SCHED; PG8_LDA(At, 0, 0); PG8_STAGE(PG8_SA(1, 1), a1 + hstepA, voffA); \
            PG8_WAITX(R); PG8_WAIT_L(0); PG8_BAR; if ((t) == 0) { PG8_MMA0(0, 0, At, B0); PG8_MMA0(0, 1, At, B1); } else { PG8_MMA(0, 0, At, B0); PG8_MMA(0, 1, At, B1); } PG8_BAR; PG8_SCHED; \
              \
            PG8_LDA(At, 0, 1); PG8_STAGE(PG8_SB(0, 0), b2, voffB); PG8_STAGE(PG8_SB(0, 1), b2 + hstepB, voffB); PG8_STAGE(PG8_SA(0, 0), a2, voffA); \
            PG8_WAITX(R); PG8_WAIT_L(0); PG8_BAR; if ((t) == 0) { PG8_MMA0(1, 0, At, B0); PG8_MMA0(1, 1, At, B1); } else { PG8_MMA(1, 0, At, B0); PG8_MMA(1, 1, At, B1); } PG8_BAR; PG8_SCHED; \
              \
            PG8_LDB(B0, 1, 0); PG8_LDB(B1, 1, 1); PG8_SCHED; PG8_LDA(At, 1, 0); PG8_STAGE(PG8_SA(0, 1), a2 + hstepA, voffA); \
            PG8_WAIT_V(8); PG8_WAIT_L(0); PG8_BAR; PG8_MMA(0, 0, At, B0); PG8_MMA(0, 1, At, B1); PG8_BAR; PG8_SCHED; \
              \
            PG8_LDA(At, 1, 1); PG8_STAGE(PG8_SB(1, 0), b3, voffB); PG8_STAGE(PG8_SB(1, 1), b3 + hstepB, voffB); PG8_STAGE(PG8_SA(1, 0), a3, voffA); \
            PG8_WAIT_V(8); PG8_WAIT_L(0); PG8_BAR; PG8_MMA(1, 0, At, B0); PG8_MMA(1, 1, At, B1); PG8_BAR; PG8_SCHED; \
        } while (0)
        for (int t = 0; t < nt; t += 2) PG8_KBODY(t, false, t == nt - 2);
        if (wr == 0) PG8_BAR;
        PG8_TIE_ACC("s_nop 15\n\ts_nop 15");
        if constexpr (I8) {
#pragma unroll
            for (int a_ = 0; a_ < 2; ++a_)
#pragma unroll
                for (int b_ = 0; b_ < 2; ++b_)
#pragma unroll
                    for (int m_ = 0; m_ < 4; ++m_)
#pragma unroll
                        for (int n_ = 0; n_ < 2; ++n_)
#pragma unroll
                            for (int j_ = 0; j_ < 4; ++j_) { const float t_ = acc[a_][b_][m_][n_][j_]; acc[a_][b_][m_][n_][j_] = (float)__float_as_int(t_) * (b_ == 1 ? isc1 : isc0); }
        }
        E(acc, cur, wr, wc, fr, fq, epre);
        if (!has_next) break;
        cur = nxt; cA = nA; cB = nB; ++ui;
        if (wr == 1) PG8_BAR;
    }
    PG8_WAIT_V(0);
    PG8_BAR;
#undef PG8_SA
#undef PG8_SB
#undef PG8_STAGE
#undef PG8_LDA
#undef PG8_LDB
#undef PG8_MMA
#undef PG8_MMA0
#undef PG8_WAIT_V
#undef PG8_TIE_ACC
#undef PG8_WAITX
#undef PG8_KBODY
#undef PG8_WAIT_L
#undef PG8_BAR
#undef PG8_SCHED
}
}

namespace att {
#define MFMA32(a, b, c) __builtin_amdgcn_mfma_f32_32x32x16_bf16((a), (b), (c), 0, 0, 0)
DI int crow(int i, int h) { return (i & 3) + 8 * (i >> 2) + 4 * h; }
typedef short v4i16_t __attribute__((ext_vector_type(4)));
DI s16x4 vtr(const LAS unsigned char* p) { return __builtin_bit_cast(s16x4, __builtin_amdgcn_ds_read_tr16_b64_v4i16((LAS v4i16_t*)p)); }
DI bf16x8 packp(const f32x16& p, int b) {
    u32x4 w; w.x = pk2(p[b], p[b + 1]); w.y = pk2(p[b + 2], p[b + 3]); w.z = pk2(p[b + 4], p[b + 5]); w.w = pk2(p[b + 6], p[b + 7]);
    return __builtin_bit_cast(bf16x8, w);
}
constexpr float NEGBIG = -1.0e30f;
constexpr float DEFER_THR = 8.0f;
template <int DK, int MASK>
DI void tile_step(const LAS unsigned char* Kb, const LAS unsigned char* Vb, const int (&koff)[4], const bf16x8 (&qr)[DK / 16], f32x16& o0, f32x16& o1, float& m, float& l,
                  LAS float* wsf, int r, int h, int lane, int qi, int kj0, const bool first) {
    f32x16 p0, p1;
#pragma unroll
    for (int i = 0; i < 16; ++i) { p0[i] = 0.f; p1[i] = 0.f; }
#pragma unroll
    for (int ks = 0; ks < DK / 16; ++ks) {
        const bf16x8 a0 = *(const LAS bf16x8*)(Kb + koff[ks]);
        const bf16x8 a1 = *(const LAS bf16x8*)(Kb + koff[ks] + 4096);
        p0 = MFMA32(a0, qr[ks], p0); p1 = MFMA32(a1, qr[ks], p1);
    }
    if (MASK) {
        const int D = qi - kj0 - 4 * h;
#pragma unroll
        for (int i = 0; i < 16; ++i) { const int c0 = (i & 3) + 8 * (i >> 2);
            if (MASK == 1) { if (D > 64 + c0) p0[i] = NEGBIG; if (D > 96 + c0) p1[i] = NEGBIG; }
            else if (MASK == 2) { if (D < -64 + c0) p0[i] = NEGBIG; if (D < -32 + c0) p1[i] = NEGBIG; }
            else { if (D > 64 + c0 || D < -64 + c0) p0[i] = NEGBIG; if (D > 96 + c0 || D < -32 + c0) p1[i] = NEGBIG; } }
    }
    float tm = fmaxf(p0[0], p1[0]);
#pragma unroll
    for (int i = 1; i < 16; ++i) tm = fmaxf(tm, fmaxf(p0[i], p1[i]));
    tm = fmaxf(tm, __shfl_xor(tm, 32));
    if (first) m = tm;
    else if (__any(tm > m + DEFER_THR)) {
        const float mn = fmaxf(m, tm), al = ex2(m - mn); l *= al; m = mn;
        if (h == 0) wsf[r] = al;
#pragma unroll
        for (int i = 0; i < 16; ++i) { const float f = wsf[crow(i, h)]; o0[i] *= f; o1[i] *= f; }
    }
    float sum = 0.f;
#pragma unroll
    for (int i = 0; i < 16; ++i) { p0[i] = ex2(p0[i] - m); p1[i] = ex2(p1[i] - m); sum += p0[i] + p1[i]; }
    l += sum;
    const LAS unsigned char* vp = Vb + ((lane >> 4) & 1) * 32 + (lane & 3) * 8 + (4 * h + ((lane & 15) >> 2)) * 64;
#pragma unroll
    for (int s = 0; s < 4; ++s) {
        const bf16x8 pa = (s == 0) ? packp(p0, 0) : (s == 1) ? packp(p0, 8) : (s == 2) ? packp(p1, 0) : packp(p1, 8);
#pragma unroll
        for (int db = 0; db < 2; ++db) {
            const s16x4 lo = vtr(vp + db * 4096 + s * 1024), hi = vtr(vp + db * 4096 + s * 1024 + 512);
            const bf16x8 vf = {lo[0], lo[1], lo[2], lo[3], hi[0], hi[1], hi[2], hi[3]};
            if (db == 0) o0 = MFMA32(pa, vf, o0); else o1 = MFMA32(pa, vf, o1);
        }
    }
}
DI void finish_store(const f32x16& o0, const f32x16& o1, float l, LAS float* wsf, LAS unsigned short* stg, int r, int h, int lane, bf16* orow0, size_t rstride) {
    const float lt = l + __shfl_xor(l, 32);
    if (h == 0) wsf[r] = 1.0f / lt;
#pragma unroll
    for (int i = 0; i < 16; ++i) { const int row = crow(i, h); const float f = wsf[row];
        stg[row * 64 + r] = (unsigned short)(pk2(o0[i] * f, 0.f) & 0xffffu); stg[row * 64 + 32 + r] = (unsigned short)(pk2(o1[i] * f, 0.f) & 0xffffu); }
#pragma unroll
    for (int it = 0; it < 4; ++it) { const int row = it * 8 + (lane >> 3), ch = lane & 7;
        const u32x4 v = *(const LAS u32x4*)(stg + row * 64 + ch * 8);
        *(u32x4*)(orow0 + (size_t)row * rstride + ch * 8) = v; }
}
#define ATT_WAITBAR(N) asm volatile("s_waitcnt vmcnt(" #N ") lgkmcnt(0)\n\ts_barrier" ::: "memory")
DI void dma16(const void* gsrc, LAS unsigned char* ldst) { __builtin_amdgcn_global_load_lds((const unsigned*)gsrc, (LAS unsigned*)ldst, 16, 0, 0); }

template <int DK, bool MF = false>
DI void dense_unit(LAS unsigned char* lds, const bf16* qS, int qp, int q0, const bf16* kA, int kpA, const bf16* kB, const bf16* vS, int vpitch, bf16* oS, int op, const f32x2* taba,
                   const bool pre, const bf16* nkA, const bf16* nkB, const bf16* nvS) {
    constexpr int NKC = DK / 8, KSLOT = NKC * 1024, VSLOT = 8192, NS = 4, KS = DK / 16;
    constexpr int OFF_V = NS * KSLOT, OFF_WS = OFF_V + NS * VSLOT, OFF_STG = OFF_WS + NWAVES * 256;
    const int tid = fresh_tid(), lane = tid & 63, r = lane & 31, h = lane >> 5; const int w = __builtin_amdgcn_readfirstlane(tid >> 6);
    LAS float* wsf = (LAS float*)(lds + OFF_WS) + w * 64;
    LAS unsigned short* stg = (LAS unsigned short*)(lds + OFF_STG) + w * 2048;
    const bf16* ksrcA = kA + (size_t)(8 * w + (lane >> 3)) * kpA + ((lane & 7) ^ ((4 * w + (lane >> 4)) & 7)) * 8;
    const bf16* ksrcB = (DK == 96) ? (kB + (size_t)(16 * (w & 3) + (lane >> 2)) * 32 + ((lane & 3) ^ ((lane >> 4) & 3)) * 8) : kA;
    const bf16* vsrc = vS + (size_t)(16 * (w & 3) + (lane >> 2)) * vpitch + (w >> 2) * 32 + (lane & 3) * 8;
    const size_t kstA = (size_t)64 * kpA, kstB = 64 * 32, vst = (size_t)64 * vpitch;
    int koff[KS];
#pragma unroll
    for (int ks = 0; ks < KS; ++ks) koff[ks] = (ks < 4) ? (r * 128 + (((2 * ks + h) ^ ((r >> 1) & 7)) << 4)) : (8192 + r * 64 + (((2 * (ks - 4) + h) ^ ((r >> 2) & 3)) << 4));
#define ISSUE_K(t) do { const int sl_ = (t) % NS; dma16(ksrcA + (size_t)(t) * kstA, lds + sl_ * KSLOT + w * 1024); \
        if (DK == 96) dma16(ksrcB + (size_t)(t) * kstB, lds + sl_ * KSLOT + (8 + (w & 3)) * 1024); } while (0)
#define ISSUE_V(t) do { const int sl_ = (t) % NS; dma16(vsrc + (size_t)(t) * vst, lds + OFF_V + sl_ * VSLOT + w * 1024); } while (0)
    bf16x8 qr[KS];
    const bf16* qrow = qS + (size_t)(q0 + w * 32 + r) * qp + 8 * h;
#pragma unroll
    for (int ks = 0; ks < KS; ++ks) qr[ks] = *(const bf16x8*)(qrow + 16 * ks);
    if (!pre) { ISSUE_K(0); ISSUE_K(1); ISSUE_V(0); ISSUE_K(2); ISSUE_V(1); }
    if (DK == 96) {
        const f32x2* tp = taba + (size_t)(q0 + w * 32 + r) * 16 + 8 * h;
        bf16x8 a = qr[4], b = qr[5];
#pragma unroll
        for (int j = 0; j < 8; ++j) { const f32x2 cs = tp[j]; const float x1 = bf2f((unsigned short)a[j]), x2 = bf2f((unsigned short)b[j]);
            a[j] = (short)(pk2(x1 * cs.x - x2 * cs.y, 0.f) & 0xffffu); b[j] = (short)(pk2(x2 * cs.x + x1 * cs.y, 0.f) & 0xffffu); }
        qr[4] = a; qr[5] = b;
    }
    f32x16 o0, o1, negm, pA0, pA1, pB0, pB1;
#pragma unroll
    for (int i = 0; i < 16; ++i) { o0[i] = 0.f; o1[i] = 0.f; negm[i] = 0.f; }
    float m = 0.f, l = 0.f;
    const LAS unsigned char* kp0 = lds;
    const LAS unsigned char* vp0 = lds + OFF_V + ((lane >> 4) & 1) * 32 + (lane & 3) * 8 + (4 * h + ((lane & 15) >> 2)) * 64;
#define QK_TILE(P0, P1, kb_) do { _Pragma("unroll") for (int ks = 0; ks < KS; ++ks) { \
        const bf16x8 a0_ = *(const LAS bf16x8*)((kb_) + koff[ks]), a1_ = *(const LAS bf16x8*)((kb_) + koff[ks] + (ks < 4 ? 4096 : 2048)); \
        if (ks == 0) { P0 = MFMA32(a0_, qr[0], negm); P1 = MFMA32(a1_, qr[0], negm); } else { P0 = MFMA32(a0_, qr[ks], P0); P1 = MFMA32(a1_, qr[ks], P1); } } } while (0)
    constexpr int NT = SEQ / 64, G = (DK == 96) ? 3 : 2;
#define ROWMAX(dst, P0, P1) do { float a_ = fmaxf(fmaxf(P0[0], P0[1]), P1[0]), b_ = fmaxf(fmaxf(P0[2], P0[3]), P1[1]); a_ = fmaxf(fmaxf(a_, P1[2]), P1[3]); \
        _Pragma("unroll") for (int i = 4; i < 16; i += 4) { a_ = fmaxf(fmaxf(a_, P0[i]), P0[i + 1]); b_ = fmaxf(fmaxf(b_, P0[i + 2]), P0[i + 3]); a_ = fmaxf(fmaxf(a_, P1[i]), P1[i + 1]); b_ = fmaxf(fmaxf(b_, P1[i + 2]), P1[i + 3]); } \
        const float m_ = fmaxf(a_, b_); const auto rr_ = __builtin_amdgcn_permlane32_swap(__float_as_uint(m_), __float_as_uint(m_), false, false); \
        dst = fmaxf(__uint_as_float(rr_[0]), __uint_as_float(rr_[1])); } while (0)
    if (DK == 96) ATT_WAITBAR(6); else ATT_WAITBAR(4);
    QK_TILE(pA0, pA1, kp0);
    float dl = 0.f; bool rebase = !MF;
    if constexpr (!MF) ROWMAX(dl, pA0, pA1);
#define STEP(t, P0, P1, Pn0, Pn1) do { \
        if ((t) + 3 <= NT) { if (DK == 96) ATT_WAITBAR(3); else ATT_WAITBAR(2); } else ATT_WAITBAR(0);       \
        if ((t) + 3 < NT) ISSUE_K((t) + 3); if ((t) + 2 < NT) ISSUE_V((t) + 2); \
          \
        if (!MF && rebase) { m += dl; const float al = ex2(-dl); l *= al; \
              _Pragma("unroll") for (int i = 0; i < 16; ++i) { P0[i] -= dl; P1[i] -= dl; negm[i] = -m; } \
              if (h == 0) wsf[r] = al; \
              _Pragma("unroll") for (int i = 0; i < 16; ++i) { const float f = wsf[crow(i, h)]; o0[i] *= f; o1[i] *= f; } } \
          \
        if ((t) + 1 < NT) QK_TILE(Pn0, Pn1, kp0 + (((t) + 1) % NS) * KSLOT); \
        _Pragma("unroll") for (int i = 0; i < 16; ++i) { P0[i] = ex2(P0[i]); l += P0[i]; P1[i] = ex2(P1[i]); l += P1[i]; } \
        const bf16x8 pa0_ = packp(P0, 0), pa1_ = packp(P0, 8), pa2_ = packp(P1, 0), pa3_ = packp(P1, 8); \
          \
        { const LAS unsigned char* vp_ = vp0 + ((t) % NS) * VSLOT; \
          _Pragma("unroll") for (int s_ = 0; s_ < 4; ++s_) { const bf16x8 pa_ = (s_ == 0) ? pa0_ : (s_ == 1) ? pa1_ : (s_ == 2) ? pa2_ : pa3_; \
            _Pragma("unroll") for (int db = 0; db < 2; ++db) { const s16x4 lo_ = vtr(vp_ + db * 4096 + s_ * 1024), hi_ = vtr(vp_ + db * 4096 + s_ * 1024 + 512); \
                const bf16x8 vf_ = {lo_[0], lo_[1], lo_[2], lo_[3], hi_[0], hi_[1], hi_[2], hi_[3]}; \
                if (db == 0) o0 = MFMA32(pa_, vf_, o0); else o1 = MFMA32(pa_, vf_, o1); } } } \
        if constexpr (!MF) { if ((t) + 1 < NT) { float tm_; ROWMAX(tm_, Pn0, Pn1); dl = fmaxf(tm_, 0.f); rebase = __any(tm_ > DEFER_THR); } } \
    } while (0)
    if (w >= 4) __builtin_amdgcn_s_setprio(1);
    for (int t = 0; t < NT; t += 2) {
        STEP(t, pA0, pA1, pB0, pB1);
        STEP(t + 1, pB0, pB1, pA0, pA1);
    }
    __builtin_amdgcn_s_setprio(0);
    if (nkA) {
        asm volatile("s_waitcnt lgkmcnt(0)\n\ts_barrier" ::: "memory");
        const bf16* nA_ = nkA + (size_t)(8 * w + (lane >> 3)) * kpA + ((lane & 7) ^ ((4 * w + (lane >> 4)) & 7)) * 8;
        const bf16* nB_ = (DK == 96) ? (nkB + (size_t)(16 * (w & 3) + (lane >> 2)) * 32 + ((lane & 3) ^ ((lane >> 4) & 3)) * 8) : nkA;
        const bf16* nV_ = nvS + (size_t)(16 * (w & 3) + (lane >> 2)) * vpitch + (w >> 2) * 32 + (lane & 3) * 8;
#define NISSUE_K(t) do { dma16(nA_ + (size_t)(t) * kstA, lds + (t) * KSLOT + w * 1024); if (DK == 96) dma16(nB_ + (size_t)(t) * kstB, lds + (t) * KSLOT + (8 + (w & 3)) * 1024); } while (0)
#define NISSUE_V(t) dma16(nV_ + (size_t)(t) * vst, lds + OFF_V + (t) * VSLOT + w * 1024)
        NISSUE_K(0); NISSUE_K(1); NISSUE_V(0); NISSUE_K(2); NISSUE_V(1);
#undef NISSUE_K
#undef NISSUE_V
    }
    finish_store(o0, o1, l, wsf, stg, r, h, lane, oS + (size_t)(q0 + w * 32) * op, (size_t)op);
    if (!nkA) ATT_WAITBAR(0);
#undef STEP
#undef ROWMAX
#undef QK_TILE
#undef ISSUE_K
#undef ISSUE_V
}

DI void dil_decode(int u, int& grp, int& b, int& head, int& res, int& c) {
    grp = u >> 10; const int idx = u & 1023; b = idx >> 6; head = (idx >> 3) & 7;
    res = grp == 0 ? 0 : (grp == 1 ? ((idx >> 1) & 3) : (idx & 7)); c = grp == 0 ? (idx & 7) : (grp == 1 ? (idx & 1) : 0);
}
DI void dil_issue(LAS unsigned char* lds, int u, const bf16* qkv) {
    constexpr int SLOT = 16384;
    int grp, b, head, res, c; dil_decode(u, grp, b, head, res, c);
    const int tid = fresh_tid(), lane = tid & 63; const int w = __builtin_amdgcn_readfirstlane(tid >> 6);
    const int dil = grp == 0 ? 1 : (grp == 1 ? 4 : 16), L = SEQ / dil, ntile = L / 64;
    const bf16* qb = qkv + (size_t)((((b * 3 + grp) * 3 + 0) * 8 + head) * SEQ) * 64;
    const bf16* kbp = qb + (size_t)8 * SEQ * 64; const bf16* vbp = qb + (size_t)16 * SEQ * 64;
#pragma unroll
    for (int s = 0; s < 6; ++s) {
        int sres, kb; bool valid;
        if (grp < 2) { sres = res; kb = 4 * c - 1 + s; valid = (kb >= 0) && (kb < ntile); }
        else { sres = 2 * res + (s >> 1); kb = s & 1; valid = s < 4; }
        if (valid) {
            const int krow = 64 * kb + 8 * w + (lane >> 3), vrow = 64 * kb + 16 * (w & 3) + (lane >> 2);
            dma16(kbp + (size_t)(sres * L + krow) * 64 + ((lane & 7) ^ ((4 * w + (lane >> 4)) & 7)) * 8, lds + s * SLOT + w * 1024);
            dma16(vbp + (size_t)(sres * L + vrow) * 64 + (w >> 2) * 32 + (lane & 3) * 8, lds + s * SLOT + 8192 + w * 1024);
        }
    }
}
DI void dil_qload(int u, const bf16* qkv, bf16x8 (&qr)[4]) {
    int grp, b, head, res, c; dil_decode(u, grp, b, head, res, c);
    const int tid = fresh_tid(), lane = tid & 63, r = lane & 31, h = lane >> 5; const int w = __builtin_amdgcn_readfirstlane(tid >> 6);
    const int dil = grp == 0 ? 1 : (grp == 1 ? 4 : 16), L = SEQ / dil;
    const bf16* qb = qkv + (size_t)((((b * 3 + grp) * 3 + 0) * 8 + head) * SEQ) * 64;
    int wres, qi0;
    if (grp < 2) { wres = res; qi0 = 256 * c + 32 * w; } else { wres = 2 * res + (w >> 2); qi0 = 32 * (w & 3); }
    const bf16* qrow = qb + (size_t)(wres * L + qi0 + r) * 64 + 8 * h;
#pragma unroll
    for (int ks = 0; ks < 4; ++ks) qr[ks] = *(const bf16x8*)(qrow + 16 * ks);
}
DI void dil_unit(LAS unsigned char* lds, int u, int unext, const bf16* qkv, bf16* og, float* lse, const bf16x8 (&qr)[4], bf16x8 (&qn)[4]) {
    constexpr int SLOT = 16384, OFF_WS = 6 * SLOT, OFF_STG = OFF_WS + NWAVES * 256;
    int grp, b, head, res, c; dil_decode(u, grp, b, head, res, c);
    const int tid = fresh_tid(), lane = tid & 63, r = lane & 31, h = lane >> 5; const int w = __builtin_amdgcn_readfirstlane(tid >> 6);
    LAS float* wsf = (LAS float*)(lds + OFF_WS) + w * 64;
    LAS unsigned short* stg = (LAS unsigned short*)(lds + OFF_STG) + w * 2048;
    const int dil = grp == 0 ? 1 : (grp == 1 ? 4 : 16), L = SEQ / dil, ntile = L / 64;
    const bf16* qb = qkv + (size_t)((((b * 3 + grp) * 3 + 0) * 8 + head) * SEQ) * 64;
    int wres, qi0, s0, kb0, nts;
    if (grp < 2) { wres = res; qi0 = 256 * c + 32 * w; s0 = w >> 1; kb0 = 4 * c + (w >> 1) - 1; nts = 3; }
    else { wres = 2 * res + (w >> 2); qi0 = 32 * (w & 3); s0 = 2 * (w >> 2); kb0 = 0; nts = 2; }
    int koff[4];
#pragma unroll
    for (int ks = 0; ks < 4; ++ks) koff[ks] = r * 128 + (((2 * ks + h) ^ ((r >> 1) & 7)) << 4);
    f32x16 o0, o1;
#pragma unroll
    for (int i = 0; i < 16; ++i) { o0[i] = 0.f; o1[i] = 0.f; }
    float m = NEGBIG, l = 0.f;
    ATT_WAITBAR(0);
    bool first = true;
    for (int j = 0; j < nts; ++j) {
        const int kb = kb0 + j;
        if (kb >= 0 && kb < ntile) {
            const LAS unsigned char* sp = lds + (s0 + j) * SLOT;
            const int rel = (grp < 2) ? j - 1 : j - ((w & 3) >> 1);
            if (rel == 0) tile_step<64, 0>(sp, sp + 8192, koff, qr, o0, o1, m, l, wsf, r, h, lane, qi0 + r, 64 * kb, first);
            else if (rel < 0) tile_step<64, 1>(sp, sp + 8192, koff, qr, o0, o1, m, l, wsf, r, h, lane, qi0 + r, 64 * kb, first);
            else tile_step<64, 2>(sp, sp + 8192, koff, qr, o0, o1, m, l, wsf, r, h, lane, qi0 + r, 64 * kb, first);
            first = false;
        }
    }
    asm volatile("s_waitcnt lgkmcnt(0)\n\ts_barrier" ::: "memory");
    if (unext >= 0) { dil_issue(lds, unext, qkv); dil_qload(unext, qkv, qn); }
    const size_t tok0 = (size_t)b * SEQ + wres + (size_t)dil * qi0;
    finish_store(o0, o1, l, wsf, stg, r, h, lane, og + tok0 * 512 + head * 64, (size_t)dil * 512);
    const float lt = l + __shfl_xor(l, 32);
    if (h == 0) lse[(tok0 + (size_t)dil * r) * 8 + head] = m + __builtin_amdgcn_logf(lt);
}
}

#define XB_TMO      128
#define XB_XCNT(j)  (256  + 64 * (j))
#define XB_XSUB(j)  (1280 + 64 * (j))
#define XB_XGEN(j)  (2304 + 64 * (j))
#define XB_TOP      3328
#define XB_TOPGEN   3392
#define XCD_BAR_WORDS 3456
#define XB_SPIN_CAP (1u << 18)
DI unsigned xb_ld(unsigned* p)              { return __hip_atomic_load(p, __ATOMIC_RELAXED, __HIP_MEMORY_SCOPE_AGENT); }
DI unsigned xb_add(unsigned* p, unsigned v) { return __hip_atomic_fetch_add(p, v, __ATOMIC_RELAXED, __HIP_MEMORY_SCOPE_AGENT); }
DI unsigned xb_xcc_id() { return (unsigned)__builtin_amdgcn_s_getreg((3 << 11) | 20) & 0xFu; }
#define XB_SPIN(cond, bar) do { unsigned _sp = 0; while (cond) { __builtin_amdgcn_s_sleep(1); \
    if ((++_sp & 255u) == 0u) { if (xb_ld(&(bar)[XB_TMO])) break; if (_sp > XB_SPIN_CAP) { atomicAdd(&(bar)[XB_TMO], 1u); break; } } } } while (0)
struct XcdBarrier { unsigned* bar; unsigned x; volatile LAS unsigned* st; };
DI XcdBarrier xcd_barrier_post(unsigned* bar, volatile LAS unsigned* st) {
    XcdBarrier b; b.bar = bar; b.x = xb_xcc_id(); b.st = st;
    if (threadIdx.x == 0) (void)xb_add(&bar[XB_XCNT(b.x)], 1u);
    return b;
}
DI void xcd_barrier_complete(unsigned* bar, unsigned x, unsigned& nloc, unsigned& nx) {
    const unsigned G = gridDim.x * gridDim.y * gridDim.z;
    unsigned sum, cnt, mine, sp = 0u;
    for (;;) {
        sum = 0u; cnt = 0u; mine = 0u;
#pragma unroll
        for (unsigned j = 0; j < 16; ++j) { const unsigned c = xb_ld(&bar[XB_XCNT(j)]); sum += c; cnt += (c > 0u) ? 1u : 0u; mine = (j == x) ? c : mine; }
        if (sum == G) break;
        __builtin_amdgcn_s_sleep(1);
        if ((++sp & 255u) == 0u) { if (xb_ld(&bar[XB_TMO])) break; if (sp > XB_SPIN_CAP) { atomicAdd(&bar[XB_TMO], 1u); break; } }
    }
    nloc = mine > 0u ? mine : 1u; nx = cnt > 0u ? cnt : 1u;
}
DI void xcd_barrier(const XcdBarrier& b) {
    asm volatile("s_waitcnt vmcnt(0)" ::: "memory");
    __syncthreads();
    if (threadIdx.x == 0) {
        unsigned* bar = b.bar;
        __builtin_amdgcn_s_waitcnt(0);
        unsigned nloc = b.st[0], nx = b.st[1];
        if (nloc == 0u) { xcd_barrier_complete(bar, b.x, nloc, nx); b.st[0] = nloc; b.st[1] = nx; }
        const unsigned old = xb_add(&bar[XB_XSUB(b.x)], 1u);
        const unsigned gen = old / nloc;
        if (old + 1u == (gen + 1u) * nloc) {
            __builtin_amdgcn_fence(__ATOMIC_RELEASE, "agent");
            asm volatile("s_waitcnt vmcnt(0)" ::: "memory");
            const unsigned og = xb_add(&bar[XB_TOP], 1u);
            const unsigned tg = og / nx;
            if (og + 1u == (tg + 1u) * nx) xb_add(&bar[XB_TOPGEN], 1u);
            else XB_SPIN(xb_ld(&bar[XB_TOPGEN]) == tg, bar);
            __builtin_amdgcn_fence(__ATOMIC_ACQUIRE, "agent");
            xb_add(&bar[XB_XGEN(b.x)], 1u);
            asm volatile("s_waitcnt vmcnt(0)" ::: "memory");
        } else {
            XB_SPIN(xb_ld(&bar[XB_XGEN(b.x)]) == gen, bar);
            __builtin_amdgcn_fence(__ATOMIC_ACQUIRE, "agent");
            asm volatile("s_waitcnt vmcnt(0)" ::: "memory");
        }
    }
    __syncthreads();
}

struct Ctx { int wave, G, bid; LAS unsigned char* lds; };

template <int F8>
DI void transpose_item(const float* W, int K, int N, void* WTv, int ldo, int row_off, int gu, LAS float* scr, int item, int lane, const float* gk = nullptr, const float wscale = 0.f) {
    const float sw8 = wscale != 0.f ? wscale : pg8::SW8, sw4 = wscale != 0.f ? wscale : 64.f;
    const int nblk = N / 32, kb = item / nblk, nb = item % nblk, k0 = 64 * kb, n0 = 32 * nb;
    float v[32];
    const float* src = W + (size_t)(k0 + (lane >> 5)) * N + n0 + (lane & 31);
#pragma unroll
    for (int i = 0; i < 32; ++i) v[i] = __builtin_nontemporal_load(src + (size_t)(2 * i) * N);
    if (gk) {
#pragma unroll
        for (int i = 0; i < 32; ++i) v[i] *= gk[k0 + 2 * i + (lane >> 5)];
    }
#pragma unroll
    for (int i = 0; i < 32; ++i) scr[(2 * i + (lane >> 5)) * 33 + (lane & 31)] = v[i];
    asm volatile("s_waitcnt lgkmcnt(0)" ::: "memory");
    const int c = lane & 7;
    const int orow0 = row_off + (gu == 0 ? n0 : ((n0 >> 7) * 256 + (gu - 1) * 128 + (n0 & 127)));
#pragma unroll
    for (int j = 0; j < 4; ++j) { const int n = (lane >> 3) + 8 * j; const LAS float* s = scr + (8 * c) * 33 + n;
        if (F8 == 2) { u32x2 o; o.x = pg8::pk4_i8(sw8 * s[0 * 33], sw8 * s[1 * 33], sw8 * s[2 * 33], sw8 * s[3 * 33]); o.y = pg8::pk4_i8(sw8 * s[4 * 33], sw8 * s[5 * 33], sw8 * s[6 * 33], sw8 * s[7 * 33]);
            *(u32x2*)((unsigned char*)WTv + (size_t)(orow0 + n) * ldo + k0 + 8 * c) = o; }
        else if (F8 == 1) { u32x2 o; o.x = pg8::pk4_fp8(sw4 * s[0 * 33], sw4 * s[1 * 33], sw4 * s[2 * 33], sw4 * s[3 * 33]); o.y = pg8::pk4_fp8(sw4 * s[4 * 33], sw4 * s[5 * 33], sw4 * s[6 * 33], sw4 * s[7 * 33]);
            *(u32x2*)((unsigned char*)WTv + (size_t)(orow0 + n) * ldo + k0 + 8 * c) = o; }
        else { u32x4 o; o.x = pk2(s[0 * 33], s[1 * 33]); o.y = pk2(s[2 * 33], s[3 * 33]); o.z = pk2(s[4 * 33], s[5 * 33]); o.w = pk2(s[6 * 33], s[7 * 33]);
            *(u32x4*)((bf16*)WTv + (size_t)(orow0 + n) * ldo + k0 + 8 * c) = o; } }
    asm volatile("s_waitcnt lgkmcnt(0)" ::: "memory");
}

DI void sincos_d(double a, float& c, float& s) {
    const double TWO_PI = 6.283185307179586476925286766559, INV = 0.15915494309189533576888376337251;
    const double n = __builtin_rint(a * INV); double x = (a - n * TWO_PI) * 0.25; const double x2 = x * x;
    double sn = x * (1.0 + x2 * (-1.0 / 6 + x2 * (1.0 / 120 + x2 * (-1.0 / 5040 + x2 * (1.0 / 362880 + x2 * (-1.0 / 39916800 + x2 * (1.0 / 6227020800.0)))))));
    double cs = 1.0 + x2 * (-0.5 + x2 * (1.0 / 24 + x2 * (-1.0 / 720 + x2 * (1.0 / 40320 + x2 * (-1.0 / 3628800 + x2 * (1.0 / 479001600.0))))));
#pragma unroll
    for (int i = 0; i < 2; ++i) { const double s2 = 2.0 * sn * cs, c2 = cs * cs - sn * sn; sn = s2; cs = c2; }
    c = (float)cs; s = (float)sn;
}

constexpr float SA1 = 32.0f, SW1 = 1000.0f;
DI void rows_first(const Ctx& C, const float* x, bf16* hb, float* rstd, unsigned char* x8) {
    const int gw = C.bid * NWAVES + C.wave, NGW = C.G * NWAVES, lane = fresh_tid() & 63;
    for (int m = gw; m < NTOK; m += 2 * NGW) {
        const f32x4* xr0 = (const f32x4*)(x + (size_t)m * DM) + lane; const f32x4* xr1 = (const f32x4*)(x + (size_t)(m + NGW) * DM) + lane;
        f32x4 v[4], w[4]; float s0 = 0.f, s1 = 0.f;
#pragma unroll
        for (int j = 0; j < 4; ++j) { v[j] = __builtin_nontemporal_load(xr0 + 64 * j); w[j] = __builtin_nontemporal_load(xr1 + 64 * j); }
#pragma unroll
        for (int j = 0; j < 4; ++j) { s0 += (v[j].x * v[j].x + v[j].y * v[j].y) + (v[j].z * v[j].z + v[j].w * v[j].w); s1 += (w[j].x * w[j].x + w[j].y * w[j].y) + (w[j].z * w[j].z + w[j].w * w[j].w); }
        const float r0 = rsq(wave_sum(s0) * (1.f / DM) + EPS), r1 = rsq(wave_sum(s1) * (1.f / DM) + EPS);
        u32x2* o0 = (u32x2*)(hb + (size_t)m * DM) + lane; u32x2* o1 = (u32x2*)(hb + (size_t)(m + NGW) * DM) + lane;
#pragma unroll
        for (int j = 0; j < 4; ++j) { u32x2 a, b; a.x = pk2(v[j].x, v[j].y); a.y = pk2(v[j].z, v[j].w); b.x = pk2(w[j].x, w[j].y); b.y = pk2(w[j].z, w[j].w); o0[64 * j] = a; o1[64 * j] = b; }
        { unsigned* q0 = (unsigned*)(x8 + (size_t)m * DM) + lane; unsigned* q1 = (unsigned*)(x8 + (size_t)(m + NGW) * DM) + lane; const float a0 = r0 * SA1, a1 = r1 * SA1;
#pragma unroll
          for (int j = 0; j < 4; ++j) { q0[64 * j] = pg8::pk4_i8(v[j].x * a0, v[j].y * a0, v[j].z * a0, v[j].w * a0); q1[64 * j] = pg8::pk4_i8(w[j].x * a1, w[j].y * a1, w[j].z * a1, w[j].w * a1); } }
        if (lane == 0) { rstd[m] = r0; rstd[m + NGW] = r1; }
    }
}

struct RowRaw { u32x2 t1[4], t2[4], hb[4]; f32x4 h32[4]; f32x2 gg; };
template <bool MOE, bool HIN32>
DI void row_load(RowRaw& R, int m, int lane_, const float* hin32, const bf16* hb, const bf16* term, const int* toks, const f32x2* tokg) {
    if (MOE) {
        const int s1 = toks[2 * m], s2 = toks[2 * m + 1]; R.gg = tokg[m];
        const u32x2* y1 = (const u32x2*)(term + (size_t)s1 * DM) + lane_; const u32x2* y2 = (const u32x2*)(term + (size_t)s2 * DM) + lane_;
#pragma unroll
        for (int j = 0; j < 4; ++j) { R.t1[j] = __builtin_nontemporal_load(y1 + 64 * j); R.t2[j] = __builtin_nontemporal_load(y2 + 64 * j); }
    } else {
        const u32x2* tr = (const u32x2*)(term + (size_t)m * DM) + lane_;
#pragma unroll
        for (int j = 0; j < 4; ++j) R.t1[j] = __builtin_nontemporal_load(tr + 64 * j);
    }
    if (HIN32) { const f32x4* hr = (const f32x4*)(hin32 + (size_t)m * DM) + lane_;
#pragma unroll
        for (int j = 0; j < 4; ++j) R.h32[j] = hr[64 * j];
    } else { const u32x2* hr = (const u32x2*)(hb + (size_t)m * DM) + lane_;
#pragma unroll
        for (int j = 0; j < 4; ++j) R.hb[j] = hr[64 * j];
    }
}
template <bool MOE, bool NEXT, bool ROUTE, bool HIN32, bool FINAL, int X8 = 0>
DI void rows_residual(const Ctx& C, const float* hin32, bf16* hb, float* out32, const bf16* term, const float* gpost, const float* gnext, float* rstd,
                      const int* toks, const f32x2* tokg, const float* wrouter, int* toke, f32x2* tokg_out, int* cnt_out, unsigned char* xn8 = nullptr) {
    const int gw = C.bid * NWAVES + C.wave, NGW = C.G * NWAVES, tid_ = fresh_tid(), lane_ = tid_ & 63;
    f32x4 gp[4], gn[4];
#pragma unroll
    for (int j = 0; j < 4; ++j) { gp[j] = *((const f32x4*)gpost + lane_ + 64 * j); gn[j] = ROUTE ? *((const f32x4*)gnext + lane_ + 64 * j) : (f32x4){0.f, 0.f, 0.f, 0.f}; }
    LAS int* lcnt = (LAS int*)C.lds;
    if (ROUTE) { if (tid_ < 8) lcnt[tid_] = 0; __syncthreads(); }
    const int rows_per_wave = NTOK / NGW;
    const int nrows = ROUTE ? rows_per_wave : (NTOK - gw + NGW - 1) / NGW;
#define ROW_OF(it_) (ROUTE ? (gw * rows_per_wave + (it_)) : (gw + (it_) * NGW))
    RowRaw cur, nxt;
    if (nrows > 0) row_load<MOE, HIN32>(cur, ROW_OF(0), lane_, hin32, hb, term, toks, tokg);
    for (int it = 0; it < nrows; ++it) {
        const int m = ROW_OF(it);
        if (it + 1 < nrows) row_load<MOE, HIN32>(nxt, ROW_OF(it + 1), lane_, hin32, hb, term, toks, tokg);
        f32x4 t[4], hv[4];
#pragma unroll
        for (int j = 0; j < 4; ++j) { const u32x2 a = cur.t1[j];
            if (MOE) { const u32x2 b = cur.t2[j]; const f32x2 gg = cur.gg;
                t[j].x = gg.x * __uint_as_float(a.x << 16) + gg.y * __uint_as_float(b.x << 16); t[j].y = gg.x * __uint_as_float(a.x & 0xffff0000u) + gg.y * __uint_as_float(b.x & 0xffff0000u);
                t[j].z = gg.x * __uint_as_float(a.y << 16) + gg.y * __uint_as_float(b.y << 16); t[j].w = gg.x * __uint_as_float(a.y & 0xffff0000u) + gg.y * __uint_as_float(b.y & 0xffff0000u); }
            else { t[j].x = __uint_as_float(a.x << 16); t[j].y = __uint_as_float(a.x & 0xffff0000u); t[j].z = __uint_as_float(a.y << 16); t[j].w = __uint_as_float(a.y & 0xffff0000u); }
            if (HIN32) hv[j] = cur.h32[j];
            else { const u32x2 c = cur.hb[j]; hv[j].x = __uint_as_float(c.x << 16); hv[j].y = __uint_as_float(c.x & 0xffff0000u); hv[j].z = __uint_as_float(c.y << 16); hv[j].w = __uint_as_float(c.y & 0xffff0000u); } }
        float s = 0.f;
#pragma unroll
        for (int j = 0; j < 4; ++j) s += (t[j].x * t[j].x + t[j].y * t[j].y) + (t[j].z * t[j].z + t[j].w * t[j].w);
        const float ri = rsq(wave_sum(s) * (1.f / DM) + EPS);
        float s2 = 0.f;
#pragma unroll
        for (int j = 0; j < 4; ++j) { hv[j] = hv[j] + t[j] * ri * gp[j]; s2 += (hv[j].x * hv[j].x + hv[j].y * hv[j].y) + (hv[j].z * hv[j].z + hv[j].w * hv[j].w); }
        if (FINAL) { f32x4* ho = (f32x4*)(out32 + (size_t)m * DM) + lane_;
#pragma unroll
            for (int j = 0; j < 4; ++j) ho[64 * j] = hv[j];
        } else { u32x2* o8 = (u32x2*)(hb + (size_t)m * DM) + lane_;
#pragma unroll
            for (int j = 0; j < 4; ++j) { u32x2 o; o.x = pk2(hv[j].x, hv[j].y); o.y = pk2(hv[j].z, hv[j].w); o8[64 * j] = o; }
        }
        if (NEXT) {
            const float r2 = rsq(wave_sum(s2) * (1.f / DM) + EPS);
            if (lane_ == 0) rstd[m] = r2;
            if (X8) { unsigned* o4 = (unsigned*)(xn8 + (size_t)m * DM) + lane_;
#pragma unroll
                for (int j = 0; j < 4; ++j) { const float q_ = (X8 == 2) ? r2 * pg8::SA8 : r2; o4[64 * j] = (X8 == 2) ? pg8::pk4_i8(hv[j].x * q_, hv[j].y * q_, hv[j].z * q_, hv[j].w * q_) : pg8::pk4_fp8(hv[j].x * q_, hv[j].y * q_, hv[j].z * q_, hv[j].w * q_); } }
            if (ROUTE) {
#pragma unroll
                for (int j = 0; j < 4; ++j) hv[j] = hv[j] * r2 * gn[j];
                float lg[8];
#pragma unroll
                for (int e = 0; e < 8; ++e) lg[e] = 0.f;
#pragma unroll
                for (int j = 0; j < 4; ++j)
#pragma unroll
                    for (int q = 0; q < 4; ++q) { const f32x4* wp = (const f32x4*)(wrouter + (size_t)(4 * lane_ + 256 * j + q) * 8); const f32x4 w0 = wp[0], w1 = wp[1]; const float a = hv[j][q];
                        lg[0] += a * w0.x; lg[1] += a * w0.y; lg[2] += a * w0.z; lg[3] += a * w0.w; lg[4] += a * w1.x; lg[5] += a * w1.y; lg[6] += a * w1.z; lg[7] += a * w1.w; }
#pragma unroll
                for (int e = 0; e < 8; ++e) lg[e] = wave_sum(lg[e]);
                int e1 = 0; float l1 = lg[0];
#pragma unroll
                for (int e = 1; e < 8; ++e) if (lg[e] > l1) { l1 = lg[e]; e1 = e; }
                int e2 = -1; float l2 = -3.0e38f;
#pragma unroll
                for (int e = 0; e < 8; ++e) if (e != e1 && lg[e] > l2) { l2 = lg[e]; e2 = e; }
                if (lane_ == 0) { const float p2 = 1.0f / (1.0f + ex2((l1 - l2) * LOG2E)); toke[m] = e1 | (e2 << 8); tokg_out[m] = (f32x2){1.0f - p2, p2};
                    atomicAdd((int*)lcnt + e1, 1); atomicAdd((int*)lcnt + e2, 1); }
            }
        }
        cur = nxt;
    }
#undef ROW_OF
    if (ROUTE) { __syncthreads(); if (tid_ < 8) cnt_out[C.bid * 8 + tid_] = lcnt[tid_]; }
}

DI void rows_l0_post(const Ctx& C, const bf16* zin, const float* gq, const float* gk, const float* gcq, const float* gckv, const f32x2* taba,
                     bf16* qa, bf16* ka, bf16* cqn, bf16* ckvn, bf16* kr, float* krn) {
    const int gw = C.bid * NWAVES + C.wave, NGW = C.G * NWAVES, lane = fresh_tid() & 63;
    const int s8 = lane & 7;
    float gqv[8], gkv[8], gcqv[8], gckvv[8];
#pragma unroll
    for (int j = 0; j < 8; ++j) { gqv[j] = gq[8 * s8 + j]; gkv[j] = gk[8 * s8 + j]; gcqv[j] = gcq[8 * (lane & 31) + j]; gckvv[j] = gckv[8 * (lane & 15) + j]; }
    const int part = s8 >> 2, isx2 = (s8 >> 1) & 1, fb = 8 * (s8 & 1);
    u32x4 c0 = (u32x4){0u, 0u, 0u, 0u}, c1 = c0, c2 = c0;
    if (gw < NTOK) { const bf16* z0 = zin + (size_t)gw * ZW; c0 = __builtin_nontemporal_load((const u32x4*)(z0 + 8 * lane)); c1 = __builtin_nontemporal_load((const u32x4*)(z0 + 512 + 8 * lane));
        if (lane < 32) c2 = __builtin_nontemporal_load((const u32x4*)(z0 + 1024 + 8 * lane)); }
    for (int tok = gw; tok < NTOK; tok += NGW) {
        const int t = tok & (SEQ - 1), prow = t >> 6, pcol = t & 63;
        u32x4 n0 = (u32x4){0u, 0u, 0u, 0u}, n1 = n0, n2 = n0;
        if (tok + NGW < NTOK) { const bf16* zn = zin + (size_t)(tok + NGW) * ZW; n0 = __builtin_nontemporal_load((const u32x4*)(zn + 8 * lane)); n1 = __builtin_nontemporal_load((const u32x4*)(zn + 512 + 8 * lane));
            if (lane < 32) n2 = __builtin_nontemporal_load((const u32x4*)(zn + 1024 + 8 * lane)); }
        float x[8], y[8], p[8];
        unpack8(c0, x);
        float ss = 0.f;
#pragma unroll
        for (int j = 0; j < 8; ++j) ss += x[j] * x[j];
        ss += __shfl_xor(ss, 1); ss += __shfl_xor(ss, 2); ss += __shfl_xor(ss, 4);
        float ri = rsq(ss * (1.f / 64) + EPS);
#pragma unroll
        for (int j = 0; j < 8; ++j) y[j] = x[j] * ri * gqv[j];
#pragma unroll
        for (int j = 0; j < 8; ++j) p[j] = __shfl_xor(y[j], 2);
        const f32x2* tp = taba + (size_t)(part ? pcol : prow) * 16 + fb;
#pragma unroll
        for (int j = 0; j < 8; ++j) { const f32x2 cs = tp[j]; y[j] = (isx2 ? (y[j] * cs.x + p[j] * cs.y) : (y[j] * cs.x - p[j] * cs.y)) * C2_64; }
        *(u32x4*)(qa + (size_t)tok * 512 + 8 * lane) = pack8(y);
        unpack8(c1, x);
        ss = 0.f;
#pragma unroll
        for (int j = 0; j < 8; ++j) ss += x[j] * x[j];
        float s3 = ss; s3 += __shfl_xor(s3, 1); s3 += __shfl_xor(s3, 2); s3 += __shfl_xor(s3, 4);
        float s5 = s3; s5 += __shfl_xor(s5, 8); s5 += __shfl_xor(s5, 16);
        if (lane < 16) {
            ri = rsq(s3 * (1.f / 64) + EPS);
#pragma unroll
            for (int j = 0; j < 8; ++j) y[j] = x[j] * ri * gkv[j];
        } else {
            ri = rsq(s5 * (1.f / 256) + EPS);
#pragma unroll
            for (int j = 0; j < 8; ++j) y[j] = x[j] * ri * gcqv[j];
        }
#pragma unroll
        for (int j = 0; j < 8; ++j) p[j] = __shfl_xor(y[j], 2);
        if (lane < 16) {
#pragma unroll
            for (int j = 0; j < 8; ++j) { const f32x2 cs = tp[j]; y[j] = isx2 ? (y[j] * cs.x + p[j] * cs.y) : (y[j] * cs.x - p[j] * cs.y); }
            *(u32x4*)(ka + (size_t)tok * 128 + 8 * lane) = pack8(y);
        } else if (lane >= 32) {
            *(u32x4*)(cqn + (size_t)tok * 256 + 8 * (lane - 32)) = pack8(y);
        }
        unpack8(c2, x);
        ss = 0.f;
#pragma unroll
        for (int j = 0; j < 8; ++j) ss += x[j] * x[j];
        ss += __shfl_xor(ss, 1); ss += __shfl_xor(ss, 2); ss += __shfl_xor(ss, 4); ss += __shfl_xor(ss, 8);
        if (lane == 16) krn[tok] = ss;
#pragma unroll
        for (int j = 0; j < 8; ++j) p[j] = __shfl_xor(x[j], 2);
        if (lane < 16) {
            ri = rsq(ss * (1.f / 128) + EPS);
#pragma unroll
            for (int j = 0; j < 8; ++j) y[j] = x[j] * ri * gckvv[j];
            *(u32x4*)(ckvn + (size_t)tok * 256 + 8 * lane) = pack8(y);
        } else if (lane < 32) {
            *(u32x4*)(ckvn + (size_t)tok * 256 + 8 * lane) = (u32x4){0u, 0u, 0u, 0u};
            if (lane < 20) {
                const int sl = lane - 16; const f32x2* tq = taba + (size_t)t * 16 + 8 * (sl & 1);
#pragma unroll
                for (int j = 0; j < 8; ++j) { const f32x2 cs = tq[j]; y[j] = (sl >> 1) ? (x[j] * cs.x + p[j] * cs.y) : (x[j] * cs.x - p[j] * cs.y); }
                *(u32x4*)(kr + (size_t)tok * 32 + 8 * sl) = pack8(y);
            }
        }
        c0 = n0; c1 = n1; c2 = n2;
    }
}

DI void rows_merge(const Ctx& C, const bf16* og, const float* lse, bf16* o1) {
    const int gw = C.bid * NWAVES + C.wave, NGW = C.G * NWAVES, lane = fresh_tid() & 63, head = lane >> 3;
    u32x4 ra = (u32x4){0u, 0u, 0u, 0u}, rb = ra, rc = ra; float l0 = 0.f, l1 = 0.f, l2 = 0.f;
#define MERGE_LOAD(A, B, Cc, L0, L1, L2, tk) do { A = __builtin_nontemporal_load((const u32x4*)(og + (size_t)(tk) * 512 + 8 * lane)); B = __builtin_nontemporal_load((const u32x4*)(og + (size_t)(NTOK + (tk)) * 512 + 8 * lane)); \
        Cc = __builtin_nontemporal_load((const u32x4*)(og + (size_t)(2 * NTOK + (tk)) * 512 + 8 * lane)); L0 = lse[(size_t)(tk) * 8 + head]; L1 = lse[(size_t)(NTOK + (tk)) * 8 + head]; L2 = lse[(size_t)(2 * NTOK + (tk)) * 8 + head]; } while (0)
    if (gw < NTOK) MERGE_LOAD(ra, rb, rc, l0, l1, l2, gw);
    for (int tok = gw; tok < NTOK; tok += NGW) {
        u32x4 na = ra, nb = rb, nc = rc; float m0 = 0.f, m1 = 0.f, m2 = 0.f;
        if (tok + NGW < NTOK) MERGE_LOAD(na, nb, nc, m0, m1, m2, tok + NGW);
        const float mx = fmaxf(l0, fmaxf(l1, l2));
        float w0 = ex2(l0 - mx), w1 = ex2(l1 - mx), w2 = ex2(l2 - mx); const float inv = 1.0f / (w0 + w1 + w2); w0 *= inv; w1 *= inv; w2 *= inv;
        float a[8], b[8], c[8], o[8];
        unpack8(ra, a); unpack8(rb, b); unpack8(rc, c);
#pragma unroll
        for (int j = 0; j < 8; ++j) o[j] = w0 * a[j] + w1 * b[j] + w2 * c[j];
        *(u32x4*)(o1 + (size_t)tok * 512 + 8 * lane) = pack8(o);
        ra = na; rb = nb; rc = nc; l0 = m0; l1 = m1; l2 = m2;
    }
#undef MERGE_LOAD
}

DI void moe_assign_gather(const Ctx& C, const int* cnt, const int* toke, int* toks, int* tilee, const bf16* xn, const float* rstd, unsigned char* xs) {
    LAS int* L = (LAS int*)C.lds;
    const int lane = fresh_tid() & 63, w = C.bid;
    if (C.wave == 0) {
        int base[8]; int tot[8];
#pragma unroll
        for (int e = 0; e < 8; ++e) { int below = 0, all = 0;
            for (int i = lane; i < C.G; i += 64) { const int c = cnt[i * 8 + e]; all += c; if (i < w) below += c; }
#pragma unroll
            for (int o = 1; o < 64; o <<= 1) { below += __shfl_xor(below, o); all += __shfl_xor(all, o); }
            base[e] = below; tot[e] = all; }
        int start = 0;
#pragma unroll
        for (int e = 0; e < 8; ++e) { const int padded = (tot[e] + 255) & ~255; base[e] += start;
            if (w == 0) { for (int tix = (start >> 8) + lane; tix < ((start + padded) >> 8); tix += 64) tilee[8 + tix] = e; }
            start += padded;
            if (w == 0 && lane == 0 && e < 7) tilee[1 + e] = start >> 8; }
        if (w == 0 && lane == 0) tilee[0] = start >> 8;
#pragma unroll
        for (int k = 0; k < 4; ++k) {
            const int pidx = 64 * k + lane, tok = 128 * w + (pidx >> 1), kk = pidx & 1;
            const int e = (toke[tok] >> (8 * kk)) & 0xff; int slot = 0;
#pragma unroll
            for (int ee = 0; ee < 8; ++ee) { const unsigned long long mk = __ballot(e == ee); const int rank = __popcll(mk & ((1ull << lane) - 1ull));
                if (e == ee) slot = base[ee] + rank; base[ee] += __popcll(mk); }
            toks[2 * tok + kk] = slot; L[16 + pidx] = slot;
        }
    }
    __syncthreads();
    for (int i0 = 0; i0 < 32; i0 += 4) {
        u32x4 ra[4], rb[4]; float rs[4]; int sl[4];
#pragma unroll
        for (int q = 0; q < 4; ++q) { const int pidx = 32 * C.wave + i0 + q, tok = 128 * w + (pidx >> 1); sl[q] = L[16 + pidx];
            const u32x4* src = (const u32x4*)(xn + (size_t)tok * DM) + 2 * lane; ra[q] = src[0]; rb[q] = src[1]; rs[q] = rstd[tok]; }
#pragma unroll
        for (int q = 0; q < 4; ++q) { float x[8], y[8]; unpack8(ra[q], x); unpack8(rb[q], y);
#pragma unroll
            for (int j = 0; j < 8; ++j) { x[j] *= rs[q]; y[j] *= rs[q]; }
            u32x4 o; o.x = pg8::pk4_fp8(x[0], x[1], x[2], x[3]); o.y = pg8::pk4_fp8(x[4], x[5], x[6], x[7]); o.z = pg8::pk4_fp8(y[0], y[1], y[2], y[3]); o.w = pg8::pk4_fp8(y[4], y[5], y[6], y[7]);
            *((u32x4*)(xs + (size_t)sl[q] * DM) + lane) = o; }
    }
    __syncthreads();
}

struct Args { const float* in[27]; float* out; unsigned char* ws; };
enum { I_X = 0, I_P, I_MIXPRE, I_MIXPOST, I_FFNPRE, I_FFNPOST, I_PLEPROJ, I_PLEGN, I_PLEGATE, I_PLEPOST, I_WIN, I_GQ, I_GK, I_GCQ, I_WUQ, I_GCKV, I_WUKV, I_WOUT0,
       I_WG0, I_WU0, I_WD0, I_WQKV1, I_WOUT1, I_WR, I_MWG, I_MWU, I_MWD };

DI const float* arg_in(int i) { const __attribute__((address_space(4))) char* kp = (const __attribute__((address_space(4))) char*)__builtin_amdgcn_kernarg_segment_ptr(); asm volatile("" : "+s"(kp));
    return *(const float* const __attribute__((address_space(4)))*)(kp + 8 * i); }
__global__ void __launch_bounds__(NTHREADS, 2) fwd_kernel(Args a) {
    extern __shared__ __attribute__((aligned(16))) unsigned char lds_raw[];
    LAS unsigned char* lds = (LAS unsigned char*)lds_raw;
    volatile LAS unsigned* MISC = (volatile LAS unsigned*)(lds + MISC_OFF);
    Ctx C; C.wave = __builtin_amdgcn_readfirstlane((int)threadIdx.x >> 6); C.G = gridDim.x; C.bid = blockIdx.x; C.lds = lds;
    unsigned char* ws = a.ws;
#define AIN(i) arg_in(i)
    unsigned* ctl = (unsigned*)(ws + WS_CTL);
    for (int u = threadIdx.x; u < (LDS_BYTES - LDSCTL_OFF) / 4; u += NTHREADS) ((LAS unsigned*)(lds + LDSCTL_OFF))[u] = 0u;
    __syncthreads();
    XcdBarrier bar = xcd_barrier_post(ctl + CW_BAR, MISC + 8);
#define GRID_BAR() xcd_barrier(bar)
    const int gw = C.bid * NWAVES + C.wave, NGW = C.G * NWAVES, NGT = C.G * NTHREADS;
    const f32x2* taba = (const f32x2*)(ws + WS_TABA); const f32x2* tabp = (const f32x2*)(ws + WS_TABP);
    bf16* XN = (bf16*)(ws + WS_XN);
    float* hres = a.out;

    {
        LAS float* scr = (LAS float*)(lds + C.wave * 16384);
        const int tid = fresh_tid(), lane = tid & 63, gtid = C.bid * NTHREADS + tid;
#define TR(Wp, Kd, Nd, dst, ldo, roff, gu, gk) { constexpr int NI_ = ((Kd) / 64) * ((Nd) / 32); if (r < NI_) { transpose_item<0>((Wp), (Kd), (Nd), (bf16*)(dst), (ldo), (roff), (gu), scr, r, lane, (gk)); continue; } r -= NI_; }
        constexpr int NSMALL = 16 * 37 + 4 * 24 + 2 * 32 + 16 * 32 + 3 * 1792 + 2 * 128 + 2 * 512 + 16 * 144 + 8 * 32;
        for (int it = gw; it < NSMALL; it += NGW) {
            int r = it;
            { constexpr int NI_ = (1024 / 64) * (1184 / 32); if (r < NI_) { transpose_item<2>(AIN(I_WIN), 1024, 1184, ws + W_IN, 1024, 0, 0, scr, r, lane, AIN(I_MIXPRE), SW1); continue; } r -= NI_; }
            TR(AIN(I_WUQ), 256, 768, ws + W_UQ, 256, 0, 0, nullptr)
            TR(AIN(I_WUKV), 128, 1024, ws + W_UKV, 256, 0, 0, nullptr)
            TR(AIN(I_WOUT0), 1024, 1024, ws + W_OUT0, 1024, 0, 0, nullptr)
            { constexpr int NI_ = (1024 / 64) * (3584 / 32); if (r < NI_) { transpose_item<2>(AIN(I_WG0), 1024, 3584, ws + W_GU0, 1024, 0, 1, scr, r, lane, AIN(I_FFNPRE)); continue; } r -= NI_; }
            { constexpr int NI_ = (1024 / 64) * (3584 / 32); if (r < NI_) { transpose_item<2>(AIN(I_WU0), 1024, 3584, ws + W_GU0, 1024, 0, 2, scr, r, lane, AIN(I_FFNPRE)); continue; } r -= NI_; }
            { constexpr int NI_ = (3584 / 64) * (1024 / 32); if (r < NI_) { transpose_item<1>(AIN(I_WD0), 3584, 1024, ws + W_D0, 3584, 0, 0, scr, r, lane); continue; } r -= NI_; }
            TR(AIN(I_PLEPROJ), 256, 1024, ws + W_PP, 256, 0, 0, nullptr)
            TR(AIN(I_PLEPROJ) + 256 * 1024, 256, 1024, ws + W_PP + 1024 * 256 * 2, 256, 0, 0, nullptr)
            { constexpr int NI_ = (1024 / 64) * (1024 / 32); if (r < NI_) { transpose_item<2>(AIN(I_PLEGATE), 1024, 1024, ws + W_PG, 1024, 0, 0, scr, r, lane, AIN(I_PLEGN)); continue; } r -= NI_; }
            { constexpr int NI_ = (1024 / 64) * (1024 / 32); if (r < NI_) { transpose_item<1>(AIN(I_PLEGATE) + 1024 * 1024, 1024, 1024, ws + W_PG + 1024 * 1024 * 2, 1024, 0, 0, scr, r, lane, AIN(I_PLEGN) + DM); continue; } r -= NI_; }
            { constexpr int NI_ = (1024 / 64) * (4608 / 32); if (r < NI_) { transpose_item<2>(AIN(I_WQKV1), 1024, 4608, ws + W_QKV1, 1024, 0, 0, scr, r, lane, AIN(I_MIXPRE) + DM); continue; } r -= NI_; }
            TR(AIN(I_WOUT1), 512, 1024, ws + W_OUT1, 512, 0, 0, nullptr)
        }
        for (int i = gtid; i < 6144; i += NGT) ((u32x4*)(ws + W_IN + (size_t)1184 * 1024))[i] = (u32x4){0u, 0u, 0u, 0u};
        for (int i = gtid; i < 16384; i += NGT) ((u32x4*)(ws + W_UKV))[(size_t)(i >> 4) * 32 + 16 + (i & 15)] = (u32x4){0u, 0u, 0u, 0u};
        for (int i = gtid; i < 2048 * 16; i += NGT) { const int t = i >> 4, f = i & 15; double iv = 1.0; for (int k = 0; k < f; ++k) iv *= 0.56234132519034907; const float ang = (float)t * (float)iv;
            float c, s; sincos_d((double)ang, c, s); ((f32x2*)(ws + WS_TABA))[i] = (f32x2){c, s}; }
        for (int i = gtid; i < 2048 * 8; i += NGT) { const int t = i >> 3, f = i & 7; double iv = 1.0; for (int k = 0; k < f; ++k) iv *= 0.19392274474868576; const float ang = (float)t * (float)iv;
            float c, s; sincos_d((double)ang, c, s); ((f32x2*)(ws + WS_TABP))[i] = (f32x2){c, s}; }
        { const f32x4* psrc = (const f32x4*)AIN(I_P); u32x4* pdst = (u32x4*)(ws + WS_PB);
          for (int i = gtid; i < 2 * NTOK * 256 / 8; i += 4 * NGT) {
              f32x4 u0[4], u1[4];
#pragma unroll
              for (int q = 0; q < 4; ++q) { u0[q] = __builtin_nontemporal_load(psrc + 2 * (i + q * NGT)); u1[q] = __builtin_nontemporal_load(psrc + 2 * (i + q * NGT) + 1); }
#pragma unroll
              for (int q = 0; q < 4; ++q) { u32x4 o; o.x = pk2(u0[q].x, u0[q].y); o.y = pk2(u0[q].z, u0[q].w); o.z = pk2(u1[q].x, u1[q].y); o.w = pk2(u1[q].z, u1[q].w); pdst[i + q * NGT] = o; } } }
        rows_first(C, AIN(I_X), XN, (float*)(ws + WS_RSTD), ws + B_XN8);
    }
    GRID_BAR();

    { pg8::Gemm g{(const bf16*)(ws + B_XN8), (const bf16*)(ws + W_IN), 512, 512, 512}; pg8::StaticOrder S; S.init(NTOK / 256, ZW / 256, C.G, C.bid);
      pg8::EpiStore E{(bf16*)(ws + B_ZIN), ZW, 1.0f, nullptr}; pg8::gemm_phase<pg8::EpiStore, pg8::StaticOrder, false, true>(lds, g, S, E, 0, 0, 1.0f / (SA1 * SW1), 1.0f / (SA1 * SW1)); }
    GRID_BAR();
    rows_l0_post(C, (const bf16*)(ws + B_ZIN), AIN(I_GQ), AIN(I_GK), AIN(I_GCQ), AIN(I_GCKV), taba,
                 (bf16*)(ws + B_QA), (bf16*)(ws + B_KA), (bf16*)(ws + B_CQN), (bf16*)(ws + B_CKVN), (bf16*)(ws + B_KR), (float*)(ws + WS_LSE));
    GRID_BAR();
    { pg8::Gemm g{(const bf16*)(ws + B_CQN), (const bf16*)(ws + W_UQ), 256, 256, 256}; pg8::StaticOrder S; S.init(NTOK / 256, 3, C.G, C.bid);
      pg8::EpiStore E{(bf16*)(ws + B_QM), 768, C2_96, nullptr}; pg8::gemm_phase(lds, g, S, E); }
    { pg8::Gemm g{(const bf16*)(ws + B_CKVN), (const bf16*)(ws + W_UKV), 256, 256, 256}; pg8::StaticOrder S; S.init(NTOK / 256, 4, C.G, C.bid);
      pg8::EpiStoreKV E{(bf16*)(ws + B_KV), 1024, ctl + CW_KP}; pg8::gemm_phase(lds, g, S, E); }
    GRID_BAR();
    bool gqa_mf;
    { const int lane = fresh_tid() & 63; float mq = fabsf(AIN(I_GQ)[lane]), mk = fabsf(AIN(I_GK)[lane]);
#pragma unroll
      for (int o = 1; o < 64; o <<= 1) { mq = fmaxf(mq, __shfl_xor(mq, o)); mk = fmaxf(mk, __shfl_xor(mk, o)); }
      gqa_mf = __builtin_amdgcn_readfirstlane((64.0f * C2_64 * mq * mk <= 100.0f) ? 1 : 0) != 0; }
    const int pb = (C.G % 8 == 0) ? ((C.bid & 7) * (C.G >> 3) + (C.bid >> 3)) : C.bid;
    for (int u = C.bid; u < 1024; u += C.G) {
        const int b = u >> 6, head = (u >> 3) & 7, ch = u & 7, kvh = head >> 2; const size_t rb = (size_t)b * SEQ;
        const int un = u + C.G; const bool hn = un < 1024; const int bn = un >> 6, kvhn = ((un >> 3) & 7) >> 2; const size_t rbn = (size_t)bn * SEQ;
        const bf16* nk = hn ? (const bf16*)(ws + B_KA) + rbn * 128 + kvhn * 64 : nullptr; const bf16* nv = (const bf16*)(ws + B_ZIN) + rbn * ZW + 640 + kvhn * 64;
        if (gqa_mf) att::dense_unit<64, true>(lds, (const bf16*)(ws + B_QA) + rb * 512 + head * 64, 512, 256 * ch, (const bf16*)(ws + B_KA) + rb * 128 + kvh * 64, 128, nullptr,
                            (const bf16*)(ws + B_ZIN) + rb * ZW + 640 + kvh * 64, ZW, (bf16*)(ws + B_O0) + rb * 1024 + head * 64, 1024, taba, u != C.bid, nk, nullptr, nv);
        else att::dense_unit<64, false>(lds, (const bf16*)(ws + B_QA) + rb * 512 + head * 64, 512, 256 * ch, (const bf16*)(ws + B_KA) + rb * 128 + kvh * 64, 128, nullptr,
                            (const bf16*)(ws + B_ZIN) + rb * ZW + 640 + kvh * 64, ZW, (bf16*)(ws + B_O0) + rb * 1024 + head * 64, 1024, taba, u != C.bid, nk, nullptr, nv);
    }
    unsigned mla_mf = 0u;
    { const int tid = fresh_tid(), lane = tid & 63, r = lane & 31, h = lane >> 5; LAS float* xq = (LAS float*)lds; int ui = 0;
      __syncthreads();
      for (int u = pb; u < 1024 && ui < 8; u += C.G, ++ui) {
          const int b = u >> 6, head = (u >> 3) & 7, ch = u & 7;
          const bf16* qrow = (const bf16*)(ws + B_QM) + ((size_t)b * SEQ + 256 * ch + C.wave * 32 + r) * 768 + head * 96 + 8 * h; float nq = 0.f;
#pragma unroll
          for (int ks = 0; ks < 6; ++ks) { const bf16x8 q8 = *(const bf16x8*)(qrow + 16 * ks);
#pragma unroll
              for (int j = 0; j < 8; ++j) { const float f = bf2f((unsigned short)q8[j]); nq += f * f; } }
          nq += __shfl_xor(nq, 32);
#pragma unroll
          for (int o = 1; o < 32; o <<= 1) nq = fmaxf(nq, __shfl_xor(nq, o));
          const f32x4 kv4 = *((const f32x4*)((const float*)(ws + WS_LSE) + (size_t)b * SEQ) + tid);
          float km = fmaxf(fmaxf(kv4.x, kv4.y), fmaxf(kv4.z, kv4.w));
#pragma unroll
          for (int o = 1; o < 64; o <<= 1) km = fmaxf(km, __shfl_xor(km, o));
          if (lane == 0) { xq[ui * 8 + C.wave] = nq; xq[64 + ui * 8 + C.wave] = km; } }
      __syncthreads();
      ui = 0;
      for (int u = pb; u < 1024 && ui < 8; u += C.G, ++ui) {
          const int b = u >> 6, head = (u >> 3) & 7; float qm2 = 0.f;
#pragma unroll
          for (int i = 0; i < 8; ++i) qm2 = fmaxf(qm2, xq[ui * 8 + i]);
          const unsigned* kp = ctl + CW_KP + (b * 8 + head) * 64; float krm = 0.f;
#pragma unroll
          for (int i = 0; i < 8; ++i) krm = fmaxf(krm, xq[64 + ui * 8 + i]);
          const float kb2 = (__uint_as_float(__hip_atomic_load(kp, __ATOMIC_RELAXED, __HIP_MEMORY_SCOPE_AGENT)) + __uint_as_float(__hip_atomic_load(kp + 32, __ATOMIC_RELAXED, __HIP_MEMORY_SCOPE_AGENT)) + krm) * 1.02f;
          if (qm2 * kb2 <= 1.0e4f) mla_mf |= 1u << ui; }
      mla_mf = (unsigned)__builtin_amdgcn_readfirstlane((int)mla_mf);
      __syncthreads(); }
    { int ui = 0;
      for (int u = pb; u < 1024; u += C.G, ++ui) {
        const int b = u >> 6, head = (u >> 3) & 7, ch = u & 7; const size_t rb = (size_t)b * SEQ;
        const int un = u + C.G; const bool hn = un < 1024; const int bn = un >> 6, headn = (un >> 3) & 7; const size_t rbn = (size_t)bn * SEQ;
        const bf16* nk = hn ? (const bf16*)(ws + B_KV) + rbn * 1024 + headn * 128 : nullptr; const bf16* nkr = (const bf16*)(ws + B_KR) + rbn * 32; const bf16* nv = (const bf16*)(ws + B_KV) + rbn * 1024 + headn * 128 + 64;
        if (ui < 8 && ((mla_mf >> ui) & 1u))
            att::dense_unit<96, true>(lds, (const bf16*)(ws + B_QM) + rb * 768 + head * 96, 768, 256 * ch, (const bf16*)(ws + B_KV) + rb * 1024 + head * 128, 1024, (const bf16*)(ws + B_KR) + rb * 32,
                                (const bf16*)(ws + B_KV) + rb * 1024 + head * 128 + 64, 1024, (bf16*)(ws + B_O0) + rb * 1024 + 512 + head * 64, 1024, taba, u != pb, nk, nkr, nv);
        else
            att::dense_unit<96, false>(lds, (const bf16*)(ws + B_QM) + rb * 768 + head * 96, 768, 256 * ch, (const bf16*)(ws + B_KV) + rb * 1024 + head * 128, 1024, (const bf16*)(ws + B_KR) + rb * 32,
                                (const bf16*)(ws + B_KV) + rb * 1024 + head * 128 + 64, 1024, (bf16*)(ws + B_O0) + rb * 1024 + 512 + head * 64, 1024, taba, u != pb, nk, nkr, nv);
      } }
    GRID_BAR();
    { pg8::Gemm g{(const bf16*)(ws + B_O0), (const bf16*)(ws + W_OUT0), 1024, 1024, 1024}; pg8::StaticOrder S; S.init(NTOK / 256, 4, C.G, C.bid);
      pg8::EpiStore E{(bf16*)(ws + B_MO0), 1024, 1.0f, nullptr}; pg8::gemm_phase(lds, g, S, E); }
    GRID_BAR();
    rows_residual<false, true, false, false, false, 2>(C, nullptr, XN, nullptr, (const bf16*)(ws + B_MO0), AIN(I_MIXPOST), nullptr, (float*)(ws + WS_RSTD), nullptr, nullptr, nullptr, nullptr, nullptr, nullptr, ws + B_XN8);
    GRID_BAR();
    { pg8::Gemm g{(const bf16*)(ws + B_XN8), (const bf16*)(ws + W_GU0), 512, 512, 512}; pg8::StaticOrder S; S.init(NTOK / 256, 28, C.G, C.bid);
      pg8::EpiSwiGLU8 E{ws + B_HID, DFF}; pg8::gemm_phase<pg8::EpiSwiGLU8, pg8::StaticOrder, false, true>(lds, g, S, E, 0, 0, pg8::ISC8 * LOG2E, pg8::ISC8 * 8.f / LOG2E); }
    GRID_BAR();
    { pg8::Gemm g{(const bf16*)(ws + B_HID), (const bf16*)(ws + W_D0), DFF / 2, DFF / 2, DFF / 2}; pg8::StaticOrder S; S.init(NTOK / 256, 4, C.G, C.bid);
      pg8::EpiStore E{(bf16*)(ws + B_F), 1024, 1.0f, nullptr}; pg8::gemm_phase<pg8::EpiStore, pg8::StaticOrder, true>(lds, g, S, E, 0x79797979, 0x7c7c7c7c); }
    { pg8::Gemm g{(const bf16*)(ws + WS_PB), (const bf16*)(ws + W_PP), 256, 256, 256}; pg8::StaticOrder S; S.init(NTOK / 256, 4, C.G, C.bid);
      pg8::EpiStore E{(bf16*)(ws + B_E0), 1024, 1.0f, nullptr}; pg8::gemm_phase(lds, g, S, E); }
    GRID_BAR();
    rows_residual<false, true, false, false, false, 2>(C, nullptr, XN, nullptr, (const bf16*)(ws + B_F), AIN(I_FFNPOST), nullptr, (float*)(ws + WS_RSTD), nullptr, nullptr, nullptr, nullptr, nullptr, nullptr, ws + B_XN8);
    GRID_BAR();
    { pg8::Gemm g{(const bf16*)(ws + B_XN8), (const bf16*)(ws + W_PG), 512, 512, 512}; pg8::StaticOrder S; S.init(NTOK / 256, 4, C.G, C.bid);
      pg8::EpiPleGate E{(const bf16*)(ws + B_E0), (bf16*)(ws + B_E), 1024, nullptr}; pg8::gemm_phase<pg8::EpiPleGate, pg8::StaticOrder, false, true>(lds, g, S, E, 0, 0, pg8::ISC8, pg8::ISC8); }
    GRID_BAR();
    rows_residual<false, true, false, false, false, 2>(C, nullptr, XN, nullptr, (const bf16*)(ws + B_E), AIN(I_PLEPOST), nullptr, (float*)(ws + WS_RSTD), nullptr, nullptr, nullptr, nullptr, nullptr, nullptr, ws + B_XN8);
    GRID_BAR();

    { pg8::Gemm g{(const bf16*)(ws + B_XN8), (const bf16*)(ws + W_QKV1), 512, 512, 512}; pg8::StaticOrder S; S.init(NTOK / 256, 18, C.G, C.bid);
      pg8::EpiQKV1 E{(bf16*)(ws + B_QKV), tabp, nullptr}; pg8::gemm_phase<pg8::EpiQKV1, pg8::StaticOrder, false, true>(lds, g, S, E, 0, 0, pg8::ISC8, pg8::ISC8); }
    GRID_BAR();
    __syncthreads();
    { bf16x8 qA[4], qB[4];
      if (pb < 3072) { att::dil_issue(lds, pb, (const bf16*)(ws + B_QKV)); att::dil_qload(pb, (const bf16*)(ws + B_QKV), qA); }
      for (int u = pb; u < 3072; u += 2 * C.G) {
        { const int grp = u >> 10;
          att::dil_unit(lds, u, (u + C.G < 3072) ? u + C.G : -1, (const bf16*)(ws + B_QKV), (bf16*)(ws + B_OG) + (size_t)grp * NTOK * 512, (float*)(ws + WS_LSE) + (size_t)grp * NTOK * 8, qA, qB); }
        if (u + C.G < 3072) { const int u2 = u + C.G, grp = u2 >> 10;
          att::dil_unit(lds, u2, (u2 + C.G < 3072) ? u2 + C.G : -1, (const bf16*)(ws + B_QKV), (bf16*)(ws + B_OG) + (size_t)grp * NTOK * 512, (float*)(ws + WS_LSE) + (size_t)grp * NTOK * 8, qB, qA); }
      } }
    asm volatile("s_waitcnt vmcnt(0) lgkmcnt(0)\n\ts_barrier" ::: "memory");
    GRID_BAR();
    rows_merge(C, (const bf16*)(ws + B_OG), (const float*)(ws + WS_LSE), (bf16*)(ws + B_O1));
    {
        LAS float* scr = (LAS float*)(lds + C.wave * 16384);
        const int lane = fresh_tid() & 63;
        for (int it = gw; it < 3 * 8 * 1792; it += NGW) {
            const int kind = it / (8 * 1792), e = (it / 1792) & 7, r = it % 1792;
            if (kind == 0) transpose_item<1>(AIN(I_MWG) + (size_t)e * 1024 * DFF, 1024, DFF, ws + B_WGU + (size_t)e * 7168 * 1024, 1024, 0, 1, scr, r, lane, AIN(I_FFNPRE) + DM, 64.f * LOG2E);
            else if (kind == 1) transpose_item<1>(AIN(I_MWU) + (size_t)e * 1024 * DFF, 1024, DFF, ws + B_WGU + (size_t)e * 7168 * 1024, 1024, 0, 2, scr, r, lane, AIN(I_FFNPRE) + DM, 64.f / LOG2E);
            else transpose_item<1>(AIN(I_MWD) + (size_t)e * DFF * 1024, DFF, 1024, ws + B_WD + (size_t)e * 1024 * DFF, DFF, 0, 0, scr, r, lane);
        }
    }
    GRID_BAR();
    { pg8::Gemm g{(const bf16*)(ws + B_O1), (const bf16*)(ws + W_OUT1), 512, 512, 512}; pg8::StaticOrder S; S.init(NTOK / 256, 4, C.G, C.bid);
      pg8::EpiStore E{(bf16*)(ws + B_MO1), 1024, 1.0f, nullptr}; pg8::gemm_phase(lds, g, S, E); }
    GRID_BAR();
    rows_residual<false, true, true, false, false>(C, nullptr, XN, nullptr, (const bf16*)(ws + B_MO1), AIN(I_MIXPOST) + DM, AIN(I_FFNPRE) + DM, (float*)(ws + WS_RSTD), nullptr, nullptr, AIN(I_WR),
                                     (int*)(ws + WS_TOKE), (f32x2*)(ws + WS_TOKG), (int*)(ws + WS_CNT));
    GRID_BAR();
    moe_assign_gather(C, (const int*)(ws + WS_CNT), (const int*)(ws + WS_TOKE), (int*)(ws + WS_TOKS), (int*)(ws + WS_TILEE), XN, (const float*)(ws + WS_RSTD), ws + B_XS);
    GRID_BAR();
    int ntail = 0, tailrow0 = 0;
    {
        const int* tilee = (const int*)(ws + WS_TILEE);
        const int ntiles = __builtin_amdgcn_readfirstlane(tilee[0]);
        int tend[7];
#pragma unroll
        for (int j = 0; j < 7; ++j) tend[j] = __builtin_amdgcn_readfirstlane(tilee[1 + j]);
        for (int c = 0; c < 2; ++c) {
            const int tile0 = 128 * c; int ntl = ntiles - tile0; if (ntl <= 0) break; if (c == 0 && ntl > 128) ntl = 128;
            { pg8::Gemm g{(const bf16*)(ws + B_XS), (const bf16*)(ws + B_WGU), 512, 512, 512};
              pg8::MoeOrder S; S.so.init(ntl, 28, C.G, C.bid); for (int j = 0; j < 7; ++j) S.tend[j] = tend[j]; S.tile0 = tile0; S.nbt = 28; S.a_global = true;
              pg8::EpiSwiGLU8 E{ws + B_HC, DFF}; pg8::gemm_phase<pg8::EpiSwiGLU8, pg8::MoeOrder, true>(lds, g, S, E, 0x79797979, 0x7f7f7f7f, 1.f, 1.f, 0x7c7c7c7c); }
            GRID_BAR();
            const int ntm = (c == 1 && ntl >= 128 && ntl <= 135) ? 128 : ntl; ntail = ntl - ntm; tailrow0 = (tile0 + ntm) * 256;
            { pg8::Gemm g{(const bf16*)(ws + B_HC), (const bf16*)(ws + B_WD), DFF / 2, DFF / 2, DFF / 2};
              pg8::MoeOrder S; S.so.init(ntm, 4, C.G, C.bid); for (int j = 0; j < 7; ++j) S.tend[j] = tend[j]; S.tile0 = tile0; S.nbt = 4; S.a_global = false;
              pg8::EpiStore E{(bf16*)(ws + B_Y), 1024, 1.0f, nullptr}; pg8::gemm_phase<pg8::EpiStore, pg8::MoeOrder, true>(lds, g, S, E, 0x79797979, 0x7c7c7c7c); }
            for (int u = C.bid; u < ntail * 28; u += C.G) {
                const int sl = u % 7, t = u / 7, pn = t & 3, tm = t >> 2, tl = tile0 + ntm + tm; int e = 0;
#pragma unroll
                for (int j = 0; j < 7; ++j) e += (tl >= tend[j]) ? 1 : 0;
                pg8::Gemm g{(const bf16*)(ws + B_HC + sl * 512), (const bf16*)(ws + B_WD + sl * 512), DFF / 2, DFF / 2, 256};
                pg8::OneUnit S; S.u.pm = tm; S.u.pn = pn; S.u.pa = ntm + tm; S.u.pb = e * 4 + pn; S.has = true;
                pg8::EpiStore E{(bf16*)(ws + B_YP + sl * YP_STRIDE), 1024, 1.0f, nullptr}; pg8::gemm_phase<pg8::EpiStore, pg8::OneUnit, true>(lds, g, S, E, 0x79797979, 0x7c7c7c7c); }
            GRID_BAR();
        }
    }
    { const int gw = C.bid * NWAVES + C.wave, NGW = C.G * NWAVES, lane = fresh_tid() & 63;
      for (int r = gw; r < ntail * 256; r += NGW) {
          float a[16];
#pragma unroll
          for (int i = 0; i < 16; ++i) a[i] = 0.f;
#pragma unroll
          for (int sl = 0; sl < 7; ++sl) { const u32x4* src = (const u32x4*)(ws + B_YP + sl * YP_STRIDE + (size_t)r * 2048); const u32x4 v0 = src[lane], v1 = src[64 + lane];
              a[0] += __uint_as_float(v0.x << 16); a[1] += __uint_as_float(v0.x & 0xffff0000u); a[2] += __uint_as_float(v0.y << 16); a[3] += __uint_as_float(v0.y & 0xffff0000u);
              a[4] += __uint_as_float(v0.z << 16); a[5] += __uint_as_float(v0.z & 0xffff0000u); a[6] += __uint_as_float(v0.w << 16); a[7] += __uint_as_float(v0.w & 0xffff0000u);
              a[8] += __uint_as_float(v1.x << 16); a[9] += __uint_as_float(v1.x & 0xffff0000u); a[10] += __uint_as_float(v1.y << 16); a[11] += __uint_as_float(v1.y & 0xffff0000u);
              a[12] += __uint_as_float(v1.z << 16); a[13] += __uint_as_float(v1.z & 0xffff0000u); a[14] += __uint_as_float(v1.w << 16); a[15] += __uint_as_float(v1.w & 0xffff0000u); }
          u32x4 o0, o1; o0.x = pk2(a[0], a[1]); o0.y = pk2(a[2], a[3]); o0.z = pk2(a[4], a[5]); o0.w = pk2(a[6], a[7]); o1.x = pk2(a[8], a[9]); o1.y = pk2(a[10], a[11]); o1.z = pk2(a[12], a[13]); o1.w = pk2(a[14], a[15]);
          u32x4* dst = (u32x4*)(ws + B_Y + (size_t)(tailrow0 + r) * 2048); dst[lane] = o0; dst[64 + lane] = o1; } }
    { pg8::Gemm g{(const bf16*)(ws + WS_PB) + (size_t)NTOK * 256, (const bf16*)(ws + W_PP) + 1024 * 256, 256, 256, 256}; pg8::StaticOrder S; S.init(NTOK / 256, 4, C.G, C.bid);
      pg8::EpiStore E{(bf16*)(ws + B_E0b), 1024, 1.0f, nullptr}; pg8::gemm_phase(lds, g, S, E); }
    GRID_BAR();
    rows_residual<true, true, false, false, false, 1>(C, nullptr, XN, nullptr, (const bf16*)(ws + B_Y), AIN(I_FFNPOST) + DM, nullptr, (float*)(ws + WS_RSTD), (const int*)(ws + WS_TOKS), (const f32x2*)(ws + WS_TOKG),
                                     nullptr, nullptr, nullptr, nullptr, ws + B_XN8b);
    GRID_BAR();
    { pg8::Gemm g{(const bf16*)(ws + B_XN8b), (const bf16*)(ws + W_PG) + 1024 * 1024, 512, 512, 512}; pg8::StaticOrder S; S.init(NTOK / 256, 4, C.G, C.bid);
      pg8::EpiPleGate E{(const bf16*)(ws + B_E0b), (bf16*)(ws + B_Eb), 1024, nullptr}; pg8::gemm_phase<pg8::EpiPleGate, pg8::StaticOrder, true>(lds, g, S, E, 0x79797979, 0x7f7f7f7f); }
    GRID_BAR();
    rows_residual<false, false, false, false, true>(C, nullptr, XN, hres, (const bf16*)(ws + B_Eb), AIN(I_PLEPOST) + DM, nullptr, nullptr, nullptr, nullptr, nullptr, nullptr, nullptr, nullptr);
#undef TR
#undef GRID_BAR
#undef AIN
}

extern "C" void kernel_launch(void* const* d_in, const int* in_sizes, int n_in, void* d_out, int out_size, void* d_ws, size_t ws_size, hipStream_t stream) {
    static int grid = 0;
    if (grid == 0) {
        if (n_in != 27 || in_sizes[0] != NTOK * DM || out_size != NTOK * DM || ws_size < WS_END) { fprintf(stderr, "kernel_launch: unexpected shapes / workspace (%zu < %zu)\n", ws_size, (size_t)WS_END); grid = -1; return; }
        int dev = 0, cus = 0;
        if (hipGetDevice(&dev) != hipSuccess || hipDeviceGetAttribute(&cus, hipDeviceAttributeMultiprocessorCount, dev) != hipSuccess) { grid = -1; return; }
        if (hipFuncSetAttribute((const void*)fwd_kernel, hipFuncAttributeMaxDynamicSharedMemorySize, LDS_BYTES) != hipSuccess) { fprintf(stderr, "kernel_launch: hipFuncSetAttribute failed\n"); grid = -1; return; }
        int per_cu = 0;
        if (hipOccupancyMaxActiveBlocksPerMultiprocessor(&per_cu, (const void*)fwd_kernel, NTHREADS, LDS_BYTES) != hipSuccess || per_cu < 1) fprintf(stderr, "kernel_launch: occupancy query reports %d\n", per_cu);
        (void)hipGetLastError();
        if (cus != 256) { fprintf(stderr, "kernel_launch: built for 256 CUs, device has %d\n", cus); grid = -1; return; }
        grid = cus;
    }
    if (grid < 0) return;
    (void)hipMemsetAsync((char*)d_ws + WS_CTL, 0, CTL_ZERO_BYTES, stream);
    Args a{};
    for (int i = 0; i < 27; ++i) a.in[i] = (const float*)d_in[i];
    a.out = (float*)d_out; a.ws = (unsigned char*)d_ws;
    hipLaunchKernelGGL(fwd_kernel, dim3(grid), dim3(NTHREADS), LDS_BYTES, stream, a);
}
```

```cpp
#include <hip/hip_runtime.h>
#include <cstdio>
#include <cstdint>

#define DI __device__ __forceinline__
#define LAS __attribute__((address_space(3)))
#define GAS __attribute__((address_space(1)))
typedef unsigned short bf16;
typedef short bf16x8 __attribute__((ext_vector_type(8)));
typedef short s16x4 __attribute__((ext_vector_type(4)));
typedef float f32x2 __attribute__((ext_vector_type(2)));
typedef float f32x4 __attribute__((ext_vector_type(4)));
typedef float f32x16 __attribute__((ext_vector_type(16)));
typedef unsigned u32x2 __attribute__((ext_vector_type(2)));
typedef unsigned u32x4 __attribute__((ext_vector_type(4)));
typedef __bf16 bf16x2_t __attribute__((ext_vector_type(2)));

constexpr int BATCH = 16, SEQ = 2048, DM = 1024, NTOK = BATCH * SEQ;
constexpr int ZW = 1280;
constexpr int DFF = 3584, NEXP = 8;
constexpr int QKVW = 4608;
constexpr float EPS = 1e-6f;
constexpr float LOG2E = 1.4426950408889634f;
constexpr float C2_64 = 0.125f * LOG2E;
constexpr float C2_96 = 0.10206207261596577f * LOG2E;
constexpr int NWAVES = 8, NTHREADS = 512;
constexpr int MAXTILES = 264;
constexpr int NSLOTS = MAXTILES * 256;

constexpr size_t MiB = 1u << 20;
constexpr size_t WS_CTL = 0, CTL_ZERO_BYTES = 64 * 1024;
constexpr size_t WS_TABA = 1 * MiB;
constexpr size_t WS_TABP = WS_TABA + 2048 * 16 * 8;
constexpr size_t WS_TOKE = 2 * MiB;
constexpr size_t WS_TOKG = WS_TOKE + NTOK * 4;
constexpr size_t WS_TOKS = WS_TOKG + NTOK * 8;
constexpr size_t WS_CNT = WS_TOKS + NTOK * 8;
constexpr size_t WS_TILEE = WS_CNT + 256 * 8 * 4;
constexpr size_t WS_RSTD = 2 * MiB + 768 * 1024;
constexpr size_t WS_LSE = 3 * MiB;
constexpr size_t WS_W = 6 * MiB;
constexpr size_t W_IN = WS_W;
constexpr size_t W_UQ = W_IN + (size_t)ZW * 1024 * 2;
constexpr size_t W_UKV = W_UQ + 768 * 256 * 2;
constexpr size_t W_OUT0 = W_UKV + 1024 * 256 * 2;
constexpr size_t W_GU0 = W_OUT0 + 1024 * 1024 * 2;
constexpr size_t W_D0 = W_GU0 + (size_t)7168 * 1024 * 2;
constexpr size_t W_PP = W_D0 + (size_t)1024 * 3584 * 2;
constexpr size_t W_PG = W_PP + 2 * 1024 * 256 * 2;
constexpr size_t W_QKV1 = W_PG + 2 * 1024 * 1024 * 2;
constexpr size_t W_OUT1 = W_QKV1 + (size_t)QKVW * 1024 * 2;
constexpr size_t W_END = W_OUT1 + 1024 * 512 * 2;
constexpr size_t WS_PB = 48 * MiB;
constexpr size_t WS_XN = 80 * MiB;
constexpr size_t WS_BIG = 144 * MiB;
static_assert(W_END <= WS_PB, "weights");
constexpr size_t B_ZIN = WS_BIG;
constexpr size_t B_QA = WS_BIG + 80 * MiB;
constexpr size_t B_KA = WS_BIG + 112 * MiB;
constexpr size_t B_CQN = WS_BIG + 120 * MiB;
constexpr size_t B_CKVN = WS_BIG + 136 * MiB;
constexpr size_t B_KR = WS_BIG + 152 * MiB;
constexpr size_t B_QM = WS_BIG + 154 * MiB;
constexpr size_t B_KV = WS_BIG + 202 * MiB;
constexpr size_t B_O0 = WS_BIG + 266 * MiB;
constexpr size_t B_MO0 = WS_BIG;
constexpr size_t B_HID = WS_BIG;
constexpr size_t B_F = WS_BIG + 224 * MiB;
constexpr size_t B_E0 = WS_BIG + 288 * MiB;
constexpr size_t B_E = WS_BIG;
constexpr size_t B_QKV = WS_BIG;
constexpr size_t B_OG = WS_BIG + 288 * MiB;
constexpr size_t B_O1 = WS_BIG + 388 * MiB;
constexpr size_t B_XN8 = WS_BIG + 388 * MiB;
constexpr size_t B_MO1 = WS_BIG + 288 * MiB;
constexpr size_t B_WGU = WS_BIG;
constexpr size_t B_WD = WS_BIG + 56 * MiB;
constexpr size_t B_XS = WS_BIG + 84 * MiB;
constexpr size_t B_Y = WS_BIG + 152 * MiB;
constexpr size_t B_HC = WS_BIG + 300 * MiB;
constexpr size_t B_YP = WS_BIG + 84 * MiB;
constexpr size_t YP_STRIDE = (size_t)7 * 256 * 1024 * 2;
constexpr size_t B_E0b = WS_BIG + 356 * MiB;
constexpr size_t B_Eb = WS_BIG;
constexpr size_t B_XN8b = WS_BIG + 96 * MiB;
constexpr size_t WS_END = WS_BIG + 420 * MiB;

constexpr int CW_BAR = 1024;
constexpr int CW_KP = 8192;

constexpr int RING_BYTES = 133120;
constexpr int LDSCTL_OFF = RING_BYTES, MISC_OFF = LDSCTL_OFF + 320;
constexpr int LDS_BYTES = 147456;

DI float bf2f(unsigned short v) { return __uint_as_float((unsigned)v << 16); }
DI unsigned pk2(float lo, float hi) { f32x2 v = {lo, hi}; bf16x2_t b = __builtin_convertvector(v, bf16x2_t); return __builtin_bit_cast(unsigned, b); }
DI float wave_sum(float v) {
#pragma unroll
    for (int o = 1; o < 64; o <<= 1) v += __shfl_xor(v, o);
    return v;
}
DI int fresh_tid() { int t = threadIdx.x; asm volatile("" : "+v"(t)); return t; }
DI float ex2(float x) { return __builtin_amdgcn_exp2f(x); }
DI float rsq(float x) { return 1.0f / sqrtf(x); }
DI void unpack8(u32x4 w, float (&x)[8]) {
    x[0] = __uint_as_float(w.x << 16); x[1] = __uint_as_float(w.x & 0xffff0000u);
    x[2] = __uint_as_float(w.y << 16); x[3] = __uint_as_float(w.y & 0xffff0000u);
    x[4] = __uint_as_float(w.z << 16); x[5] = __uint_as_float(w.z & 0xffff0000u);
    x[6] = __uint_as_float(w.w << 16); x[7] = __uint_as_float(w.w & 0xffff0000u);
}
DI u32x4 pack8(const float (&x)[8]) { u32x4 w; w.x = pk2(x[0], x[1]); w.y = pk2(x[2], x[3]); w.z = pk2(x[4], x[5]); w.w = pk2(x[6], x[7]); return w; }

namespace pg8 {
constexpr int BM = 256, BK = 64, HALF = 128, HTB = HALF * BK * 2, STAGE_BYTES = 8 * HTB, NXCD = 8, WGM = 8;
constexpr int RS_LDS_OFF = STAGE_BYTES;
__host__ __device__ __forceinline__ int lds_byte(int r, int c) { const int st = (r >> 4) * 2 + (c >> 5), rr = r & 15, cc = c & 31, ob = rr * 64 + cc * 2; return st * 1024 + (ob ^ (((ob >> 9) & 1) << 5)); }
__host__ __device__ __forceinline__ void stage_rc(int b, int& R, int& C) { const int st = b / 1024, sb = b % 1024, swz = sb ^ (((sb >> 9) & 1) << 5); R = (st >> 1) * 16 + swz / 64; C = (st & 1) * 32 + (swz % 64) / 2; }
__host__ __device__ __forceinline__ int perm32(int rho) { const int n = rho >> 4, i = rho & 15; return 8 * (i >> 2) + 4 * n + (i & 3); }

struct Unit { int pm, pn, pa, pb; };
struct Gemm { const bf16* A; const bf16* Bt; int lda, ldb, K; };

struct StaticOrder {
    int nM, nN, nwg, G, c;
    DI void init(int nM_, int nN_, int G_, int c_) { nM = nM_; nN = nN_; nwg = nM * nN; G = G_; c = c_; }
    DI bool map(int i, int& pm, int& pn) const {
        const long L = (long)i * G + c; if (L >= nwg) return false;
        int wgid = (int)L; { const int q = nwg / NXCD, r = nwg % NXCD, xcd = wgid % NXCD, off = wgid / NXCD; wgid = (xcd < r ? xcd * (q + 1) : r * (q + 1) + (xcd - r) * q) + off; }
        const int nig = WGM * nN, gid = wgid / nig, fm = gid * WGM, gsz = (nM - fm) < WGM ? (nM - fm) : WGM;
        pm = fm + ((wgid % nig) % gsz); pn = (wgid % nig) / gsz; return true;
    }
    DI bool next(int i, Unit& u) const { int pm, pn; if (!map(i, pm, pn)) return false; u.pm = pm; u.pn = pn; u.pa = pm; u.pb = pn; return true; }
};
struct MoeOrder {
    StaticOrder so; int tend[7]; int tile0, nbt; bool a_global;
    DI bool next(int i, Unit& u) const {
        int pm, pn; if (!so.map(i, pm, pn)) return false;
        const int tl = tile0 + pm; int e = 0;
#pragma unroll
        for (int j = 0; j < 7; ++j) e += (tl >= tend[j]) ? 1 : 0;
        u.pn = pn; u.pb = e * nbt + pn;
        if (a_global) { u.pa = tile0 + pm; u.pm = pm; } else { u.pa = pm; u.pm = tile0 + pm; }
        return true;
    }
};

struct OneUnit { Unit u; bool has; DI bool next(int i, Unit& o) const { if (i != 0 || !has) return false; o = u; return true; } };

struct EpiStore {
    bf16* O; int ldc; float scale; const float* rs;
    static constexpr int NSTORES = 16;
    struct Pre { const LAS float* t; };
    DI Pre pre(const Unit& u, LAS unsigned char* lds, int par, int wid, int lane) const { LAS float* t = (LAS float*)(lds + RS_LDS_OFF + par * 1024);
        return Pre{t}; }
    DI void operator()(const f32x4 (&acc)[2][2][4][2], const Unit& u, int wr, int wc, int fr, int fq, const Pre& P) const {
        const int row0 = u.pm * BM + wr * 64 + fr, col0 = u.pn * BM + wc * 32 + 8 * fq;
#pragma unroll
        for (int ai = 0; ai < 2; ++ai)
#pragma unroll
            for (int m = 0; m < 4; ++m) { bf16* rowp = O + (size_t)(row0 + ai * HALF + m * 16) * ldc + col0; const float sc = rs ? scale * rs[row0 + ai * HALF + m * 16] : scale;
#pragma unroll
                for (int bj = 0; bj < 2; ++bj) { const f32x4 v0 = acc[ai][bj][m][0] * sc, v1 = acc[ai][bj][m][1] * sc;
                    u32x4 w; w.x = pk2(v0[0], v0[1]); w.y = pk2(v0[2], v0[3]); w.z = pk2(v1[0], v1[1]); w.w = pk2(v1[2], v1[3]);
                    *(u32x4*)(rowp + bj * HALF) = w; } }
    }
};
struct EpiStoreKV {
    bf16* O; int ldc; unsigned* kp;
    static constexpr int NSTORES = 16;
    struct Pre { };
    DI Pre pre(const Unit&, LAS unsigned char*, int, int, int) const { return Pre{}; }
    DI void operator()(const f32x4 (&acc)[2][2][4][2], const Unit& u, int wr, int wc, int fr, int fq, const Pre&) const {
        const int row0 = u.pm * BM + wr * 64 + fr, col0 = u.pn * BM + wc * 32 + 8 * fq;
#pragma unroll
        for (int ai = 0; ai < 2; ++ai)
#pragma unroll
            for (int m = 0; m < 4; ++m) { bf16* rowp = O + (size_t)(row0 + ai * HALF + m * 16) * ldc + col0;
#pragma unroll
                for (int bj = 0; bj < 2; ++bj) { const f32x4 v0 = acc[ai][bj][m][0], v1 = acc[ai][bj][m][1];
                    u32x4 w; w.x = pk2(v0[0], v0[1]); w.y = pk2(v0[2], v0[3]); w.z = pk2(v1[0], v1[1]); w.w = pk2(v1[2], v1[3]);
                    *(u32x4*)(rowp + bj * HALF) = w; } }
        if (wc < 2) {
#pragma unroll
            for (int bj = 0; bj < 2; ++bj) { float mx = 0.f;
#pragma unroll
                for (int ai = 0; ai < 2; ++ai)
#pragma unroll
                    for (int m = 0; m < 4; ++m) { const f32x4 v0 = acc[ai][bj][m][0], v1 = acc[ai][bj][m][1];
                        float pq = (v0[0] * v0[0] + v0[1] * v0[1]) + (v0[2] * v0[2] + v0[3] * v0[3]) + (v1[0] * v1[0] + v1[1] * v1[1]) + (v1[2] * v1[2] + v1[3] * v1[3]);
                        pq += __shfl_xor(pq, 16); pq += __shfl_xor(pq, 32); mx = fmaxf(mx, pq); }
                mx = fmaxf(mx, __shfl_xor(mx, 1)); mx = fmaxf(mx, __shfl_xor(mx, 2)); mx = fmaxf(mx, __shfl_xor(mx, 4)); mx = fmaxf(mx, __shfl_xor(mx, 8));
                if (fr == 0 && fq == 0) atomicMax(kp + (((u.pm >> 3) * 8 + 2 * u.pn + bj) * 2 + wc) * 32, __float_as_uint(mx)); }
        }
    }
};
DI float silu_mul(float g, float u) { return g * u * __builtin_amdgcn_rcpf(1.0f + ex2(-g * LOG2E)); }
struct EpiSwiGLU {
    bf16* H; int ldh; const float* rs;
    static constexpr int NSTORES = 8;
    struct Pre { const LAS float* t; };
    DI Pre pre(const Unit& u, LAS unsigned char* lds, int par, int wid, int lane) const { LAS float* t = (LAS float*)(lds + RS_LDS_OFF + par * 1024);
        return Pre{t}; }
    DI void operator()(const f32x4 (&acc)[2][2][4][2], const Unit& u, int wr, int wc, int fr, int fq, const Pre& P) const {
        const int row0 = u.pm * BM + wr * 64 + fr, col0 = u.pn * HALF + wc * 32 + 8 * fq;
#pragma unroll
        for (int ai = 0; ai < 2; ++ai)
#pragma unroll
            for (int m = 0; m < 4; ++m) { bf16* rowp = H + (size_t)(row0 + ai * HALF + m * 16) * ldh + col0; const float sc = rs ? rs[row0 + ai * HALF + m * 16] : 1.0f;
                const f32x4 g0 = acc[ai][0][m][0] * sc, g1 = acc[ai][0][m][1] * sc, u0 = acc[ai][1][m][0] * sc, u1 = acc[ai][1][m][1] * sc;
                u32x4 w; w.x = pk2(silu_mul(g0[0], u0[0]), silu_mul(g0[1], u0[1])); w.y = pk2(silu_mul(g0[2], u0[2]), silu_mul(g0[3], u0[3]));
                w.z = pk2(silu_mul(g1[0], u1[0]), silu_mul(g1[1], u1[1])); w.w = pk2(silu_mul(g1[2], u1[2]), silu_mul(g1[3], u1[3]));
                *(u32x4*)rowp = w; }
    }
};
constexpr float SA8 = 32.0f, SW8 = 1000.0f, ISC8 = 1.0f / (SA8 * SW8);
DI unsigned pk4_i8(float a, float b, float c, float d) {
    const int ia = (int)__builtin_amdgcn_fmed3f(__builtin_rintf(a), -127.f, 127.f), ib = (int)__builtin_amdgcn_fmed3f(__builtin_rintf(b), -127.f, 127.f);
    const int ic = (int)__builtin_amdgcn_fmed3f(__builtin_rintf(c), -127.f, 127.f), id = (int)__builtin_amdgcn_fmed3f(__builtin_rintf(d), -127.f, 127.f);
    return ((unsigned)ia & 0xffu) | (((unsigned)ib & 0xffu) << 8) | (((unsigned)ic & 0xffu) << 16) | ((unsigned)id << 24); }
DI unsigned pk4_fp8(float a, float b, float c, float d) {
    a = __builtin_amdgcn_fmed3f(a, -448.f, 448.f); b = __builtin_amdgcn_fmed3f(b, -448.f, 448.f); c = __builtin_amdgcn_fmed3f(c, -448.f, 448.f); d = __builtin_amdgcn_fmed3f(d, -448.f, 448.f);
    int w = 0; w = __builtin_amdgcn_cvt_pk_fp8_f32(a, b, w, false); w = __builtin_amdgcn_cvt_pk_fp8_f32(c, d, w, true); return (unsigned)w; }
DI float silu_mul_l2(float gl, float ul) { return gl * ul * __builtin_amdgcn_rcpf(1.0f + ex2(-gl)); }
struct EpiSwiGLU8 {
    unsigned char* H; int ldh;
    static constexpr int NSTORES = 8;
    struct Pre { };
    DI Pre pre(const Unit&, LAS unsigned char*, int, int, int) const { return Pre{}; }
    DI void operator()(const f32x4 (&acc)[2][2][4][2], const Unit& u, int wr, int wc, int fr, int fq, const Pre&) const {
        const int row0 = u.pm * BM + wr * 64 + fr, col0 = u.pn * HALF + wc * 32 + 8 * fq;
#pragma unroll
        for (int ai = 0; ai < 2; ++ai)
#pragma unroll
            for (int m = 0; m < 4; ++m) { unsigned char* rowp = H + (size_t)(row0 + ai * HALF + m * 16) * ldh + col0;
                const f32x4 g0 = acc[ai][0][m][0], g1 = acc[ai][0][m][1], u0 = acc[ai][1][m][0], u1 = acc[ai][1][m][1];
                u32x2 w; w.x = pk4_fp8(silu_mul_l2(g0[0], u0[0]), silu_mul_l2(g0[1], u0[1]), silu_mul_l2(g0[2], u0[2]), silu_mul_l2(g0[3], u0[3]));
                w.y = pk4_fp8(silu_mul_l2(g1[0], u1[0]), silu_mul_l2(g1[1], u1[1]), silu_mul_l2(g1[2], u1[2]), silu_mul_l2(g1[3], u1[3]));
                *(u32x2*)rowp = w; }
    }
};
struct EpiPleGate {
    const bf16* E0; bf16* E; int ldc; const float* rs;
    static constexpr int NSTORES = 16;
    struct Pre { const LAS float* t; };
    DI Pre pre(const Unit& u, LAS unsigned char* lds, int par, int wid, int lane) const { LAS float* t = (LAS float*)(lds + RS_LDS_OFF + par * 1024);
        return Pre{t}; }
    DI void operator()(const f32x4 (&acc)[2][2][4][2], const Unit& u, int wr, int wc, int fr, int fq, const Pre& P) const {
        const int row0 = u.pm * BM + wr * 64 + fr, col0 = u.pn * BM + wc * 32 + 8 * fq;
#pragma unroll
        for (int ai = 0; ai < 2; ++ai)
#pragma unroll
            for (int m = 0; m < 4; ++m) { const size_t off = (size_t)(row0 + ai * HALF + m * 16) * ldc + col0; const float sc = rs ? rs[row0 + ai * HALF + m * 16] * LOG2E : LOG2E;
#pragma unroll
                for (int bj = 0; bj < 2; ++bj) { const u32x4 ew = *(const u32x4*)(E0 + off + bj * HALF); float e[8]; unpack8(ew, e);
                    const f32x4 v0 = acc[ai][bj][m][0] * sc, v1 = acc[ai][bj][m][1] * sc; float o[8];
#pragma unroll
                    for (int j = 0; j < 4; ++j) { o[j] = e[j] * __builtin_amdgcn_rcpf(1.0f + ex2(-v0[j])); o[4 + j] = e[4 + j] * __builtin_amdgcn_rcpf(1.0f + ex2(-v1[j])); }
                    *(u32x4*)(E + off + bj * HALF) = pack8(o); } }
    }
};
struct EpiQKV1 {
    bf16* O; const f32x2* tabp; const float* rs;
    static constexpr int NSTORES = 16;
    struct Pre { const LAS float* t; };
    DI Pre pre(const Unit& u, LAS unsigned char* lds, int par, int wid, int lane) const { LAS float* t = (LAS float*)(lds + RS_LDS_OFF + par * 1024);
        return Pre{t}; }
    DI void operator()(const f32x4 (&acc)[2][2][4][2], const Unit& u, int wr, int wc, int fr, int fq, const Pre& P) const {
        const int row0 = u.pm * BM + wr * 64 + fr;
        const int which = ((u.pn * BM) % 1536) / 512;
        const int grp = (u.pn * BM) / 1536, sh = 2 * grp;
        const float sc = which == 0 ? C2_64 : 1.0f;
        const bool rot = which < 2;
        const bool mine = ((wc & 1) == 0) && (fq < 2);
#pragma unroll
        for (int ai = 0; ai < 2; ++ai)
#pragma unroll
            for (int m = 0; m < 4; ++m) { const int row = row0 + ai * HALF + m * 16, bb = row >> 11, t = row & (SEQ - 1);
                const int pos = ((t & ((1 << sh) - 1)) << (11 - sh)) + (t >> sh);
                const float scr = rs ? sc * rs[row] : sc;
                f32x4 cs4[4];
                if (rot && mine) {
#pragma unroll
                    for (int q = 0; q < 4; ++q) cs4[q] = ((const f32x4*)(tabp + (size_t)t * 8))[q];
                }
#pragma unroll
                for (int bj = 0; bj < 2; ++bj) { float v[8];
                    const int head = ((u.pn * BM + bj * HALF + wc * 32) % 512) / 64, d0 = ((wc & 1) * 32) + 8 * fq;
                    bf16* dst = O + ((size_t)((((bb * 3 + grp) * 3 + which) * 8 + head) * SEQ + pos)) * 64 + d0;
#pragma unroll
                    for (int j = 0; j < 4; ++j) { v[j] = acc[ai][bj][m][0][j]; v[4 + j] = acc[ai][bj][m][1][j]; }
                    if (rot) {
                        float p[8];
#pragma unroll
                        for (int j = 0; j < 8; ++j) p[j] = __shfl_xor(v[j], 16);
                        if (mine) {
#pragma unroll
                            for (int j = 0; j < 8; ++j) { const float cx = cs4[j >> 1][(j & 1) * 2], sy = cs4[j >> 1][(j & 1) * 2 + 1]; v[j] = (fq == 0) ? (v[j] * cx - p[j] * sy) : (v[j] * cx + p[j] * sy); }
                        }
                    }
#pragma unroll
                    for (int j = 0; j < 8; ++j) v[j] *= scr;
                    *(u32x4*)dst = pack8(v); } }
    }
};

typedef int v8i32 __attribute__((ext_vector_type(8)));
typedef int v4i32 __attribute__((ext_vector_type(4)));
DI v8i32 cat8(bf16x8 lo, bf16x8 hi) { const v4i32 a = __builtin_bit_cast(v4i32, lo), b = __builtin_bit_cast(v4i32, hi); return __builtin_shufflevector(a, b, 0, 1, 2, 3, 4, 5, 6, 7); }
template <class Epi, class Sched, bool FP8 = false, bool I8 = false>
DI void gemm_phase(LAS unsigned char* lds, const Gemm g, const Sched& S, const Epi& E, const int scw = 0x7f7f7f7f, const int sca = 0x7f7f7f7f, const float isc0 = 1.f, const float isc1 = 1.f, const int scw1 = 0) {
    const int tid = fresh_tid(), wid = __builtin_amdgcn_readfirstlane(tid >> 6), lane = tid & 63, wr = wid >> 2, wc = wid & 3, fr = lane & 15, fq = lane >> 4;
    const int scwb = scw1 ? scw1 : scw;
    const int K = g.K; int nt = K / BK; if constexpr (FP8 || I8) asm volatile("" : "+s"(nt));
    unsigned voffA[2], voffB[2];
#pragma unroll
    for (int i = 0; i < 2; ++i) { int R, C; stage_rc(tid * 16 + i * 8192, R, C); const int Rb = (R & ~31) + perm32(R & 31);
        voffA[i] = (unsigned)(R * g.lda + C) * 2u; voffB[i] = (unsigned)(Rb * g.ldb + C) * 2u; }
    const size_t kstep = (size_t)(BK * 2);
    const size_t hstepA = (size_t)HALF * g.lda * 2, hstepB = (size_t)HALF * g.ldb * 2;
    const size_t tstepA = 2 * hstepA, tstepB = 2 * hstepB;
    const unsigned ldsw = (unsigned)wid * 1024u;
    const int aoff = lds_byte(wr * 64 + fr, fq * 8), boff = lds_byte(wc * 32 + fr, fq * 8);
#define PG8_SA(b, h) (((b) * 2 + (h)) * HTB)
#define PG8_SB(b, h) ((4 + (b) * 2 + (h)) * HTB)
#define PG8_STAGE(bufoff, gbase, voff) do { _Pragma("unroll") for (int _i = 0; _i < 2; ++_i) \
        __builtin_amdgcn_global_load_lds((const unsigned*)((const char*)(gbase) + (voff)[_i]), (LAS unsigned*)(lds + (bufoff) + ldsw + _i * 8192), 16, 0, 0); } while (0)
#define PG8_LDA(dst, b, h) do { _Pragma("unroll") for (int m = 0; m < 4; ++m) { \
        if constexpr (FP8) dst##8[m] = cat8(*(const LAS bf16x8*)(lds + PG8_SA(b, h) + aoff + m * 2048), *(const LAS bf16x8*)(lds + PG8_SA(b, h) + aoff + m * 2048 + 1024)); \
        else { _Pragma("unroll") for (int k = 0; k < 2; ++k) dst[m][k] = *(const LAS bf16x8*)(lds + PG8_SA(b, h) + aoff + m * 2048 + k * 1024); } } } while (0)
#define PG8_LDB(dst, b, h) do { _Pragma("unroll") for (int n = 0; n < 2; ++n) { \
        if constexpr (FP8) dst##8[n] = cat8(*(const LAS bf16x8*)(lds + PG8_SB(b, h) + boff + n * 2048), *(const LAS bf16x8*)(lds + PG8_SB(b, h) + boff + n * 2048 + 1024)); \
        else { _Pragma("unroll") for (int k = 0; k < 2; ++k) dst[n][k] = *(const LAS bf16x8*)(lds + PG8_SB(b, h) + boff + n * 2048 + k * 1024); } } } while (0)
#define PG8_MMA(ai, bj, At, Bt) do { __builtin_amdgcn_s_setprio(1); \
        if constexpr (FP8) { _Pragma("unroll") for (int m = 0; m < 4; ++m) _Pragma("unroll") for (int n = 0; n < 2; ++n) \
            asm volatile("s_nop 1\n\tv_mfma_scale_f32_16x16x128_f8f6f4 %0, %1, %2, %0, %3, %4 op_sel_hi:[0,0,0]" : "+v"(acc[ai][bj][m][n]) : "v"(Bt##8[n]), "v"(At##8[m]), "v"((bj) == 1 ? scwb : scw), "v"(sca)); } \
        else if constexpr (I8) { _Pragma("unroll") for (int k = 0; k < 2; ++k) _Pragma("unroll") for (int m = 0; m < 4; ++m) _Pragma("unroll") for (int n = 0; n < 2; ++n) \
            asm volatile("v_mfma_i32_16x16x64_i8 %0, %1, %2, %0" : "+v"(acc[ai][bj][m][n]) : "v"(Bt[n][k]), "v"(At[m][k])); } \
        else { _Pragma("unroll") for (int k = 0; k < 2; ++k) _Pragma("unroll") for (int m = 0; m < 4; ++m) _Pragma("unroll") for (int n = 0; n < 2; ++n)     \
            asm volatile("v_mfma_f32_16x16x32_bf16 %0, %1, %2, %0" : "+v"(acc[ai][bj][m][n]) : "v"(Bt[n][k]), "v"(At[m][k])); } \
        __builtin_amdgcn_s_setprio(0); } while (0)
#define PG8_MMA0(ai, bj, At, Bt) do { __builtin_amdgcn_s_setprio(1); \
        if constexpr (FP8) { _Pragma("unroll") for (int m = 0; m < 4; ++m) _Pragma("unroll") for (int n = 0; n < 2; ++n) \
            asm volatile("s_nop 1\n\tv_mfma_scale_f32_16x16x128_f8f6f4 %0, %1, %2, 0, %3, %4 op_sel_hi:[0,0,0]" : "=&v"(acc[ai][bj][m][n]) : "v"(Bt##8[n]), "v"(At##8[m]), "v"((bj) == 1 ? scwb : scw), "v"(sca)); } \
        else if constexpr (I8) { _Pragma("unroll") for (int m = 0; m < 4; ++m) _Pragma("unroll") for (int n = 0; n < 2; ++n) \
            asm volatile("v_mfma_i32_16x16x64_i8 %0, %1, %2, 0" : "=&v"(acc[ai][bj][m][n]) : "v"(Bt[n][0]), "v"(At[m][0])); \
          _Pragma("unroll") for (int m = 0; m < 4; ++m) _Pragma("unroll") for (int n = 0; n < 2; ++n) \
            asm volatile("v_mfma_i32_16x16x64_i8 %0, %1, %2, %0" : "+v"(acc[ai][bj][m][n]) : "v"(Bt[n][1]), "v"(At[m][1])); } \
        else { _Pragma("unroll") for (int m = 0; m < 4; ++m) _Pragma("unroll") for (int n = 0; n < 2; ++n) \
            asm volatile("v_mfma_f32_16x16x32_bf16 %0, %1, %2, 0" : "=&v"(acc[ai][bj][m][n]) : "v"(Bt[n][0]), "v"(At[m][0])); \
          _Pragma("unroll") for (int m = 0; m < 4; ++m) _Pragma("unroll") for (int n = 0; n < 2; ++n) \
            asm volatile("v_mfma_f32_16x16x32_bf16 %0, %1, %2, %0" : "+v"(acc[ai][bj][m][n]) : "v"(Bt[n][1]), "v"(At[m][1])); } \
        __builtin_amdgcn_s_setprio(0); } while (0)
#define PG8_TIE_ACC(NOPS) do { \
        asm volatile(NOPS : "+v"(acc[0][0][0][0]), "+v"(acc[0][0][0][1]), "+v"(acc[0][0][1][0]), "+v"(acc[0][0][1][1]), "+v"(acc[0][0][2][0]), "+v"(acc[0][0][2][1]), "+v"(acc[0][0][3][0]), "+v"(acc[0][0][3][1]), \
                            "+v"(acc[0][1][0][0]), "+v"(acc[0][1][0][1]), "+v"(acc[0][1][1][0]), "+v"(acc[0][1][1][1]), "+v"(acc[0][1][2][0]), "+v"(acc[0][1][2][1]), "+v"(acc[0][1][3][0]), "+v"(acc[0][1][3][1])); \
        asm volatile("" : "+v"(acc[1][0][0][0]), "+v"(acc[1][0][0][1]), "+v"(acc[1][0][1][0]), "+v"(acc[1][0][1][1]), "+v"(acc[1][0][2][0]), "+v"(acc[1][0][2][1]), "+v"(acc[1][0][3][0]), "+v"(acc[1][0][3][1]), \
                          "+v"(acc[1][1][0][0]), "+v"(acc[1][1][0][1]), "+v"(acc[1][1][1][0]), "+v"(acc[1][1][1][1]), "+v"(acc[1][1][2][0]), "+v"(acc[1][1][2][1]), "+v"(acc[1][1][3][0]), "+v"(acc[1][1][3][1])); } while (0)
#define PG8_WAIT_V(n) asm volatile("s_waitcnt vmcnt(" #n ")" ::: "memory")
#define PG8_WAIT_L(n) asm volatile("s_waitcnt lgkmcnt(" #n ")" ::: "memory")
#define PG8_BAR __builtin_amdgcn_s_barrier()
#define PG8_SCHED __builtin_amdgcn_sched_barrier(0)
    Unit cur, nxt; int ui = 0;
    if (!S.next(0, cur)) return;
    f32x4 acc[2][2][4][2];
    bf16x8 At[4][2], B0[2][2], B1[2][2]; v8i32 At8[4], B08[2], B18[2];
    const char* cA = (const char*)g.A + (size_t)cur.pa * tstepA; const char* cB = (const char*)g.Bt + (size_t)cur.pb * tstepB;
    PG8_STAGE(PG8_SB(0, 0), cB, voffB); PG8_STAGE(PG8_SB(0, 1), cB + hstepB, voffB); PG8_STAGE(PG8_SA(0, 0), cA, voffA); PG8_STAGE(PG8_SA(0, 1), cA + hstepA, voffA);
    if (wr == 1) PG8_BAR;
    PG8_WAIT_V(2); PG8_BAR;
    PG8_STAGE(PG8_SB(1, 0), cB + kstep, voffB); PG8_STAGE(PG8_SA(1, 0), cA + kstep, voffA); PG8_STAGE(PG8_SB(1, 1), cB + hstepB + kstep, voffB);
    PG8_WAIT_V(0); PG8_BAR;
    for (;;) {
        const bool has_next = S.next(ui + 1, nxt);
        const typename Epi::Pre epre = E.pre(cur, lds, ui & 1, wid, lane);
        const char* nA = has_next ? (const char*)g.A + (size_t)nxt.pa * tstepA : cA; const char* nB = has_next ? (const char*)g.Bt + (size_t)nxt.pb * tstepB : cB;
#define PG8_WAITX(R) PG8_WAIT_V(8)
#define PG8_KBODY(t, R, LASTX) do { \
            const bool last = (LASTX); \
            const char* a1 = cA + (size_t)((t) + 1) * kstep; \
            const char* a2 = last ? nA : cA + (size_t)((t) + 2) * kstep; const char* b2 = last ? nB : cB + (size_t)((t) + 2) * kstep; \
            const char* a3 = a2 + kstep; const char* b3 = b2 + kstep; \
              \
            PG8_LDB(B0, 0, 0); PG8_LDB(B1, 0, 1); PG8_SCHED; PG8_LDA(At, 0, 0); PG8_STAGE(PG8_SA(1, 1), a1 + hstepA, voffA); \
            PG8_WAITX(R); PG8_WAIT_L(0); PG8_BAR; if ((t) == 0) { PG8_MMA0(0, 0, At, B0); PG8_MMA0(0, 1, At, B1); } else { PG8_MMA(0, 0, At, B0); PG8_MMA(0, 1, At, B1); } PG8_BAR; PG8_SCHED; \
              \
            PG8_LDA(At, 0, 1); PG8_STAGE(PG8_SB(0, 0), b2, voffB); PG8_STAGE(PG8_SB(0, 1), b2 + hstepB, voffB); PG8_STAGE(PG8_SA(0, 0), a2, voffA); \
            PG8_WAITX(R); PG8_WAIT_L(0); PG8_BAR; if ((t) == 0) { PG8_MMA0(1, 0, At, B0); PG8_MMA0(1, 1, At, B1); } else { PG8_MMA(1, 0, At, B0); PG8_MMA(1, 1, At, B1); } PG8_BAR; PG8_SCHED; \
              \
            PG8_LDB(B0, 1, 0); PG8_LDB(B1, 1, 1); PG8_SCHED; PG8_LDA(At, 1, 0); PG8_STAGE(PG8_SA(0, 1), a2 + hstepA, voffA); \
            PG8_WAIT_V(8); PG8_WAIT_L(0); PG8_BAR; PG8_MMA(0, 0, At, B0); PG8_MMA(0, 1, At, B1); PG8_BAR; PG8_SCHED; \
              \
            PG8_LDA(At, 1, 1); PG8_STAGE(PG8_SB(1, 0), b3, voffB); PG8_STAGE(PG8_SB(1, 1), b3 + hstepB, voffB); PG8_STAGE(PG8_SA(1, 0), a3, voffA); \
            PG8_WAIT_V(8); PG8_WAIT_L(0); PG8_BAR; PG8_MMA(1, 0, At, B0); PG8_MMA(1, 1, At, B1); PG8_BAR; PG8_SCHED; \
        } while (0)
        for (int t = 0; t < nt; t += 2) PG8_KBODY(t, false, t == nt - 2);
        if (wr == 0) PG8_BAR;
        PG8_TIE_ACC("s_nop 15\n\ts_nop 15");
        if constexpr (I8) {
#pragma unroll
            for (int a_ = 0; a_ < 2; ++a_)
#pragma unroll
                for (int b_ = 0; b_ < 2; ++b_)
#pragma unroll
                    for (int m_ = 0; m_ < 4; ++m_)
#pragma unroll
                        for (int n_ = 0; n_ < 2; ++n_)
#pragma unroll
                            for (int j_ = 0; j_ < 4; ++j_) { const float t_ = acc[a_][b_][m_][n_][j_]; acc[a_][b_][m_][n_][j_] = (float)__float_as_int(t_) * (b_ == 1 ? isc1 : isc0); }
        }
        E(acc, cur, wr, wc, fr, fq, epre);
        if (!has_next) break;
        cur = nxt; cA = nA; cB = nB; ++ui;
        if (wr == 1) PG8_BAR;
    }
    PG8_WAIT_V(0);
    PG8_BAR;
#undef PG8_SA
#undef PG8_SB
#undef PG8_STAGE
#undef PG8_LDA
#undef PG8_LDB
#undef PG8_MMA
#undef PG8_MMA0
#undef PG8_WAIT_V
#undef PG8_TIE_ACC
#undef PG8_WAITX
#undef PG8_KBODY
#undef PG8_WAIT_L
#undef PG8_BAR
#undef PG8_SCHED
}
}

namespace att {
#define MFMA32(a, b, c) __builtin_amdgcn_mfma_f32_32x32x16_bf16((a), (b), (c), 0, 0, 0)
DI int crow(int i, int h) { return (i & 3) + 8 * (i >> 2) + 4 * h; }
typedef short v4i16_t __attribute__((ext_vector_type(4)));
DI s16x4 vtr(const LAS unsigned char* p) { return __builtin_bit_cast(s16x4, __builtin_amdgcn_ds_read_tr16_b64_v4i16((LAS v4i16_t*)p)); }
DI bf16x8 packp(const f32x16& p, int b) {
    u32x4 w; w.x = pk2(p[b], p[b + 1]); w.y = pk2(p[b + 2], p[b + 3]); w.z = pk2(p[b + 4], p[b + 5]); w.w = pk2(p[b + 6], p[b + 7]);
    return __builtin_bit_cast(bf16x8, w);
}
constexpr float NEGBIG = -1.0e30f;
constexpr float DEFER_THR = 8.0f;
template <int DK, int MASK>
DI void tile_step(const LAS unsigned char* Kb, const LAS unsigned char* Vb, const int (&koff)[4], const bf16x8 (&qr)[DK / 16], f32x16& o0, f32x16& o1, float& m, float& l,
                  LAS float* wsf, int r, int h, int lane, int qi, int kj0, const bool first) {
    f32x16 p0, p1;
#pragma unroll
    for (int i = 0; i < 16; ++i) { p0[i] = 0.f; p1[i] = 0.f; }
#pragma unroll
    for (int ks = 0; ks < DK / 16; ++ks) {
        const bf16x8 a0 = *(const LAS bf16x8*)(Kb + koff[ks]);
        const bf16x8 a1 = *(const LAS bf16x8*)(Kb + koff[ks] + 4096);
        p0 = MFMA32(a0, qr[ks], p0); p1 = MFMA32(a1, qr[ks], p1);
    }
    if (MASK) {
        const int D = qi - kj0 - 4 * h;
#pragma unroll
        for (int i = 0; i < 16; ++i) { const int c0 = (i & 3) + 8 * (i >> 2);
            if (MASK == 1) { if (D > 64 + c0) p0[i] = NEGBIG; if (D > 96 + c0) p1[i] = NEGBIG; }
            else if (MASK == 2) { if (D < -64 + c0) p0[i] = NEGBIG; if (D < -32 + c0) p1[i] = NEGBIG; }
            else { if (D > 64 + c0 || D < -64 + c0) p0[i] = NEGBIG; if (D > 96 + c0 || D < -32 + c0) p1[i] = NEGBIG; } }
    }
    float tm = fmaxf(p0[0], p1[0]);
#pragma unroll
    for (int i = 1; i < 16; ++i) tm = fmaxf(tm, fmaxf(p0[i], p1[i]));
    tm = fmaxf(tm, __shfl_xor(tm, 32));
    if (first) m = tm;
    else if (__any(tm > m + DEFER_THR)) {
        const float mn = fmaxf(m, tm), al = ex2(m - mn); l *= al; m = mn;
        if (h == 0) wsf[r] = al;
#pragma unroll
        for (int i = 0; i < 16; ++i) { const float f = wsf[crow(i, h)]; o0[i] *= f; o1[i] *= f; }
    }
    float sum = 0.f;
#pragma unroll
    for (int i = 0; i < 16; ++i) { p0[i] = ex2(p0[i] - m); p1[i] = ex2(p1[i] - m); sum += p0[i] + p1[i]; }
    l += sum;
    const LAS unsigned char* vp = Vb + ((lane >> 4) & 1) * 32 + (lane & 3) * 8 + (4 * h + ((lane & 15) >> 2)) * 64;
#pragma unroll
    for (int s = 0; s < 4; ++s) {
        const bf16x8 pa = (s == 0) ? packp(p0, 0) : (s == 1) ? packp(p0, 8) : (s == 2) ? packp(p1, 0) : packp(p1, 8);
#pragma unroll
        for (int db = 0; db < 2; ++db) {
            const s16x4 lo = vtr(vp + db * 4096 + s * 1024), hi = vtr(vp + db * 4096 + s * 1024 + 512);
            const bf16x8 vf = {lo[0], lo[1], lo[2], lo[3], hi[0], hi[1], hi[2], hi[3]};
            if (db == 0) o0 = MFMA32(pa, vf, o0); else o1 = MFMA32(pa, vf, o1);
        }
    }
}
DI void finish_store(const f32x16& o0, const f32x16& o1, float l, LAS float* wsf, LAS unsigned short* stg, int r, int h, int lane, bf16* orow0, size_t rstride) {
    const float lt = l + __shfl_xor(l, 32);
    if (h == 0) wsf[r] = 1.0f / lt;
#pragma unroll
    for (int i = 0; i < 16; ++i) { const int row = crow(i, h); const float f = wsf[row];
        stg[row * 64 + r] = (unsigned short)(pk2(o0[i] * f, 0.f) & 0xffffu); stg[row * 64 + 32 + r] = (unsigned short)(pk2(o1[i] * f, 0.f) & 0xffffu); }
#pragma unroll
    for (int it = 0; it < 4; ++it) { const int row = it * 8 + (lane >> 3), ch = lane & 7;
        const u32x4 v = *(const LAS u32x4*)(stg + row * 64 + ch * 8);
        *(u32x4*)(orow0 + (size_t)row * rstride + ch * 8) = v; }
}
#define ATT_WAITBAR(N) asm volatile("s_waitcnt vmcnt(" #N ") lgkmcnt(0)\n\ts_barrier" ::: "memory")
DI void dma16(const void* gsrc, LAS unsigned char* ldst) { __builtin_amdgcn_global_load_lds((const unsigned*)gsrc, (LAS unsigned*)ldst, 16, 0, 0); }

template <int DK, bool MF = false>
DI void dense_unit(LAS unsigned char* lds, const bf16* qS, int qp, int q0, const bf16* kA, int kpA, const bf16* kB, const bf16* vS, int vpitch, bf16* oS, int op, const f32x2* taba,
                   const bool pre, const bf16* nkA, const bf16* nkB, const bf16* nvS) {
    constexpr int NKC = DK / 8, KSLOT = NKC * 1024, VSLOT = 8192, NS = 4, KS = DK / 16;
    constexpr int OFF_V = NS * KSLOT, OFF_WS = OFF_V + NS * VSLOT, OFF_STG = OFF_WS + NWAVES * 256;
    const int tid = fresh_tid(), lane = tid & 63, r = lane & 31, h = lane >> 5; const int w = __builtin_amdgcn_readfirstlane(tid >> 6);
    LAS float* wsf = (LAS float*)(lds + OFF_WS) + w * 64;
    LAS unsigned short* stg = (LAS unsigned short*)(lds + OFF_STG) + w * 2048;
    const bf16* ksrcA = kA + (size_t)(8 * w + (lane >> 3)) * kpA + ((lane & 7) ^ ((4 * w + (lane >> 4)) & 7)) * 8;
    const bf16* ksrcB = (DK == 96) ? (kB + (size_t)(16 * (w & 3) + (lane >> 2)) * 32 + ((lane & 3) ^ ((lane >> 4) & 3)) * 8) : kA;
    const bf16* vsrc = vS + (size_t)(16 * (w & 3) + (lane >> 2)) * vpitch + (w >> 2) * 32 + (lane & 3) * 8;
    const size_t kstA = (size_t)64 * kpA, kstB = 64 * 32, vst = (size_t)64 * vpitch;
    int koff[KS];
#pragma unroll
    for (int ks = 0; ks < KS; ++ks) koff[ks] = (ks < 4) ? (r * 128 + (((2 * ks + h) ^ ((r >> 1) & 7)) << 4)) : (8192 + r * 64 + (((2 * (ks - 4) + h) ^ ((r >> 2) & 3)) << 4));
#define ISSUE_K(t) do { const int sl_ = (t) % NS; dma16(ksrcA + (size_t)(t) * kstA, lds + sl_ * KSLOT + w * 1024); \
        if (DK == 96) dma16(ksrcB + (size_t)(t) * kstB, lds + sl_ * KSLOT + (8 + (w & 3)) * 1024); } while (0)
#define ISSUE_V(t) do { const int sl_ = (t) % NS; dma16(vsrc + (size_t)(t) * vst, lds + OFF_V + sl_ * VSLOT + w * 1024); } while (0)
    bf16x8 qr[KS];
    const bf16* qrow = qS + (size_t)(q0 + w * 32 + r) * qp + 8 * h;
#pragma unroll
    for (int ks = 0; ks < KS; ++ks) qr[ks] = *(const bf16x8*)(qrow + 16 * ks);
    if (!pre) { ISSUE_K(0); ISSUE_K(1); ISSUE_V(0); ISSUE_K(2); ISSUE_V(1); }
    if (DK == 96) {
        const f32x2* tp = taba + (size_t)(q0 + w * 32 + r) * 16 + 8 * h;
        bf16x8 a = qr[4], b = qr[5];
#pragma unroll
        for (int j = 0; j < 8; ++j) { const f32x2 cs = tp[j]; const float x1 = bf2f((unsigned short)a[j]), x2 = bf2f((unsigned short)b[j]);
            a[j] = (short)(pk2(x1 * cs.x - x2 * cs.y, 0.f) & 0xffffu); b[j] = (short)(pk2(x2 * cs.x + x1 * cs.y, 0.f) & 0xffffu); }
        qr[4] = a; qr[5] = b;
    }
    f32x16 o0, o1, negm, pA0, pA1, pB0, pB1;
#pragma unroll
    for (int i = 0; i < 16; ++i) { o0[i] = 0.f; o1[i] = 0.f; negm[i] = 0.f; }
    float m = 0.f, l = 0.f;
    const LAS unsigned char* kp0 = lds;
    const LAS unsigned char* vp0 = lds + OFF_V + ((lane >> 4) & 1) * 32 + (lane & 3) * 8 + (4 * h + ((lane & 15) >> 2)) * 64;
#define QK_TILE(P0, P1, kb_) do { _Pragma("unroll") for (int ks = 0; ks < KS; ++ks) { \
        const bf16x8 a0_ = *(const LAS bf16x8*)((kb_) + koff[ks]), a1_ = *(const LAS bf16x8*)((kb_) + koff[ks] + (ks < 4 ? 4096 : 2048)); \
        if (ks == 0) { P0 = MFMA32(a0_, qr[0], negm); P1 = MFMA32(a1_, qr[0], negm); } else { P0 = MFMA32(a0_, qr[ks], P0); P1 = MFMA32(a1_, qr[ks], P1); } } } while (0)
    constexpr int NT = SEQ / 64, G = (DK == 96) ? 3 : 2;
#define ROWMAX(dst, P0, P1) do { float a_ = fmaxf(fmaxf(P0[0], P0[1]), P1[0]), b_ = fmaxf(fmaxf(P0[2], P0[3]), P1[1]); a_ = fmaxf(fmaxf(a_, P1[2]), P1[3]); \
        _Pragma("unroll") for (int i = 4; i < 16; i += 4) { a_ = fmaxf(fmaxf(a_, P0[i]), P0[i + 1]); b_ = fmaxf(fmaxf(b_, P0[i + 2]), P0[i + 3]); a_ = fmaxf(fmaxf(a_, P1[i]), P1[i + 1]); b_ = fmaxf(fmaxf(b_, P1[i + 2]), P1[i + 3]); } \
        const float m_ = fmaxf(a_, b_); const auto rr_ = __builtin_amdgcn_permlane32_swap(__float_as_uint(m_), __float_as_uint(m_), false, false); \
        dst = fmaxf(__uint_as_float(rr_[0]), __uint_as_float(rr_[1])); } while (0)
    if (DK == 96) ATT_WAITBAR(6); else ATT_WAITBAR(4);
    QK_TILE(pA0, pA1, kp0);
    float dl = 0.f; bool rebase = !MF;
    if constexpr (!MF) ROWMAX(dl, pA0, pA1);
#define STEP(t, P0, P1, Pn0, Pn1) do { \
        if ((t) + 3 <= NT) { if (DK == 96) ATT_WAITBAR(3); else ATT_WAITBAR(2); } else ATT_WAITBAR(0);       \
        if ((t) + 3 < NT) ISSUE_K((t) + 3); if ((t) + 2 < NT) ISSUE_V((t) + 2); \
          \
        if (!MF && rebase) { m += dl; const float al = ex2(-dl); l *= al; \
              _Pragma("unroll") for (int i = 0; i < 16; ++i) { P0[i] -= dl; P1[i] -= dl; negm[i] = -m; } \
              if (h == 0) wsf[r] = al; \
              _Pragma("unroll") for (int i = 0; i < 16; ++i) { const float f = wsf[crow(i, h)]; o0[i] *= f; o1[i] *= f; } } \
          \
        if ((t) + 1 < NT) QK_TILE(Pn0, Pn1, kp0 + (((t) + 1) % NS) * KSLOT); \
        _Pragma("unroll") for (int i = 0; i < 16; ++i) { P0[i] = ex2(P0[i]); l += P0[i]; P1[i] = ex2(P1[i]); l += P1[i]; } \
        const bf16x8 pa0_ = packp(P0, 0), pa1_ = packp(P0, 8), pa2_ = packp(P1, 0), pa3_ = packp(P1, 8); \
          \
        { const LAS unsigned char* vp_ = vp0 + ((t) % NS) * VSLOT; \
          _Pragma("unroll") for (int s_ = 0; s_ < 4; ++s_) { const bf16x8 pa_ = (s_ == 0) ? pa0_ : (s_ == 1) ? pa1_ : (s_ == 2) ? pa2_ : pa3_; \
            _Pragma("unroll") for (int db = 0; db < 2; ++db) { const s16x4 lo_ = vtr(vp_ + db * 4096 + s_ * 1024), hi_ = vtr(vp_ + db * 4096 + s_ * 1024 + 512); \
                const bf16x8 vf_ = {lo_[0], lo_[1], lo_[2], lo_[3], hi_[0], hi_[1], hi_[2], hi_[3]}; \
                if (db == 0) o0 = MFMA32(pa_, vf_, o0); else o1 = MFMA32(pa_, vf_, o1); } } } \
        if constexpr (!MF) { if ((t) + 1 < NT) { float tm_; ROWMAX(tm_, Pn0, Pn1); dl = fmaxf(tm_, 0.f); rebase = __any(tm_ > DEFER_THR); } } \
    } while (0)
    if (w >= 4) __builtin_amdgcn_s_setprio(1);
    for (int t = 0; t < NT; t += 2) {
        STEP(t, pA0, pA1, pB0, pB1);
        STEP(t + 1, pB0, pB1, pA0, pA1);
    }
    __builtin_amdgcn_s_setprio(0);
    if (nkA) {
        asm volatile("s_waitcnt lgkmcnt(0)\n\ts_barrier" ::: "memory");
        const bf16* nA_ = nkA + (size_t)(8 * w + (lane >> 3)) * kpA + ((lane & 7) ^ ((4 * w + (lane >> 4)) & 7)) * 8;
        const bf16* nB_ = (DK == 96) ? (nkB + (size_t)(16 * (w & 3) + (lane >> 2)) * 32 + ((lane & 3) ^ ((lane >> 4) & 3)) * 8) : nkA;
        const bf16* nV_ = nvS + (size_t)(16 * (w & 3) + (lane >> 2)) * vpitch + (w >> 2) * 32 + (lane & 3) * 8;
#define NISSUE_K(t) do { dma16(nA_ + (size_t)(t) * kstA, lds + (t) * KSLOT + w * 1024); if (DK == 96) dma16(nB_ + (size_t)(t) * kstB, lds + (t) * KSLOT + (8 + (w & 3)) * 1024); } while (0)
#define NISSUE_V(t) dma16(nV_ + (size_t)(t) * vst, lds + OFF_V + (t) * VSLOT + w * 1024)
        NISSUE_K(0); NISSUE_K(1); NISSUE_V(0); NISSUE_K(2); NISSUE_V(1);
#undef NISSUE_K
#undef NISSUE_V
    }
    finish_store(o0, o1, l, wsf, stg, r, h, lane, oS + (size_t)(q0 + w * 32) * op, (size_t)op);
    if (!nkA) ATT_WAITBAR(0);
#undef STEP
#undef ROWMAX
#undef QK_TILE
#undef ISSUE_K
#undef ISSUE_V
}

DI void dil_decode(int u, int& grp, int& b, int& head, int& res, int& c) {
    grp = u >> 10; const int idx = u & 1023; b = idx >> 6; head = (idx >> 3) & 7;
    res = grp == 0 ? 0 : (grp == 1 ? ((idx >> 1) & 3) : (idx & 7)); c = grp == 0 ? (idx & 7) : (grp == 1 ? (idx & 1) : 0);
}
DI void dil_issue(LAS unsigned char* lds, int u, const bf16* qkv) {
    constexpr int SLOT = 16384;
    int grp, b, head, res, c; dil_decode(u, grp, b, head, res, c);
    const int tid = fresh_tid(), lane = tid & 63; const int w = __builtin_amdgcn_readfirstlane(tid >> 6);
    const int dil = grp == 0 ? 1 : (grp == 1 ? 4 : 16), L = SEQ / dil, ntile = L / 64;
    const bf16* qb = qkv + (size_t)((((b * 3 + grp) * 3 + 0) * 8 + head) * SEQ) * 64;
    const bf16* kbp = qb + (size_t)8 * SEQ * 64; const bf16* vbp = qb + (size_t)16 * SEQ * 64;
#pragma unroll
    for (int s = 0; s < 6; ++s) {
        int sres, kb; bool valid;
        if (grp < 2) { sres = res; kb = 4 * c - 1 + s; valid = (kb >= 0) && (kb < ntile); }
        else { sres = 2 * res + (s >> 1); kb = s & 1; valid = s < 4; }
        if (valid) {
            const int krow = 64 * kb + 8 * w + (lane >> 3), vrow = 64 * kb + 16 * (w & 3) + (lane >> 2);
            dma16(kbp + (size_t)(sres * L + krow) * 64 + ((lane & 7) ^ ((4 * w + (lane >> 4)) & 7)) * 8, lds + s * SLOT + w * 1024);
            dma16(vbp + (size_t)(sres * L + vrow) * 64 + (w >> 2) * 32 + (lane & 3) * 8, lds + s * SLOT + 8192 + w * 1024);
        }
    }
}
DI void dil_qload(int u, const bf16* qkv, bf16x8 (&qr)[4]) {
    int grp, b, head, res, c; dil_decode(u, grp, b, head, res, c);
    const int tid = fresh_tid(), lane = tid & 63, r = lane & 31, h = lane >> 5; const int w = __builtin_amdgcn_readfirstlane(tid >> 6);
    const int dil = grp == 0 ? 1 : (grp == 1 ? 4 : 16), L = SEQ / dil;
    const bf16* qb = qkv + (size_t)((((b * 3 + grp) * 3 + 0) * 8 + head) * SEQ) * 64;
    int wres, qi0;
    if (grp < 2) { wres = res; qi0 = 256 * c + 32 * w; } else { wres = 2 * res + (w >> 2); qi0 = 32 * (w & 3); }
    const bf16* qrow = qb + (size_t)(wres * L + qi0 + r) * 64 + 8 * h;
#pragma unroll
    for (int ks = 0; ks < 4; ++ks) qr[ks] = *(const bf16x8*)(qrow + 16 * ks);
}
DI void dil_unit(LAS unsigned char* lds, int u, int unext, const bf16* qkv, bf16* og, float* lse, const bf16x8 (&qr)[4], bf16x8 (&qn)[4]) {
    constexpr int SLOT = 16384, OFF_WS = 6 * SLOT, OFF_STG = OFF_WS + NWAVES * 256;
    int grp, b, head, res, c; dil_decode(u, grp, b, head, res, c);
    const int tid = fresh_tid(), lane = tid & 63, r = lane & 31, h = lane >> 5; const int w = __builtin_amdgcn_readfirstlane(tid >> 6);
    LAS float* wsf = (LAS float*)(lds + OFF_WS) + w * 64;
    LAS unsigned short* stg = (LAS unsigned short*)(lds + OFF_STG) + w * 2048;
    const int dil = grp == 0 ? 1 : (grp == 1 ? 4 : 16), L = SEQ / dil, ntile = L / 64;
    const bf16* qb = qkv + (size_t)((((b * 3 + grp) * 3 + 0) * 8 + head) * SEQ) * 64;
    int wres, qi0, s0, kb0, nts;
    if (grp < 2) { wres = res; qi0 = 256 * c + 32 * w; s0 = w >> 1; kb0 = 4 * c + (w >> 1) - 1; nts = 3; }
    else { wres = 2 * res + (w >> 2); qi0 = 32 * (w & 3); s0 = 2 * (w >> 2); kb0 = 0; nts = 2; }
    int koff[4];
#pragma unroll
    for (int ks = 0; ks < 4; ++ks) koff[ks] = r * 128 + (((2 * ks + h) ^ ((r >> 1) & 7)) << 4);
    f32x16 o0, o1;
#pragma unroll
    for (int i = 0; i < 16; ++i) { o0[i] = 0.f; o1[i] = 0.f; }
    float m = NEGBIG, l = 0.f;
    ATT_WAITBAR(0);
    bool first = true;
    for (int j = 0; j < nts; ++j) {
        const int kb = kb0 + j;
        if (kb >= 0 && kb < ntile) {
            const LAS unsigned char* sp = lds + (s0 + j) * SLOT;
            const int rel = (grp < 2) ? j - 1 : j - ((w & 3) >> 1);
            if (rel == 0) tile_step<64, 0>(sp, sp + 8192, koff, qr, o0, o1, m, l, wsf, r, h, lane, qi0 + r, 64 * kb, first);
            else if (rel < 0) tile_step<64, 1>(sp, sp + 8192, koff, qr, o0, o1, m, l, wsf, r, h, lane, qi0 + r, 64 * kb, first);
            else tile_step<64, 2>(sp, sp + 8192, koff, qr, o0, o1, m, l, wsf, r, h, lane, qi0 + r, 64 * kb, first);
            first = false;
        }
    }
    asm volatile("s_waitcnt lgkmcnt(0)\n\ts_barrier" ::: "memory");
    if (unext >= 0) { dil_issue(lds, unext, qkv); dil_qload(unext, qkv, qn); }
    const size_t tok0 = (size_t)b * SEQ + wres + (size_t)dil * qi0;
    finish_store(o0, o1, l, wsf, stg, r, h, lane, og + tok0 * 512 + head * 64, (size_t)dil * 512);
    const float lt = l + __shfl_xor(l, 32);
    if (h == 0) lse[(tok0 + (size_t)dil * r) * 8 + head] = m + __builtin_amdgcn_logf(lt);
}
}

#define XB_TMO      128
#define XB_XCNT(j)  (256  + 64 * (j))
#define XB_XSUB(j)  (1280 + 64 * (j))
#define XB_XGEN(j)  (2304 + 64 * (j))
#define XB_TOP      3328
#define XB_TOPGEN   3392
#define XCD_BAR_WORDS 3456
#define XB_SPIN_CAP (1u << 18)
DI unsigned xb_ld(unsigned* p)              { return __hip_atomic_load(p, __ATOMIC_RELAXED, __HIP_MEMORY_SCOPE_AGENT); }
DI unsigned xb_add(unsigned* p, unsigned v) { return __hip_atomic_fetch_add(p, v, __ATOMIC_RELAXED, __HIP_MEMORY_SCOPE_AGENT); }
DI unsigned xb_xcc_id() { return (unsigned)__builtin_amdgcn_s_getreg((3 << 11) | 20) & 0xFu; }
#define XB_SPIN(cond, bar) do { unsigned _sp = 0; while (cond) { __builtin_amdgcn_s_sleep(1); \
    if ((++_sp & 255u) == 0u) { if (xb_ld(&(bar)[XB_TMO])) break; if (_sp > XB_SPIN_CAP) { atomicAdd(&(bar)[XB_TMO], 1u); break; } } } } while (0)
struct XcdBarrier { unsigned* bar; unsigned x; volatile LAS unsigned* st; };
DI XcdBarrier xcd_barrier_post(unsigned* bar, volatile LAS unsigned* st) {
    XcdBarrier b; b.bar = bar; b.x = xb_xcc_id(); b.st = st;
    if (threadIdx.x == 0) (void)xb_add(&bar[XB_XCNT(b.x)], 1u);
    return b;
}
DI void xcd_barrier_complete(unsigned* bar, unsigned x, unsigned& nloc, unsigned& nx) {
    const unsigned G = gridDim.x * gridDim.y * gridDim.z;
    unsigned sum, cnt, mine, sp = 0u;
    for (;;) {
        sum = 0u; cnt = 0u; mine = 0u;
#pragma unroll
        for (unsigned j = 0; j < 16; ++j) { const unsigned c = xb_ld(&bar[XB_XCNT(j)]); sum += c; cnt += (c > 0u) ? 1u : 0u; mine = (j == x) ? c : mine; }
        if (sum == G) break;
        __builtin_amdgcn_s_sleep(1);
        if ((++sp & 255u) == 0u) { if (xb_ld(&bar[XB_TMO])) break; if (sp > XB_SPIN_CAP) { atomicAdd(&bar[XB_TMO], 1u); break; } }
    }
    nloc = mine > 0u ? mine : 1u; nx = cnt > 0u ? cnt : 1u;
}
DI void xcd_barrier(const XcdBarrier& b) {
    asm volatile("s_waitcnt vmcnt(0)" ::: "memory");
    __syncthreads();
    if (threadIdx.x == 0) {
        unsigned* bar = b.bar;
        __builtin_amdgcn_s_waitcnt(0);
        unsigned nloc = b.st[0], nx = b.st[1];
        if (nloc == 0u) { xcd_barrier_complete(bar, b.x, nloc, nx); b.st[0] = nloc; b.st[1] = nx; }
        const unsigned old = xb_add(&bar[XB_XSUB(b.x)], 1u);
        const unsigned gen = old / nloc;
        if (old + 1u == (gen + 1u) * nloc) {
            __builtin_amdgcn_fence(__ATOMIC_RELEASE, "agent");
            asm volatile("s_waitcnt vmcnt(0)" ::: "memory");
            const unsigned og = xb_add(&bar[XB_TOP], 1u);
            const unsigned tg = og / nx;
            if (og + 1u == (tg + 1u) * nx) xb_add(&bar[XB_TOPGEN], 1u);
            else XB_SPIN(xb_ld(&bar[XB_TOPGEN]) == tg, bar);
            __builtin_amdgcn_fence(__ATOMIC_ACQUIRE, "agent");
            xb_add(&bar[XB_XGEN(b.x)], 1u);
            asm volatile("s_waitcnt vmcnt(0)" ::: "memory");
        } else {
            XB_SPIN(xb_ld(&bar[XB_XGEN(b.x)]) == gen, bar);
            __builtin_amdgcn_fence(__ATOMIC_ACQUIRE, "agent");
            asm volatile("s_waitcnt vmcnt(0)" ::: "memory");
        }
    }
    __syncthreads();
}

struct Ctx { int wave, G, bid; LAS unsigned char* lds; };

template <int F8>
DI void transpose_item(const float* W, int K, int N, void* WTv, int ldo, int row_off, int gu, LAS float* scr, int item, int lane, const float* gk = nullptr, const float wscale = 0.f) {
    const float sw8 = wscale != 0.f ? wscale : pg8::SW8, sw4 = wscale != 0.f ? wscale : 64.f;
    const int nblk = N / 32, kb = item / nblk, nb = item % nblk, k0 = 64 * kb, n0 = 32 * nb;
    float v[32];
    const float* src = W + (size_t)(k0 + (lane >> 5)) * N + n0 + (lane & 31);
#pragma unroll
    for (int i = 0; i < 32; ++i) v[i] = __builtin_nontemporal_load(src + (size_t)(2 * i) * N);
    if (gk) {
#pragma unroll
        for (int i = 0; i < 32; ++i) v[i] *= gk[k0 + 2 * i + (lane >> 5)];
    }
#pragma unroll
    for (int i = 0; i < 32; ++i) scr[(2 * i + (lane >> 5)) * 33 + (lane & 31)] = v[i];
    asm volatile("s_waitcnt lgkmcnt(0)" ::: "memory");
    const int c = lane & 7;
    const int orow0 = row_off + (gu == 0 ? n0 : ((n0 >> 7) * 256 + (gu - 1) * 128 + (n0 & 127)));
#pragma unroll
    for (int j = 0; j < 4; ++j) { const int n = (lane >> 3) + 8 * j; const LAS float* s = scr + (8 * c) * 33 + n;
        if (F8 == 2) { u32x2 o; o.x = pg8::pk4_i8(sw8 * s[0 * 33], sw8 * s[1 * 33], sw8 * s[2 * 33], sw8 * s[3 * 33]); o.y = pg8::pk4_i8(sw8 * s[4 * 33], sw8 * s[5 * 33], sw8 * s[6 * 33], sw8 * s[7 * 33]);
            *(u32x2*)((unsigned char*)WTv + (size_t)(orow0 + n) * ldo + k0 + 8 * c) = o; }
        else if (F8 == 1) { u32x2 o; o.x = pg8::pk4_fp8(sw4 * s[0 * 33], sw4 * s[1 * 33], sw4 * s[2 * 33], sw4 * s[3 * 33]); o.y = pg8::pk4_fp8(sw4 * s[4 * 33], sw4 * s[5 * 33], sw4 * s[6 * 33], sw4 * s[7 * 33]);
            *(u32x2*)((unsigned char*)WTv + (size_t)(orow0 + n) * ldo + k0 + 8 * c) = o; }
        else { u32x4 o; o.x = pk2(s[0 * 33], s[1 * 33]); o.y = pk2(s[2 * 33], s[3 * 33]); o.z = pk2(s[4 * 33], s[5 * 33]); o.w = pk2(s[6 * 33], s[7 * 33]);
            *(u32x4*)((bf16*)WTv + (size_t)(orow0 + n) * ldo + k0 + 8 * c) = o; } }
    asm volatile("s_waitcnt lgkmcnt(0)" ::: "memory");
}

DI void sincos_d(double a, float& c, float& s) {
    const double TWO_PI = 6.283185307179586476925286766559, INV = 0.15915494309189533576888376337251;
    const double n = __builtin_rint(a * INV); double x = (a - n * TWO_PI) * 0.25; const double x2 = x * x;
    double sn = x * (1.0 + x2 * (-1.0 / 6 + x2 * (1.0 / 120 + x2 * (-1.0 / 5040 + x2 * (1.0 / 362880 + x2 * (-1.0 / 39916800 + x2 * (1.0 / 6227020800.0)))))));
    double cs = 1.0 + x2 * (-0.5 + x2 * (1.0 / 24 + x2 * (-1.0 / 720 + x2 * (1.0 / 40320 + x2 * (-1.0 / 3628800 + x2 * (1.0 / 479001600.0))))));
#pragma unroll
    for (int i = 0; i < 2; ++i) { const double s2 = 2.0 * sn * cs, c2 = cs * cs - sn * sn; sn = s2; cs = c2; }
    c = (float)cs; s = (float)sn;
}

constexpr float SA1 = 32.0f, SW1 = 1000.0f;
DI void rows_first(const Ctx& C, const float* x, bf16* hb, float* rstd, unsigned char* x8) {
    const int gw = C.bid * NWAVES + C.wave, NGW = C.G * NWAVES, lane = fresh_tid() & 63;
    for (int m = gw; m < NTOK; m += 2 * NGW) {
        const f32x4* xr0 = (const f32x4*)(x + (size_t)m * DM) + lane; const f32x4* xr1 = (const f32x4*)(x + (size_t)(m + NGW) * DM) + lane;
        f32x4 v[4], w[4]; float s0 = 0.f, s1 = 0.f;
#pragma unroll
        for (int j = 0; j < 4; ++j) { v[j] = __builtin_nontemporal_load(xr0 + 64 * j); w[j] = __builtin_nontemporal_load(xr1 + 64 * j); }
#pragma unroll
        for (int j = 0; j < 4; ++j) { s0 += (v[j].x * v[j].x + v[j].y * v[j].y) + (v[j].z * v[j].z + v[j].w * v[j].w); s1 += (w[j].x * w[j].x + w[j].y * w[j].y) + (w[j].z * w[j].z + w[j].w * w[j].w); }
        const float r0 = rsq(wave_sum(s0) * (1.f / DM) + EPS), r1 = rsq(wave_sum(s1) * (1.f / DM) + EPS);
        u32x2* o0 = (u32x2*)(hb + (size_t)m * DM) + lane; u32x2* o1 = (u32x2*)(hb + (size_t)(m + NGW) * DM) + lane;
#pragma unroll
        for (int j = 0; j < 4; ++j) { u32x2 a, b; a.x = pk2(v[j].x, v[j].y); a.y = pk2(v[j].z, v[j].w); b.x = pk2(w[j].x, w[j].y); b.y = pk2(w[j].z, w[j].w); o0[64 * j] = a; o1[64 * j] = b; }
        { unsigned* q0 = (unsigned*)(x8 + (size_t)m * DM) + lane; unsigned* q1 = (unsigned*)(x8 + (size_t)(m + NGW) * DM) + lane; const float a0 = r0 * SA1, a1 = r1 * SA1;
#pragma unroll
          for (int j = 0; j < 4; ++j) { q0[64 * j] = pg8::pk4_i8(v[j].x * a0, v[j].y * a0, v[j].z * a0, v[j].w * a0); q1[64 * j] = pg8::pk4_i8(w[j].x * a1, w[j].y * a1, w[j].z * a1, w[j].w * a1); } }
        if (lane == 0) { rstd[m] = r0; rstd[m + NGW] = r1; }
    }
}

struct RowRaw { u32x2 t1[4], t2[4], hb[4]; f32x4 h32[4]; f32x2 gg; };
template <bool MOE, bool HIN32>
DI void row_load(RowRaw& R, int m, int lane_, const float* hin32, const bf16* hb, const bf16* term, const int* toks, const f32x2* tokg) {
    if (MOE) {
        const int s1 = toks[2 * m], s2 = toks[2 * m + 1]; R.gg = tokg[m];
        const u32x2* y1 = (const u32x2*)(term + (size_t)s1 * DM) + lane_; const u32x2* y2 = (const u32x2*)(term + (size_t)s2 * DM) + lane_;
#pragma unroll
        for (int j = 0; j < 4; ++j) { R.t1[j] = __builtin_nontemporal_load(y1 + 64 * j); R.t2[j] = __builtin_nontemporal_load(y2 + 64 * j); }
    } else {
        const u32x2* tr = (const u32x2*)(term + (size_t)m * DM) + lane_;
#pragma unroll
        for (int j = 0; j < 4; ++j) R.t1[j] = __builtin_nontemporal_load(tr + 64 * j);
    }
    if (HIN32) { const f32x4* hr = (const f32x4*)(hin32 + (size_t)m * DM) + lane_;
#pragma unroll
        for (int j = 0; j < 4; ++j) R.h32[j] = hr[64 * j];
    } else { const u32x2* hr = (const u32x2*)(hb + (size_t)m * DM) + lane_;
#pragma unroll
        for (int j = 0; j < 4; ++j) R.hb[j] = hr[64 * j];
    }
}
template <bool MOE, bool NEXT, bool ROUTE, bool HIN32, bool FINAL, int X8 = 0>
DI void rows_residual(const Ctx& C, const float* hin32, bf16* hb, float* out32, const bf16* term, const float* gpost, const float* gnext, float* rstd,
                      const int* toks, const f32x2* tokg, const float* wrouter, int* toke, f32x2* tokg_out, int* cnt_out, unsigned char* xn8 = nullptr) {
    const int gw = C.bid * NWAVES + C.wave, NGW = C.G * NWAVES, tid_ = fresh_tid(), lane_ = tid_ & 63;
    f32x4 gp[4], gn[4];
#pragma unroll
    for (int j = 0; j < 4; ++j) { gp[j] = *((const f32x4*)gpost + lane_ + 64 * j); gn[j] = ROUTE ? *((const f32x4*)gnext + lane_ + 64 * j) : (f32x4){0.f, 0.f, 0.f, 0.f}; }
    LAS int* lcnt = (LAS int*)C.lds;
    if (ROUTE) { if (tid_ < 8) lcnt[tid_] = 0; __syncthreads(); }
    const int rows_per_wave = NTOK / NGW;
    const int nrows = ROUTE ? rows_per_wave : (NTOK - gw + NGW - 1) / NGW;
#define ROW_OF(it_) (ROUTE ? (gw * rows_per_wave + (it_)) : (gw + (it_) * NGW))
    RowRaw cur, nxt, nx2;
    if (nrows > 0) row_load<MOE, HIN32>(cur, ROW_OF(0), lane_, hin32, hb, term, toks, tokg);
    if (nrows > 1) row_load<MOE, HIN32>(nxt, ROW_OF(1), lane_, hin32, hb, term, toks, tokg); else nxt = cur;
    nx2 = nxt;
    for (int it = 0; it < nrows; ++it) {
        const int m = ROW_OF(it);
        if (it + 2 < nrows) row_load<MOE, HIN32>(nx2, ROW_OF(it + 2), lane_, hin32, hb, term, toks, tokg);
        f32x4 t[4], hv[4];
#pragma unroll
        for (int j = 0; j < 4; ++j) { const u32x2 a = cur.t1[j];
            if (MOE) { const u32x2 b = cur.t2[j]; const f32x2 gg = cur.gg;
                t[j].x = gg.x * __uint_as_float(a.x << 16) + gg.y * __uint_as_float(b.x << 16); t[j].y = gg.x * __uint_as_float(a.x & 0xffff0000u) + gg.y * __uint_as_float(b.x & 0xffff0000u);
                t[j].z = gg.x * __uint_as_float(a.y << 16) + gg.y * __uint_as_float(b.y << 16); t[j].w = gg.x * __uint_as_float(a.y & 0xffff0000u) + gg.y * __uint_as_float(b.y & 0xffff0000u); }
            else { t[j].x = __uint_as_float(a.x << 16); t[j].y = __uint_as_float(a.x & 0xffff0000u); t[j].z = __uint_as_float(a.y << 16); t[j].w = __uint_as_float(a.y & 0xffff0000u); }
            if (HIN32) hv[j] = cur.h32[j];
            else { const u32x2 c = cur.hb[j]; hv[j].x = __uint_as_float(c.x << 16); hv[j].y = __uint_as_float(c.x & 0xffff0000u); hv[j].z = __uint_as_float(c.y << 16); hv[j].w = __uint_as_float(c.y & 0xffff0000u); } }
        float s = 0.f;
#pragma unroll
        for (int j = 0; j < 4; ++j) s += (t[j].x * t[j].x + t[j].y * t[j].y) + (t[j].z * t[j].z + t[j].w * t[j].w);
        const float ri = rsq(wave_sum(s) * (1.f / DM) + EPS);
        float s2 = 0.f;
#pragma unroll
        for (int j = 0; j < 4; ++j) { hv[j] = hv[j] + t[j] * ri * gp[j]; s2 += (hv[j].x * hv[j].x + hv[j].y * hv[j].y) + (hv[j].z * hv[j].z + hv[j].w * hv[j].w); }
        if (FINAL) { f32x4* ho = (f32x4*)(out32 + (size_t)m * DM) + lane_;
#pragma unroll
            for (int j = 0; j < 4; ++j) ho[64 * j] = hv[j];
        } else { u32x2* o8 = (u32x2*)(hb + (size_t)m * DM) + lane_;
#pragma unroll
            for (int j = 0; j < 4; ++j) { u32x2 o; o.x = pk2(hv[j].x, hv[j].y); o.y = pk2(hv[j].z, hv[j].w); o8[64 * j] = o; }
        }
        if (NEXT) {
            const float r2 = rsq(wave_sum(s2) * (1.f / DM) + EPS);
            if (lane_ == 0) rstd[m] = r2;
            if (X8) { unsigned* o4 = (unsigned*)(xn8 + (size_t)m * DM) + lane_;
#pragma unroll
                for (int j = 0; j < 4; ++j) { const float q_ = (X8 == 2) ? r2 * pg8::SA8 : r2; o4[64 * j] = (X8 == 2) ? pg8::pk4_i8(hv[j].x * q_, hv[j].y * q_, hv[j].z * q_, hv[j].w * q_) : pg8::pk4_fp8(hv[j].x * q_, hv[j].y * q_, hv[j].z * q_, hv[j].w * q_); } }
            if (ROUTE) {
#pragma unroll
                for (int j = 0; j < 4; ++j) hv[j] = hv[j] * r2 * gn[j];
                float lg[8];
#pragma unroll
                for (int e = 0; e < 8; ++e) lg[e] = 0.f;
#pragma unroll
                for (int j = 0; j < 4; ++j)
#pragma unroll
                    for (int q = 0; q < 4; ++q) { const f32x4* wp = (const f32x4*)(wrouter + (size_t)(4 * lane_ + 256 * j + q) * 8); const f32x4 w0 = wp[0], w1 = wp[1]; const float a = hv[j][q];
                        lg[0] += a * w0.x; lg[1] += a * w0.y; lg[2] += a * w0.z; lg[3] += a * w0.w; lg[4] += a * w1.x; lg[5] += a * w1.y; lg[6] += a * w1.z; lg[7] += a * w1.w; }
#pragma unroll
                for (int e = 0; e < 8; ++e) lg[e] = wave_sum(lg[e]);
                int e1 = 0; float l1 = lg[0];
#pragma unroll
                for (int e = 1; e < 8; ++e) if (lg[e] > l1) { l1 = lg[e]; e1 = e; }
                int e2 = -1; float l2 = -3.0e38f;
#pragma unroll
                for (int e = 0; e < 8; ++e) if (e != e1 && lg[e] > l2) { l2 = lg[e]; e2 = e; }
                if (lane_ == 0) { const float p2 = 1.0f / (1.0f + ex2((l1 - l2) * LOG2E)); toke[m] = e1 | (e2 << 8); tokg_out[m] = (f32x2){1.0f - p2, p2};
                    atomicAdd((int*)lcnt + e1, 1); atomicAdd((int*)lcnt + e2, 1); }
            }
        }
        cur = nxt; nxt = nx2;
    }
#undef ROW_OF
    if (ROUTE) { __syncthreads(); if (tid_ < 8) cnt_out[C.bid * 8 + tid_] = lcnt[tid_]; }
}

DI void rows_l0_post(const Ctx& C, const bf16* zin, const float* gq, const float* gk, const float* gcq, const float* gckv, const f32x2* taba,
                     bf16* qa, bf16* ka, bf16* cqn, bf16* ckvn, bf16* kr, float* krn) {
    const int gw = C.bid * NWAVES + C.wave, NGW = C.G * NWAVES, lane = fresh_tid() & 63;
    const int s8 = lane & 7;
    float gqv[8], gkv[8], gcqv[8], gckvv[8];
#pragma unroll
    for (int j = 0; j < 8; ++j) { gqv[j] = gq[8 * s8 + j]; gkv[j] = gk[8 * s8 + j]; gcqv[j] = gcq[8 * (lane & 31) + j]; gckvv[j] = gckv[8 * (lane & 15) + j]; }
    const int part = s8 >> 2, isx2 = (s8 >> 1) & 1, fb = 8 * (s8 & 1);
    u32x4 c0 = (u32x4){0u, 0u, 0u, 0u}, c1 = c0, c2 = c0;
    if (gw < NTOK) { const bf16* z0 = zin + (size_t)gw * ZW; c0 = __builtin_nontemporal_load((const u32x4*)(z0 + 8 * lane)); c1 = __builtin_nontemporal_load((const u32x4*)(z0 + 512 + 8 * lane));
        if (lane < 32) c2 = __builtin_nontemporal_load((const u32x4*)(z0 + 1024 + 8 * lane)); }
    for (int tok = gw; tok < NTOK; tok += NGW) {
        const int t = tok & (SEQ - 1), prow = t >> 6, pcol = t & 63;
        u32x4 n0 = (u32x4){0u, 0u, 0u, 0u}, n1 = n0, n2 = n0;
        if (tok + NGW < NTOK) { const bf16* zn = zin + (size_t)(tok + NGW) * ZW; n0 = __builtin_nontemporal_load((const u32x4*)(zn + 8 * lane)); n1 = __builtin_nontemporal_load((const u32x4*)(zn + 512 + 8 * lane));
            if (lane < 32) n2 = __builtin_nontemporal_load((const u32x4*)(zn + 1024 + 8 * lane)); }
        float x[8], y[8], p[8];
        unpack8(c0, x);
        float ss = 0.f;
#pragma unroll
        for (int j = 0; j < 8; ++j) ss += x[j] * x[j];
        ss += __shfl_xor(ss, 1); ss += __shfl_xor(ss, 2); ss += __shfl_xor(ss, 4);
        float ri = rsq(ss * (1.f / 64) + EPS);
#pragma unroll
        for (int j = 0; j < 8; ++j) y[j] = x[j] * ri * gqv[j];
#pragma unroll
        for (int j = 0; j < 8; ++j) p[j] = __shfl_xor(y[j], 2);
        const f32x2* tp = taba + (size_t)(part ? pcol : prow) * 16 + fb;
#pragma unroll
        for (int j = 0; j < 8; ++j) { const f32x2 cs = tp[j]; y[j] = (isx2 ? (y[j] * cs.x + p[j] * cs.y) : (y[j] * cs.x - p[j] * cs.y)) * C2_64; }
        *(u32x4*)(qa + (size_t)tok * 512 + 8 * lane) = pack8(y);
        unpack8(c1, x);
        ss = 0.f;
#pragma unroll
        for (int j = 0; j < 8; ++j) ss += x[j] * x[j];
        float s3 = ss; s3 += __shfl_xor(s3, 1); s3 += __shfl_xor(s3, 2); s3 += __shfl_xor(s3, 4);
        float s5 = s3; s5 += __shfl_xor(s5, 8); s5 += __shfl_xor(s5, 16);
        if (lane < 16) {
            ri = rsq(s3 * (1.f / 64) + EPS);
#pragma unroll
            for (int j = 0; j < 8; ++j) y[j] = x[j] * ri * gkv[j];
        } else {
            ri = rsq(s5 * (1.f / 256) + EPS);
#pragma unroll
            for (int j = 0; j < 8; ++j) y[j] = x[j] * ri * gcqv[j];
        }
#pragma unroll
        for (int j = 0; j < 8; ++j) p[j] = __shfl_xor(y[j], 2);
        if (lane < 16) {
#pragma unroll
            for (int j = 0; j < 8; ++j) { const f32x2 cs = tp[j]; y[j] = isx2 ? (y[j] * cs.x + p[j] * cs.y) : (y[j] * cs.x - p[j] * cs.y); }
            *(u32x4*)(ka + (size_t)tok * 128 + 8 * lane) = pack8(y);
        } else if (lane >= 32) {
            *(u32x4*)(cqn + (size_t)tok * 256 + 8 * (lane - 32)) = pack8(y);
        }
        unpack8(c2, x);
        ss = 0.f;
#pragma unroll
        for (int j = 0; j < 8; ++j) ss += x[j] * x[j];
        ss += __shfl_xor(ss, 1); ss += __shfl_xor(ss, 2); ss += __shfl_xor(ss, 4); ss += __shfl_xor(ss, 8);
        if (lane == 16) krn[tok] = ss;
#pragma unroll
        for (int j = 0; j < 8; ++j) p[j] = __shfl_xor(x[j], 2);
        if (lane < 16) {
            ri = rsq(ss * (1.f / 128) + EPS);
#pragma unroll
            for (int j = 0; j < 8; ++j) y[j] = x[j] * ri * gckvv[j];
            *(u32x4*)(ckvn + (size_t)tok * 256 + 8 * lane) = pack8(y);
        } else if (lane < 32) {
            *(u32x4*)(ckvn + (size_t)tok * 256 + 8 * lane) = (u32x4){0u, 0u, 0u, 0u};
            if (lane < 20) {
                const int sl = lane - 16; const f32x2* tq = taba + (size_t)t * 16 + 8 * (sl & 1);
#pragma unroll
                for (int j = 0; j < 8; ++j) { const f32x2 cs = tq[j]; y[j] = (sl >> 1) ? (x[j] * cs.x + p[j] * cs.y) : (x[j] * cs.x - p[j] * cs.y); }
                *(u32x4*)(kr + (size_t)tok * 32 + 8 * sl) = pack8(y);
            }
        }
        c0 = n0; c1 = n1; c2 = n2;
    }
}

DI void rows_merge(const Ctx& C, const bf16* og, const float* lse, bf16* o1) {
    const int gw = C.bid * NWAVES + C.wave, NGW = C.G * NWAVES, lane = fresh_tid() & 63, head = lane >> 3;
    u32x4 ra = (u32x4){0u, 0u, 0u, 0u}, rb = ra, rc = ra; float l0 = 0.f, l1 = 0.f, l2 = 0.f;
#define MERGE_LOAD(A, B, Cc, L0, L1, L2, tk) do { A = __builtin_nontemporal_load((const u32x4*)(og + (size_t)(tk) * 512 + 8 * lane)); B = __builtin_nontemporal_load((const u32x4*)(og + (size_t)(NTOK + (tk)) * 512 + 8 * lane)); \
        Cc = __builtin_nontemporal_load((const u32x4*)(og + (size_t)(2 * NTOK + (tk)) * 512 + 8 * lane)); L0 = lse[(size_t)(tk) * 8 + head]; L1 = lse[(size_t)(NTOK + (tk)) * 8 + head]; L2 = lse[(size_t)(2 * NTOK + (tk)) * 8 + head]; } while (0)
    if (gw < NTOK) MERGE_LOAD(ra, rb, rc, l0, l1, l2, gw);
    for (int tok = gw; tok < NTOK; tok += NGW) {
        u32x4 na = ra, nb = rb, nc = rc; float m0 = 0.f, m1 = 0.f, m2 = 0.f;
        if (tok + NGW < NTOK) MERGE_LOAD(na, nb, nc, m0, m1, m2, tok + NGW);
        const float mx = fmaxf(l0, fmaxf(l1, l2));
        float w0 = ex2(l0 - mx), w1 = ex2(l1 - mx), w2 = ex2(l2 - mx); const float inv = 1.0f / (w0 + w1 + w2); w0 *= inv; w1 *= inv; w2 *= inv;
        float a[8], b[8], c[8], o[8];
        unpack8(ra, a); unpack8(rb, b); unpack8(rc, c);
#pragma unroll
        for (int j = 0; j < 8; ++j) o[j] = w0 * a[j] + w1 * b[j] + w2 * c[j];
        *(u32x4*)(o1 + (size_t)tok * 512 + 8 * lane) = pack8(o);
        ra = na; rb = nb; rc = nc; l0 = m0; l1 = m1; l2 = m2;
    }
#undef MERGE_LOAD
}

DI void moe_assign_gather(const Ctx& C, const int* cnt, const int* toke, int* toks, int* tilee, const bf16* xn, const float* rstd, unsigned char* xs) {
    LAS int* L = (LAS int*)C.lds;
    const int lane = fresh_tid() & 63, w = C.bid;
    if (C.wave == 0) {
        int base[8]; int tot[8];
#pragma unroll
        for (int e = 0; e < 8; ++e) { int below = 0, all = 0;
            for (int i = lane; i < C.G; i += 64) { const int c = cnt[i * 8 + e]; all += c; if (i < w) below += c; }
#pragma unroll
            for (int o = 1; o < 64; o <<= 1) { below += __shfl_xor(below, o); all += __shfl_xor(all, o); }
            base[e] = below; tot[e] = all; }
        int start = 0;
#pragma unroll
        for (int e = 0; e < 8; ++e) { const int padded = (tot[e] + 255) & ~255; base[e] += start;
            if (w == 0) { for (int tix = (start >> 8) + lane; tix < ((start + padded) >> 8); tix += 64) tilee[8 + tix] = e; }
            start += padded;
            if (w == 0 && lane == 0 && e < 7) tilee[1 + e] = start >> 8; }
        if (w == 0 && lane == 0) tilee[0] = start >> 8;
#pragma unroll
        for (int k = 0; k < 4; ++k) {
            const int pidx = 64 * k + lane, tok = 128 * w + (pidx >> 1), kk = pidx & 1;
            const int e = (toke[tok] >> (8 * kk)) & 0xff; int slot = 0;
#pragma unroll
            for (int ee = 0; ee < 8; ++ee) { const unsigned long long mk = __ballot(e == ee); const int rank = __popcll(mk & ((1ull << lane) - 1ull));
                if (e == ee) slot = base[ee] + rank; base[ee] += __popcll(mk); }
            toks[2 * tok + kk] = slot; L[16 + pidx] = slot;
        }
    }
    __syncthreads();
    for (int i0 = 0; i0 < 32; i0 += 4) {
        u32x4 ra[4], rb[4]; float rs[4]; int sl[4];
#pragma unroll
        for (int q = 0; q < 4; ++q) { const int pidx = 32 * C.wave + i0 + q, tok = 128 * w + (pidx >> 1); sl[q] = L[16 + pidx];
            const u32x4* src = (const u32x4*)(xn + (size_t)tok * DM) + 2 * lane; ra[q] = src[0]; rb[q] = src[1]; rs[q] = rstd[tok]; }
#pragma unroll
        for (int q = 0; q < 4; ++q) { float x[8], y[8]; unpack8(ra[q], x); unpack8(rb[q], y);
#pragma unroll
            for (int j = 0; j < 8; ++j) { x[j] *= rs[q]; y[j] *= rs[q]; }
            u32x4 o; o.x = pg8::pk4_fp8(x[0], x[1], x[2], x[3]); o.y = pg8::pk4_fp8(x[4], x[5], x[6], x[7]); o.z = pg8::pk4_fp8(y[0], y[1], y[2], y[3]); o.w = pg8::pk4_fp8(y[4], y[5], y[6], y[7]);
            *((u32x4*)(xs + (size_t)sl[q] * DM) + lane) = o; }
    }
    __syncthreads();
}

struct Args { const float* in[27]; float* out; unsigned char* ws; };
enum { I_X = 0, I_P, I_MIXPRE, I_MIXPOST, I_FFNPRE, I_FFNPOST, I_PLEPROJ, I_PLEGN, I_PLEGATE, I_PLEPOST, I_WIN, I_GQ, I_GK, I_GCQ, I_WUQ, I_GCKV, I_WUKV, I_WOUT0,
       I_WG0, I_WU0, I_WD0, I_WQKV1, I_WOUT1, I_WR, I_MWG, I_MWU, I_MWD };

DI const float* arg_in(int i) { const __attribute__((address_space(4))) char* kp = (const __attribute__((address_space(4))) char*)__builtin_amdgcn_kernarg_segment_ptr(); asm volatile("" : "+s"(kp));
    return *(const float* const __attribute__((address_space(4)))*)(kp + 8 * i); }
__global__ void __launch_bounds__(NTHREADS, 2) fwd_kernel(Args a) {
    extern __shared__ __attribute__((aligned(16))) unsigned char lds_raw[];
    LAS unsigned char* lds = (LAS unsigned char*)lds_raw;
    volatile LAS unsigned* MISC = (volatile LAS unsigned*)(lds + MISC_OFF);
    Ctx C; C.wave = __builtin_amdgcn_readfirstlane((int)threadIdx.x >> 6); C.G = gridDim.x; C.bid = blockIdx.x; C.lds = lds;
    unsigned char* ws = a.ws;
#define AIN(i) arg_in(i)
    unsigned* ctl = (unsigned*)(ws + WS_CTL);
    for (int u = threadIdx.x; u < (LDS_BYTES - LDSCTL_OFF) / 4; u += NTHREADS) ((LAS unsigned*)(lds + LDSCTL_OFF))[u] = 0u;
    __syncthreads();
    XcdBarrier bar = xcd_barrier_post(ctl + CW_BAR, MISC + 8);
#define GRID_BAR() xcd_barrier(bar)
    const int gw = C.bid * NWAVES + C.wave, NGW = C.G * NWAVES, NGT = C.G * NTHREADS;
    const f32x2* taba = (const f32x2*)(ws + WS_TABA); const f32x2* tabp = (const f32x2*)(ws + WS_TABP);
    bf16* XN = (bf16*)(ws + WS_XN);
    float* hres = a.out;

    {
        LAS float* scr = (LAS float*)(lds + C.wave * 16384);
        const int tid = fresh_tid(), lane = tid & 63, gtid = C.bid * NTHREADS + tid;
#define TR(Wp, Kd, Nd, dst, ldo, roff, gu, gk) { constexpr int NI_ = ((Kd) / 64) * ((Nd) / 32); if (r < NI_) { transpose_item<0>((Wp), (Kd), (Nd), (bf16*)(dst), (ldo), (roff), (gu), scr, r, lane, (gk)); continue; } r -= NI_; }
        constexpr int NSMALL = 16 * 37 + 4 * 24 + 2 * 32 + 16 * 32 + 3 * 1792 + 2 * 128 + 2 * 512 + 16 * 144 + 8 * 32;
        for (int it = gw; it < NSMALL; it += NGW) {
            int r = it;
            { constexpr int NI_ = (1024 / 64) * (1184 / 32); if (r < NI_) { transpose_item<2>(AIN(I_WIN), 1024, 1184, ws + W_IN, 1024, 0, 0, scr, r, lane, AIN(I_MIXPRE), SW1); continue; } r -= NI_; }
            TR(AIN(I_WUQ), 256, 768, ws + W_UQ, 256, 0, 0, nullptr)
            TR(AIN(I_WUKV), 128, 1024, ws + W_UKV, 256, 0, 0, nullptr)
            TR(AIN(I_WOUT0), 1024, 1024, ws + W_OUT0, 1024, 0, 0, nullptr)
            { constexpr int NI_ = (1024 / 64) * (3584 / 32); if (r < NI_) { transpose_item<2>(AIN(I_WG0), 1024, 3584, ws + W_GU0, 1024, 0, 1, scr, r, lane, AIN(I_FFNPRE)); continue; } r -= NI_; }
            { constexpr int NI_ = (1024 / 64) * (3584 / 32); if (r < NI_) { transpose_item<2>(AIN(I_WU0), 1024, 3584, ws + W_GU0, 1024, 0, 2, scr, r, lane, AIN(I_FFNPRE)); continue; } r -= NI_; }
            { constexpr int NI_ = (3584 / 64) * (1024 / 32); if (r < NI_) { transpose_item<1>(AIN(I_WD0), 3584, 1024, ws + W_D0, 3584, 0, 0, scr, r, lane); continue; } r -= NI_; }
            TR(AIN(I_PLEPROJ), 256, 1024, ws + W_PP, 256, 0, 0, nullptr)
            TR(AIN(I_PLEPROJ) + 256 * 1024, 256, 1024, ws + W_PP + 1024 * 256 * 2, 256, 0, 0, nullptr)
            { constexpr int NI_ = (1024 / 64) * (1024 / 32); if (r < NI_) { transpose_item<2>(AIN(I_PLEGATE), 1024, 1024, ws + W_PG, 1024, 0, 0, scr, r, lane, AIN(I_PLEGN)); continue; } r -= NI_; }
            { constexpr int NI_ = (1024 / 64) * (1024 / 32); if (r < NI_) { transpose_item<1>(AIN(I_PLEGATE) + 1024 * 1024, 1024, 1024, ws + W_PG + 1024 * 1024 * 2, 1024, 0, 0, scr, r, lane, AIN(I_PLEGN) + DM); continue; } r -= NI_; }
            { constexpr int NI_ = (1024 / 64) * (4608 / 32); if (r < NI_) { transpose_item<2>(AIN(I_WQKV1), 1024, 4608, ws + W_QKV1, 1024, 0, 0, scr, r, lane, AIN(I_MIXPRE) + DM); continue; } r -= NI_; }
            TR(AIN(I_WOUT1), 512, 1024, ws + W_OUT1, 512, 0, 0, nullptr)
        }
        for (int i = gtid; i < 6144; i += NGT) ((u32x4*)(ws + W_IN + (size_t)1184 * 1024))[i] = (u32x4){0u, 0u, 0u, 0u};
        for (int i = gtid; i < 16384; i += NGT) ((u32x4*)(ws + W_UKV))[(size_t)(i >> 4) * 32 + 16 + (i & 15)] = (u32x4){0u, 0u, 0u, 0u};
        for (int i = gtid; i < 2048 * 16; i += NGT) { const int t = i >> 4, f = i & 15; double iv = 1.0; for (int k = 0; k < f; ++k) iv *= 0.56234132519034907; const float ang = (float)t * (float)iv;
            float c, s; sincos_d((double)ang, c, s); ((f32x2*)(ws + WS_TABA))[i] = (f32x2){c, s}; }
        for (int i = gtid; i < 2048 * 8; i += NGT) { const int t = i >> 3, f = i & 7; double iv = 1.0; for (int k = 0; k < f; ++k) iv *= 0.19392274474868576; const float ang = (float)t * (float)iv;
            float c, s; sincos_d((double)ang, c, s); ((f32x2*)(ws + WS_TABP))[i] = (f32x2){c, s}; }
        { const f32x4* psrc = (const f32x4*)AIN(I_P); u32x4* pdst = (u32x4*)(ws + WS_PB);
          for (int i = gtid; i < 2 * NTOK * 256 / 8; i += 4 * NGT) {
              f32x4 u0[4], u1[4];
#pragma unroll
              for (int q = 0; q < 4; ++q) { u0[q] = __builtin_nontemporal_load(psrc + 2 * (i + q * NGT)); u1[q] = __builtin_nontemporal_load(psrc + 2 * (i + q * NGT) + 1); }
#pragma unroll
              for (int q = 0; q < 4; ++q) { u32x4 o; o.x = pk2(u0[q].x, u0[q].y); o.y = pk2(u0[q].z, u0[q].w); o.z = pk2(u1[q].x, u1[q].y); o.w = pk2(u1[q].z, u1[q].w); pdst[i + q * NGT] = o; } } }
        rows_first(C, AIN(I_X), XN, (float*)(ws + WS_RSTD), ws + B_XN8);
    }
    GRID_BAR();

    { pg8::Gemm g{(const bf16*)(ws + B_XN8), (const bf16*)(ws + W_IN), 512, 512, 512}; pg8::StaticOrder S; S.init(NTOK / 256, ZW / 256, C.G, C.bid);
      pg8::EpiStore E{(bf16*)(ws + B_ZIN), ZW, 1.0f, nullptr}; pg8::gemm_phase<pg8::EpiStore, pg8::StaticOrder, false, true>(lds, g, S, E, 0, 0, 1.0f / (SA1 * SW1), 1.0f / (SA1 * SW1)); }
    GRID_BAR();
    rows_l0_post(C, (const bf16*)(ws + B_ZIN), AIN(I_GQ), AIN(I_GK), AIN(I_GCQ), AIN(I_GCKV), taba,
                 (bf16*)(ws + B_QA), (bf16*)(ws + B_KA), (bf16*)(ws + B_CQN), (bf16*)(ws + B_CKVN), (bf16*)(ws + B_KR), (float*)(ws + WS_LSE));
    GRID_BAR();
    { pg8::Gemm g{(const bf16*)(ws + B_CQN), (const bf16*)(ws + W_UQ), 256, 256, 256}; pg8::StaticOrder S; S.init(NTOK / 256, 3, C.G, C.bid);
      pg8::EpiStore E{(bf16*)(ws + B_QM), 768, C2_96, nullptr}; pg8::gemm_phase(lds, g, S, E); }
    { pg8::Gemm g{(const bf16*)(ws + B_CKVN), (const bf16*)(ws + W_UKV), 256, 256, 256}; pg8::StaticOrder S; S.init(NTOK / 256, 4, C.G, C.bid);
      pg8::EpiStoreKV E{(bf16*)(ws + B_KV), 1024, ctl + CW_KP}; pg8::gemm_phase(lds, g, S, E); }
    GRID_BAR();
    bool gqa_mf;
    { const int lane = fresh_tid() & 63; float mq = fabsf(AIN(I_GQ)[lane]), mk = fabsf(AIN(I_GK)[lane]);
#pragma unroll
      for (int o = 1; o < 64; o <<= 1) { mq = fmaxf(mq, __shfl_xor(mq, o)); mk = fmaxf(mk, __shfl_xor(mk, o)); }
      gqa_mf = __builtin_amdgcn_readfirstlane((64.0f * C2_64 * mq * mk <= 100.0f) ? 1 : 0) != 0; }
    const int pb = (C.G % 8 == 0) ? ((C.bid & 7) * (C.G >> 3) + (C.bid >> 3)) : C.bid;
#define GQA_MAP(v) ((C.G == 256) ? (((((v) & 255) >> 4) << 6) | ((((((v) & 255) >> 3) & 1) * 4 + ((v) >> 8)) << 3) | ((v) & 7)) : (v))
    for (int uq = C.bid; uq < 1024; uq += C.G) {
        const int u = GQA_MAP(uq);
        const int b = u >> 6, head = (u >> 3) & 7, ch = u & 7, kvh = head >> 2; const size_t rb = (size_t)b * SEQ;
        const bool hn = uq + C.G < 1024; const int un = hn ? GQA_MAP(uq + C.G) : 0; const int bn = un >> 6, kvhn = ((un >> 3) & 7) >> 2; const size_t rbn = (size_t)bn * SEQ;
        const bf16* nk = hn ? (const bf16*)(ws + B_KA) + rbn * 128 + kvhn * 64 : nullptr; const bf16* nv = (const bf16*)(ws + B_ZIN) + rbn * ZW + 640 + kvhn * 64;
        if (gqa_mf) att::dense_unit<64, true>(lds, (const bf16*)(ws + B_QA) + rb * 512 + head * 64, 512, 256 * ch, (const bf16*)(ws + B_KA) + rb * 128 + kvh * 64, 128, nullptr,
                            (const bf16*)(ws + B_ZIN) + rb * ZW + 640 + kvh * 64, ZW, (bf16*)(ws + B_O0) + rb * 1024 + head * 64, 1024, taba, uq != C.bid, nk, nullptr, nv);
        else att::dense_unit<64, false>(lds, (const bf16*)(ws + B_QA) + rb * 512 + head * 64, 512, 256 * ch, (const bf16*)(ws + B_KA) + rb * 128 + kvh * 64, 128, nullptr,
                            (const bf16*)(ws + B_ZIN) + rb * ZW + 640 + kvh * 64, ZW, (bf16*)(ws + B_O0) + rb * 1024 + head * 64, 1024, taba, uq != C.bid, nk, nullptr, nv);
    }
    unsigned mla_mf = 0u;
    { const int tid = fresh_tid(), lane = tid & 63, r = lane & 31, h = lane >> 5; LAS float* xq = (LAS float*)lds; int ui = 0;
      __syncthreads();
      for (int u = pb; u < 1024 && ui < 8; u += C.G, ++ui) {
          const int b = u >> 6, head = (u >> 3) & 7, ch = u & 7;
          const bf16* qrow = (const bf16*)(ws + B_QM) + ((size_t)b * SEQ + 256 * ch + C.wave * 32 + r) * 768 + head * 96 + 8 * h; float nq = 0.f;
#pragma unroll
          for (int ks = 0; ks < 6; ++ks) { const bf16x8 q8 = *(const bf16x8*)(qrow + 16 * ks);
#pragma unroll
              for (int j = 0; j < 8; ++j) { const float f = bf2f((unsigned short)q8[j]); nq += f * f; } }
          nq += __shfl_xor(nq, 32);
#pragma unroll
          for (int o = 1; o < 32; o <<= 1) nq = fmaxf(nq, __shfl_xor(nq, o));
          const f32x4 kv4 = *((const f32x4*)((const float*)(ws + WS_LSE) + (size_t)b * SEQ) + tid);
          float km = fmaxf(fmaxf(kv4.x, kv4.y), fmaxf(kv4.z, kv4.w));
#pragma unroll
          for (int o = 1; o < 64; o <<= 1) km = fmaxf(km, __shfl_xor(km, o));
          if (lane == 0) { xq[ui * 8 + C.wave] = nq; xq[64 + ui * 8 + C.wave] = km; } }
      __syncthreads();
      ui = 0;
      for (int u = pb; u < 1024 && ui < 8; u += C.G, ++ui) {
          const int b = u >> 6, head = (u >> 3) & 7; float qm2 = 0.f;
#pragma unroll
          for (int i = 0; i < 8; ++i) qm2 = fmaxf(qm2, xq[ui * 8 + i]);
          const unsigned* kp = ctl + CW_KP + (b * 8 + head) * 64; float krm = 0.f;
#pragma unroll
          for (int i = 0; i < 8; ++i) krm = fmaxf(krm, xq[64 + ui * 8 + i]);
          const float kb2 = (__uint_as_float(__hip_atomic_load(kp, __ATOMIC_RELAXED, __HIP_MEMORY_SCOPE_AGENT)) + __uint_as_float(__hip_atomic_load(kp + 32, __ATOMIC_RELAXED, __HIP_MEMORY_SCOPE_AGENT)) + krm) * 1.02f;
          if (qm2 * kb2 <= 1.0e4f) mla_mf |= 1u << ui; }
      mla_mf = (unsigned)__builtin_amdgcn_readfirstlane((int)mla_mf);
      __syncthreads(); }
    { int ui = 0;
      for (int u = pb; u < 1024; u += C.G, ++ui) {
        const int b = u >> 6, head = (u >> 3) & 7, ch = u & 7; const size_t rb = (size_t)b * SEQ;
        const int un = u + C.G; const bool hn = un < 1024; const int bn = un >> 6, headn = (un >> 3) & 7; const size_t rbn = (size_t)bn * SEQ;
        const bf16* nk = hn ? (const bf16*)(ws + B_KV) + rbn * 1024 + headn * 128 : nullptr; const bf16* nkr = (const bf16*)(ws + B_KR) + rbn * 32; const bf16* nv = (const bf16*)(ws + B_KV) + rbn * 1024 + headn * 128 + 64;
        if (ui < 8 && ((mla_mf >> ui) & 1u))
            att::dense_unit<96, true>(lds, (const bf16*)(ws + B_QM) + rb * 768 + head * 96, 768, 256 * ch, (const bf16*)(ws + B_KV) + rb * 1024 + head * 128, 1024, (const bf16*)(ws + B_KR) + rb * 32,
                                (const bf16*)(ws + B_KV) + rb * 1024 + head * 128 + 64, 1024, (bf16*)(ws + B_O0) + rb * 1024 + 512 + head * 64, 1024, taba, u != pb, nk, nkr, nv);
        else
            att::dense_unit<96, false>(lds, (const bf16*)(ws + B_QM) + rb * 768 + head * 96, 768, 256 * ch, (const bf16*)(ws + B_KV) + rb * 1024 + head * 128, 1024, (const bf16*)(ws + B_KR) + rb * 32,
                                (const bf16*)(ws + B_KV) + rb * 1024 + head * 128 + 64, 1024, (bf16*)(ws + B_O0) + rb * 1024 + 512 + head * 64, 1024, taba, u != pb, nk, nkr, nv);
      } }
    GRID_BAR();
    { pg8::Gemm g{(const bf16*)(ws + B_O0), (const bf16*)(ws + W_OUT0), 1024, 1024, 1024}; pg8::StaticOrder S; S.init(NTOK / 256, 4, C.G, C.bid);
      pg8::EpiStore E{(bf16*)(ws + B_MO0), 1024, 1.0f, nullptr}; pg8::gemm_phase(lds, g, S, E); }
    GRID_BAR();
    rows_residual<false, true, false, false, false, 2>(C, nullptr, XN, nullptr, (const bf16*)(ws + B_MO0), AIN(I_MIXPOST), nullptr, (float*)(ws + WS_RSTD), nullptr, nullptr, nullptr, nullptr, nullptr, nullptr, ws + B_XN8);
    GRID_BAR();
    { pg8::Gemm g{(const bf16*)(ws + B_XN8), (const bf16*)(ws + W_GU0), 512, 512, 512}; pg8::StaticOrder S; S.init(NTOK / 256, 28, C.G, C.bid);
      pg8::EpiSwiGLU8 E{ws + B_HID, DFF}; pg8::gemm_phase<pg8::EpiSwiGLU8, pg8::StaticOrder, false, true>(lds, g, S, E, 0, 0, pg8::ISC8 * LOG2E, pg8::ISC8 * 8.f / LOG2E); }
    GRID_BAR();
    { pg8::Gemm g{(const bf16*)(ws + B_HID), (const bf16*)(ws + W_D0), DFF / 2, DFF / 2, DFF / 2}; pg8::StaticOrder S; S.init(NTOK / 256, 4, C.G, C.bid);
      pg8::EpiStore E{(bf16*)(ws + B_F), 1024, 1.0f, nullptr}; pg8::gemm_phase<pg8::EpiStore, pg8::StaticOrder, true>(lds, g, S, E, 0x79797979, 0x7c7c7c7c); }
    { pg8::Gemm g{(const bf16*)(ws + WS_PB), (const bf16*)(ws + W_PP), 256, 256, 256}; pg8::StaticOrder S; S.init(NTOK / 256, 4, C.G, C.bid);
      pg8::EpiStore E{(bf16*)(ws + B_E0), 1024, 1.0f, nullptr}; pg8::gemm_phase(lds, g, S, E); }
    GRID_BAR();
    rows_residual<false, true, false, false, false, 2>(C, nullptr, XN, nullptr, (const bf16*)(ws + B_F), AIN(I_FFNPOST), nullptr, (float*)(ws + WS_RSTD), nullptr, nullptr, nullptr, nullptr, nullptr, nullptr, ws + B_XN8);
    GRID_BAR();
    { pg8::Gemm g{(const bf16*)(ws + B_XN8), (const bf16*)(ws + W_PG), 512, 512, 512}; pg8::StaticOrder S; S.init(NTOK / 256, 4, C.G, C.bid);
      pg8::EpiPleGate E{(const bf16*)(ws + B_E0), (bf16*)(ws + B_E), 1024, nullptr}; pg8::gemm_phase<pg8::EpiPleGate, pg8::StaticOrder, false, true>(lds, g, S, E, 0, 0, pg8::ISC8, pg8::ISC8); }
    GRID_BAR();
    rows_residual<false, true, false, false, false, 2>(C, nullptr, XN, nullptr, (const bf16*)(ws + B_E), AIN(I_PLEPOST), nullptr, (float*)(ws + WS_RSTD), nullptr, nullptr, nullptr, nullptr, nullptr, nullptr, ws + B_XN8);
    GRID_BAR();

    { pg8::Gemm g{(const bf16*)(ws + B_XN8), (const bf16*)(ws + W_QKV1), 512, 512, 512}; pg8::StaticOrder S; S.init(NTOK / 256, 18, C.G, C.bid);
      pg8::EpiQKV1 E{(bf16*)(ws + B_QKV), tabp, nullptr}; pg8::gemm_phase<pg8::EpiQKV1, pg8::StaticOrder, false, true>(lds, g, S, E, 0, 0, pg8::ISC8, pg8::ISC8); }
    GRID_BAR();
    __syncthreads();
    { bf16x8 qA[4], qB[4];
      if (pb < 3072) { att::dil_issue(lds, pb, (const bf16*)(ws + B_QKV)); att::dil_qload(pb, (const bf16*)(ws + B_QKV), qA); }
      for (int u = pb; u < 3072; u += 2 * C.G) {
        { const int grp = u >> 10;
          att::dil_unit(lds, u, (u + C.G < 3072) ? u + C.G : -1, (const bf16*)(ws + B_QKV), (bf16*)(ws + B_OG) + (size_t)grp * NTOK * 512, (float*)(ws + WS_LSE) + (size_t)grp * NTOK * 8, qA, qB); }
        if (u + C.G < 3072) { const int u2 = u + C.G, grp = u2 >> 10;
          att::dil_unit(lds, u2, (u2 + C.G < 3072) ? u2 + C.G : -1, (const bf16*)(ws + B_QKV), (bf16*)(ws + B_OG) + (size_t)grp * NTOK * 512, (float*)(ws + WS_LSE) + (size_t)grp * NTOK * 8, qB, qA); }
      } }
    asm volatile("s_waitcnt vmcnt(0) lgkmcnt(0)\n\ts_barrier" ::: "memory");
    GRID_BAR();
    rows_merge(C, (const bf16*)(ws + B_OG), (const float*)(ws + WS_LSE), (bf16*)(ws + B_O1));
    {
        LAS float* scr = (LAS float*)(lds + C.wave * 16384);
        const int lane = fresh_tid() & 63;
        for (int it = gw; it < 3 * 8 * 1792; it += NGW) {
            const int kind = it / (8 * 1792), e = (it / 1792) & 7, r = it % 1792;
            if (kind == 0) transpose_item<1>(AIN(I_MWG) + (size_t)e * 1024 * DFF, 1024, DFF, ws + B_WGU + (size_t)e * 7168 * 1024, 1024, 0, 1, scr, r, lane, AIN(I_FFNPRE) + DM, 64.f * LOG2E);
            else if (kind == 1) transpose_item<1>(AIN(I_MWU) + (size_t)e * 1024 * DFF, 1024, DFF, ws + B_WGU + (size_t)e * 7168 * 1024, 1024, 0, 2, scr, r, lane, AIN(I_FFNPRE) + DM, 64.f / LOG2E);
            else transpose_item<1>(AIN(I_MWD) + (size_t)e * DFF * 1024, DFF, 1024, ws + B_WD + (size_t)e * 1024 * DFF, DFF, 0, 0, scr, r, lane);
        }
    }
    GRID_BAR();
    { pg8::Gemm g{(const bf16*)(ws + B_O1), (const bf16*)(ws + W_OUT1), 512, 512, 512}; pg8::StaticOrder S; S.init(NTOK / 256, 4, C.G, C.bid);
      pg8::EpiStore E{(bf16*)(ws + B_MO1), 1024, 1.0f, nullptr}; pg8::gemm_phase(lds, g, S, E); }
    GRID_BAR();
    rows_residual<false, true, true, false, false>(C, nullptr, XN, nullptr, (const bf16*)(ws + B_MO1), AIN(I_MIXPOST) + DM, AIN(I_FFNPRE) + DM, (float*)(ws + WS_RSTD), nullptr, nullptr, AIN(I_WR),
                                     (int*)(ws + WS_TOKE), (f32x2*)(ws + WS_TOKG), (int*)(ws + WS_CNT));
    GRID_BAR();
    moe_assign_gather(C, (const int*)(ws + WS_CNT), (const int*)(ws + WS_TOKE), (int*)(ws + WS_TOKS), (int*)(ws + WS_TILEE), XN, (const float*)(ws + WS_RSTD), ws + B_XS);
    GRID_BAR();
    int ntail = 0, tailrow0 = 0;
    {
        const int* tilee = (const int*)(ws + WS_TILEE);
        const int ntiles = __builtin_amdgcn_readfirstlane(tilee[0]);
        int tend[7];
#pragma unroll
        for (int j = 0; j < 7; ++j) tend[j] = __builtin_amdgcn_readfirstlane(tilee[1 + j]);
        for (int c = 0; c < 2; ++c) {
            const int tile0 = 128 * c; int ntl = ntiles - tile0; if (ntl <= 0) break; if (c == 0 && ntl > 128) ntl = 128;
            { pg8::Gemm g{(const bf16*)(ws + B_XS), (const bf16*)(ws + B_WGU), 512, 512, 512};
              pg8::MoeOrder S; S.so.init(ntl, 28, C.G, C.bid); for (int j = 0; j < 7; ++j) S.tend[j] = tend[j]; S.tile0 = tile0; S.nbt = 28; S.a_global = true;
              pg8::EpiSwiGLU8 E{ws + B_HC, DFF}; pg8::gemm_phase<pg8::EpiSwiGLU8, pg8::MoeOrder, true>(lds, g, S, E, 0x79797979, 0x7f7f7f7f, 1.f, 1.f, 0x7c7c7c7c); }
            GRID_BAR();
            const int ntm = (c == 1 && ntl >= 128 && ntl <= 135) ? 128 : ntl; ntail = ntl - ntm; tailrow0 = (tile0 + ntm) * 256;
            { pg8::Gemm g{(const bf16*)(ws + B_HC), (const bf16*)(ws + B_WD), DFF / 2, DFF / 2, DFF / 2};
              pg8::MoeOrder S; S.so.init(ntm, 4, C.G, C.bid); for (int j = 0; j < 7; ++j) S.tend[j] = tend[j]; S.tile0 = tile0; S.nbt = 4; S.a_global = false;
              pg8::EpiStore E{(bf16*)(ws + B_Y), 1024, 1.0f, nullptr}; pg8::gemm_phase<pg8::EpiStore, pg8::MoeOrder, true>(lds, g, S, E, 0x79797979, 0x7c7c7c7c); }
            for (int u = C.bid; u < ntail * 28; u += C.G) {
                const int sl = u % 7, t = u / 7, pn = t & 3, tm = t >> 2, tl = tile0 + ntm + tm; int e = 0;
#pragma unroll
                for (int j = 0; j < 7; ++j) e += (tl >= tend[j]) ? 1 : 0;
                pg8::Gemm g{(const bf16*)(ws + B_HC + sl * 512), (const bf16*)(ws + B_WD + sl * 512), DFF / 2, DFF / 2, 256};
                pg8::OneUnit S; S.u.pm = tm; S.u.pn = pn; S.u.pa = ntm + tm; S.u.pb = e * 4 + pn; S.has = true;
                pg8::EpiStore E{(bf16*)(ws + B_YP + sl * YP_STRIDE), 1024, 1.0f, nullptr}; pg8::gemm_phase<pg8::EpiStore, pg8::OneUnit, true>(lds, g, S, E, 0x79797979, 0x7c7c7c7c); }
            GRID_BAR();
        }
    }
    { const int gw = C.bid * NWAVES + C.wave, NGW = C.G * NWAVES, lane = fresh_tid() & 63;
      for (int r = gw; r < ntail * 256; r += NGW) {
          float a[16];
#pragma unroll
          for (int i = 0; i < 16; ++i) a[i] = 0.f;
#pragma unroll
          for (int sl = 0; sl < 7; ++sl) { const u32x4* src = (const u32x4*)(ws + B_YP + sl * YP_STRIDE + (size_t)r * 2048); const u32x4 v0 = src[lane], v1 = src[64 + lane];
              a[0] += __uint_as_float(v0.x << 16); a[1] += __uint_as_float(v0.x & 0xffff0000u); a[2] += __uint_as_float(v0.y << 16); a[3] += __uint_as_float(v0.y & 0xffff0000u);
              a[4] += __uint_as_float(v0.z << 16); a[5] += __uint_as_float(v0.z & 0xffff0000u); a[6] += __uint_as_float(v0.w << 16); a[7] += __uint_as_float(v0.w & 0xffff0000u);
              a[8] += __uint_as_float(v1.x << 16); a[9] += __uint_as_float(v1.x & 0xffff0000u); a[10] += __uint_as_float(v1.y << 16); a[11] += __uint_as_float(v1.y & 0xffff0000u);
              a[12] += __uint_as_float(v1.z << 16); a[13] += __uint_as_float(v1.z & 0xffff0000u); a[14] += __uint_as_float(v1.w << 16); a[15] += __uint_as_float(v1.w & 0xffff0000u); }
          u32x4 o0, o1; o0.x = pk2(a[0], a[1]); o0.y = pk2(a[2], a[3]); o0.z = pk2(a[4], a[5]); o0.w = pk2(a[6], a[7]); o1.x = pk2(a[8], a[9]); o1.y = pk2(a[10], a[11]); o1.z = pk2(a[12], a[13]); o1.w = pk2(a[14], a[15]);
          u32x4* dst = (u32x4*)(ws + B_Y + (size_t)(tailrow0 + r) * 2048); dst[lane] = o0; dst[64 + lane] = o1; } }
    { pg8::Gemm g{(const bf16*)(ws + WS_PB) + (size_t)NTOK * 256, (const bf16*)(ws + W_PP) + 1024 * 256, 256, 256, 256}; pg8::StaticOrder S; S.init(NTOK / 256, 4, C.G, C.bid);
      pg8::EpiStore E{(bf16*)(ws + B_E0b), 1024, 1.0f, nullptr}; pg8::gemm_phase(lds, g, S, E); }
    GRID_BAR();
    rows_residual<true, true, false, false, false, 1>(C, nullptr, XN, nullptr, (const bf16*)(ws + B_Y), AIN(I_FFNPOST) + DM, nullptr, (float*)(ws + WS_RSTD), (const int*)(ws + WS_TOKS), (const f32x2*)(ws + WS_TOKG),
                                     nullptr, nullptr, nullptr, nullptr, ws + B_XN8b);
    GRID_BAR();
    { pg8::Gemm g{(const bf16*)(ws + B_XN8b), (const bf16*)(ws + W_PG) + 1024 * 1024, 512, 512, 512}; pg8::StaticOrder S; S.init(NTOK / 256, 4, C.G, C.bid);
      pg8::EpiPleGate E{(const bf16*)(ws + B_E0b), (bf16*)(ws + B_Eb), 1024, nullptr}; pg8::gemm_phase<pg8::EpiPleGate, pg8::StaticOrder, true>(lds, g, S, E, 0x79797979, 0x7f7f7f7f); }
    GRID_BAR();
    rows_residual<false, false, false, false, true>(C, nullptr, XN, hres, (const bf16*)(ws + B_Eb), AIN(I_PLEPOST) + DM, nullptr, nullptr, nullptr, nullptr, nullptr, nullptr, nullptr, nullptr);
#undef TR
#undef GRID_BAR
#undef AIN
}

extern "C" void kernel_launch(void* const* d_in, const int* in_sizes, int n_in, void* d_out, int out_size, void* d_ws, size_t ws_size, hipStream_t stream) {
    static int grid = 0;
    if (grid == 0) {
        if (n_in != 27 || in_sizes[0] != NTOK * DM || out_size != NTOK * DM || ws_size < WS_END) { fprintf(stderr, "kernel_launch: unexpected shapes / workspace (%zu < %zu)\n", ws_size, (size_t)WS_END); grid = -1; return; }
        int dev = 0, cus = 0;
        if (hipGetDevice(&dev) != hipSuccess || hipDeviceGetAttribute(&cus, hipDeviceAttributeMultiprocessorCount, dev) != hipSuccess) { grid = -1; return; }
        if (hipFuncSetAttribute((const void*)fwd_kernel, hipFuncAttributeMaxDynamicSharedMemorySize, LDS_BYTES) != hipSuccess) { fprintf(stderr, "kernel_launch: hipFuncSetAttribute failed\n"); grid = -1; return; }
        int per_cu = 0;
        if (hipOccupancyMaxActiveBlocksPerMultiprocessor(&per_cu, (const void*)fwd_kernel, NTHREADS, LDS_BYTES) != hipSuccess || per_cu < 1) fprintf(stderr, "kernel_launch: occupancy query reports %d\n", per_cu);
        (void)hipGetLastError();
        if (cus != 256) { fprintf(stderr, "kernel_launch: built for 256 CUs, device has %d\n", cus); grid = -1; return; }
        grid = cus;
    }
    if (grid < 0) return;
    (void)hipMemsetAsync((char*)d_ws + WS_CTL, 0, CTL_ZERO_BYTES, stream);
    Args a{};
    for (int i = 0; i < 27; ++i) a.in[i] = (const float*)d_in[i];
    a.out = (float*)d_out; a.ws = (unsigned char*)d_ws;
    hipLaunchKernelGGL(fwd_kernel, dim3(grid), dim3(NTHREADS), LDS_BYTES, stream, a);
}
```
